# Optimizing an MI355X kernel written in HIP

```python
import jax, jax.numpy as jnp
from jax import lax
import numpy as np


D_MODEL = 1024
BATCH = 8
SEQ = 4096
DEPTH = 2

CTX_LEN = 256
GRID_W = 64
A_HEADS = 4
A_HEAD_DIM = 128
A_WIDTH = A_HEADS * A_HEAD_DIM
A_CHUNK = 64
B_GROUPS = 4
B_GROUP_DIM = 128
B_WIDTH = B_GROUPS * B_GROUP_DIM
C_GROUPS = 4
C_GROUP_DIM = 128
C_WIDTH = C_GROUPS * C_GROUP_DIM
SGU_CHUNK = 128
ROWS_PER_CHUNK = SGU_CHUNK // GRID_W
N_BRANCH = 3
A_IN = 4 * A_WIDTH
IN_COLS = A_IN + A_WIDTH + B_WIDTH + 2 * C_WIDTH + N_BRANCH * D_MODEL
N_EXPERTS = 16
D_EXPERT = 1024
CAPACITY_FACTOR = 2
EPS = 1e-6
LB_FLOOR = 1e-20

kernel_name = 'hybrid_hgrn2_fourier_sgu_ecmoe_diffusion_block'


def rmsnorm(x, w):
    xf = x.astype(jnp.float32)
    y = xf * lax.rsqrt(jnp.mean(xf * xf, axis=-1, keepdims=True) + EPS)
    return (y * w.astype(jnp.float32)).astype(x.dtype)


def adaln(cvec, w, b):
    return jnp.split(jax.nn.silu(cvec) @ w + b, 6, axis=-1)


def modulate(h, shift, scale):
    return h * (1.0 + scale) + shift


def log_forget(z, lb):
    zf = z.astype(jnp.float32)
    return jnp.logaddexp(jnp.log(jnp.maximum(lb, LB_FLOOR)), jnp.log1p(-lb) + jax.nn.log_sigmoid(zf))


def hgrn_scan(q, v, log_f, s0):
    bsz, t_len, heads, _ = q.shape
    n_chunks = t_len // A_CHUNK

    def to_chunks(a):
        a = a.astype(jnp.float32).reshape(bsz, n_chunks, A_CHUNK, heads, a.shape[-1])
        return a.transpose(1, 0, 3, 2, 4)

    tri = jnp.tril(jnp.ones((A_CHUNK, A_CHUNK), dtype=bool))[:, :, None]

    def step(state, inp):
        qc, vc, lfc = inp
        kc = -jnp.expm1(lfc)
        b = jnp.cumsum(lfc, axis=2)
        o_inter = jnp.einsum('bhtk,bhkv->bhtv', qc * jnp.exp(b), state)
        diff = b[:, :, :, None, :] - b[:, :, None, :, :]
        decay = jnp.where(tri, jnp.exp(jnp.where(tri, diff, 0.0)), 0.0)
        scores = jnp.einsum('bhtk,bhsk,bhtsk->bhts', qc, kc, decay)
        o_intra = jnp.einsum('bhts,bhsv->bhtv', scores, vc)
        b_end = b[:, :, -1:, :]
        new_state = jnp.exp(b_end)[:, :, 0, :, None] * state + jnp.einsum('bhsk,bhsv->bhkv', kc * jnp.exp(b_end - b), vc)
        return new_state, o_inter + o_intra

    final_state, o = lax.scan(step, s0, (to_chunks(q), to_chunks(v), to_chunks(log_f)))
    o = o.transpose(1, 0, 3, 2, 4).reshape(bsz, t_len, heads, -1)
    return o, final_state


def hgrn_scan_inputs(z_a, lb_f, lb_b):
    bsz, t_len, _ = z_a.shape
    q, ff, fb, i = jnp.split(z_a, 4, axis=-1)
    heads = lambda a: a.reshape(bsz, t_len, A_HEADS, A_HEAD_DIM)
    return heads(jax.nn.silu(q)), log_forget(heads(ff), lb_f), log_forget(heads(fb), lb_b), heads(i)


def hgrn_bidir(q, lf_f, lf_b, v, s0_f, s0_b):
    flip = lambda a: jnp.flip(a, axis=1)
    o_f, s_f = hgrn_scan(q, v, lf_f, s0_f)
    o_b, s_b = hgrn_scan(flip(q), flip(v), flip(lf_b), s0_b)
    return o_f + flip(o_b), s_f, s_b


def fourier_mix(z):
    bsz, t_len, _ = z.shape
    zg = z.astype(jnp.float32).reshape(bsz, t_len, B_GROUPS, B_GROUP_DIM)
    out = jnp.fft.fft2(zg, axes=(1, 3), norm='ortho').real
    return out.reshape(bsz, t_len, B_WIDTH).astype(z.dtype)


def spatial_gate(u, v, w_s, b_s, norm_w, n_chunks):
    bsz, t_len, _ = u.shape
    u = jax.nn.gelu(u, approximate=False)
    v = rmsnorm(jax.nn.gelu(v, approximate=False).reshape(bsz, t_len, C_GROUPS, C_GROUP_DIM), norm_w)
    vc = v.reshape(bsz, n_chunks, SGU_CHUNK, C_GROUPS, C_GROUP_DIM)
    mixed = jnp.einsum('gpq,bnqgd->bnpgd', w_s, vc) + b_s.T[None, None, :, :, None]
    return u * mixed.reshape(bsz, t_len, C_WIDTH)


def token_mix(h, s0_f, s0_b, n_chunks, w_in, lb_f, lb_b, gnorm_w, sgu_w, sgu_b, sgu_norm_w, w_branch, w_out):
    bsz, t_len, _ = h.shape
    z = h @ w_in
    splits = np.cumsum([A_IN, A_WIDTH, B_WIDTH, C_WIDTH, C_WIDTH]).tolist()
    z_a, g_a, z_b, u, v, gates = jnp.split(z, splits, axis=-1)
    q, lf_f, lf_b, vv = hgrn_scan_inputs(z_a, lb_f, lb_b)
    o_a, s_f, s_b = hgrn_bidir(q, lf_f, lf_b, vv, s0_f, s0_b)
    o_a = rmsnorm(o_a, gnorm_w).reshape(bsz, t_len, A_WIDTH).astype(h.dtype) * jax.nn.silu(g_a)
    o_b = fourier_mix(z_b)
    o_c = spatial_gate(u, v, sgu_w, sgu_b, sgu_norm_w, n_chunks)
    g = jax.nn.sigmoid(gates).reshape(bsz, t_len, N_BRANCH, D_MODEL)
    merged = g[:, :, 0] * (o_a @ w_branch[0]) + g[:, :, 1] * (o_b @ w_branch[1]) + g[:, :, 2] * (o_c @ w_branch[2])
    return merged @ w_out, s_f, s_b


def context_states(h, w_in, lb_f, lb_b, s0):
    q, lf_f, lf_b, vv = hgrn_scan_inputs(h @ w_in[:, :A_IN], lb_f, lb_b)
    _, s_f, s_b = hgrn_bidir(q, lf_f, lf_b, vv, s0, s0)
    return s_f, s_b


def expert_choice_moe(h, router_w, w13, w2):
    bsz, t_len, d = h.shape
    cap = CAPACITY_FACTOR * t_len // N_EXPERTS
    affinity = jax.nn.softmax((h @ router_w).astype(jnp.float32), axis=-1)
    gate, idx = lax.top_k(affinity.transpose(0, 2, 1), cap)
    xe = jax.vmap(lambda hb, ib: hb[ib])(h, idx)
    a, b = jnp.split(jnp.einsum('becd,edf->becf', xe, w13), 2, axis=-1)
    y = jnp.einsum('becf,efd->becd', jax.nn.silu(a) * b, w2) * gate[..., None].astype(h.dtype)
    return jax.vmap(lambda ib, yb: jnp.zeros((t_len, d), yb.dtype).at[ib.reshape(-1)].add(yb.reshape(-1, d)))(idx, y)


def setup_inputs(seed: int = 0) -> dict:
    key = jax.random.key(seed)
    ks = jax.random.split(key, 18)
    nrm = lambda k, shape, s: jax.random.normal(k, shape, jnp.float32) * s
    return {
        'x': nrm(ks[0], (BATCH, SEQ, D_MODEL), 1.0),
        'c': nrm(ks[1], (BATCH, D_MODEL), 1.0),
        'ctx': nrm(ks[2], (BATCH, CTX_LEN, D_MODEL), 1.0),
        'c_ctx': nrm(ks[3], (D_MODEL,), 1.0),
        'ada_w': nrm(ks[4], (DEPTH, D_MODEL, 6 * D_MODEL), 0.5 * D_MODEL ** -0.5),
        'ada_b': nrm(ks[5], (DEPTH, 6 * D_MODEL), 0.02),
        'norm_w': 1.0 + nrm(ks[6], (DEPTH, 4, D_MODEL), 0.05),
        'w_in': nrm(ks[7], (DEPTH, D_MODEL, IN_COLS), D_MODEL ** -0.5),
        'hgrn_lb_raw': nrm(ks[8], (2, DEPTH, A_WIDTH), 0.5),
        'hgrn_gnorm_w': 1.0 + nrm(ks[9], (DEPTH, A_HEAD_DIM), 0.05),
        'sgu_w': nrm(ks[10], (DEPTH, C_GROUPS, SGU_CHUNK, SGU_CHUNK), SGU_CHUNK ** -0.5),
        'sgu_b': 1.0 + nrm(ks[11], (DEPTH, C_GROUPS, SGU_CHUNK), 0.05),
        'sgu_norm_w': 1.0 + nrm(ks[12], (DEPTH, C_GROUPS, C_GROUP_DIM), 0.05),
        'w_branch': nrm(ks[13], (DEPTH, N_BRANCH, A_WIDTH, D_MODEL), A_WIDTH ** -0.5),
        'w_out': nrm(ks[14], (DEPTH, D_MODEL, D_MODEL), D_MODEL ** -0.5),
        'router_w': nrm(ks[15], (DEPTH, D_MODEL, N_EXPERTS), D_MODEL ** -0.5),
        'exp_w13': nrm(ks[16], (DEPTH, N_EXPERTS, D_MODEL, 2 * D_EXPERT), D_MODEL ** -0.5),
        'exp_w2': nrm(ks[17], (DEPTH, N_EXPERTS, D_EXPERT, D_MODEL), D_EXPERT ** -0.5),
    }


def reference(x, c, ctx, c_ctx, ada_w, ada_b, norm_w, w_in, hgrn_lb_raw, hgrn_gnorm_w, sgu_w, sgu_b, sgu_norm_w, w_branch, w_out, router_w, exp_w13, exp_w2):
    rows = x.shape[1] // GRID_W
    lat_chunks = rows // ROWS_PER_CHUNK
    ctx_chunks = ctx.shape[1] // SGU_CHUNK
    p = jax.nn.softmax(hgrn_lb_raw.astype(jnp.float32), axis=1)
    lower_bounds = jnp.cumsum(p, axis=1) - p[:, :1]
    zero_state = jnp.zeros((x.shape[0], A_HEADS, A_HEAD_DIM, A_HEAD_DIM), jnp.float32)
    for l in range(DEPTH):
        last = l == DEPTH - 1
        lb_f = lower_bounds[0, l].reshape(A_HEADS, A_HEAD_DIM)
        lb_b = lower_bounds[1, l].reshape(A_HEADS, A_HEAD_DIM)
        sh1, sc1, g1, sh2, sc2, g2 = adaln(c[:, None, :], ada_w[l], ada_b[l])
        csh1, csc1, cg1, csh2, csc2, cg2 = adaln(c_ctx[None, None, :], ada_w[l], ada_b[l])
        mix_params = (w_in[l], lb_f, lb_b, hgrn_gnorm_w[l], sgu_w[l], sgu_b[l], sgu_norm_w[l], w_branch[l], w_out[l])
        h_ctx = modulate(rmsnorm(ctx, norm_w[l, 0]), csh1, csc1)
        h_lat = modulate(rmsnorm(x, norm_w[l, 0]), sh1, sc1)
        if last:
            s_f, s_b = context_states(h_ctx, w_in[l], lb_f, lb_b, zero_state)
        else:
            y_ctx, s_f, s_b = token_mix(h_ctx, zero_state, zero_state, ctx_chunks, *mix_params)
            ctx_mid = ctx + cg1 * rmsnorm(y_ctx, norm_w[l, 1])
        y_lat, _, _ = token_mix(h_lat, s_f, s_b, lat_chunks, *mix_params)
        x = x + g1 * rmsnorm(y_lat, norm_w[l, 1])
        m_lat = expert_choice_moe(modulate(rmsnorm(x, norm_w[l, 2]), sh2, sc2), router_w[l], exp_w13[l], exp_w2[l])
        x = x + g2 * rmsnorm(m_lat, norm_w[l, 3])
        if not last:
            m_ctx = expert_choice_moe(modulate(rmsnorm(ctx_mid, norm_w[l, 2]), csh2, csc2), router_w[l], exp_w13[l], exp_w2[l])
            ctx = ctx_mid + cg2 * rmsnorm(m_ctx, norm_w[l, 3])
    return x
```

```cpp
#include <hip/hip_runtime.h>
#include <hip/hip_cooperative_groups.h>
#include <cstdio>
#include <cstdint>
namespace cg = cooperative_groups;

#ifndef COOP
#define COOP 0
#endif

typedef unsigned short bf16_t;
typedef short bf16x8 __attribute__((ext_vector_type(8)));
typedef float f32x4 __attribute__((ext_vector_type(4)));
typedef unsigned u32x4 __attribute__((ext_vector_type(4)));
typedef unsigned u32x2 __attribute__((ext_vector_type(2)));

constexpr int D = 1024, NB = 8, TL = 4096, TCX = 256;
constexpr int NL = NB * TL, NC = NB * TCX, NT = NL + NC;
constexpr int INC = 7168;
constexpr int NSLOT_L = 16 * 8 * 512, NSLOT_C = 16 * 8 * 32, NSLOT = NSLOT_L + NSLOT_C;
constexpr int NTHREADS = 256;
constexpr int LDS_BYTES = 65536;
constexpr int LDS_TOTAL = LDS_BYTES;

constexpr size_t al(size_t x) { return (x + 255) & ~(size_t)255; }
constexpr size_t O_WIN = 0;
constexpr size_t O_WBR = O_WIN + al((size_t)INC * D * 2);
constexpr size_t O_WOUT = O_WBR + al((size_t)3 * D * 512 * 2);
constexpr size_t O_W13 = O_WOUT + al((size_t)D * D * 2);
constexpr size_t O_W2 = O_W13 + al((size_t)16 * 2048 * D * 2);
constexpr size_t O_FTL = O_W2 + al((size_t)16 * D * D * 2);
constexpr size_t O_FTC = O_FTL + al((size_t)4096 * 8192 * 2);
constexpr size_t O_CS = O_FTC + al((size_t)256 * 512 * 2);
constexpr size_t O_MOD = O_CS + al((size_t)256 * 128 * 2);
constexpr size_t O_LB = O_MOD + al((size_t)2 * 9 * 6144 * 4);
constexpr size_t O_CNT = O_LB + al((size_t)2 * 2 * 512 * 4);
constexpr size_t O_H = O_CNT + 256;
constexpr size_t O_Y = O_H + al((size_t)NT * D * 2);
constexpr size_t O_CTXB = O_Y + al((size_t)NT * D * 2);
constexpr size_t O_AFF = O_CTXB + al((size_t)NC * D * 4);
constexpr size_t O_SEL = O_AFF + al((size_t)NT * 16 * 4);
constexpr size_t O_IDX = O_SEL + al((size_t)NT * 16 * 4);
constexpr size_t O_GATE = O_IDX + al((size_t)NSLOT * 4);
constexpr size_t O_Z = O_GATE + al((size_t)NSLOT * 4);
constexpr size_t SZ512 = al((size_t)NT * 512 * 2);
constexpr size_t O_Q = O_Z, O_LFF = O_Q + SZ512, O_LFB = O_LFF + SZ512, O_I = O_LFB + SZ512, O_GA = O_I + SZ512,
                 O_U = O_GA + SZ512, O_ZB = O_U + SZ512, O_VT = O_ZB + SZ512, O_OF = O_VT + SZ512, O_OBK = O_OF + SZ512;
constexpr size_t O_G = O_OBK + SZ512;
constexpr size_t O_ZCL = O_G + al((size_t)NT * 3072 * 2);
constexpr size_t O_ZCC = O_ZCL + al((size_t)8 * 512 * 8192 * 2);
constexpr size_t O_ZEND = O_ZCC + al((size_t)8 * 512 * 512 * 2);
constexpr size_t O_AB = O_Z;
constexpr size_t O_YS = O_AB + al((size_t)NSLOT * 2048 * 2);
static_assert(O_YS + (size_t)NSLOT * 1024 * 2 <= O_ZEND, "moe arena");
constexpr size_t WS_NEED = O_ZEND;

struct Params {
  const float *x, *c, *ctx, *c_ctx, *ada_w, *ada_b, *norm_w, *w_in, *lb_raw, *gnorm_w, *sgu_w, *sgu_b, *sgu_norm_w, *w_branch, *w_out,
      *router_w, *w13, *w2;
  float* out;
  char* ws;
};

typedef __bf16 bf16v2_t __attribute__((ext_vector_type(2)));
typedef float f32x2_t __attribute__((ext_vector_type(2)));
__device__ __forceinline__ unsigned pk_bf16(float lo, float hi) {
  const f32x2_t v = {lo, hi};
  const bf16v2_t r = __builtin_convertvector(v, bf16v2_t);
  return __builtin_bit_cast(unsigned, r);
}
__device__ __forceinline__ bf16_t f2bf(float x) { return (bf16_t)(pk_bf16(x, 0.f) & 0xffffu); }
__device__ __forceinline__ float bf2f(bf16_t v) { return __uint_as_float(((unsigned)v) << 16); }
__device__ __forceinline__ float bflo(unsigned w) { return __uint_as_float(w << 16); }
__device__ __forceinline__ float bfhi(unsigned w) { return __uint_as_float(w & 0xffff0000u); }
__device__ __forceinline__ void st4bf(bf16_t* p, f32x4 v) {
  u32x2 w;
  w.x = pk_bf16(v[0], v[1]);
  w.y = pk_bf16(v[2], v[3]);
  *(u32x2*)p = w;
}
__device__ __forceinline__ float sigmoidf_(float x) { return 1.0f / (1.0f + __expf(-x)); }
__device__ __forceinline__ float siluf_(float x) { return x / (1.0f + __expf(-x)); }
__device__ __forceinline__ float geluf_(float x) { return 0.5f * x * (1.0f + erff(x * 0.70710678118f)); }
__device__ __forceinline__ float wave_sum(float v) {
#pragma unroll
  for (int o = 32; o > 0; o >>= 1) v += __shfl_xor(v, o);
  return v;
}

template <class LA, class LB>
__device__ __forceinline__ void gemm_main(f32x4 (&acc)[4][4], const int nk, const LA& la, const LB& lb, char* lds) {
  const int tid = threadIdx.x, lane = tid & 63, wid = tid >> 6, fr = lane & 15, fq = lane >> 4, wr = wid >> 1, wc = wid & 1;
  const int sr = tid >> 3, sc = tid & 7;
  const int wofs = sr * 128 + ((sc ^ (sr & 7)) << 4);
  const int aofs = (wr * 64 + fr) * 128, bofs = 16384 + (wc * 64 + fr) * 128;
  const int x0 = ((fq) ^ (fr & 7)) << 4, x1 = ((4 + fq) ^ (fr & 7)) << 4;
  bf16x8 ra[4], rb[4];
#pragma unroll
  for (int i = 0; i < 4; ++i) {
    ra[i] = la(i, 0);
    rb[i] = lb(i, 0);
  }
#pragma unroll
  for (int i = 0; i < 4; ++i) {
    *(bf16x8*)(lds + wofs + i * 4096) = ra[i];
    *(bf16x8*)(lds + 16384 + wofs + i * 4096) = rb[i];
  }
  __syncthreads();
  for (int kt = 0; kt < nk; ++kt) {
    const char* cur = lds + (kt & 1) * 32768;
    const bool more = kt + 1 < nk;
    if (more) {
#pragma unroll
      for (int i = 0; i < 4; ++i) {
        ra[i] = la(i, (kt + 1) * 64);
        rb[i] = lb(i, (kt + 1) * 64);
      }
    }
#pragma unroll
    for (int kk = 0; kk < 2; ++kk) {
      const int xo = kk ? x1 : x0;
      bf16x8 af[4], bv[4];
#pragma unroll
      for (int m = 0; m < 4; ++m) af[m] = *(const bf16x8*)(cur + aofs + m * 2048 + xo);
#pragma unroll
      for (int n = 0; n < 4; ++n) bv[n] = *(const bf16x8*)(cur + bofs + n * 2048 + xo);
#pragma unroll
      for (int m = 0; m < 4; ++m)
#pragma unroll
        for (int n = 0; n < 4; ++n) acc[m][n] = __builtin_amdgcn_mfma_f32_16x16x32_bf16(bv[n], af[m], acc[m][n], 0, 0, 0);
    }
    if (more) {
      char* nxt = lds + ((kt + 1) & 1) * 32768;
#pragma unroll
      for (int i = 0; i < 4; ++i) {
        *(bf16x8*)(nxt + wofs + i * 4096) = ra[i];
        *(bf16x8*)(nxt + 16384 + wofs + i * 4096) = rb[i];
      }
    }
    __syncthreads();
  }
}
__device__ __forceinline__ void zero_acc(f32x4 (&acc)[4][4]) {
#pragma unroll
  for (int m = 0; m < 4; ++m)
#pragma unroll
    for (int n = 0; n < 4; ++n) acc[m][n] = (f32x4){0.f, 0.f, 0.f, 0.f};
}
template <class EP>
__device__ __forceinline__ void gemm_epi(const f32x4 (&acc)[4][4], const EP& ep) {
  const int tid = threadIdx.x, lane = tid & 63, wid = tid >> 6, fr = lane & 15, fq = lane >> 4, wr = wid >> 1, wc = wid & 1;
#pragma unroll
  for (int m = 0; m < 4; ++m)
#pragma unroll
    for (int n = 0; n < 4; ++n) ep(wr * 64 + m * 16 + fr, wc * 64 + n * 16 + fq * 4, acc[m][n]);
}
struct RowLd {
  const bf16_t* p[4];
  __device__ __forceinline__ RowLd(const bf16_t* base, size_t r0, size_t ld) {
    const int tid = threadIdx.x;
#pragma unroll
    for (int i = 0; i < 4; ++i) p[i] = base + (r0 + (tid >> 3) + 32 * i) * ld + (tid & 7) * 8;
  }
  __device__ __forceinline__ bf16x8 operator()(int i, int k0) const { return *(const bf16x8*)(p[i] + k0); }
};

__device__ void build_costab(float* tab) {
  for (int j = threadIdx.x; j < 4096; j += NTHREADS) tab[j] = cospif((float)j * (1.0f / 2048.0f));
  __syncthreads();
}
__device__ void phase_setup(const Params& p, char* lds) {
  float* tab = (float*)lds;
  float* sv = (float*)(lds + 16384);
  const int tid = threadIdx.x;
  float* mod = (float*)(p.ws + O_MOD);
  bf16_t* FTL = (bf16_t*)(p.ws + O_FTL);
  bool have_tab = false;
  const int NITEM = 48 + 4096 + 1;
  for (int item = blockIdx.x; item < NITEM; item += gridDim.x) {
    if (item < 48) {
      const int l = item / 24, n = (item % 24) * 256 + tid;
      for (int e = tid; e < 9 * 1024; e += NTHREADS) {
        const int r = e >> 10, k = e & 1023;
        const float v = r < 8 ? p.c[r * 1024 + k] : p.c_ctx[k];
        sv[e] = siluf_(v);
      }
      __syncthreads();
      float acc[9];
#pragma unroll
      for (int r = 0; r < 9; ++r) acc[r] = 0.f;
      const float* w = p.ada_w + (size_t)l * 1024 * 6144 + n;
#pragma unroll 4
      for (int k = 0; k < 1024; ++k) {
        const float wv = w[(size_t)k * 6144];
#pragma unroll
        for (int r = 0; r < 9; ++r) acc[r] += sv[r * 1024 + k] * wv;
      }
      const float bv = p.ada_b[l * 6144 + n];
#pragma unroll
      for (int r = 0; r < 9; ++r) mod[(l * 9 + r) * 6144 + n] = acc[r] + bv;
      __syncthreads();
    } else {
      if (!have_tab) {
        build_costab(tab);
        have_tab = true;
      }
      if (item < 48 + 4096) {
        const int k = item - 48;
        const float scale = 0.0013810679320049757f;
        for (int e8 = tid; e8 < 1024; e8 += NTHREADS) {
          float v[8];
#pragma unroll
          for (int j = 0; j < 8; ++j) {
            const int e = e8 * 8 + j, t = e & 4095, cs = e >> 12;
            const int jj = (k * t) & 4095;
            v[j] = (cs == 0 ? tab[jj] : -tab[(jj - 1024) & 4095]) * scale;
          }
          u32x4 w;
          w.x = pk_bf16(v[0], v[1]);
          w.y = pk_bf16(v[2], v[3]);
          w.z = pk_bf16(v[4], v[5]);
          w.w = pk_bf16(v[6], v[7]);
          *(u32x4*)(FTL + (size_t)k * 8192 + e8 * 8) = w;
        }
      } else {
        bf16_t* FTC = (bf16_t*)(p.ws + O_FTC);
        bf16_t* CS = (bf16_t*)(p.ws + O_CS);
        const float scale_c = 0.005524271728019903f;
        for (int e = tid; e < 256 * 512; e += NTHREADS) {
          const int k = e >> 9, cs = (e >> 8) & 1, t = e & 255;
          const int jj = ((k * t) & 255) * 16;
          FTC[e] = f2bf((cs == 0 ? tab[jj] : -tab[(jj - 1024) & 4095]) * scale_c);
        }
        for (int e = tid; e < 256 * 128; e += NTHREADS) {
          const int row = e >> 7, d = e & 127, cs = row >> 7, m = row & 127;
          const int jj = ((m * d) & 127) * 32;
          CS[e] = f2bf(cs == 0 ? tab[jj] : tab[(jj - 1024) & 4095]);
        }
        float* lb = (float*)(p.ws + O_LB);
        for (int e = tid; e < 2 * 512; e += NTHREADS) {
          const int dir = e >> 9, ch = e & 511;
          const float r0 = p.lb_raw[(dir * 2 + 0) * 512 + ch], r1 = p.lb_raw[(dir * 2 + 1) * 512 + ch];
          const float mx = fmaxf(r0, r1), e0 = expf(r0 - mx), e1 = expf(r1 - mx);
          const float p0 = e0 / (e0 + e1), p1 = e1 / (e0 + e1);
          lb[(dir * 2 + 0) * 512 + ch] = p0 - p0;
          lb[(dir * 2 + 1) * 512 + ch] = (p0 + p1) - p0;
        }
        if (tid < 64) ((unsigned*)(p.ws + O_CNT))[tid] = 0u;
      }
    }
  }
}

__device__ void conv_tile(const float* src, int N, bf16_t* dst, int K, int k0, int n0, float* tile) {
  const int tid = threadIdx.x;
#pragma unroll
  for (int i = 0; i < 16; ++i) {
    const int kk = i * 4 + (tid >> 6), nn = tid & 63;
    tile[nn * 65 + kk] = src[(size_t)(k0 + kk) * N + n0 + nn];
  }
  __syncthreads();
#pragma unroll
  for (int i = 0; i < 2; ++i) {
    const int q = tid + i * 256, nn = q >> 3, kc = (q & 7) * 8;
    const float* t = tile + nn * 65 + kc;
    u32x4 w;
    w.x = pk_bf16(t[0], t[1]);
    w.y = pk_bf16(t[2], t[3]);
    w.z = pk_bf16(t[4], t[5]);
    w.w = pk_bf16(t[6], t[7]);
    *(u32x4*)(dst + (size_t)(n0 + nn) * K + k0 + kc) = w;
  }
  __syncthreads();
}
__device__ void phase_conv(const Params& p, int l, char* lds) {
  float* tile = (float*)lds;
  const int NITEM = 1792 + 384 + 256 + 8192 + 4096;
  for (int item = blockIdx.x; item < NITEM; item += gridDim.x) {
    int i = item;
    const float* src;
    bf16_t* dst;
    int K, N;
    if (i < 1792) {
      src = p.w_in + (size_t)l * 1024 * INC; dst = (bf16_t*)(p.ws + O_WIN); K = 1024; N = INC;
    } else if ((i -= 1792) < 384) {
      const int j = i / 128; i -= j * 128;
      src = p.w_branch + ((size_t)l * 3 + j) * 512 * 1024; dst = (bf16_t*)(p.ws + O_WBR) + (size_t)j * 1024 * 512; K = 512; N = 1024;
    } else if ((i -= 384) < 256) {
      src = p.w_out + (size_t)l * 1024 * 1024; dst = (bf16_t*)(p.ws + O_WOUT); K = 1024; N = 1024;
    } else if ((i -= 256) < 8192) {
      const int e = i / 512; i -= e * 512;
      src = p.w13 + ((size_t)l * 16 + e) * 1024 * 2048; dst = (bf16_t*)(p.ws + O_W13) + (size_t)e * 2048 * 1024; K = 1024; N = 2048;
    } else {
      i -= 8192;
      const int e = i / 256; i -= e * 256;
      src = p.w2 + ((size_t)l * 16 + e) * 1024 * 1024; dst = (bf16_t*)(p.ws + O_W2) + (size_t)e * 1024 * 1024; K = 1024; N = 1024;
    }
    const int nkt = K / 64;
    const int nt = i / nkt, kt = i % nkt;
    conv_tile(src, N, dst, K, kt * 64, nt * 64, tile);
  }
}

__device__ void phase_rowA(const Params& p, int l) {
  const int tid = threadIdx.x, wid = tid >> 6, lane = tid & 63;
  const float* xlat = l == 0 ? p.x : p.out;
  const float* xctx = l == 0 ? p.ctx : (const float*)(p.ws + O_CTXB);
  const float* mod = (const float*)(p.ws + O_MOD);
  bf16_t* H = (bf16_t*)(p.ws + O_H);
  const float* nw = p.norm_w + (size_t)(l * 4 + 0) * 1024;
  for (int row = blockIdx.x * 4 + wid; row < NT; row += gridDim.x * 4) {
    const float* xr = row < NL ? xlat + (size_t)row * 1024 : xctx + (size_t)(row - NL) * 1024;
    const int mr = row < NL ? (row >> 12) : 8;
    const float* md = mod + (size_t)(l * 9 + mr) * 6144;
    f32x4 v[4];
    float ss = 0.f;
#pragma unroll
    for (int i = 0; i < 4; ++i) {
      v[i] = *(const f32x4*)(xr + i * 256 + lane * 4);
      ss += v[i][0] * v[i][0] + v[i][1] * v[i][1] + v[i][2] * v[i][2] + v[i][3] * v[i][3];
    }
    ss = wave_sum(ss);
    const float rs = rsqrtf(ss * (1.0f / 1024.0f) + 1e-6f);
#pragma unroll
    for (int i = 0; i < 4; ++i) {
      const int e = i * 256 + lane * 4;
      const f32x4 w = *(const f32x4*)(nw + e), sh = *(const f32x4*)(md + e), sc = *(const f32x4*)(md + 1024 + e);
      f32x4 o;
#pragma unroll
      for (int j = 0; j < 4; ++j) o[j] = v[i][j] * rs * w[j] * (1.0f + sc[j]) + sh[j];
      st4bf(H + (size_t)row * 1024 + e, o);
    }
  }
}

__device__ void phase_gin(const Params& p, int l, char* lds) {
  const bool last = (l == 1);
  const bf16_t* H = (const bf16_t*)(p.ws + O_H);
  const bf16_t* W = (const bf16_t*)(p.ws + O_WIN);
  const float* lbp = (const float*)(p.ws + O_LB);
  const int NTILE = 272 * 56;
  for (int t = blockIdx.x; t < NTILE; t += gridDim.x) {
    const int mt = t / 56, nt = t % 56;
    if (last && mt >= 256 && nt >= 16) continue;
    const int m0 = mt * 128, n0 = nt * 128, sec = n0 >> 9, cin = n0 & 511;
    f32x4 acc[4][4];
    zero_acc(acc);
    if (sec == 7) {
      RowLd la(W, n0, 1024), lb(H, m0, 1024);
      gemm_main(acc, 16, la, lb, lds);
      bf16_t* VT = (bf16_t*)(p.ws + O_VT) + ((size_t)mt * 4 + (cin >> 7)) * 128 * 128;
      gemm_epi(acc, [&](int r, int c, f32x4 v) {
        f32x4 o;
#pragma unroll
        for (int j = 0; j < 4; ++j) o[j] = geluf_(v[j]);
        st4bf(VT + r * 128 + c, o);
      });
    } else {
      RowLd la(H, m0, 1024), lb(W, n0, 1024);
      gemm_main(acc, 16, la, lb, lds);
      if (sec >= 8) {
        bf16_t* G = (bf16_t*)(p.ws + O_G);
        const int gc = n0 - 4096;
        gemm_epi(acc, [&](int r, int c, f32x4 v) {
          f32x4 o;
#pragma unroll
          for (int j = 0; j < 4; ++j) o[j] = sigmoidf_(v[j]);
          st4bf(G + (size_t)(m0 + r) * 3072 + gc + c, o);
        });
      } else if (sec == 1 || sec == 2) {
        bf16_t* LF = (bf16_t*)(p.ws + (sec == 1 ? O_LFF : O_LFB));
        const float* lbv = lbp + ((sec - 1) * 2 + l) * 512 + cin;
        gemm_epi(acc, [&](int r, int c, f32x4 v) {
          const f32x4 b4 = *(const f32x4*)(lbv + c);
          f32x4 o;
#pragma unroll
          for (int j = 0; j < 4; ++j) {
            const float f = fmaxf(b4[j], 1e-20f) + (1.0f - b4[j]) * sigmoidf_(v[j]);
            o[j] = __logf(f);
          }
          st4bf(LF + (size_t)(m0 + r) * 512 + cin + c, o);
        });
      } else {
        const size_t off = sec == 0 ? O_Q : sec == 3 ? O_I : sec == 4 ? O_GA : sec == 5 ? O_ZB : O_U;
        bf16_t* dst = (bf16_t*)(p.ws + off);
        const int act = (sec == 0 || sec == 4) ? 1 : (sec == 6 ? 2 : 0);
        gemm_epi(acc, [&](int r, int c, f32x4 v) {
          f32x4 o;
#pragma unroll
          for (int j = 0; j < 4; ++j) o[j] = act == 1 ? siluf_(v[j]) : act == 2 ? geluf_(v[j]) : v[j];
          st4bf(dst + (size_t)(m0 + r) * 512 + cin + c, o);
        });
      }
    }
  }
}

__device__ void phase_mix1(const Params& p, int l, char* lds) {
  const bool last = (l == 1);
  const int tid = threadIdx.x;
  const bf16_t* CS = (const bf16_t*)(p.ws + O_CS);
  const bf16_t* ZB = (const bf16_t*)(p.ws + O_ZB);
  const int NF1L = 2048, NF1C = last ? 0 : 128, NCH = last ? 256 : 272;
  const int NITEM = NF1L + NF1C + NCH * 4;
  for (int item = blockIdx.x; item < NITEM; item += gridDim.x) {
    f32x4 acc[4][4];
    zero_acc(acc);
    if (item < NF1L + NF1C) {
      const bool isl = item < NF1L;
      int i = isl ? item : item - NF1L;
      const int mh = i & 1;
      i >>= 1;
      int tt, g, b;
      if (isl) { tt = i & 31; i >>= 5; } else { tt = i & 1; i >>= 1; }
      g = i & 3; b = i >> 2;
      const size_t rowbase = isl ? (size_t)b * 4096 + tt * 128 : (size_t)NL + b * 256 + tt * 128;
      RowLd la(CS, mh * 128, 128), lb(ZB + g * 128, rowbase, 512);
      gemm_main(acc, 2, la, lb, lds);
      bf16_t* dst = isl ? (bf16_t*)(p.ws + O_ZCL) + ((size_t)b * 512 + g * 128) * 8192 + mh * 4096 + tt * 128
                        : (bf16_t*)(p.ws + O_ZCC) + ((size_t)b * 512 + g * 128) * 512 + mh * 256 + tt * 128;
      const size_t ld = isl ? 8192 : 512;
      gemm_epi(acc, [&](int r, int c, f32x4 v) { st4bf(dst + (size_t)r * ld + c, v); });
    } else {
      const int i = item - (NF1L + NF1C), ch = i >> 2, g = i & 3;
      const bf16_t* VT = (const bf16_t*)(p.ws + O_VT) + ((size_t)ch * 4 + g) * 128 * 128;
      float* rstd = (float*)lds;
      if (tid < 128) {
        float ss = 0.f;
        for (int d = 0; d < 128; ++d) {
          const float v = bf2f(VT[d * 128 + tid]);
          ss += v * v;
        }
        rstd[tid] = rsqrtf(ss * (1.0f / 128.0f) + 1e-6f);
      }
      __syncthreads();
      const float* ws = p.sgu_w + ((size_t)l * 4 + g) * 128 * 128;
      const int kc = (tid & 7) * 8;
      float rr[2][8];
#pragma unroll
      for (int h2 = 0; h2 < 2; ++h2)
#pragma unroll
        for (int j = 0; j < 8; ++j) rr[h2][j] = rstd[h2 * 64 + kc + j];
      __syncthreads();
      auto la = [&](int ii, int k0) -> bf16x8 {
        const float* s = ws + (size_t)((tid >> 3) + 32 * ii) * 128 + k0 + kc;
        const f32x4 a = *(const f32x4*)s, b = *(const f32x4*)(s + 4);
        const int h2 = k0 >> 6;
        u32x4 w;
        w.x = pk_bf16(a[0] * (h2 ? rr[1][0] : rr[0][0]), a[1] * (h2 ? rr[1][1] : rr[0][1]));
        w.y = pk_bf16(a[2] * (h2 ? rr[1][2] : rr[0][2]), a[3] * (h2 ? rr[1][3] : rr[0][3]));
        w.z = pk_bf16(b[0] * (h2 ? rr[1][4] : rr[0][4]), b[1] * (h2 ? rr[1][5] : rr[0][5]));
        w.w = pk_bf16(b[2] * (h2 ? rr[1][6] : rr[0][6]), b[3] * (h2 ? rr[1][7] : rr[0][7]));
        return __builtin_bit_cast(bf16x8, w);
      };
      RowLd lb(VT, 0, 128);
      gemm_main(acc, 2, la, lb, lds);
      bf16_t* U = (bf16_t*)(p.ws + O_U) + (size_t)ch * 128 * 512 + g * 128;
      const float* nwv = p.sgu_norm_w + ((size_t)l * 4 + g) * 128;
      const float* sb = p.sgu_b + ((size_t)l * 4 + g) * 128;
      gemm_epi(acc, [&](int r, int c, f32x4 v) {
        const f32x4 nw4 = *(const f32x4*)(nwv + c);
        const float bb = sb[r];
        bf16_t* up = U + (size_t)r * 512 + c;
        const u32x2 uw = *(const u32x2*)up;
        f32x4 o;
        o[0] = bflo(uw.x) * (v[0] * nw4[0] + bb);
        o[1] = bfhi(uw.x) * (v[1] * nw4[1] + bb);
        o[2] = bflo(uw.y) * (v[2] * nw4[2] + bb);
        o[3] = bfhi(uw.y) * (v[3] * nw4[3] + bb);
        st4bf(up, o);
      });
      __syncthreads();
    }
  }
}

__device__ void scan_item(const Params& p, int item, char* lds) {
  const int tid = threadIdx.x, vl = tid & 63, kq = tid >> 6;
  const int vh = item & 1, dir = (item >> 1) & 1, h = (item >> 2) & 3, b = item >> 4;
  float* sq = (float*)lds;
  float* sf = sq + 2048;
  float* sk = sf + 2048;
  float* si = sk + 2048;
  float* sp = si + 1024;
  const bf16_t* Q = (const bf16_t*)(p.ws + O_Q);
  const bf16_t* LF = (const bf16_t*)(p.ws + (dir ? O_LFB : O_LFF));
  const bf16_t* I = (const bf16_t*)(p.ws + O_I);
  bf16_t* O = (bf16_t*)(p.ws + (dir ? O_OBK : O_OF));
  float S[32];
#pragma unroll
  for (int j = 0; j < 32; ++j) S[j] = 0.f;
  for (int blk = 0; blk < 272; ++blk) {
    auto rowOf = [&](int tt) -> size_t {
      const int s = blk * 16 + tt;
      if (s < 256) return (size_t)NL + b * 256 + (dir ? 255 - s : s);
      const int u = s - 256;
      return (size_t)b * 4096 + (dir ? 4095 - u : u);
    };
    for (int e = tid; e < 2048; e += NTHREADS) {
      const int tt = e >> 7, k = e & 127;
      const size_t o = rowOf(tt) * 512 + h * 128 + k;
      const float lf = bf2f(LF[o]);
      sq[e] = bf2f(Q[o]);
      sf[e] = __expf(lf);
      sk[e] = -expm1f(lf);
    }
    for (int e = tid; e < 1024; e += NTHREADS) {
      const int tt = e >> 6, v = e & 63;
      si[e] = bf2f(I[rowOf(tt) * 512 + h * 128 + vh * 64 + v]);
    }
    __syncthreads();
#pragma unroll 1
    for (int tt = 0; tt < 16; ++tt) {
      const float iv = si[tt * 64 + vl];
      float a0 = 0.f, a1 = 0.f;
      const float* pf = sf + tt * 128 + kq * 32;
      const float* pk = sk + tt * 128 + kq * 32;
      const float* pq = sq + tt * 128 + kq * 32;
#pragma unroll
      for (int j4 = 0; j4 < 8; ++j4) {
        const f32x4 f4 = *(const f32x4*)(pf + j4 * 4), k4 = *(const f32x4*)(pk + j4 * 4), q4 = *(const f32x4*)(pq + j4 * 4);
#pragma unroll
        for (int j = 0; j < 4; ++j) {
          const float s = f4[j] * S[j4 * 4 + j] + k4[j] * iv;
          S[j4 * 4 + j] = s;
          if (j & 1) a1 += s * q4[j]; else a0 += s * q4[j];
        }
      }
      sp[(kq * 16 + tt) * 64 + vl] = a0 + a1;
    }
    __syncthreads();
    for (int e = tid; e < 1024; e += NTHREADS) {
      const int tt = e >> 6, v = e & 63;
      const float o = sp[(0 * 16 + tt) * 64 + v] + sp[(1 * 16 + tt) * 64 + v] + sp[(2 * 16 + tt) * 64 + v] + sp[(3 * 16 + tt) * 64 + v];
      O[rowOf(tt) * 512 + h * 128 + vh * 64 + v] = f2bf(o);
    }
  }
  __syncthreads();
}

__device__ void phase_mix2(const Params& p, int l, char* lds) {
  const bool last = (l == 1);
  unsigned* cnt = (unsigned*)(p.ws + O_CNT) + l * 8;
  int* sitem = (int*)lds;
  const int NSCAN = 128, NF2L = 1024, NF2C = last ? 0 : 64;
  const int NITEM = NSCAN + NF2L + NF2C;
  const bf16_t* FTL = (const bf16_t*)(p.ws + O_FTL);
  const bf16_t* FTC = (const bf16_t*)(p.ws + O_FTC);
  bf16_t* OB = (bf16_t*)(p.ws + O_ZB);
  for (;;) {
    __syncthreads();
    if (threadIdx.x == 0) *sitem = (int)atomicAdd(cnt, 1u);
    __syncthreads();
    const int item = *sitem;
    __syncthreads();
    if (item >= NITEM) break;
    if (item < NSCAN) {
      scan_item(p, item, lds);
    } else {
      f32x4 acc[4][4];
      zero_acc(acc);
      if (item < NSCAN + NF2L) {
        const int i = item - NSCAN, nt = i & 3, b = (i >> 2) & 7, mt = i >> 5;
        RowLd la(FTL, mt * 128, 8192), lb((const bf16_t*)(p.ws + O_ZCL), (size_t)b * 512 + nt * 128, 8192);
        gemm_main(acc, 128, la, lb, lds);
        bf16_t* dst = OB + ((size_t)b * 4096 + mt * 128) * 512 + nt * 128;
        gemm_epi(acc, [&](int r, int c, f32x4 v) { st4bf(dst + (size_t)r * 512 + c, v); });
      } else {
        const int i = item - NSCAN - NF2L, nt = i & 3, mt = (i >> 2) & 1, b = i >> 3;
        RowLd la(FTC, mt * 128, 512), lb((const bf16_t*)(p.ws + O_ZCC), (size_t)b * 512 + nt * 128, 512);
        gemm_main(acc, 8, la, lb, lds);
        bf16_t* dst = OB + ((size_t)NL + b * 256 + mt * 128) * 512 + nt * 128;
        gemm_epi(acc, [&](int r, int c, f32x4 v) { st4bf(dst + (size_t)r * 512 + c, v); });
      }
    }
  }
}

__device__ void phase_oa(const Params& p, int l) {
  const int tid = threadIdx.x, wid = tid >> 6, lane = tid & 63;
  const int nrow = (l == 1) ? NL : NT;
  const bf16_t* OF = (const bf16_t*)(p.ws + O_OF);
  const bf16_t* OK = (const bf16_t*)(p.ws + O_OBK);
  bf16_t* GA = (bf16_t*)(p.ws + O_GA);
  const float* gw = p.gnorm_w + (size_t)l * 128;
  for (int row = blockIdx.x * 4 + wid; row < nrow; row += gridDim.x * 4) {
    const size_t o = (size_t)row * 512 + lane * 8;
    const u32x4 a = *(const u32x4*)(OF + o), b = *(const u32x4*)(OK + o), g = *(const u32x4*)(GA + o);
    float v[8];
    v[0] = bflo(a.x) + bflo(b.x); v[1] = bfhi(a.x) + bfhi(b.x);
    v[2] = bflo(a.y) + bflo(b.y); v[3] = bfhi(a.y) + bfhi(b.y);
    v[4] = bflo(a.z) + bflo(b.z); v[5] = bfhi(a.z) + bfhi(b.z);
    v[6] = bflo(a.w) + bflo(b.w); v[7] = bfhi(a.w) + bfhi(b.w);
    float ss = 0.f;
#pragma unroll
    for (int j = 0; j < 8; ++j) ss += v[j] * v[j];
    ss += __shfl_xor(ss, 1); ss += __shfl_xor(ss, 2); ss += __shfl_xor(ss, 4); ss += __shfl_xor(ss, 8);
    const float rs = rsqrtf(ss * (1.0f / 128.0f) + 1e-6f);
    const float* gwp = gw + (lane & 15) * 8;
    const f32x4 w0 = *(const f32x4*)gwp, w1 = *(const f32x4*)(gwp + 4);
    float gg[8] = {bflo(g.x), bfhi(g.x), bflo(g.y), bfhi(g.y), bflo(g.z), bfhi(g.z), bflo(g.w), bfhi(g.w)};
    u32x4 w;
    w.x = pk_bf16(v[0] * rs * w0[0] * gg[0], v[1] * rs * w0[1] * gg[1]);
    w.y = pk_bf16(v[2] * rs * w0[2] * gg[2], v[3] * rs * w0[3] * gg[3]);
    w.z = pk_bf16(v[4] * rs * w1[0] * gg[4], v[5] * rs * w1[1] * gg[5]);
    w.w = pk_bf16(v[6] * rs * w1[2] * gg[6], v[7] * rs * w1[3] * gg[7]);
    *(u32x4*)(GA + o) = w;
  }
}

__device__ void phase_merge(const Params& p, int l, char* lds) {
  const int nmt = (l == 1) ? 256 : 272;
  const bf16_t* WBR = (const bf16_t*)(p.ws + O_WBR);
  const bf16_t* G = (const bf16_t*)(p.ws + O_G);
  bf16_t* MG = (bf16_t*)(p.ws + O_H);
  for (int t = blockIdx.x; t < nmt * 8; t += gridDim.x) {
    const int mt = t >> 3, nt = t & 7, m0 = mt * 128, n0 = nt * 128;
    f32x4 macc[4][4];
    zero_acc(macc);
#pragma unroll 1
    for (int j = 0; j < 3; ++j) {
      const bf16_t* Oj = (const bf16_t*)(p.ws + (j == 0 ? O_GA : j == 1 ? O_ZB : O_U));
      f32x4 acc[4][4];
      zero_acc(acc);
      RowLd la(Oj, m0, 512), lb(WBR + (size_t)j * 1024 * 512, n0, 512);
      gemm_main(acc, 8, la, lb, lds);
      const int tid = threadIdx.x, lane = tid & 63, wid = tid >> 6, fr = lane & 15, fq = lane >> 4, wr = wid >> 1, wc = wid & 1;
#pragma unroll
      for (int m = 0; m < 4; ++m)
#pragma unroll
        for (int n = 0; n < 4; ++n) {
          const int r = wr * 64 + m * 16 + fr, c = wc * 64 + n * 16 + fq * 4;
          const u32x2 gw = *(const u32x2*)(G + (size_t)(m0 + r) * 3072 + j * 1024 + n0 + c);
          macc[m][n][0] += bflo(gw.x) * acc[m][n][0];
          macc[m][n][1] += bfhi(gw.x) * acc[m][n][1];
          macc[m][n][2] += bflo(gw.y) * acc[m][n][2];
          macc[m][n][3] += bfhi(gw.y) * acc[m][n][3];
        }
    }
    gemm_epi(macc, [&](int r, int c, f32x4 v) { st4bf(MG + (size_t)(m0 + r) * 1024 + n0 + c, v); });
  }
}

__device__ void phase_wout(const Params& p, int l, char* lds) {
  const int nmt = (l == 1) ? 256 : 272;
  const bf16_t* MG = (const bf16_t*)(p.ws + O_H);
  const bf16_t* W = (const bf16_t*)(p.ws + O_WOUT);
  bf16_t* Y = (bf16_t*)(p.ws + O_Y);
  for (int t = blockIdx.x; t < nmt * 8; t += gridDim.x) {
    const int mt = t >> 3, nt = t & 7, m0 = mt * 128, n0 = nt * 128;
    f32x4 acc[4][4];
    zero_acc(acc);
    RowLd la(MG, m0, 1024), lb(W, n0, 1024);
    gemm_main(acc, 16, la, lb, lds);
    gemm_epi(acc, [&](int r, int c, f32x4 v) { st4bf(Y + (size_t)(m0 + r) * 1024 + n0 + c, v); });
  }
}

__device__ void phase_rowB(const Params& p, int l) {
  const int tid = threadIdx.x, wid = tid >> 6, lane = tid & 63;
  const int nrow = (l == 1) ? NL : NT;
  const float* xlat = l == 0 ? p.x : p.out;
  const float* xctx = l == 0 ? p.ctx : (const float*)(p.ws + O_CTXB);
  float* olat = p.out;
  float* octx = (float*)(p.ws + O_CTXB);
  const float* mod = (const float*)(p.ws + O_MOD);
  const bf16_t* Y = (const bf16_t*)(p.ws + O_Y);
  bf16_t* H = (bf16_t*)(p.ws + O_H);
  float* aff = (float*)(p.ws + O_AFF);
  const float* nw1 = p.norm_w + (size_t)(l * 4 + 1) * 1024;
  const float* nw2 = p.norm_w + (size_t)(l * 4 + 2) * 1024;
  const float* rw = p.router_w + (size_t)l * 1024 * 16;
  for (int row = blockIdx.x * 4 + wid; row < nrow; row += gridDim.x * 4) {
    const float* xr = row < NL ? xlat + (size_t)row * 1024 : xctx + (size_t)(row - NL) * 1024;
    float* xo = row < NL ? olat + (size_t)row * 1024 : octx + (size_t)(row - NL) * 1024;
    const int mr = row < NL ? (row >> 12) : 8;
    const float* md = mod + (size_t)(l * 9 + mr) * 6144;
    float yv[16], xv[16];
    float ss = 0.f;
#pragma unroll
    for (int i = 0; i < 2; ++i) {
      const int e = i * 512 + lane * 8;
      const u32x4 w = *(const u32x4*)(Y + (size_t)row * 1024 + e);
      yv[i * 8 + 0] = bflo(w.x); yv[i * 8 + 1] = bfhi(w.x); yv[i * 8 + 2] = bflo(w.y); yv[i * 8 + 3] = bfhi(w.y);
      yv[i * 8 + 4] = bflo(w.z); yv[i * 8 + 5] = bfhi(w.z); yv[i * 8 + 6] = bflo(w.w); yv[i * 8 + 7] = bfhi(w.w);
      const f32x4 a = *(const f32x4*)(xr + e), b = *(const f32x4*)(xr + e + 4);
#pragma unroll
      for (int j = 0; j < 4; ++j) { xv[i * 8 + j] = a[j]; xv[i * 8 + 4 + j] = b[j]; }
    }
#pragma unroll
    for (int j = 0; j < 16; ++j) ss += yv[j] * yv[j];
    ss = wave_sum(ss);
    const float rs = rsqrtf(ss * (1.0f / 1024.0f) + 1e-6f);
    float ss2 = 0.f;
#pragma unroll
    for (int i = 0; i < 2; ++i) {
      const int e = i * 512 + lane * 8;
#pragma unroll
      for (int h4 = 0; h4 < 2; ++h4) {
        const f32x4 w = *(const f32x4*)(nw1 + e + h4 * 4), g1 = *(const f32x4*)(md + 2048 + e + h4 * 4);
        f32x4 o;
#pragma unroll
        for (int j = 0; j < 4; ++j) {
          const int q = i * 8 + h4 * 4 + j;
          xv[q] = xv[q] + g1[j] * (yv[q] * rs * w[j]);
          o[j] = xv[q];
          ss2 += xv[q] * xv[q];
        }
        *(f32x4*)(xo + e + h4 * 4) = o;
      }
    }
    ss2 = wave_sum(ss2);
    const float rs2 = rsqrtf(ss2 * (1.0f / 1024.0f) + 1e-6f);
    float lg[16];
#pragma unroll
    for (int e2 = 0; e2 < 16; ++e2) lg[e2] = 0.f;
#pragma unroll
    for (int i = 0; i < 2; ++i) {
      const int e = i * 512 + lane * 8;
      float hv[8];
#pragma unroll
      for (int h4 = 0; h4 < 2; ++h4) {
        const f32x4 w = *(const f32x4*)(nw2 + e + h4 * 4), sh = *(const f32x4*)(md + 3072 + e + h4 * 4), sc = *(const f32x4*)(md + 4096 + e + h4 * 4);
#pragma unroll
        for (int j = 0; j < 4; ++j) hv[h4 * 4 + j] = xv[i * 8 + h4 * 4 + j] * rs2 * w[j] * (1.0f + sc[j]) + sh[j];
      }
      u32x4 w;
      w.x = pk_bf16(hv[0], hv[1]); w.y = pk_bf16(hv[2], hv[3]); w.z = pk_bf16(hv[4], hv[5]); w.w = pk_bf16(hv[6], hv[7]);
      *(u32x4*)(H + (size_t)row * 1024 + e) = w;
#pragma unroll
      for (int j = 0; j < 8; ++j) {
        const float* rp = rw + (size_t)(e + j) * 16;
#pragma unroll
        for (int q4 = 0; q4 < 4; ++q4) {
          const f32x4 r4 = *(const f32x4*)(rp + q4 * 4);
#pragma unroll
          for (int jj = 0; jj < 4; ++jj) lg[q4 * 4 + jj] += hv[j] * r4[jj];
        }
      }
    }
#pragma unroll
    for (int e2 = 0; e2 < 16; ++e2) lg[e2] = wave_sum(lg[e2]);
    float mx = lg[0];
#pragma unroll
    for (int e2 = 1; e2 < 16; ++e2) mx = fmaxf(mx, lg[e2]);
    float se = 0.f;
#pragma unroll
    for (int e2 = 0; e2 < 16; ++e2) { lg[e2] = expf(lg[e2] - mx); se += lg[e2]; }
    const float inv = 1.0f / se;
    if (lane < 16) {
      float mine = lg[0];
#pragma unroll
      for (int e2 = 1; e2 < 16; ++e2) mine = (lane == e2) ? lg[e2] : mine;
      aff[(size_t)row * 16 + lane] = mine * inv;
    }
  }
}

template <int NI>
__device__ void topk_body(const Params& p, int s, int e, float* a) {
  const int tid = threadIdx.x;
  constexpr int T = NI * 256, CAP = T / 8;
  const bool isl = NI == 16;
  const size_t rowbase = isl ? (size_t)s * 4096 : (size_t)NL + (size_t)(s - 8) * 256;
  const float* aff = (const float*)(p.ws + O_AFF);
  int* sel = (int*)(p.ws + O_SEL);
  int* idx = (int*)(p.ws + O_IDX);
  float* gate = (float*)(p.ws + O_GATE);
  for (int t = tid; t < T; t += NTHREADS) a[t] = aff[(rowbase + t) * 16 + e];
  __syncthreads();
  float ai[NI];
  int cnt[NI];
#pragma unroll
  for (int q = 0; q < NI; ++q) { ai[q] = a[tid + q * 256]; cnt[q] = 0; }
  for (int j = 0; j < T; j += 4) {
    const f32x4 v = *(const f32x4*)(a + j);
#pragma unroll
    for (int jj = 0; jj < 4; ++jj) {
      const float vj = v[jj];
#pragma unroll
      for (int q = 0; q < NI; ++q) {
        const int i = tid + q * 256;
        cnt[q] += (vj > ai[q]) ? 1 : ((vj == ai[q] && (j + jj) < i) ? 1 : 0);
      }
    }
  }
  const size_t slotbase = isl ? ((size_t)e * 8 + s) * CAP : (size_t)NSLOT_L + ((size_t)e * 8 + (s - 8)) * CAP;
#pragma unroll
  for (int q = 0; q < NI; ++q) {
    const int i = tid + q * 256;
    const bool in = cnt[q] < CAP;
    sel[(rowbase + i) * 16 + e] = in ? cnt[q] : -1;
    if (in) {
      idx[slotbase + cnt[q]] = (int)(rowbase + i);
      gate[slotbase + cnt[q]] = ai[q];
    }
  }
  __syncthreads();
}
__device__ void phase_topk(const Params& p, int l, char* lds) {
  const int NITEM = (l == 1) ? 128 : 256;
  float* a = (float*)lds;
  for (int item = blockIdx.x; item < NITEM; item += gridDim.x) {
    const int s = item >> 4, e = item & 15;
    if (s < 8) topk_body<16>(p, s, e, a);
    else topk_body<1>(p, s, e, a);
  }
}

__device__ void phase_moe1(const Params& p, int l, char* lds) {
  const int nrt = (l == 1) ? 512 : 544;
  const bf16_t* H = (const bf16_t*)(p.ws + O_H);
  const bf16_t* W = (const bf16_t*)(p.ws + O_W13);
  const int* idx = (const int*)(p.ws + O_IDX);
  bf16_t* AB = (bf16_t*)(p.ws + O_AB);
  const int tid = threadIdx.x;
  for (int t = blockIdx.x; t < nrt * 16; t += gridDim.x) {
    const int rt = t >> 4, nt = t & 15, s0 = rt * 128, n0 = nt * 128;
    const int e = rt < 512 ? (rt >> 5) : ((rt - 512) >> 1);
    const bf16_t* ap[4];
#pragma unroll
    for (int i = 0; i < 4; ++i) {
      int tok = idx[s0 + (tid >> 3) + 32 * i];
      tok = tok < 0 ? 0 : (tok >= NT ? NT - 1 : tok);
      ap[i] = H + (size_t)tok * 1024 + (tid & 7) * 8;
    }
    auto la = [&](int i, int k0) -> bf16x8 { return *(const bf16x8*)(ap[i] + k0); };
    RowLd lb(W + (size_t)e * 2048 * 1024, n0, 1024);
    f32x4 acc[4][4];
    zero_acc(acc);
    gemm_main(acc, 16, la, lb, lds);
    gemm_epi(acc, [&](int r, int c, f32x4 v) { st4bf(AB + (size_t)(s0 + r) * 2048 + n0 + c, v); });
  }
}
__device__ void phase_moe2(const Params& p, int l, char* lds) {
  const int nrt = (l == 1) ? 512 : 544;
  const bf16_t* W = (const bf16_t*)(p.ws + O_W2);
  const bf16_t* AB = (const bf16_t*)(p.ws + O_AB);
  const float* gate = (const float*)(p.ws + O_GATE);
  bf16_t* YS = (bf16_t*)(p.ws + O_YS);
  const int tid = threadIdx.x;
  for (int t = blockIdx.x; t < nrt * 8; t += gridDim.x) {
    const int rt = t >> 3, nt = t & 7, s0 = rt * 128, n0 = nt * 128;
    const int e = rt < 512 ? (rt >> 5) : ((rt - 512) >> 1);
    const bf16_t* ap[4];
#pragma unroll
    for (int i = 0; i < 4; ++i) ap[i] = AB + (size_t)(s0 + (tid >> 3) + 32 * i) * 2048 + (tid & 7) * 8;
    auto la = [&](int i, int k0) -> bf16x8 {
      const u32x4 a = *(const u32x4*)(ap[i] + k0), b = *(const u32x4*)(ap[i] + 1024 + k0);
      u32x4 w;
      w.x = pk_bf16(siluf_(bflo(a.x)) * bflo(b.x), siluf_(bfhi(a.x)) * bfhi(b.x));
      w.y = pk_bf16(siluf_(bflo(a.y)) * bflo(b.y), siluf_(bfhi(a.y)) * bfhi(b.y));
      w.z = pk_bf16(siluf_(bflo(a.z)) * bflo(b.z), siluf_(bfhi(a.z)) * bfhi(b.z));
      w.w = pk_bf16(siluf_(bflo(a.w)) * bflo(b.w), siluf_(bfhi(a.w)) * bfhi(b.w));
      return __builtin_bit_cast(bf16x8, w);
    };
    RowLd lb(W + (size_t)e * 1024 * 1024, n0, 1024);
    f32x4 acc[4][4];
    zero_acc(acc);
    gemm_main(acc, 16, la, lb, lds);
    gemm_epi(acc, [&](int r, int c, f32x4 v) {
      const float g = gate[s0 + r];
      st4bf(YS + (size_t)(s0 + r) * 1024 + n0 + c, v * g);
    });
  }
}

__device__ void phase_rowC(const Params& p, int l) {
  const int tid = threadIdx.x, wid = tid >> 6, lane = tid & 63;
  const int nrow = (l == 1) ? NL : NT;
  float* olat = p.out;
  float* octx = (float*)(p.ws + O_CTXB);
  const float* mod = (const float*)(p.ws + O_MOD);
  const bf16_t* YS = (const bf16_t*)(p.ws + O_YS);
  const int* sel = (const int*)(p.ws + O_SEL);
  const float* nw3 = p.norm_w + (size_t)(l * 4 + 3) * 1024;
  for (int row = blockIdx.x * 4 + wid; row < nrow; row += gridDim.x * 4) {
    float* xo = row < NL ? olat + (size_t)row * 1024 : octx + (size_t)(row - NL) * 1024;
    const bool isl = row < NL;
    const int mr = isl ? (row >> 12) : 8;
    const int s = isl ? (row >> 12) : ((row - NL) >> 8);
    const float* md = mod + (size_t)(l * 9 + mr) * 6144;
    float mv[16];
#pragma unroll
    for (int j = 0; j < 16; ++j) mv[j] = 0.f;
    for (int e = 0; e < 16; ++e) {
      const int rk = sel[(size_t)row * 16 + e];
      if (rk >= 0) {
        const size_t slot = isl ? ((size_t)e * 8 + s) * 512 + rk : (size_t)NSLOT_L + ((size_t)e * 8 + s) * 32 + rk;
#pragma unroll
        for (int i = 0; i < 2; ++i) {
          const u32x4 w = *(const u32x4*)(YS + slot * 1024 + i * 512 + lane * 8);
          mv[i * 8 + 0] += bflo(w.x); mv[i * 8 + 1] += bfhi(w.x); mv[i * 8 + 2] += bflo(w.y); mv[i * 8 + 3] += bfhi(w.y);
          mv[i * 8 + 4] += bflo(w.z); mv[i * 8 + 5] += bfhi(w.z); mv[i * 8 + 6] += bflo(w.w); mv[i * 8 + 7] += bfhi(w.w);
        }
      }
    }
    float ss = 0.f;
#pragma unroll
    for (int j = 0; j < 16; ++j) ss += mv[j] * mv[j];
    ss = wave_sum(ss);
    const float rs = rsqrtf(ss * (1.0f / 1024.0f) + 1e-6f);
#pragma unroll
    for (int i = 0; i < 2; ++i) {
      const int e = i * 512 + lane * 8;
#pragma unroll
      for (int h4 = 0; h4 < 2; ++h4) {
        const f32x4 w = *(const f32x4*)(nw3 + e + h4 * 4), g2 = *(const f32x4*)(md + 5120 + e + h4 * 4);
        f32x4 xv = *(const f32x4*)(xo + e + h4 * 4);
#pragma unroll
        for (int j = 0; j < 4; ++j) xv[j] += g2[j] * (mv[i * 8 + h4 * 4 + j] * rs * w[j]);
        *(f32x4*)(xo + e + h4 * 4) = xv;
      }
    }
  }
}

__device__ void phase_dump(const Params& p, size_t lo, size_t hi) {
  const size_t OUTN = (size_t)NL * 1024;
  const bf16_t* src = (const bf16_t*)(p.ws + lo);
  const size_t n = (hi - lo) / 2;
  for (size_t i = (size_t)blockIdx.x * NTHREADS + threadIdx.x; i < OUTN; i += (size_t)gridDim.x * NTHREADS) {
    float acc = 0.f;
    for (size_t e = i; e < n; e += OUTN) acc += bf2f(src[e]);
    p.out[i] = acc;
  }
}
__global__ void __launch_bounds__(NTHREADS, 2) dump_kernel(Params p, size_t lo, size_t hi) { phase_dump(p, lo, hi); }

enum { PH_SETUP = 0, PH_CONV, PH_ROWA, PH_GIN, PH_MIX1, PH_MIX2, PH_OA, PH_MERGE, PH_WOUT, PH_ROWB, PH_TOPK, PH_MOE1, PH_MOE2, PH_ROWC, NPH };

__device__ __forceinline__ void run_phase(const Params& p, int ph, int l, char* lds) {
  switch (ph) {
    case PH_SETUP: phase_setup(p, lds); break;
    case PH_CONV: phase_conv(p, l, lds); break;
    case PH_ROWA: phase_rowA(p, l); break;
    case PH_GIN: phase_gin(p, l, lds); break;
    case PH_MIX1: phase_mix1(p, l, lds); break;
    case PH_MIX2: phase_mix2(p, l, lds); break;
    case PH_OA: phase_oa(p, l); break;
    case PH_MERGE: phase_merge(p, l, lds); break;
    case PH_WOUT: phase_wout(p, l, lds); break;
    case PH_ROWB: phase_rowB(p, l); break;
    case PH_TOPK: phase_topk(p, l, lds); break;
    case PH_MOE1: phase_moe1(p, l, lds); break;
    case PH_MOE2: phase_moe2(p, l, lds); break;
    case PH_ROWC: phase_rowC(p, l); break;
    default: break;
  }
}

#if COOP
__global__ void __launch_bounds__(NTHREADS, 2) fwd_mega(Params p) {
  extern __shared__ __attribute__((aligned(16))) char lds[];
  cg::grid_group grid = cg::this_grid();
  run_phase(p, PH_SETUP, 0, lds);
  grid.sync();
  for (int l = 0; l < 2; ++l) {
    for (int ph = PH_CONV; ph < NPH; ++ph) {
      run_phase(p, ph, l, lds);
      if (!(l == 1 && ph == NPH - 1)) grid.sync();
    }
  }
}
#else
__global__ void __launch_bounds__(NTHREADS, 2) fwd_phase(Params p, int ph, int l) {
  extern __shared__ __attribute__((aligned(16))) char lds[];
  run_phase(p, ph, l, lds);
}
#endif

extern "C" void kernel_launch(void* const* d_in, const int* in_sizes, int n_in, void* d_out, int out_size, void* d_ws, size_t ws_size,
                              hipStream_t stream) {
  if (ws_size < WS_NEED) {
    fprintf(stderr, "kernel_launch: workspace too small: %zu < %zu\n", ws_size, (size_t)WS_NEED);
    return;
  }
  Params p{};
  p.x = (const float*)d_in[0]; p.c = (const float*)d_in[1]; p.ctx = (const float*)d_in[2]; p.c_ctx = (const float*)d_in[3];
  p.ada_w = (const float*)d_in[4]; p.ada_b = (const float*)d_in[5]; p.norm_w = (const float*)d_in[6]; p.w_in = (const float*)d_in[7];
  p.lb_raw = (const float*)d_in[8]; p.gnorm_w = (const float*)d_in[9]; p.sgu_w = (const float*)d_in[10]; p.sgu_b = (const float*)d_in[11];
  p.sgu_norm_w = (const float*)d_in[12]; p.w_branch = (const float*)d_in[13]; p.w_out = (const float*)d_in[14];
  p.router_w = (const float*)d_in[15]; p.w13 = (const float*)d_in[16]; p.w2 = (const float*)d_in[17];
  p.out = (float*)d_out;
  p.ws = (char*)d_ws;
#if COOP
  static int grid_blocks = 0;
  if (!grid_blocks) {
    int dev = 0, cus = 0, per_cu = 0;
    hipGetDevice(&dev);
    hipDeviceGetAttribute(&cus, hipDeviceAttributeMultiprocessorCount, dev);
    hipFuncSetAttribute((const void*)fwd_mega, hipFuncAttributeMaxDynamicSharedMemorySize, LDS_TOTAL);
    hipOccupancyMaxActiveBlocksPerMultiprocessor(&per_cu, fwd_mega, NTHREADS, LDS_TOTAL);
    if (per_cu > 2) per_cu = 2;
    grid_blocks = cus * per_cu;
  }
  void* args[] = {&p};
  hipError_t e = hipLaunchCooperativeKernel((void*)fwd_mega, dim3(grid_blocks), dim3(NTHREADS), args, LDS_TOTAL, stream);
  if (e != hipSuccess) fprintf(stderr, "cooperative launch failed: %s (grid %d)\n", hipGetErrorString(e), grid_blocks);
#else
  const int grid = 512;
  static bool attr_set = false;
  if (!attr_set) {
    hipFuncSetAttribute((const void*)fwd_phase, hipFuncAttributeMaxDynamicSharedMemorySize, LDS_TOTAL);
    attr_set = true;
  }
#ifndef MAXSTEP
#define MAXSTEP 1000
#endif
  int step = 0;
  fwd_phase<<<grid, NTHREADS, LDS_TOTAL, stream>>>(p, PH_SETUP, 0);
  for (int l = 0; l < 2; ++l)
    for (int ph = PH_CONV; ph < NPH; ++ph) {
#ifdef DUMP_LO
      if (++step > MAXSTEP) {
        dump_kernel<<<grid, NTHREADS, 0, stream>>>(p, DUMP_LO, DUMP_HI);
        return;
      }
#endif
      fwd_phase<<<grid, NTHREADS, LDS_TOTAL, stream>>>(p, ph, l);
    }
#endif
}
```

```cpp
#include <hip/hip_runtime.h>
#include <hip/hip_cooperative_groups.h>
#include <cstdio>
#include <cstdint>
namespace cg = cooperative_groups;

typedef unsigned short bf16_t;
typedef short bf16x8 __attribute__((ext_vector_type(8)));
typedef float f32x4 __attribute__((ext_vector_type(4)));
typedef float f32x2 __attribute__((ext_vector_type(2)));
typedef unsigned u32x4 __attribute__((ext_vector_type(4)));
typedef unsigned u32x2 __attribute__((ext_vector_type(2)));

constexpr int D = 1024, NB = 8, TL = 4096, TCX = 256;
constexpr int NL = NB * TL, NC = NB * TCX, NT = NL + NC;
constexpr int INC = 7168;
constexpr int NSLOT_L = 16 * 8 * 512, NSLOT_C = 16 * 8 * 32, NSLOT = NSLOT_L + NSLOT_C;
constexpr int NTHREADS = 512, NWAVE = 8;
constexpr int LDS_MAIN = 147456;
constexpr int LDS_TOTAL = LDS_MAIN + 16;

constexpr size_t al(size_t x) { return (x + 255) & ~(size_t)255; }
constexpr size_t O_WIN = 0;
constexpr size_t O_WBR = O_WIN + al((size_t)INC * D * 2);
constexpr size_t O_WOUT = O_WBR + al((size_t)3 * D * 512 * 2);
constexpr size_t O_W13 = O_WOUT + al((size_t)D * D * 2);
constexpr size_t O_W2 = O_W13 + al((size_t)16 * 2048 * D * 2);
constexpr size_t O_FTL = O_W2 + al((size_t)16 * D * D * 2);
constexpr size_t O_FTC = O_FTL + al((size_t)4096 * 8192 * 2);
constexpr size_t O_CS = O_FTC + al((size_t)256 * 512 * 2);
constexpr size_t O_MOD = O_CS + al((size_t)256 * 128 * 2);
constexpr size_t O_LB = O_MOD + al((size_t)2 * 9 * 6144 * 4);
constexpr size_t O_BAR = O_LB + al((size_t)2 * 2 * 512 * 4);
constexpr size_t BAR_BYTES = 3456 * 4;
constexpr size_t O_H = O_BAR + al(BAR_BYTES);
constexpr size_t O_Y = O_H + al((size_t)NT * D * 2);
constexpr size_t O_CTXB = O_Y + al((size_t)NT * D * 2);
constexpr size_t O_AFF = O_CTXB + al((size_t)NC * D * 4);
constexpr size_t O_SEL = O_AFF + al((size_t)NT * 16 * 4);
constexpr size_t O_GATE = O_SEL + al((size_t)NT * 16 * 4);
constexpr size_t O_TOK = O_GATE + al((size_t)NSLOT * 4);
constexpr size_t O_Z = O_TOK + al((size_t)NSLOT * 4);
constexpr size_t SZ512 = al((size_t)NT * 512 * 2);
constexpr size_t O_Q = O_Z, O_LFF = O_Q + SZ512, O_LFB = O_LFF + SZ512, O_I = O_LFB + SZ512, O_GA = O_I + SZ512,
                 O_U = O_GA + SZ512, O_ZB = O_U + SZ512, O_VT = O_ZB + SZ512, O_OF = O_VT + SZ512, O_OBK = O_OF + SZ512;
constexpr size_t O_G = O_OBK + SZ512;
constexpr size_t O_ZCL = O_G + al((size_t)NT * 3072 * 2);
constexpr size_t O_ZCC = O_ZCL + al((size_t)8 * 512 * 8192 * 2);
constexpr size_t O_ZF = O_ZCC + al((size_t)8 * 512 * 512 * 2);
constexpr int KH = 2176, KF = 2 * KH;
constexpr size_t O_ZEND = O_ZF + al((size_t)8 * 512 * KF * 2);
constexpr size_t SZSLOT = al((size_t)NSLOT * 1024 * 2);
constexpr size_t O_XE = O_Z, O_HID = O_XE + SZSLOT, O_YS = O_HID + SZSLOT;
static_assert(O_YS + SZSLOT <= O_ZEND, "moe arena");
constexpr size_t O_W2B = O_ZEND;
constexpr size_t WS_NEED = O_ZEND, WS_NEED_W2B = O_W2B + al((size_t)16 * D * D * 2);

struct Params {
  const float *x, *c, *ctx, *c_ctx, *ada_w, *ada_b, *norm_w, *w_in, *lb_raw, *gnorm_w, *sgu_w, *sgu_b, *sgu_norm_w, *w_branch, *w_out,
      *router_w, *w13, *w2;
  float* out;
  char* ws;
  int w2sep;
};

typedef __bf16 bf16v2_t __attribute__((ext_vector_type(2)));
__device__ __forceinline__ unsigned pk_bf16(float lo, float hi) {
  const f32x2 v = {lo, hi};
  const bf16v2_t r = __builtin_convertvector(v, bf16v2_t);
  return __builtin_bit_cast(unsigned, r);
}
__device__ __forceinline__ bf16_t f2bf(float x) { return (bf16_t)(pk_bf16(x, 0.f) & 0xffffu); }
__device__ __forceinline__ float bf2f(bf16_t v) { return __uint_as_float(((unsigned)v) << 16); }
__device__ __forceinline__ float bflo(unsigned w) { return __uint_as_float(w << 16); }
__device__ __forceinline__ float bfhi(unsigned w) { return __uint_as_float(w & 0xffff0000u); }
__device__ __forceinline__ void st4bf(bf16_t* p, f32x4 v) {
  u32x2 w;
  w.x = pk_bf16(v[0], v[1]);
  w.y = pk_bf16(v[2], v[3]);
  *(u32x2*)p = w;
}
__device__ __forceinline__ void st8bf(bf16_t* p, f32x4 a, f32x4 b) {
  u32x4 w;
  w.x = pk_bf16(a[0], a[1]); w.y = pk_bf16(a[2], a[3]); w.z = pk_bf16(b[0], b[1]); w.w = pk_bf16(b[2], b[3]);
  *(u32x4*)p = w;
}
__device__ __forceinline__ float sigmoidf_(float x) { return __builtin_amdgcn_rcpf(1.0f + __expf(-x)); }
__device__ __forceinline__ float siluf_(float x) { return x * __builtin_amdgcn_rcpf(1.0f + __expf(-x)); }
__device__ __forceinline__ float geluf_(float v) {
  const float av = fabsf(v), t = __builtin_amdgcn_rcpf(av * 0.2316418882f + 1.0f);
  float q = t * 0.5307027145f + (-0.7265760135f);
  q = q * t + 0.7107068705f; q = q * t + (-0.142248368f); q = q * t + 0.127414796f; q = q * t;
  const float e = __builtin_amdgcn_exp2f((v * v) * (-0.72134752044f));
  const float m = v * (q * e);
  return v < 0.f ? m : v - m;
}
__device__ __forceinline__ int opaque_tid(int wid0) {
  int lane;
  asm volatile("v_mbcnt_lo_u32_b32 %0, -1, 0\n\tv_mbcnt_hi_u32_b32 %0, -1, %0" : "=v"(lane));
  return (wid0 << 6) | lane;
}
__device__ __forceinline__ float wave_sum(float v) {
#pragma unroll
  for (int o = 32; o > 0; o >>= 1) v += __shfl_xor(v, o);
  return v;
}

namespace pg8 {
#define PG8_LAS __attribute__((address_space(3)))
constexpr int BM = 256, BK = 64, HALF = 128, HTB = HALF * BK * 2, STAGE_BYTES = 8 * HTB, NXCD = 8, WGM = 8;
__device__ __forceinline__ int lds_byte(int r, int c) { const int st = (r >> 4) * 2 + (c >> 5), rr = r & 15, cc = c & 31, ob = rr * 64 + cc * 2; return st * 1024 + (ob ^ (((ob >> 9) & 1) << 5)); }
__device__ __forceinline__ void stage_rc(int b, int& R, int& C) { const int st = b / 1024, sb = b % 1024, swz = sb ^ (((sb >> 9) & 1) << 5); R = (st >> 1) * 16 + swz / 64; C = (st & 1) * 32 + (swz % 64) / 2; }
__device__ __forceinline__ int perm32(int rho) { const int n = rho >> 4, i = rho & 15; return 8 * (i >> 2) + 4 * n + (i & 3); }
struct Unit { int pm, pn, z; };
template <class T, class = void> struct gather_of { static constexpr bool v = false; };
template <class T> struct gather_of<T, decltype((void)T::GATHER)> { static constexpr bool v = T::GATHER; };

template <class Epi, class Sched>
__device__ __forceinline__ void gemm_phase(PG8_LAS unsigned char* lds, const int K, const Sched& S, const Epi& E, const int tid_in) {
  int tid = tid_in;
  asm volatile("" : "+v"(tid));
  const int wid = __builtin_amdgcn_readfirstlane(tid >> 6), lane = tid & 63, wr = wid >> 2, wc = wid & 3, fr = lane & 15, fq = lane >> 4;
  const int nt = K / BK;
  constexpr bool GA = gather_of<Sched>::v;
  unsigned voffA[2], voffB[2];
  unsigned cvA[2][2], nvA[2][2];
  int gR = 0; unsigned gC2 = 0;
#pragma unroll
  for (int i = 0; i < 2; ++i) { int R, C; stage_rc(tid * 16 + i * 8192, R, C); const int Rb = (R & ~31) + perm32(R & 31);
    if (i == 0) { gR = R; gC2 = (unsigned)C * 2u; }
    voffA[i] = (unsigned)(R * K + C) * 2u; voffB[i] = (unsigned)(Rb * K + C) * 2u; }
  const size_t kstep = (size_t)(BK * 2);
  const size_t hstep = (size_t)HALF * K * 2;
  const size_t hstepA = GA ? (size_t)0 : hstep;
  const PG8_LAS int* idxl = (const PG8_LAS int*)(lds + STAGE_BYTES);
  const unsigned ldsw = (unsigned)wid * 1024u;
  const int aoff = lds_byte(wr * 64 + fr, fq * 8), boff = lds_byte(wc * 32 + fr, fq * 8);
#define PG8_SA(b, h) (((b) * 2 + (h)) * HTB)
#define PG8_SB(b, h) ((4 + (b) * 2 + (h)) * HTB)
#define PG8_STAGE_(bufoff, gbase, voff) do { _Pragma("unroll") for (int _i = 0; _i < 2; ++_i) \
    __builtin_amdgcn_global_load_lds((const unsigned*)((const char*)(gbase) + voff[_i]), (PG8_LAS unsigned*)(lds + (bufoff) + ldsw + _i * 8192), 16, 0, 0); } while (0)
#define PG8_STAGE(bufoff, gbase) PG8_STAGE_(bufoff, gbase, voffB)
#define PG8_STAGE_A(bufoff, gbase, NX) do { _Pragma("unroll") for (int _i = 0; _i < 2; ++_i) { unsigned _vo; \
    if constexpr (GA) { _vo = (NX) ? nvA[((bufoff) / HTB) & 1][_i] : cvA[((bufoff) / HTB) & 1][_i]; } else _vo = voffA[_i]; \
    __builtin_amdgcn_global_load_lds((const unsigned*)((const char*)(gbase) + _vo), (PG8_LAS unsigned*)(lds + (bufoff) + ldsw + _i * 8192), 16, 0, 0); } } while (0)
#define PG8_LDA(dst, b, h) do { _Pragma("unroll") for (int m = 0; m < 4; ++m) _Pragma("unroll") for (int k = 0; k < 2; ++k) dst[m][k] = *(const PG8_LAS bf16x8*)(lds + PG8_SA(b, h) + aoff + m * 2048 + k * 1024); } while (0)
#define PG8_LDB(dst, b, h) do { _Pragma("unroll") for (int n = 0; n < 2; ++n) _Pragma("unroll") for (int k = 0; k < 2; ++k) dst[n][k] = *(const PG8_LAS bf16x8*)(lds + PG8_SB(b, h) + boff + n * 2048 + k * 1024); } while (0)
#define PG8_MMA(ai, bj, At, Bt) do { __builtin_amdgcn_s_setprio(1); _Pragma("unroll") for (int m = 0; m < 4; ++m) _Pragma("unroll") for (int n = 0; n < 2; ++n) _Pragma("unroll") for (int k = 0; k < 2; ++k) \
    acc[ai][bj][m][n] = __builtin_amdgcn_mfma_f32_16x16x32_bf16(Bt[n][k], At[m][k], acc[ai][bj][m][n], 0, 0, 0); __builtin_amdgcn_s_setprio(0); } while (0)
#define PG8_WAIT_V(n) asm volatile("s_waitcnt vmcnt(" #n ")" ::: "memory")
#define PG8_WAIT_L(n) asm volatile("s_waitcnt lgkmcnt(" #n ")" ::: "memory")
#define PG8_BAR __builtin_amdgcn_s_barrier()
#define PG8_SCHED __builtin_amdgcn_sched_barrier(0)
  Unit cur, nxt; int ui = 0;
  if (!S.next(0, cur)) return;
  f32x4 acc[2][2][4][2];
#pragma unroll
  for (int a = 0; a < 2; ++a)
#pragma unroll
    for (int b = 0; b < 2; ++b)
#pragma unroll
      for (int m = 0; m < 4; ++m)
#pragma unroll
        for (int n = 0; n < 2; ++n) acc[a][b][m][n] = (f32x4){0.f, 0.f, 0.f, 0.f};
  bf16x8 At[4][2], B0[2][2], B1[2][2];
  const char* cA = S.aptr(cur); const char* cB = S.bptr(cur);
  if constexpr (GA) {
    const int* tk = S.tokptr(cur);
#pragma unroll
    for (int h = 0; h < 2; ++h)
#pragma unroll
      for (int i = 0; i < 2; ++i) { cvA[h][i] = (unsigned)tk[h * 128 + i * 64 + gR] * (unsigned)(K * 2) + gC2; nvA[h][i] = cvA[h][i]; }
  }
  PG8_STAGE(PG8_SB(0, 0), cB); PG8_STAGE_A(PG8_SA(0, 0), cA, false); PG8_STAGE(PG8_SB(0, 1), cB + hstep); PG8_STAGE_A(PG8_SA(0, 1), cA + hstepA, false);
  if (wr == 1) PG8_BAR;
  PG8_WAIT_V(4); PG8_BAR;
  PG8_STAGE(PG8_SB(1, 0), cB + kstep); PG8_STAGE_A(PG8_SA(1, 0), cA + kstep, false); PG8_STAGE(PG8_SB(1, 1), cB + hstep + kstep);
  PG8_WAIT_V(6); PG8_BAR;
  for (;;) {
    const bool has_next = S.next(ui + 1, nxt);
    const char* nA = has_next ? S.aptr(nxt) : cA; const char* nB = has_next ? S.bptr(nxt) : cB;
    if constexpr (GA) {
      if (has_next && wid < 4)
        __builtin_amdgcn_global_load_lds((const unsigned*)(S.tokptr(nxt) + wid * 64 + lane), (PG8_LAS unsigned*)(lds + STAGE_BYTES + wid * 256), 4, 0, 0);
    }
    for (int t = 0; t < nt; t += 2) {
      const bool last = (t == nt - 2);
      const bool lastn = last && has_next;
      if constexpr (GA) {
#pragma unroll
        for (int h = 0; h < 2; ++h)
#pragma unroll
          for (int i = 0; i < 2; ++i) nvA[h][i] = (unsigned)idxl[h * 128 + i * 64 + gR] * (unsigned)(K * 2) + gC2;
      }
      const char* a1 = cA + (size_t)(t + 1) * kstep;
      const char* a2 = last ? nA : cA + (size_t)(t + 2) * kstep; const char* b2 = last ? nB : cB + (size_t)(t + 2) * kstep;
      const char* a3 = a2 + kstep; const char* b3 = b2 + kstep;
      PG8_LDB(B0, 0, 0); PG8_SCHED; PG8_LDA(At, 0, 0); PG8_STAGE_A(PG8_SA(1, 1), a1 + hstepA, false);
      PG8_WAIT_L(8); PG8_BAR; PG8_WAIT_L(0); PG8_MMA(0, 0, At, B0); PG8_BAR; PG8_SCHED;
      PG8_LDB(B1, 0, 1); PG8_STAGE(PG8_SB(0, 0), b2);
      PG8_BAR; PG8_WAIT_L(0); PG8_MMA(0, 1, At, B1); PG8_BAR;
      PG8_LDA(At, 0, 1); PG8_STAGE_A(PG8_SA(0, 0), a2, lastn);
      PG8_BAR; PG8_WAIT_L(0); PG8_MMA(1, 0, At, B0); PG8_BAR; PG8_SCHED;
      PG8_STAGE(PG8_SB(0, 1), b2 + hstep);
      PG8_WAIT_V(6); PG8_BAR; PG8_MMA(1, 1, At, B1); PG8_BAR;
      PG8_LDB(B0, 1, 0); PG8_SCHED; PG8_LDA(At, 1, 0); PG8_STAGE_A(PG8_SA(0, 1), a2 + hstepA, lastn);
      PG8_WAIT_L(8); PG8_BAR; PG8_WAIT_L(0); PG8_MMA(0, 0, At, B0); PG8_BAR; PG8_SCHED;
      PG8_LDB(B1, 1, 1); PG8_STAGE(PG8_SB(1, 0), b3);
      PG8_BAR; PG8_WAIT_L(0); PG8_MMA(0, 1, At, B1); PG8_BAR;
      PG8_LDA(At, 1, 1); PG8_STAGE_A(PG8_SA(1, 0), a3, lastn);
      PG8_BAR; PG8_WAIT_L(0); PG8_MMA(1, 0, At, B0); PG8_BAR; PG8_SCHED;
      PG8_STAGE(PG8_SB(1, 1), b3 + hstep);
      PG8_WAIT_V(6); PG8_BAR; PG8_MMA(1, 1, At, B1); PG8_BAR;
    }
    if (wr == 0) PG8_BAR;
    bool keep;
    { int fr2 = fr, fq2 = fq; asm volatile("" : "+v"(fr2), "+v"(fq2));
      keep = E(acc, cur, wr, wc, fr2, fq2); }
    if (!has_next) break;
    if (!keep)
#pragma unroll
    for (int a = 0; a < 2; ++a)
#pragma unroll
      for (int b = 0; b < 2; ++b)
#pragma unroll
        for (int m = 0; m < 4; ++m)
#pragma unroll
          for (int n = 0; n < 2; ++n) acc[a][b][m][n] = (f32x4){0.f, 0.f, 0.f, 0.f};
    cur = nxt; cA = nA; cB = nB; ++ui;
    if constexpr (GA) {
#pragma unroll
      for (int h = 0; h < 2; ++h)
#pragma unroll
        for (int i = 0; i < 2; ++i) cvA[h][i] = nvA[h][i];
    }
    if (wr == 1) PG8_BAR;
  }
  PG8_WAIT_V(0);
  PG8_BAR;
#undef PG8_SA
#undef PG8_SB
#undef PG8_STAGE
#undef PG8_STAGE_
#undef PG8_STAGE_A
#undef PG8_LDA
#undef PG8_LDB
#undef PG8_MMA
#undef PG8_WAIT_V
#undef PG8_WAIT_L
#undef PG8_BAR
#undef PG8_SCHED
}
template <class F>
__device__ __forceinline__ void epi_each(const f32x4 (&acc)[2][2][4][2], int wr, int wc, int fr, int fq, const F& f) {
#pragma unroll
  for (int ai = 0; ai < 2; ++ai)
#pragma unroll
    for (int m = 0; m < 4; ++m)
#pragma unroll
      for (int bj = 0; bj < 2; ++bj) f(ai * HALF + wr * 64 + m * 16 + fr, bj * HALF + wc * 32 + 8 * fq, acc[ai][bj][m][0], acc[ai][bj][m][1]);
}
struct GridSched {
  const char* A; const char* B; size_t tstep; int nM, nN, nwg, G, c, pm0;
  __device__ __forceinline__ void init(const void* A_, const void* B_, int K, int nM_, int nN_, int pm0_, int G_, int c_) {
    A = (const char*)A_; B = (const char*)B_; tstep = (size_t)BM * K * 2; nM = nM_; nN = nN_; nwg = nM * nN; G = G_; c = c_; pm0 = pm0_;
  }
  __device__ __forceinline__ bool next(int i, Unit& u) const {
    const long L = (long)i * G + c; if (L >= nwg) return false;
    int wgid = (int)L; { const int q = nwg / NXCD, r = nwg % NXCD, xcd = wgid % NXCD, off = wgid / NXCD; wgid = (xcd < r ? xcd * (q + 1) : r * (q + 1) + (xcd - r) * q) + off; }
    const int nig = WGM * nN, gid = wgid / nig, fm = gid * WGM, gsz = (nM - fm) < WGM ? (nM - fm) : WGM;
    u.pm = pm0 + fm + ((wgid % nig) % gsz); u.pn = (wgid % nig) / gsz; u.z = 0; return true;
  }
  __device__ __forceinline__ const char* aptr(const Unit& u) const { return A + (size_t)u.pm * tstep; }
  __device__ __forceinline__ const char* bptr(const Unit& u) const { return B + (size_t)u.pn * tstep; }
};
}
using pg8::Unit;


#define XB_TMO      128
#define XB_XCNT(j)  (256  + 64 * (j))
#define XB_XSUB(j)  (1280 + 64 * (j))
#define XB_XGEN(j)  (2304 + 64 * (j))
#define XB_TOP      3328
#define XB_TOPGEN   3392
#define XB_SPIN_CAP (1u << 18)
__device__ __forceinline__ unsigned xb_ld(unsigned* p)              { return __hip_atomic_load(p, __ATOMIC_RELAXED, __HIP_MEMORY_SCOPE_AGENT); }
__device__ __forceinline__ unsigned xb_add(unsigned* p, unsigned v) { return __hip_atomic_fetch_add(p, v, __ATOMIC_RELAXED, __HIP_MEMORY_SCOPE_AGENT); }
__device__ __forceinline__ unsigned xb_xcc_id() { return (unsigned)__builtin_amdgcn_s_getreg((3 << 11) | 20) & 0xFu; }
#define XB_SPIN(cond, bar) do { unsigned _sp = 0; while (cond) { __builtin_amdgcn_s_sleep(1); \
    if ((++_sp & 255u) == 0u) { if (xb_ld(&(bar)[XB_TMO])) break; if (_sp > XB_SPIN_CAP) { atomicAdd(&(bar)[XB_TMO], 1u); break; } } } } while (0)
struct XcdBarrier { unsigned* bar; unsigned x; volatile PG8_LAS unsigned* st; };
__device__ __forceinline__ XcdBarrier xcd_barrier_post(unsigned* bar, volatile PG8_LAS unsigned* st) {
  XcdBarrier b; b.bar = bar; b.x = xb_xcc_id(); b.st = st;
  if (threadIdx.x == 0) (void)xb_add(&bar[XB_XCNT(b.x)], 1u);
  return b;
}
__device__ __forceinline__ void xcd_barrier_complete(unsigned* bar, unsigned x, unsigned& nloc, unsigned& nx) {
  const unsigned G = gridDim.x * gridDim.y * gridDim.z;
  unsigned sum, cnt, mine, sp = 0u;
  for (;;) {
    sum = 0u; cnt = 0u; mine = 0u;
#pragma unroll
    for (unsigned j = 0; j < 16; ++j) { const unsigned c = xb_ld(&bar[XB_XCNT(j)]); sum += c; cnt += (c > 0u) ? 1u : 0u; mine = (j == x) ? c : mine; }
    if (sum == G) break;
    __builtin_amdgcn_s_sleep(1);
    if ((++sp & 255u) == 0u) { if (xb_ld(&bar[XB_TMO])) break; if (sp > XB_SPIN_CAP) { atomicAdd(&bar[XB_TMO], 1u); break; } }
  }
  nloc = mine > 0u ? mine : 1u; nx = cnt > 0u ? cnt : 1u;
}
__device__ __forceinline__ void xcd_barrier(const XcdBarrier& b) {
  asm volatile("s_waitcnt vmcnt(0)" ::: "memory");
  __syncthreads();
  if (threadIdx.x == 0) {
    unsigned* bar = b.bar;
    __builtin_amdgcn_s_waitcnt(0);
    unsigned nloc = b.st[0], nx = b.st[1];
    if (nloc == 0u) { xcd_barrier_complete(bar, b.x, nloc, nx); b.st[0] = nloc; b.st[1] = nx; }
    const unsigned old = xb_add(&bar[XB_XSUB(b.x)], 1u);
    const unsigned gen = old / nloc;
    if (old + 1u == (gen + 1u) * nloc) {
      __builtin_amdgcn_fence(__ATOMIC_RELEASE, "agent");
      asm volatile("s_waitcnt vmcnt(0)" ::: "memory");
      const unsigned og = xb_add(&bar[XB_TOP], 1u);
      const unsigned tg = og / nx;
      if (og + 1u == (tg + 1u) * nx) xb_add(&bar[XB_TOPGEN], 1u);
      else XB_SPIN(xb_ld(&bar[XB_TOPGEN]) == tg, bar);
      __builtin_amdgcn_fence(__ATOMIC_ACQUIRE, "agent");
      xb_add(&bar[XB_XGEN(b.x)], 1u);
      asm volatile("s_waitcnt vmcnt(0)" ::: "memory");
    } else {
      XB_SPIN(xb_ld(&bar[XB_XGEN(b.x)]) == gen, bar);
      __builtin_amdgcn_fence(__ATOMIC_ACQUIRE, "agent");
      asm volatile("s_waitcnt vmcnt(0)" ::: "memory");
    }
  }
  __syncthreads();
}


__device__ __forceinline__ void sub_barrier(unsigned* cnt, int nb) {
  asm volatile("s_waitcnt vmcnt(0)" ::: "memory");
  __syncthreads();
  if (threadIdx.x == 0) {
    __builtin_amdgcn_fence(__ATOMIC_RELEASE, "agent");
    asm volatile("s_waitcnt vmcnt(0)" ::: "memory");
    (void)xb_add(cnt, 1u);
    unsigned sp = 0;
    while (xb_ld(cnt) < (unsigned)nb && ++sp < (1u << 20)) __builtin_amdgcn_s_sleep(1);
    __builtin_amdgcn_fence(__ATOMIC_ACQUIRE, "agent");
    asm volatile("s_waitcnt vmcnt(0)" ::: "memory");
  }
  __syncthreads();
}

template <class LA, class LB>
__device__ __forceinline__ void gemm_main(f32x4 (&acc)[4][4], const int nk, const LA& la, const LB& lb, char* lds, const int t) {
  const int lane = t & 63, wid = t >> 6, fr = lane & 15, fq = lane >> 4, wr = wid >> 1, wc = wid & 1;
  const int sr = t >> 3, sc = t & 7;
  const int wofs = sr * 128 + ((sc ^ (sr & 7)) << 4);
  const int aofs = (wr * 64 + fr) * 128, bofs = 16384 + (wc * 64 + fr) * 128;
  const int x0 = ((fq) ^ (fr & 7)) << 4, x1 = ((4 + fq) ^ (fr & 7)) << 4;
  bf16x8 ra[4], rb[4];
#pragma unroll
  for (int i = 0; i < 4; ++i) { ra[i] = la(i, 0); rb[i] = lb(i, 0); }
#pragma unroll
  for (int i = 0; i < 4; ++i) { *(bf16x8*)(lds + wofs + i * 4096) = ra[i]; *(bf16x8*)(lds + 16384 + wofs + i * 4096) = rb[i]; }
  __syncthreads();
  for (int kt = 0; kt < nk; ++kt) {
    const char* cur = lds + (kt & 1) * 32768;
    const bool more = kt + 1 < nk;
    if (more) {
#pragma unroll
      for (int i = 0; i < 4; ++i) { ra[i] = la(i, (kt + 1) * 64); rb[i] = lb(i, (kt + 1) * 64); }
    }
#pragma unroll
    for (int kk = 0; kk < 2; ++kk) {
      const int xo = kk ? x1 : x0;
      bf16x8 af[4], bv[4];
#pragma unroll
      for (int m = 0; m < 4; ++m) af[m] = *(const bf16x8*)(cur + aofs + m * 2048 + xo);
#pragma unroll
      for (int n = 0; n < 4; ++n) bv[n] = *(const bf16x8*)(cur + bofs + n * 2048 + xo);
#pragma unroll
      for (int m = 0; m < 4; ++m)
#pragma unroll
        for (int n = 0; n < 4; ++n) acc[m][n] = __builtin_amdgcn_mfma_f32_16x16x32_bf16(bv[n], af[m], acc[m][n], 0, 0, 0);
    }
    if (more) {
      char* nxt = lds + ((kt + 1) & 1) * 32768;
#pragma unroll
      for (int i = 0; i < 4; ++i) { *(bf16x8*)(nxt + wofs + i * 4096) = ra[i]; *(bf16x8*)(nxt + 16384 + wofs + i * 4096) = rb[i]; }
    }
    __syncthreads();
  }
}
__device__ __forceinline__ void zero_acc(f32x4 (&acc)[4][4]) {
#pragma unroll
  for (int m = 0; m < 4; ++m)
#pragma unroll
    for (int n = 0; n < 4; ++n) acc[m][n] = (f32x4){0.f, 0.f, 0.f, 0.f};
}
template <class EP>
__device__ __forceinline__ void gemm_epi(const f32x4 (&acc)[4][4], const EP& ep, const int t) {
  const int lane = t & 63, wid = t >> 6, fr = lane & 15, fq = lane >> 4, wr = wid >> 1, wc = wid & 1;
#pragma unroll
  for (int m = 0; m < 4; ++m)
#pragma unroll
    for (int n = 0; n < 4; ++n) ep(wr * 64 + m * 16 + fr, wc * 64 + n * 16 + fq * 4, acc[m][n]);
}
struct RowLd {
  const bf16_t* p[4];
  __device__ __forceinline__ RowLd(const bf16_t* base, size_t r0, size_t ld, const int t) {
#pragma unroll
    for (int i = 0; i < 4; ++i) p[i] = base + (r0 + (t >> 3) + 32 * i) * ld + (t & 7) * 8;
  }
  __device__ __forceinline__ bf16x8 operator()(int i, int k0) const { return *(const bf16x8*)(p[i] + k0); }
};

__device__ __forceinline__ void phase_setup(const Params& p, char* lds, int wid0) {
  float* tab = (float*)lds;
  float* sv = (float*)(lds + 16384);
  float* red = (float*)(lds + 16384 + 36864);
  const int tid = opaque_tid(wid0);
  float* mod = (float*)(p.ws + O_MOD);
  bf16_t* FTL = (bf16_t*)(p.ws + O_FTL);
  bool have_tab = false;
  const int NMOD = 192, NITEM = NMOD + 4096 + 1;
  for (int item = blockIdx.x; item < NITEM; item += gridDim.x) {
    if (item < NMOD) {
      const int l = item / 96, n = (item % 96) * 64 + (tid & 63), kp = tid >> 6;
      for (int e = tid; e < 9 * 1024; e += NTHREADS) {
        const int r = e >> 10, k = e & 1023;
        const float v = r < 8 ? p.c[r * 1024 + k] : p.c_ctx[k];
        sv[e] = v / (1.0f + __expf(-v));
      }
      __syncthreads();
      float acc[9];
#pragma unroll
      for (int r = 0; r < 9; ++r) acc[r] = 0.f;
      const float* w = p.ada_w + (size_t)l * 1024 * 6144 + n;
#pragma unroll 8
      for (int k = kp * 128; k < kp * 128 + 128; ++k) {
        const float wv = w[(size_t)k * 6144];
#pragma unroll
        for (int r = 0; r < 9; ++r) acc[r] += sv[r * 1024 + k] * wv;
      }
#pragma unroll
      for (int r = 0; r < 9; ++r) red[(kp * 9 + r) * 64 + (tid & 63)] = acc[r];
      __syncthreads();
      for (int e = tid; e < 9 * 64; e += NTHREADS) {
        const int r = e >> 6, c = e & 63;
        float a = 0.f;
#pragma unroll
        for (int q8 = 0; q8 < 8; ++q8) a += red[(q8 * 9 + r) * 64 + c];
        const int nn = (item % 96) * 64 + c;
        mod[(l * 9 + r) * 6144 + nn] = a + p.ada_b[l * 6144 + nn];
      }
      __syncthreads();
    } else {
      if (!have_tab) {
        for (int j = tid; j < 4096; j += NTHREADS) tab[j] = cospif((float)j * (1.0f / 2048.0f));
        __syncthreads();
        have_tab = true;
      }
      if (item < NMOD + 4096) {
        const int k = (item - NMOD) & 2047, part = (item - NMOD) >> 11;
        const float scale = 0.0013810679320049757f;
        for (int e8 = tid; e8 < KH / 8; e8 += NTHREADS) {
          float v[8];
#pragma unroll
          for (int jx = 0; jx < 8; ++jx) {
            const int t = e8 * 8 + jx, jj = (k * t) & 4095;
            if (part == 0) v[jx] = t <= 2048 ? tab[jj] * scale : 0.f;
            else v[jx] = t < 2048 ? -tab[(jj - 1024) & 4095] * scale : 0.f;
          }
          u32x4 w;
          w.x = pk_bf16(v[0], v[1]); w.y = pk_bf16(v[2], v[3]); w.z = pk_bf16(v[4], v[5]); w.w = pk_bf16(v[6], v[7]);
          *(u32x4*)(FTL + ((size_t)part * 2048 + k) * KH + e8 * 8) = w;
        }
      } else {
        bf16_t* FTC = (bf16_t*)(p.ws + O_FTC);
        bf16_t* CS = (bf16_t*)(p.ws + O_CS);
        const float scale_c = 0.005524271728019903f;
        for (int e = tid; e < 256 * 512; e += NTHREADS) {
          const int k = e >> 9, cs = (e >> 8) & 1, t = e & 255;
          const int jj = ((k * t) & 255) * 16;
          FTC[e] = f2bf((cs == 0 ? tab[jj] : -tab[(jj - 1024) & 4095]) * scale_c);
        }
        for (int e = tid; e < 256 * 128; e += NTHREADS) {
          const int row = e >> 7, d = e & 127, cs = row >> 7, m = row & 127;
          const int jj = ((m * d) & 127) * 32;
          CS[e] = f2bf(cs == 0 ? tab[jj] : tab[(jj - 1024) & 4095]);
        }
        float* lb = (float*)(p.ws + O_LB);
        for (int e = tid; e < 2 * 512; e += NTHREADS) {
          const int dir = e >> 9, ch = e & 511;
          const float r0 = p.lb_raw[(dir * 2 + 0) * 512 + ch], r1 = p.lb_raw[(dir * 2 + 1) * 512 + ch];
          const float mx = fmaxf(r0, r1), e0 = expf(r0 - mx), e1 = expf(r1 - mx);
          const float p0 = e0 / (e0 + e1), p1 = e1 / (e0 + e1);
          lb[(dir * 2 + 0) * 512 + ch] = p0 - p0;
          lb[(dir * 2 + 1) * 512 + ch] = (p0 + p1) - p0;
        }
      }
    }
  }
  __syncthreads();
}

constexpr size_t OUT_W13B = (size_t)NL * D * 2;
template <bool VMAP>
__device__ __forceinline__ void conv_items(const Params& p, int l, char* lds, int wid0, const int lo, const int hi, const int r, const int n) {
  const int tid = opaque_tid(wid0);
  float* tile = (float*)lds;
  struct Item { const float* src; bf16_t* dst; int K, N, n0, k0, drow0; };
  auto decode = [&](int item) -> Item {
    int i = item;
    if (VMAP) {
      if (p.w2sep) i = i < 2048 ? i + 608 : i < 2496 ? i - 2048 : i < 3520 ? i + 160 : i - 3072;
      else i = i < 2048 ? i + 608 : i < 2656 ? i - 2048 : i;
    }
    Item it;
    bool w13 = false;
    if (i < 448) {
      it.src = p.w_in + (size_t)l * 1024 * INC; it.dst = (bf16_t*)(p.ws + O_WIN); it.K = 1024; it.N = INC;
    } else if ((i -= 448) < 96) {
      const int j = i / 32; i -= j * 32;
      it.src = p.w_branch + ((size_t)l * 3 + j) * 512 * 1024; it.dst = (bf16_t*)(p.ws + O_WBR) + (size_t)j * 1024 * 512; it.K = 512; it.N = 1024;
    } else if ((i -= 96) < 64) {
      it.src = p.w_out + (size_t)l * 1024 * 1024; it.dst = (bf16_t*)(p.ws + O_WOUT); it.K = 1024; it.N = 1024;
    } else if ((i -= 64) < 2048) {
      const int e = i / 128; i -= e * 128;
      it.src = p.w13 + ((size_t)l * 16 + e) * 1024 * 2048;
      it.dst = (l == 1 ? (bf16_t*)((char*)p.out + OUT_W13B) : (bf16_t*)(p.ws + O_W13)) + (size_t)e * 2048 * 1024; it.K = 1024; it.N = 2048; w13 = true;
    } else {
      i -= 2048;
      const int e = i / 64; i -= e * 64;
      it.src = p.w2 + ((size_t)l * 16 + e) * 1024 * 1024; it.dst = (bf16_t*)(p.ws + (l == 1 && p.w2sep ? O_W2B : O_W2)) + (size_t)e * 1024 * 1024; it.K = 1024; it.N = 1024;
    }
    const int nkt = it.K / 128;
    it.n0 = (i / nkt) * 128; it.k0 = (i % nkt) * 128;
    it.drow0 = w13 ? (((it.n0 & 1023) >> 7) * 256 + (it.n0 >> 10) * 128) : it.n0;
    return it;
  };
  f32x4 pf[8];
  auto fetch = [&](const Item& it) {
#pragma unroll
    for (int q = 0; q < 8; ++q) pf[q] = *(const f32x4*)(it.src + (size_t)(it.k0 + q * 16 + (tid >> 5)) * it.N + it.n0 + (tid & 31) * 4);
  };
  int rr = r; asm volatile("" : "+s"(rr));
  const int item0 = lo + rr;
  Item cur = decode(item0 < hi ? item0 : lo);
  if (item0 < hi) fetch(cur);
  for (int item = item0; item < hi; item += n) {
#pragma unroll
    for (int q = 0; q < 8; ++q) {
      const int kk = q * 16 + (tid >> 5), nn = (tid & 31) * 4;
      tile[(nn + 0) * 129 + kk] = pf[q][0]; tile[(nn + 1) * 129 + kk] = pf[q][1]; tile[(nn + 2) * 129 + kk] = pf[q][2]; tile[(nn + 3) * 129 + kk] = pf[q][3];
    }
    const Item me = cur;
    if (item + n < hi) { cur = decode(item + n); fetch(cur); }
    __syncthreads();
#pragma unroll
    for (int q2 = 0; q2 < 4; ++q2) {
      const int q = tid + q2 * 512, nn = q >> 4, kc = (q & 15) * 8;
      const float* tp = tile + nn * 129 + kc;
      u32x4 w;
      w.x = pk_bf16(tp[0], tp[1]); w.y = pk_bf16(tp[2], tp[3]); w.z = pk_bf16(tp[4], tp[5]); w.w = pk_bf16(tp[6], tp[7]);
      *(u32x4*)(me.dst + (size_t)(me.drow0 + nn) * me.K + me.k0 + kc) = w;
    }
    __syncthreads();
  }
}
__device__ __forceinline__ void phase_conv(const Params& p, int l, char* lds, int wid0) { conv_items<false>(p, l, lds, wid0, 0, 3680, blockIdx.x, gridDim.x); }
constexpr int CF_S0 = 2304, CF_S2 = 320;
__device__ __forceinline__ void conv_fill(const Params& p, char* lds, int wid0, const int slot, const int r, const int n) {
  const bool tuned = gridDim.x == 256;
  int a, b;
  int c0 = CF_S0, c2 = CF_S0 + CF_S2;
  if (!p.w2sep) { c0 = c0 < 2496 ? c0 : 2496; c2 = c2 < 2656 ? c2 : 2656; }
  if (slot == 0) { a = 0; b = c0; } else if (slot == 2) { a = c0; b = c2; } else { a = c2; b = 3680; }
  if (slot < 4) { if (!tuned) return; }
  else if (!tuned) a = 0;
  conv_items<true>(p, 1, lds, wid0, a, b, r, n);
}
__device__ __forceinline__ void phase_rowA(const Params& p, int l, int wid0) {
  const int tid = opaque_tid(wid0), wid = tid >> 6, lane = tid & 63;
  const float* xlat = l == 0 ? p.x : p.out;
  const float* xctx = l == 0 ? p.ctx : (const float*)(p.ws + O_CTXB);
  const float* mod = (const float*)(p.ws + O_MOD);
  bf16_t* H = (bf16_t*)(p.ws + O_H);
  const float* nw = p.norm_w + (size_t)(l * 4 + 0) * 1024;
  for (int row = blockIdx.x * NWAVE + wid; row < NT; row += gridDim.x * NWAVE) {
    const float* xr = row < NL ? xlat + (size_t)row * 1024 : xctx + (size_t)(row - NL) * 1024;
    const int mr = row < NL ? (row >> 12) : 8;
    const float* md = mod + (size_t)(l * 9 + mr) * 6144;
    f32x4 v[4];
    float ss = 0.f;
#pragma unroll
    for (int i = 0; i < 4; ++i) {
      v[i] = *(const f32x4*)(xr + i * 256 + lane * 4);
      ss += v[i][0] * v[i][0] + v[i][1] * v[i][1] + v[i][2] * v[i][2] + v[i][3] * v[i][3];
    }
    ss = wave_sum(ss);
    const float rs = rsqrtf(ss * (1.0f / 1024.0f) + 1e-6f);
#pragma unroll
    for (int i = 0; i < 4; ++i) {
      const int e = i * 256 + lane * 4;
      const f32x4 w = *(const f32x4*)(nw + e), sh = *(const f32x4*)(md + e), sc = *(const f32x4*)(md + 1024 + e);
      f32x4 o;
#pragma unroll
      for (int j = 0; j < 4; ++j) o[j] = v[i][j] * rs * w[j] * (1.0f + sc[j]) + sh[j];
      st4bf(H + (size_t)row * 1024 + e, o);
    }
  }
}

struct EpiGin {
  char* ws; const float* lbp; int l; int pn0;
  __device__ __forceinline__ bool operator()(f32x4 (&acc)[2][2][4][2], const Unit& u, int wr, int wc, int fr, int fq) const {
    const int pn = u.pn + pn0;
    const int sec = pn >> 1, cin0 = (pn & 1) * 256;
    const size_t row0 = (size_t)u.pm * 256;
    if (sec >= 8) {
      const int tl = (wr * 4 + wc) * 64 + fq * 16 + fr;
      unsigned char* GT = (unsigned char*)(ws + O_G) + ((size_t)u.pm * 12 + (pn - 16)) * 65536 + (size_t)tl * 8;
      auto q8 = [](float z) { return __builtin_amdgcn_rcpf(__builtin_fmaf(__expf(-z), 0.00390625f, 0.00390625f)); };
#pragma unroll
      for (int ai = 0; ai < 2; ++ai)
#pragma unroll
        for (int m = 0; m < 4; ++m)
#pragma unroll
          for (int bj = 0; bj < 2; ++bj) {
            const f32x4 a = acc[ai][bj][m][0], b = acc[ai][bj][m][1];
            u32x2 w; w.x = 0u; w.y = 0u;
#pragma unroll
            for (int j = 0; j < 4; ++j) { w.x = __builtin_amdgcn_cvt_pk_u8_f32(q8(a[j]), j, w.x); w.y = __builtin_amdgcn_cvt_pk_u8_f32(q8(b[j]), j, w.y); }
            *(u32x2*)(GT + (size_t)((ai * 4 + m) * 2 + bj) * 4096) = w;
          }
    } else if (sec == 7) {
      bf16_t* VT = (bf16_t*)(ws + O_VT);
      pg8::epi_each(acc, wr, wc, fr, fq, [&](int r, int c, f32x4 v0, f32x4 v1) {
        const int chunk = u.pm * 2 + (r >> 7), q = r & 127, g = (cin0 + c) >> 7, d = c & 127;
        bf16_t* dst = VT + (((size_t)chunk * 4 + g) * 128 + d) * 128 + q;
#pragma unroll
        for (int j = 0; j < 4; ++j) { dst[j * 128] = f2bf(geluf_(v0[j])); dst[(4 + j) * 128] = f2bf(geluf_(v1[j])); }
      });
    } else if (sec == 1 || sec == 2) {
      bf16_t* LF = (bf16_t*)(ws + (sec == 1 ? O_LFF : O_LFB)) + row0 * 512 + cin0;
      const float* lbv = lbp + ((sec - 1) * 2 + l) * 512 + cin0;
      pg8::epi_each(acc, wr, wc, fr, fq, [&](int r, int c, f32x4 v0, f32x4 v1) {
        const f32x4 b0 = *(const f32x4*)(lbv + c), b1 = *(const f32x4*)(lbv + c + 4);
        f32x4 o0, o1;
#pragma unroll
        for (int j = 0; j < 4; ++j) {
          o0[j] = 1.0f - (fmaxf(b0[j], 1e-20f) + (1.0f - b0[j]) * sigmoidf_(v0[j]));
          o1[j] = 1.0f - (fmaxf(b1[j], 1e-20f) + (1.0f - b1[j]) * sigmoidf_(v1[j]));
        }
        st8bf(LF + (size_t)r * 512 + c, o0, o1);
      });
    } else {
      const size_t off = sec == 0 ? O_Q : sec == 3 ? O_I : sec == 4 ? O_GA : sec == 5 ? O_ZB : O_U;
      bf16_t* dst = (bf16_t*)(ws + off) + row0 * 512 + cin0;
      const int act = (sec == 0 || sec == 4) ? 1 : (sec == 6 ? 2 : 0);
      pg8::epi_each(acc, wr, wc, fr, fq, [&](int r, int c, f32x4 v0, f32x4 v1) {
        f32x4 o0, o1;
#pragma unroll
        for (int j = 0; j < 4; ++j) {
          o0[j] = act == 1 ? siluf_(v0[j]) : act == 2 ? geluf_(v0[j]) : v0[j];
          o1[j] = act == 1 ? siluf_(v1[j]) : act == 2 ? geluf_(v1[j]) : v1[j];
        }
        st8bf(dst + (size_t)r * 512 + c, o0, o1);
      });
    }
    return false;
  }
};
constexpr int GIN_R0 = 0;
__device__ __forceinline__ void phase_gin(const Params& p, int l, char* lds, int wid0) {
  const int tid = opaque_tid(wid0);
  PG8_LAS unsigned char* L = (PG8_LAS unsigned char*)lds;
  EpiGin E{p.ws, (const float*)(p.ws + O_LB), l, 0};
  pg8::GridSched S;
  const int R0 = gridDim.x == 256 ? GIN_R0 : 0;
  S.init(p.ws + O_H, p.ws + O_WIN, 1024, (l == 0 ? 136 : 128) - R0, 28, R0, gridDim.x, blockIdx.x);
  pg8::gemm_phase(L, 1024, S, E, tid);
  S.init(p.ws + O_H, p.ws + O_WIN, 1024, R0, 16, 0, gridDim.x, blockIdx.x);
  pg8::gemm_phase(L, 1024, S, E, tid);
  if (l == 1) {
    S.init(p.ws + O_H, p.ws + O_WIN, 1024, 8, 8, 128, gridDim.x, (blockIdx.x + gridDim.x / 2) % gridDim.x);
    pg8::gemm_phase(L, 1024, S, E, tid);
  }
}

__device__ __forceinline__ void phase_mix1(const Params& p, int l, char* lds0, int wid0, int kind, int bfirst, int bi_o = -1, int nb_o = 0) {
  const bool last = (l == 1);
  const int tid = opaque_tid(wid0), t = tid & 255, half = tid >> 8;
  char* lds = lds0 + half * 65536;
  const bf16_t* CS = (const bf16_t*)(p.ws + O_CS);
  const bf16_t* ZB = (const bf16_t*)(p.ws + O_ZB);
  const int NF1L = 2048, NF1C = last ? 0 : 128, NCH = last ? 256 : 272;
  const int ITEM0 = kind == 0 ? 0 : NF1L + NF1C, NITEM = kind == 0 ? NF1L + NF1C : NF1L + NF1C + NCH * 4;
  const int bi = nb_o > 0 ? bi_o : (int)blockIdx.x - bfirst, nb = nb_o > 0 ? nb_o : (int)gridDim.x - bfirst;
  if (bi < 0) return;
  for (int item = ITEM0 + bi * 2 + half; item < NITEM; item += nb * 2) {
    f32x4 acc[4][4];
    zero_acc(acc);
    if (item < NF1L + NF1C) {
      const bool isl = item < NF1L;
      int i = isl ? item : item - NF1L;
      const int mh = i & 1;
      i >>= 1;
      int tt, g, b;
      if (isl) { tt = i & 31; i >>= 5; } else { tt = i & 1; i >>= 1; }
      g = i & 3; b = i >> 2;
      const size_t rowbase = isl ? (size_t)b * 4096 + tt * 128 : (size_t)NL + b * 256 + tt * 128;
      RowLd la(CS, mh * 128, 128, t), lb(ZB + g * 128, rowbase, 512, t);
      gemm_main(acc, 2, la, lb, lds, t);
      bf16_t* dst = isl ? (bf16_t*)(p.ws + O_ZCL) + ((size_t)b * 512 + g * 128) * 8192 + mh * 4096 + tt * 128
                        : (bf16_t*)(p.ws + O_ZCC) + ((size_t)b * 512 + g * 128) * 512 + mh * 256 + tt * 128;
      const size_t ld = isl ? 8192 : 512;
      gemm_epi(acc, [&](int r, int c, f32x4 v) { st4bf(dst + (size_t)r * ld + c, v); }, t);
    } else {
      const int i = item - (NF1L + NF1C), ch = i >> 2, g = i & 3;
      const bf16_t* VT = (const bf16_t*)(p.ws + O_VT) + ((size_t)ch * 4 + g) * 128 * 128;
      float* rstd = (float*)lds;
      if (t < 128) {
        float ss = 0.f;
        for (int d = 0; d < 128; ++d) {
          const float v = bf2f(VT[d * 128 + t]);
          ss += v * v;
        }
        rstd[t] = rsqrtf(ss * (1.0f / 128.0f) + 1e-6f);
      }
      __syncthreads();
      const float* wsg = p.sgu_w + ((size_t)l * 4 + g) * 128 * 128;
      const int kc = (t & 7) * 8;
      float rr[2][8];
#pragma unroll
      for (int h2 = 0; h2 < 2; ++h2)
#pragma unroll
        for (int j = 0; j < 8; ++j) rr[h2][j] = rstd[h2 * 64 + kc + j];
      __syncthreads();
      auto la = [&](int ii, int k0) -> bf16x8 {
        const float* s = wsg + (size_t)((t >> 3) + 32 * ii) * 128 + k0 + kc;
        const f32x4 a = *(const f32x4*)s, b = *(const f32x4*)(s + 4);
        const int h2 = k0 >> 6;
        u32x4 w;
        w.x = pk_bf16(a[0] * (h2 ? rr[1][0] : rr[0][0]), a[1] * (h2 ? rr[1][1] : rr[0][1]));
        w.y = pk_bf16(a[2] * (h2 ? rr[1][2] : rr[0][2]), a[3] * (h2 ? rr[1][3] : rr[0][3]));
        w.z = pk_bf16(b[0] * (h2 ? rr[1][4] : rr[0][4]), b[1] * (h2 ? rr[1][5] : rr[0][5]));
        w.w = pk_bf16(b[2] * (h2 ? rr[1][6] : rr[0][6]), b[3] * (h2 ? rr[1][7] : rr[0][7]));
        return __builtin_bit_cast(bf16x8, w);
      };
      RowLd lb(VT, 0, 128, t);
      gemm_main(acc, 2, la, lb, lds, t);
      bf16_t* U = (bf16_t*)(p.ws + O_U) + (size_t)ch * 128 * 512 + g * 128;
      const float* nwv = p.sgu_norm_w + ((size_t)l * 4 + g) * 128;
      const float* sb = p.sgu_b + ((size_t)l * 4 + g) * 128;
      gemm_epi(acc, [&](int r, int c, f32x4 v) {
        const f32x4 nw4 = *(const f32x4*)(nwv + c);
        const float bb = sb[r];
        bf16_t* up = U + (size_t)r * 512 + c;
        const u32x2 uw = *(const u32x2*)up;
        f32x4 o;
        o[0] = bflo(uw.x) * (v[0] * nw4[0] + bb);
        o[1] = bfhi(uw.x) * (v[1] * nw4[1] + bb);
        o[2] = bflo(uw.y) * (v[2] * nw4[2] + bb);
        o[3] = bfhi(uw.y) * (v[3] * nw4[3] + bb);
        st4bf(up, o);
      }, t);
    }
  }
  __syncthreads();
}

#define SCAN_BAR() do { asm volatile("s_waitcnt lgkmcnt(0)" ::: "memory"); __builtin_amdgcn_s_barrier(); asm volatile("" ::: "memory"); } while (0)
__device__ __forceinline__ void scan_item(const Params& p, int item, char* lds, const int tid) {
  const int dir = item & 1, h = (item >> 1) & 3, b = item >> 3;
  const int wv = tid >> 6, lane = tid & 63, fr = lane & 15, fq = lane >> 4;
  const bool isP = wv < 4;
  char* RAWB = lds + 69632;
  float* qsum = (float*)(lds + 143360);
  const bf16_t* Q = (const bf16_t*)(p.ws + O_Q);
  const bf16_t* LF = (const bf16_t*)(p.ws + (dir ? O_LFB : O_LFF));
  const bf16_t* I = (const bf16_t*)(p.ws + O_I);
  bf16_t* O = (bf16_t*)(p.ws + (dir ? O_OBK : O_OF));
  auto rowOf = [&](int u) -> size_t {
    if (u < 256) return (size_t)NL + b * 256 + (dir ? 255 - u : u);
    const int v = u - 256;
    return (size_t)b * 4096 + (dir ? 4095 - v : v);
  };
  const int cp = tid & 63, tq = (tid >> 6) & 3;
  const bf16_t* srcs[3] = {LF, Q, I};
  auto dma = [&](int cc) {
    PG8_LAS unsigned char* dstb = (PG8_LAS unsigned char*)RAWB + (cc % 3) * 24576;
#pragma unroll
    for (int j = 0; j < 6; ++j) {
      const int g = j * 4 + wv, arr = g >> 3, rg = g & 7;
      const size_t o = rowOf(cc * 32 + rg * 4 + (lane >> 4)) * 512 + h * 128 + (lane & 15) * 8;
      __builtin_amdgcn_global_load_lds((const unsigned*)(srcs[arr] + o), (PG8_LAS unsigned*)(dstb + arr * 8192 + rg * 1024), 16, 0, 0);
    }
  };
  unsigned wkk[8];
  auto prepA = [&](int cc) {
    const char* raw = RAWB + (cc % 3) * 24576;
#pragma unroll
    for (int i = 0; i < 8; ++i) wkk[i] = *(const unsigned*)(raw + (tq * 8 + i) * 256 + cp * 4);
    f32x2 run = {1.f, 1.f};
#pragma unroll
    for (int i = 0; i < 8; ++i) { const f32x2 kk = {bflo(wkk[i]), bfhi(wkk[i])}; run = run * (1.0f - kk); }
    *(f32x2*)(qsum + tq * 128 + cp * 2) = run;
  };
  auto prepB = [&](int cc) {
    const char* raw = RAWB + (cc % 3) * 24576;
    char* OPB = lds + (cc & 1) * 34816;
    char* QP = OPB; char* KM = OPB + 8704; char* KT = OPB + 17408; char* VT = OPB + 25600;
    float* emid = (float*)(OPB + 33792); float* eend = emid + 128;
    unsigned wq[8], wi[8];
#pragma unroll
    for (int i = 0; i < 8; ++i) { wq[i] = *(const unsigned*)(raw + 8192 + (tq * 8 + i) * 256 + cp * 4); wi[i] = *(const unsigned*)(raw + 16384 + (tq * 8 + i) * 256 + cp * 4); }
    const f32x2 q0 = *(const f32x2*)(qsum + cp * 2), q1 = *(const f32x2*)(qsum + 128 + cp * 2), q2 = *(const f32x2*)(qsum + 256 + cp * 2), q3 = *(const f32x2*)(qsum + 384 + cp * 2);
    const f32x2 one = {1.f, 1.f};
    const f32x2 pmid = q0 * q1, pend = pmid * q2 * q3;
    const f32x2 base = tq == 0 ? one : tq == 1 ? q0 : tq == 2 ? pmid : pmid * q2;
    f32x2 rmid; rmid.x = __builtin_amdgcn_rcpf(fmaxf(pmid.x, 1e-30f)); rmid.y = __builtin_amdgcn_rcpf(fmaxf(pmid.y, 1e-30f));
    f32x2 ebm = pend * rmid; ebm.x = fminf(ebm.x, 1.0f); ebm.y = fminf(ebm.y, 1.0f);
    f32x2 run = base * rmid;
    unsigned oq[8], ok[8], kt0[4], kt1[4], vt0[4], vt1[4];
    float pk0 = 0.f, pk1 = 0.f;
#pragma unroll
    for (int i = 0; i < 8; ++i) {
      const f32x2 kk = {bflo(wkk[i]), bfhi(wkk[i])}, qv = {bflo(wq[i]), bfhi(wq[i])};
      run = run * (one - kk);
      f32x2 ea; ea.x = fminf(fmaxf(run.x, 1e-26f), 1e26f); ea.y = fminf(fmaxf(run.y, 1e-26f), 1e26f);
      f32x2 er; er.x = __builtin_amdgcn_rcpf(ea.x); er.y = __builtin_amdgcn_rcpf(ea.y);
      const f32x2 km = kk * er, qp = qv * ea, kpp = km * ebm;
      oq[i] = pk_bf16(qp.x, qp.y);
      ok[i] = pk_bf16(km.x, km.y);
      if (i & 1) {
        kt0[i >> 1] = pk_bf16(pk0, kpp.x); kt1[i >> 1] = pk_bf16(pk1, kpp.y);
        vt0[i >> 1] = (wi[i - 1] & 0xffffu) | (wi[i] << 16); vt1[i >> 1] = (wi[i - 1] >> 16) | (wi[i] & 0xffff0000u);
      } else { pk0 = kpp.x; pk1 = kpp.y; }
    }
#pragma unroll
    for (int i = 0; i < 8; ++i) { *(unsigned*)(QP + (tq * 8 + i) * 272 + cp * 4) = oq[i]; *(unsigned*)(KM + (tq * 8 + i) * 272 + cp * 4) = ok[i]; }
    u32x4 w;
    w.x = kt0[0]; w.y = kt0[1]; w.z = kt0[2]; w.w = kt0[3]; *(u32x4*)(KT + (cp * 2) * 64 + tq * 16) = w;
    w.x = kt1[0]; w.y = kt1[1]; w.z = kt1[2]; w.w = kt1[3]; *(u32x4*)(KT + (cp * 2 + 1) * 64 + tq * 16) = w;
    w.x = vt0[0]; w.y = vt0[1]; w.z = vt0[2]; w.w = vt0[3]; *(u32x4*)(VT + (cp * 2) * 64 + tq * 16) = w;
    w.x = vt1[0]; w.y = vt1[1]; w.z = vt1[2]; w.w = vt1[3]; *(u32x4*)(VT + (cp * 2 + 1) * 64 + tq * 16) = w;
    if (tq == 0) { *(f32x2*)(emid + cp * 2) = pmid; *(f32x2*)(eend + cp * 2) = pend; }
  };
  const int mw = wv - 4;
  f32x4 S[2][8];
#pragma unroll
  for (int a = 0; a < 2; ++a)
#pragma unroll
    for (int m = 0; m < 8; ++m) S[a][m] = (f32x4){0.f, 0.f, 0.f, 0.f};

  if (isP) { dma(0); dma(1); dma(2); asm volatile("s_waitcnt vmcnt(12)" ::: "memory"); }
  SCAN_BAR();
  if (isP) prepA(0);
  SCAN_BAR();
  if (isP) { prepB(0); asm volatile("s_waitcnt vmcnt(6)" ::: "memory"); }
  SCAN_BAR();
  for (int c = 0; c < 136; ++c) {
    if (isP) {
      if (c + 3 < 136) dma(c + 3);
      if (c + 1 < 136) prepA(c + 1);
      SCAN_BAR();
      if (c + 1 < 136) prepB(c + 1);
      if (c + 3 < 136) asm volatile("s_waitcnt vmcnt(6)" ::: "memory");
      else asm volatile("s_waitcnt vmcnt(0)" ::: "memory");
      SCAN_BAR();
    } else {
      const char* OPB = lds + (c & 1) * 34816;
      const char* QP = OPB; const char* KM = OPB + 8704; const char* KT = OPB + 17408; const char* VT = OPB + 25600;
      const float* emid = (const float*)(OPB + 33792); const float* eend = emid + 128;
      f32x4 PT00 = (f32x4){0.f, 0.f, 0.f, 0.f}, PT01 = PT00, PT11 = PT00;
#pragma unroll
      for (int ks = 0; ks < 4; ++ks) {
        const bf16x8 X0 = *(const bf16x8*)(KM + fr * 272 + ks * 64 + fq * 16), X1 = *(const bf16x8*)(KM + (16 + fr) * 272 + ks * 64 + fq * 16);
        const bf16x8 Y0 = *(const bf16x8*)(QP + fr * 272 + ks * 64 + fq * 16), Y1 = *(const bf16x8*)(QP + (16 + fr) * 272 + ks * 64 + fq * 16);
        PT00 = __builtin_amdgcn_mfma_f32_16x16x32_bf16(X0, Y0, PT00, 0, 0, 0);
        PT01 = __builtin_amdgcn_mfma_f32_16x16x32_bf16(X0, Y1, PT01, 0, 0, 0);
        PT11 = __builtin_amdgcn_mfma_f32_16x16x32_bf16(X1, Y1, PT11, 0, 0, 0);
      }
      SCAN_BAR();
#pragma unroll
      for (int jj = 0; jj < 4; ++jj) if (fq * 4 + jj > fr) { PT00[jj] = 0.f; PT11[jj] = 0.f; }
      u32x4 x0, x1;
      x0.x = pk_bf16(PT00[0], PT00[1]); x0.y = pk_bf16(PT00[2], PT00[3]); x0.z = 0u; x0.w = 0u;
      x1.x = pk_bf16(PT01[0], PT01[1]); x1.y = pk_bf16(PT01[2], PT01[3]); x1.z = pk_bf16(PT11[0], PT11[1]); x1.w = pk_bf16(PT11[2], PT11[3]);
      const size_t orow0 = rowOf(c * 32);
      const long ostep = dir ? -512 : 512;
#pragma unroll
      for (int a = 0; a < 2; ++a) {
        const int vcol = (mw * 2 + a) * 16 + fr;
        f32x4 o0 = (f32x4){0.f, 0.f, 0.f, 0.f}, o1 = o0;
        {
          const u32x2 vlo = *(const u32x2*)(VT + vcol * 64 + fq * 8), vhi = *(const u32x2*)(VT + vcol * 64 + 32 + fq * 8);
          u32x4 yv; yv.x = vlo.x; yv.y = vlo.y; yv.z = vhi.x; yv.w = vhi.y;
          o0 = __builtin_amdgcn_mfma_f32_16x16x32_bf16(__builtin_bit_cast(bf16x8, x0), __builtin_bit_cast(bf16x8, yv), o0, 0, 0, 0);
          o1 = __builtin_amdgcn_mfma_f32_16x16x32_bf16(__builtin_bit_cast(bf16x8, x1), __builtin_bit_cast(bf16x8, yv), o1, 0, 0, 0);
        }
#pragma unroll
        for (int ks = 0; ks < 4; ++ks) {
          const f32x4 em0 = *(const f32x4*)(emid + (2 * ks) * 16 + fq * 4), em1 = *(const f32x4*)(emid + (2 * ks + 1) * 16 + fq * 4);
          u32x4 ys;
          ys.x = pk_bf16(S[a][2 * ks][0] * em0[0], S[a][2 * ks][1] * em0[1]); ys.y = pk_bf16(S[a][2 * ks][2] * em0[2], S[a][2 * ks][3] * em0[3]);
          ys.z = pk_bf16(S[a][2 * ks + 1][0] * em1[0], S[a][2 * ks + 1][1] * em1[1]); ys.w = pk_bf16(S[a][2 * ks + 1][2] * em1[2], S[a][2 * ks + 1][3] * em1[3]);
          const u32x2 a0 = *(const u32x2*)(QP + fr * 272 + ks * 64 + fq * 8), a1 = *(const u32x2*)(QP + fr * 272 + ks * 64 + 32 + fq * 8);
          const u32x2 c0 = *(const u32x2*)(QP + (16 + fr) * 272 + ks * 64 + fq * 8), c1 = *(const u32x2*)(QP + (16 + fr) * 272 + ks * 64 + 32 + fq * 8);
          u32x4 xa, xc; xa.x = a0.x; xa.y = a0.y; xa.z = a1.x; xa.w = a1.y; xc.x = c0.x; xc.y = c0.y; xc.z = c1.x; xc.w = c1.y;
          o0 = __builtin_amdgcn_mfma_f32_16x16x32_bf16(__builtin_bit_cast(bf16x8, xa), __builtin_bit_cast(bf16x8, ys), o0, 0, 0, 0);
          o1 = __builtin_amdgcn_mfma_f32_16x16x32_bf16(__builtin_bit_cast(bf16x8, xc), __builtin_bit_cast(bf16x8, ys), o1, 0, 0, 0);
        }
        bf16_t* op = O + orow0 * 512 + h * 128 + vcol;
#pragma unroll
        for (int jj = 0; jj < 4; ++jj) {
          op[(long)(fq * 4 + jj) * ostep] = f2bf(o0[jj]);
          op[(long)(16 + fq * 4 + jj) * ostep] = f2bf(o1[jj]);
        }
        {
          const bf16x8 yv2 = *(const bf16x8*)(VT + vcol * 64 + fq * 16);
#pragma unroll
          for (int m = 0; m < 8; ++m) {
            const f32x4 ee = *(const f32x4*)(eend + m * 16 + fq * 4);
            const bf16x8 xk = *(const bf16x8*)(KT + (m * 16 + fr) * 64 + fq * 16);
            S[a][m] = __builtin_amdgcn_mfma_f32_16x16x32_bf16(xk, yv2, S[a][m] * ee, 0, 0, 0);
          }
        }
      }
      SCAN_BAR();
    }
  }
  __syncthreads();
}

struct F2Sched {
  const char* FT; const char* ZF; int G, c;
  __device__ __forceinline__ bool next(int i, Unit& u) const {
    const int P = c - 64;
    if (i > 1 || P < 0 || P >= 128) return false;
    const int loc = P >> 3; u.z = (P & 7) | (i << 3); u.pm = loc >> 1; u.pn = loc & 1; return true;
  }
  __device__ __forceinline__ const char* aptr(const Unit& u) const { return FT + (size_t)((u.z >> 3) ^ 1) * ((size_t)2048 * KH * 2) + (size_t)u.pm * ((size_t)256 * KH * 2); }
  __device__ __forceinline__ const char* bptr(const Unit& u) const { return ZF + (size_t)((u.z >> 3) ^ 1) * ((size_t)4096 * KH * 2) + ((size_t)(u.z & 7) * 512 + (size_t)u.pn * 256) * ((size_t)KH * 2); }
};
struct F2CSched {
  const char* FT; const char* ZC; int c;
  __device__ __forceinline__ bool next(int i, Unit& u) const {
    const int L = c - 192; if (i != 0 || L < 0 || L >= 16) return false;
    u.z = L >> 1; u.pm = 0; u.pn = L & 1; return true;
  }
  __device__ __forceinline__ const char* aptr(const Unit&) const { return FT; }
  __device__ __forceinline__ const char* bptr(const Unit& u) const { return ZC + (size_t)u.z * (512u * 512u * 2u) + (size_t)u.pn * (256u * 512u * 2u); }
};
struct EpiF2 {
  bf16_t* OB; int ctx; float* SX;
  __device__ __forceinline__ bool operator()(f32x4 (&acc)[2][2][4][2], const Unit& u, int wr, int wc, int fr, int fq) const {
    if (ctx) {
      bf16_t* dst = OB + ((size_t)NL + (size_t)u.z * 256) * 512 + u.pn * 256;
      pg8::epi_each(acc, wr, wc, fr, fq, [&](int r, int c, f32x4 v0, f32x4 v1) { st8bf(dst + (size_t)r * 512 + c, v0, v1); });
      return false;
    }
    const int b = u.z & 7, part = u.z >> 3;
    const int tl = (wr * 4 + wc) * 64 + fq * 16 + fr;
    float* sx = SX + ((size_t)(b + 8 * (u.pm * 2 + u.pn)) * 16) * 4096 + (size_t)tl * 8;
    bf16_t* dst = OB + (size_t)b * 4096 * 512 + u.pn * 256;
#pragma unroll
    for (int ai = 0; ai < 2; ++ai)
#pragma unroll
      for (int m = 0; m < 4; ++m)
#pragma unroll
        for (int bj = 0; bj < 2; ++bj) {
          float* q = sx + (size_t)((ai * 4 + m) * 2 + bj) * 4096;
          if (part == 0) { *(f32x4*)q = acc[ai][bj][m][0]; *(f32x4*)(q + 4) = acc[ai][bj][m][1]; }
          else {
            const f32x4 s0 = *(const f32x4*)q, s1 = *(const f32x4*)(q + 4);
            const int k = u.pm * 256 + ai * 128 + wr * 64 + m * 16 + fr, c = bj * 128 + wc * 32 + 8 * fq;
            st8bf(dst + (size_t)k * 512 + c, acc[ai][bj][m][0], acc[ai][bj][m][1]);
            if (k >= 1) st8bf(dst + (size_t)(4096 - k) * 512 + c, acc[ai][bj][m][0] - 2.0f * s0, acc[ai][bj][m][1] - 2.0f * s1);
          }
        }
    return part == 0;
  }
};
__device__ __forceinline__ void phase_fold(const Params& p, char* lds, int wid0, int bfirst) {
  const int tid = opaque_tid(wid0);
  bf16_t* zrow = (bf16_t*)lds;
  const bf16_t* ZCL = (const bf16_t*)(p.ws + O_ZCL);
  bf16_t* ZF = (bf16_t*)(p.ws + O_ZF);
  bf16_t* OB = (bf16_t*)(p.ws + O_ZB);
  float* red = (float*)(lds + 16384);
  if ((int)blockIdx.x < bfirst) return;
  for (int row = (int)blockIdx.x - bfirst; row < 8 * 512; row += (int)gridDim.x - bfirst) {
    const bf16_t* src = ZCL + (size_t)row * 8192;
#pragma unroll
    for (int i = 0; i < 2; ++i) *(u32x4*)(zrow + (tid + i * 512) * 8) = *(const u32x4*)(src + (tid + i * 512) * 8);
    __syncthreads();
    float alt = 0.f;
    for (int e8 = tid; e8 < 2 * (KH / 8); e8 += NTHREADS) {
      const int part = e8 >= KH / 8 ? 1 : 0, e = part ? e8 - KH / 8 : e8;
      float v[8];
#pragma unroll
      for (int jx = 0; jx < 8; ++jx) {
        const int t = e * 8 + jx;
        if (!part) v[jx] = t > 2048 ? 0.f : (t == 0 || t == 2048) ? bf2f(zrow[t]) : bf2f(zrow[t]) + bf2f(zrow[4096 - t]);
        else v[jx] = (t == 0 || t >= 2048) ? 0.f : bf2f(zrow[4096 + t]) - bf2f(zrow[4096 + 4096 - t]);
      }
      u32x4 w;
      w.x = pk_bf16(v[0], v[1]); w.y = pk_bf16(v[2], v[3]); w.z = pk_bf16(v[4], v[5]); w.w = pk_bf16(v[6], v[7]);
      *(u32x4*)(ZF + ((size_t)part * 4096 + row) * KH + e * 8) = w;
      if (!part) alt += (bflo(w.x) - bfhi(w.x)) + (bflo(w.y) - bfhi(w.y)) + (bflo(w.z) - bfhi(w.z)) + (bflo(w.w) - bfhi(w.w));
    }
    alt = wave_sum(alt);
    if ((tid & 63) == 0) red[tid >> 6] = alt;
    __syncthreads();
    if (tid == 0) {
      float a = 0.f;
#pragma unroll
      for (int w8 = 0; w8 < 8; ++w8) a += red[w8];
      OB[((size_t)(row >> 9) * 4096 + 2048) * 512 + (row & 511)] = f2bf(a * bf2f(f2bf(0.0013810679320049757f)));
    }
  }
}
__device__ __forceinline__ void phase_mix2(const Params& p, int l, char* lds, int wid0) {
  const int tid = opaque_tid(wid0);
  if (blockIdx.x < 64) { scan_item(p, blockIdx.x, lds, tid); return; }
  unsigned* bar = (unsigned*)(p.ws + O_BAR);
  const int nb = (int)gridDim.x - 64;
  phase_mix1(p, l, lds, wid0, 0, 64);
  sub_barrier(bar + (l * 2 + 0) * 16, nb);
  phase_fold(p, lds, wid0, 64);
  sub_barrier(bar + (l * 2 + 1) * 16, nb);
  PG8_LAS unsigned char* L = (PG8_LAS unsigned char*)lds;
  {
    F2Sched S{p.ws + O_FTL, p.ws + O_ZF, (int)gridDim.x, (int)blockIdx.x};
    EpiF2 E{(bf16_t*)(p.ws + O_ZB), 0, (float*)(p.ws + O_ZCL)};
    pg8::gemm_phase(L, KH, S, E, tid);
  }
  if (l == 0) {
    F2CSched S{p.ws + O_FTC, p.ws + O_ZCC, (int)blockIdx.x};
    EpiF2 E{(bf16_t*)(p.ws + O_ZB), 1, nullptr};
    pg8::gemm_phase(L, 512, S, E, tid);
  }
  if (blockIdx.x >= 192) { phase_mix1(p, l, lds, wid0, 1, 64, (int)blockIdx.x - 192, 512); }
  else { for (int sh = 0; sh < 4; ++sh) { const int v = 64 + ((int)blockIdx.x - 64) * 4 + sh; if (v < 512) phase_mix1(p, l, lds, wid0, 1, 64, v, 512); } }
  if (gridDim.x == 256) {
    pg8::GridSched S;
    S.init(p.ws + O_H, p.ws + O_WIN + (size_t)16 * 256 * 1024 * 2, 1024, GIN_R0, 12, 0, (int)gridDim.x - 64, (int)blockIdx.x - 64);
    EpiGin E{p.ws, (const float*)(p.ws + O_LB), l, 16};
    pg8::gemm_phase(L, 1024, S, E, tid);
  }
}

__device__ __forceinline__ void phase_oa(const Params& p, int l, int wid0) {
  const int tid = opaque_tid(wid0), wid = tid >> 6, lane = tid & 63;
  const int nrow = (l == 1) ? NL : NT;
  const bf16_t* OF = (const bf16_t*)(p.ws + O_OF);
  const bf16_t* OK = (const bf16_t*)(p.ws + O_OBK);
  bf16_t* GA = (bf16_t*)(p.ws + O_GA);
  const float* gw = p.gnorm_w + (size_t)l * 128;
  for (int row = blockIdx.x * NWAVE + wid; row < nrow; row += gridDim.x * NWAVE) {
    const size_t o = (size_t)row * 512 + lane * 8;
    const u32x4 a = *(const u32x4*)(OF + o), b = *(const u32x4*)(OK + o), g = *(const u32x4*)(GA + o);
    float v[8];
    v[0] = bflo(a.x) + bflo(b.x); v[1] = bfhi(a.x) + bfhi(b.x);
    v[2] = bflo(a.y) + bflo(b.y); v[3] = bfhi(a.y) + bfhi(b.y);
    v[4] = bflo(a.z) + bflo(b.z); v[5] = bfhi(a.z) + bfhi(b.z);
    v[6] = bflo(a.w) + bflo(b.w); v[7] = bfhi(a.w) + bfhi(b.w);
    float ss = 0.f;
#pragma unroll
    for (int j = 0; j < 8; ++j) ss += v[j] * v[j];
    ss += __shfl_xor(ss, 1); ss += __shfl_xor(ss, 2); ss += __shfl_xor(ss, 4); ss += __shfl_xor(ss, 8);
    const float rs = rsqrtf(ss * (1.0f / 128.0f) + 1e-6f);
    const float* gwp = gw + (lane & 15) * 8;
    const f32x4 w0 = *(const f32x4*)gwp, w1 = *(const f32x4*)(gwp + 4);
    float gg[8] = {bflo(g.x), bfhi(g.x), bflo(g.y), bfhi(g.y), bflo(g.z), bfhi(g.z), bflo(g.w), bfhi(g.w)};
    u32x4 w;
    w.x = pk_bf16(v[0] * rs * w0[0] * gg[0], v[1] * rs * w0[1] * gg[1]);
    w.y = pk_bf16(v[2] * rs * w0[2] * gg[2], v[3] * rs * w0[3] * gg[3]);
    w.z = pk_bf16(v[4] * rs * w1[0] * gg[4], v[5] * rs * w1[1] * gg[5]);
    w.w = pk_bf16(v[6] * rs * w1[2] * gg[6], v[7] * rs * w1[3] * gg[7]);
    *(u32x4*)(GA + o) = w;
  }
}

#define HC_MERGE 136
#define HC_MOE1  152
__device__ __forceinline__ void hc_publish(unsigned* cnt) {
  asm volatile("s_waitcnt vmcnt(0)" ::: "memory");
  __syncthreads();
  if (threadIdx.x == 0) { __threadfence(); (void)xb_add(cnt, 1u); }
}
__device__ __forceinline__ void hc_wait(unsigned* bar, unsigned* cnt, unsigned target) {
  if (threadIdx.x == 0) { XB_SPIN(xb_ld(cnt) < target, bar); __threadfence(); }
  __syncthreads();
}
struct OneSched {
  const char* A; const char* B; int pm, pn, z;
  __device__ __forceinline__ bool next(int i, Unit& u) const { if (i) return false; u.pm = pm; u.pn = pn; u.z = z; return true; }
  __device__ __forceinline__ const char* aptr(const Unit&) const { return A; }
  __device__ __forceinline__ const char* bptr(const Unit&) const { return B; }
};
struct EpiStoreBf16 {
  bf16_t* dst; int ld;
  __device__ __forceinline__ bool operator()(f32x4 (&acc)[2][2][4][2], const Unit& u, int wr, int wc, int fr, int fq) const {
    bf16_t* d = dst + (size_t)u.pm * 256 * ld + u.pn * 256;
    pg8::epi_each(acc, wr, wc, fr, fq, [&](int r, int c, f32x4 v0, f32x4 v1) { st8bf(d + (size_t)r * ld + c, v0, v1); });
    return false;
  }
};
struct MergeSched {
  const char* ws; int ntile, G, c, fuse;
  __device__ __forceinline__ bool next(int i, Unit& u) const {
    const int xcd = c & 7, q = c >> 3;
    int rnd = i / 3;
    if (fuse && c < 32) rnd = rnd == 0 ? 2 : rnd == 2 ? 0 : rnd;
    u.pm = (rnd * (G >> 5) + (q >> 2)) * 8 + xcd; u.pn = q & 3; u.z = i % 3;
    return u.pm * 4 < ntile && (q >> 2) < (G >> 5);
  }
  __device__ __forceinline__ const char* aptr(const Unit& u) const {
    return ws + (u.z == 0 ? O_GA : u.z == 1 ? O_ZB : O_U) + (size_t)u.pm * (256u * 512u * 2u);
  }
  __device__ __forceinline__ const char* bptr(const Unit& u) const { return ws + O_WBR + (size_t)u.z * (1024u * 512u * 2u) + (size_t)u.pn * (256u * 512u * 2u); }
};
struct EpiMerge {
  char* ws; int fuse;
  __device__ __forceinline__ bool operator()(f32x4 (&acc)[2][2][4][2], const Unit& u, int wr, int wc, int fr, int fq) const {
    const int tl = (wr * 4 + wc) * 64 + fq * 16 + fr;
    const unsigned char* GT = (const unsigned char*)(ws + O_G) + ((size_t)u.pm * 12 + u.z * 4 + u.pn) * 65536 + (size_t)tl * 8;
    auto ub = [](unsigned w, int k) { return (float)((w >> (8 * k)) & 0xffu) + 0.5f; };
    bf16_t* MG = (bf16_t*)(ws + O_H) + (size_t)u.pm * 256 * 1024 + u.pn * 256;
    const bool lastj = (u.z == 2);
#pragma unroll
    for (int ai = 0; ai < 2; ++ai)
#pragma unroll
      for (int m = 0; m < 4; ++m)
#pragma unroll
        for (int bj = 0; bj < 2; ++bj) {
          const int cidx = (ai * 4 + m) * 2 + bj;
          const u32x2 gw = *(const u32x2*)(GT + (size_t)cidx * 4096);
          f32x4 g0, g1;
#pragma unroll
          for (int q = 0; q < 4; ++q) { g0[q] = ub(gw.x, q); g1[q] = ub(gw.y, q); }
          if (lastj) {
            const int r = ai * 128 + wr * 64 + m * 16 + fr, c = bj * 128 + wc * 32 + 8 * fq;
            st8bf(MG + (size_t)r * 1024 + c, acc[ai][bj][m][0] * (g0 * 0.00390625f), acc[ai][bj][m][1] * (g1 * 0.00390625f));
          } else {
            const u32x2 hw = *(const u32x2*)(GT + 4 * 65536 + (size_t)cidx * 4096);
#pragma unroll
            for (int q = 0; q < 4; ++q) {
              acc[ai][bj][m][0][q] *= g0[q] * __builtin_amdgcn_rcpf(ub(hw.x, q));
              acc[ai][bj][m][1][q] *= g1[q] * __builtin_amdgcn_rcpf(ub(hw.y, q));
            }
          }
        }
    if (fuse && lastj && u.pm >= 128) hc_publish((unsigned*)(ws + O_BAR) + HC_MERGE);
    return !lastj;
  }
};
__device__ __forceinline__ void phase_merge(const Params& p, int l, char* lds, int wid0) {
  const int tid = opaque_tid(wid0);
  const int fuse = (l == 0 && gridDim.x == 256) ? 1 : 0;
  MergeSched S{p.ws, (l == 1 ? 128 : 136) * 4, (int)gridDim.x, (int)blockIdx.x, fuse};
  EpiMerge E{p.ws, fuse};
  pg8::gemm_phase((PG8_LAS unsigned char*)lds, 512, S, E, tid);
  if (fuse) {
    const int c = (int)blockIdx.x;
    if (c >= 32 && c < 64) {
      unsigned* bar = (unsigned*)(p.ws + O_BAR);
      hc_wait(bar, bar + HC_MERGE, 32u);
      const int pm = 128 + (c & 7), pn = (c >> 3) - 4;
      OneSched S2{p.ws + O_H + (size_t)pm * (256u * 1024u * 2u), p.ws + O_WOUT + (size_t)pn * (256u * 1024u * 2u), pm, pn, 0};
      EpiStoreBf16 E2{(bf16_t*)(p.ws + O_Y), 1024};
      pg8::gemm_phase((PG8_LAS unsigned char*)lds, 1024, S2, E2, tid);
    } else if (c >= 64) conv_fill(p, lds, wid0, 0, c - 64, 192);
  }
}

__device__ __forceinline__ void phase_wout(const Params& p, int l, char* lds, int wid0) {
  const int tid = opaque_tid(wid0);
  pg8::GridSched S;
  const bool fuse = l == 0 && gridDim.x == 256;
  S.init(p.ws + O_H, p.ws + O_WOUT, 1024, (l == 1 || fuse) ? 128 : 136, 4, 0, gridDim.x, blockIdx.x);
  EpiStoreBf16 E{(bf16_t*)(p.ws + O_Y), 1024};
  pg8::gemm_phase((PG8_LAS unsigned char*)lds, 1024, S, E, tid);
}

template <int l>
__device__ __forceinline__ void phase_rowB(const Params& p, char* lds, int wid0) {
  const int tid = opaque_tid(wid0), wid = tid >> 6, lane = tid & 63;
  const int nrow = (l == 1) ? NL : NT;
  const float* xlat = l == 0 ? p.x : p.out;
  const float* xctx = l == 0 ? p.ctx : (const float*)(p.ws + O_CTXB);
  const float* mod = (const float*)(p.ws + O_MOD);
  bf16_t* Y = (bf16_t*)(p.ws + O_Y);
  bf16_t* H = (bf16_t*)(p.ws + O_H);
  float* aff = (float*)(p.ws + O_AFF);
  const float* nw1 = p.norm_w + (size_t)(l * 4 + 1) * 1024;
  const float* nw2 = p.norm_w + (size_t)(l * 4 + 2) * 1024;
  const float* rw = p.router_w + (size_t)l * 1024 * 16;
  float* rwT = (float*)lds;
  for (int i = tid; i < 16384; i += NTHREADS) rwT[(i & 15) * 1024 + (i >> 4)] = rw[i];
  __syncthreads();
  u32x4 pfy[2]; f32x4 pfx[4];
  auto fetch = [&](int row) {
    const float* xr = row < NL ? xlat + (size_t)row * 1024 : xctx + (size_t)(row - NL) * 1024;
#pragma unroll
    for (int i = 0; i < 2; ++i) {
      const int e = i * 512 + lane * 8;
      pfy[i] = *(const u32x4*)(Y + (size_t)row * 1024 + e);
      if (l == 1) pfx[i * 2] = *(const f32x4*)((const bf16_t*)p.out + (size_t)row * 1024 + e);
      else { pfx[i * 2] = *(const f32x4*)(xr + e); pfx[i * 2 + 1] = *(const f32x4*)(xr + e + 4); }
    }
  };
  const int row0 = blockIdx.x * NWAVE + wid, rstep = gridDim.x * NWAVE;
  if (row0 < nrow) fetch(row0);
  for (int row = row0; row < nrow; row += rstep) {
    const int mr = row < NL ? (row >> 12) : 8;
    const float* md = mod + (size_t)(l * 9 + mr) * 6144;
    float yv[16], xv[16];
    float ss = 0.f;
#pragma unroll
    for (int i = 0; i < 2; ++i) {
      const u32x4 w = pfy[i];
      yv[i * 8 + 0] = bflo(w.x); yv[i * 8 + 1] = bfhi(w.x); yv[i * 8 + 2] = bflo(w.y); yv[i * 8 + 3] = bfhi(w.y);
      yv[i * 8 + 4] = bflo(w.z); yv[i * 8 + 5] = bfhi(w.z); yv[i * 8 + 6] = bflo(w.w); yv[i * 8 + 7] = bfhi(w.w);
      if (l == 1) {
        const u32x4 xw = __builtin_bit_cast(u32x4, pfx[i * 2]);
        xv[i * 8 + 0] = bflo(xw.x); xv[i * 8 + 1] = bfhi(xw.x); xv[i * 8 + 2] = bflo(xw.y); xv[i * 8 + 3] = bfhi(xw.y);
        xv[i * 8 + 4] = bflo(xw.z); xv[i * 8 + 5] = bfhi(xw.z); xv[i * 8 + 6] = bflo(xw.w); xv[i * 8 + 7] = bfhi(xw.w);
      } else {
        const f32x4 a = pfx[i * 2], b = pfx[i * 2 + 1];
#pragma unroll
        for (int j = 0; j < 4; ++j) { xv[i * 8 + j] = a[j]; xv[i * 8 + 4 + j] = b[j]; }
      }
    }
    if (row + rstep < nrow) fetch(row + rstep);
#pragma unroll
    for (int j = 0; j < 16; ++j) ss += yv[j] * yv[j];
    ss = wave_sum(ss);
    const float rs = rsqrtf(ss * (1.0f / 1024.0f) + 1e-6f);
    float ss2 = 0.f;
#pragma unroll
    for (int i = 0; i < 2; ++i) {
      const int e = i * 512 + lane * 8;
#pragma unroll
      for (int h4 = 0; h4 < 2; ++h4) {
        const f32x4 w = *(const f32x4*)(nw1 + e + h4 * 4), g1 = *(const f32x4*)(md + 2048 + e + h4 * 4);
#pragma unroll
        for (int j = 0; j < 4; ++j) {
          const int q = i * 8 + h4 * 4 + j;
          xv[q] = xv[q] + g1[j] * (yv[q] * rs * w[j]);
          ss2 += xv[q] * xv[q];
        }
      }
      u32x4 o;
      o.x = pk_bf16(xv[i * 8 + 0], xv[i * 8 + 1]); o.y = pk_bf16(xv[i * 8 + 2], xv[i * 8 + 3]); o.z = pk_bf16(xv[i * 8 + 4], xv[i * 8 + 5]); o.w = pk_bf16(xv[i * 8 + 6], xv[i * 8 + 7]);
      *(u32x4*)(Y + (size_t)row * 1024 + e) = o;
    }
    ss2 = wave_sum(ss2);
    const float rs2 = rsqrtf(ss2 * (1.0f / 1024.0f) + 1e-6f);
    float lg[16];
#pragma unroll
    for (int e2 = 0; e2 < 16; ++e2) lg[e2] = 0.f;
#pragma unroll
    for (int i = 0; i < 2; ++i) {
      const int e = i * 512 + lane * 8;
      float hv[8];
#pragma unroll
      for (int h4 = 0; h4 < 2; ++h4) {
        const f32x4 w = *(const f32x4*)(nw2 + e + h4 * 4), sh = *(const f32x4*)(md + 3072 + e + h4 * 4), sc = *(const f32x4*)(md + 4096 + e + h4 * 4);
#pragma unroll
        for (int j = 0; j < 4; ++j) hv[h4 * 4 + j] = xv[i * 8 + h4 * 4 + j] * rs2 * w[j] * (1.0f + sc[j]) + sh[j];
      }
      u32x4 w;
      w.x = pk_bf16(hv[0], hv[1]); w.y = pk_bf16(hv[2], hv[3]); w.z = pk_bf16(hv[4], hv[5]); w.w = pk_bf16(hv[6], hv[7]);
      *(u32x4*)(H + (size_t)row * 1024 + e) = w;
#pragma unroll
      for (int e2 = 0; e2 < 16; ++e2) {
        const f32x4 r0 = *(const f32x4*)(rwT + e2 * 1024 + e), r1 = *(const f32x4*)(rwT + e2 * 1024 + e + 4);
        lg[e2] += hv[0] * r0[0] + hv[1] * r0[1] + hv[2] * r0[2] + hv[3] * r0[3] + hv[4] * r1[0] + hv[5] * r1[1] + hv[6] * r1[2] + hv[7] * r1[3];
        if ((e2 & 3) == 3) __builtin_amdgcn_sched_barrier(0);
      }
    }
    float a8[8], a4[4], a2[2], a1;
    {
      const bool up = (lane & 32) != 0;
#pragma unroll
      for (int j = 0; j < 8; ++j) { const float mine = up ? lg[8 + j] : lg[j], other = up ? lg[j] : lg[8 + j]; a8[j] = mine + __shfl_xor(other, 32); }
    }
    {
      const bool up = (lane & 16) != 0;
#pragma unroll
      for (int j = 0; j < 4; ++j) { const float mine = up ? a8[4 + j] : a8[j], other = up ? a8[j] : a8[4 + j]; a4[j] = mine + __shfl_xor(other, 16); }
    }
    {
      const bool up = (lane & 8) != 0;
#pragma unroll
      for (int j = 0; j < 2; ++j) { const float mine = up ? a4[2 + j] : a4[j], other = up ? a4[j] : a4[2 + j]; a2[j] = mine + __shfl_xor(other, 8); }
    }
    {
      const bool up = (lane & 4) != 0;
      const float mine = up ? a2[1] : a2[0], other = up ? a2[0] : a2[1];
      a1 = mine + __shfl_xor(other, 4);
    }
    a1 += __shfl_xor(a1, 2);
    a1 += __shfl_xor(a1, 1);
    float mx = a1;
    mx = fmaxf(mx, __shfl_xor(mx, 4)); mx = fmaxf(mx, __shfl_xor(mx, 8)); mx = fmaxf(mx, __shfl_xor(mx, 16)); mx = fmaxf(mx, __shfl_xor(mx, 32));
    const float ex = expf(a1 - mx);
    float se = ex;
    se += __shfl_xor(se, 4); se += __shfl_xor(se, 8); se += __shfl_xor(se, 16); se += __shfl_xor(se, 32);
    if ((lane & 3) == 0) {
      const int e2 = ((lane >> 5) & 1) * 8 + ((lane >> 4) & 1) * 4 + ((lane >> 3) & 1) * 2 + ((lane >> 2) & 1);
      aff[(size_t)row * 16 + e2] = ex / se;
    }
  }
}

template <int NI, int T>
__device__ __forceinline__ void topk_body(const Params& p, int s, int e, char* lds, const int tid) {
  constexpr int CAP = T / 8;
  typedef unsigned long long u64;
  int* cntw = (int*)lds;
  int* wcnt = (int*)(lds + 256);
  int* woff = (int*)(lds + 512);
  const int wid = tid >> 6, lane = tid & 63;
  const bool isl = T == 4096;
  const size_t rowbase = isl ? (size_t)s * 4096 : (size_t)NL + (size_t)(s - 8) * 256;
  const float* aff = (const float*)(p.ws + O_AFF);
  int* sel = (int*)(p.ws + O_SEL);
  float* gate = (float*)(p.ws + O_GATE);
  int* tok = (int*)(p.ws + O_TOK);
  u64 key[NI];
  float av[NI];
#pragma unroll
  for (int q = 0; q < NI; ++q) {
    const int i = tid + q * NTHREADS;
    av[q] = 0.f; key[q] = 0ull;
    if (i < T) {
      av[q] = aff[(rowbase + i) * 16 + e];
      key[q] = ((u64)__float_as_uint(av[q]) << 12) | (u64)(4095 - i);
    }
  }
  u64 prefix = 0ull;
  for (int bit = 43; bit >= 0; --bit) {
    const u64 cand = prefix | (1ull << bit);
    int c = 0;
#pragma unroll
    for (int q = 0; q < NI; ++q) c += __popcll(__ballot(key[q] >= cand));
    if (lane == 0) cntw[(bit & 1) * 8 + wid] = c;
    __syncthreads();
    int tot = 0;
#pragma unroll
    for (int w = 0; w < 8; ++w) tot += cntw[(bit & 1) * 8 + w];
    if (tot >= CAP) prefix = cand;
  }
  int before[NI];
  bool in[NI];
#pragma unroll
  for (int q = 0; q < NI; ++q) {
    in[q] = key[q] >= prefix && key[q] != 0ull;
    const u64 m = __ballot(in[q]);
    before[q] = __popcll(m & ((1ull << lane) - 1ull));
    if (lane == 0) wcnt[q * 8 + wid] = __popcll(m);
  }
  __syncthreads();
  if (tid < 64) {
    int v = tid < NI * 8 ? wcnt[tid] : 0, x = v;
#pragma unroll
    for (int o = 1; o < 64; o <<= 1) { const int y = __shfl_up(x, o); if (lane >= o) x += y; }
    if (tid < NI * 8) woff[tid] = x - v;
  }
  __syncthreads();
  const size_t slotbase = isl ? ((size_t)e * 8 + s) * CAP : (size_t)NSLOT_L + ((size_t)e * 8 + (s - 8)) * CAP;
#pragma unroll
  for (int q = 0; q < NI; ++q) {
    const int i = tid + q * NTHREADS;
    if (i < T) {
      const int slot = woff[q * 8 + wid] + before[q];
      sel[(rowbase + i) * 16 + e] = in[q] ? slot : -1;
      if (in[q]) {
        tok[slotbase + slot] = (int)(rowbase + i);
        gate[slotbase + slot] = av[q];
      }
    }
  }
  __syncthreads();
}
__device__ __forceinline__ void phase_topk(const Params& p, int l, char* lds, int wid0) {
  const int tid = opaque_tid(wid0);
  const int NITEM = (l == 1) ? 128 : 256;
  for (int item = blockIdx.x; item < NITEM; item += gridDim.x) {
    const int s = item >> 4, e = item & 15;
    if (s < 8) topk_body<8, 4096>(p, s, e, lds, tid);
    else topk_body<1, 256>(p, s, e, lds, tid);
  }
}

struct MoeSched {
  const char* A; const char* W; int nN, nunit, G, c; size_t estep; int swap = 0;
  __device__ __forceinline__ bool next(int i, Unit& u) const {
    const int xcd = c & 7, q = c >> 3, per = (G >> 3) / nN;
    int ii = i;
    if (swap && xcd < 4) ii = i == 0 ? 8 : i == 8 ? 0 : i;
    u.pn = q % nN; u.pm = (ii * 8 + xcd) * per + q / nN;
    if (q >= per * nN || u.pm * nN >= nunit) return false;
    u.z = u.pm < 256 ? (u.pm >> 4) : (u.pm - 256); return true;
  }
  __device__ __forceinline__ const char* aptr(const Unit& u) const { return A + (size_t)u.pm * (256u * 1024u * 2u); }
  __device__ __forceinline__ const char* bptr(const Unit& u) const { return W + (size_t)u.z * estep + (size_t)u.pn * (256u * 1024u * 2u); }
};
struct MoeSchedG : MoeSched {
  static constexpr bool GATHER = true;
  const int* tok;
  __device__ __forceinline__ const char* aptr(const Unit&) const { return A; }
  __device__ __forceinline__ const int* tokptr(const Unit& u) const { return tok + (size_t)u.pm * 256; }
};
struct EpiSwiglu {
  bf16_t* HID; unsigned* cnt;
  __device__ __forceinline__ bool operator()(f32x4 (&acc)[2][2][4][2], const Unit& u, int wr, int wc, int fr, int fq) const {
    bf16_t* d = HID + (size_t)u.pm * 256 * 1024 + u.pn * 128;
#pragma unroll
    for (int ai = 0; ai < 2; ++ai)
#pragma unroll
      for (int m = 0; m < 4; ++m) {
        f32x4 o0, o1;
#pragma unroll
        for (int j = 0; j < 4; ++j) { o0[j] = siluf_(acc[ai][0][m][0][j]) * acc[ai][1][m][0][j]; o1[j] = siluf_(acc[ai][0][m][1][j]) * acc[ai][1][m][1][j]; }
        st8bf(d + (size_t)(ai * 128 + wr * 64 + m * 16 + fr) * 1024 + wc * 32 + 8 * fq, o0, o1);
      }
    if (cnt && u.pm >= 256) hc_publish(cnt);
    return false;
  }
};
__device__ __forceinline__ void phase_moe1(const Params& p, int l, char* lds, int wid0) {
  const int tid = opaque_tid(wid0);
  const int nrt = (l == 1) ? 256 : 272;
  MoeSchedG S;
  S.A = p.ws + O_H; S.W = l == 1 ? (const char*)p.out + OUT_W13B : p.ws + O_W13; S.nN = 8; S.nunit = nrt * 8; S.G = (int)gridDim.x; S.c = (int)blockIdx.x; S.estep = (size_t)2048 * 1024 * 2;
  S.tok = (const int*)(p.ws + O_TOK);
  const bool fuse = l == 0 && gridDim.x == 256;
  S.swap = fuse ? 1 : 0;
  unsigned* bar = (unsigned*)(p.ws + O_BAR);
  EpiSwiglu E{(bf16_t*)(p.ws + O_HID), fuse ? bar + HC_MOE1 : nullptr};
  pg8::gemm_phase((PG8_LAS unsigned char*)lds, 1024, S, E, tid);
  if (fuse) {
    const int xcd = (int)blockIdx.x & 7, q = (int)blockIdx.x >> 3;
    if (xcd >= 4 && q < 16) {
      const int r = q * 4 + xcd - 4, e = r >> 2, pn = r & 3, pm = 256 + e;
      hc_wait(bar, bar + HC_MOE1, 128u);
      OneSched S2{p.ws + O_HID + (size_t)pm * (256u * 1024u * 2u), p.ws + O_W2 + (size_t)e * ((size_t)1024 * 1024 * 2) + (size_t)pn * (256u * 1024u * 2u), pm, pn, e};
      EpiStoreBf16 E2{(bf16_t*)(p.ws + O_YS), 1024};
      pg8::gemm_phase((PG8_LAS unsigned char*)lds, 1024, S2, E2, tid);
    } else if (xcd >= 4) conv_fill(p, lds, wid0, 2, (q - 16) * 4 + xcd - 4, 64);
  }
}
__device__ __forceinline__ void phase_moe2(const Params& p, int l, char* lds, int wid0) {
  const int tid = opaque_tid(wid0);
  const int nrt = (l == 1 || gridDim.x == 256) ? 256 : 272;
  MoeSched S{p.ws + O_HID, p.ws + (l == 1 && p.w2sep ? O_W2B : O_W2), 4, nrt * 4, (int)gridDim.x, (int)blockIdx.x, (size_t)1024 * 1024 * 2};
  EpiStoreBf16 E{(bf16_t*)(p.ws + O_YS), 1024};
  pg8::gemm_phase((PG8_LAS unsigned char*)lds, 1024, S, E, tid);
}

__device__ __forceinline__ void phase_rowC(const Params& p, int l, int wid0) {
  const int tid = opaque_tid(wid0), wid = tid >> 6, lane = tid & 63;
  const int nrow = (l == 1) ? NL : NT;
  float* olat = p.out;
  float* octx = (float*)(p.ws + O_CTXB);
  const float* mod = (const float*)(p.ws + O_MOD);
  const bf16_t* YS = (const bf16_t*)(p.ws + O_YS);
  const int* sel = (const int*)(p.ws + O_SEL);
  const float* gate = (const float*)(p.ws + O_GATE);
  const float* nw3 = p.norm_w + (size_t)(l * 4 + 3) * 1024;
  const float* nwn = p.norm_w + (size_t)((l + 1) * 4 + 0) * 1024;
  bf16_t* H = (bf16_t*)(p.ws + O_H);
  const bf16_t* X1 = (const bf16_t*)(p.ws + O_Y);
  int pfrk; u32x4 pfx[2];
  auto fetch = [&](int row) {
    pfrk = sel[(size_t)row * 16 + (lane & 15)];
#pragma unroll
    for (int i = 0; i < 2; ++i) pfx[i] = *(const u32x4*)(X1 + (size_t)row * 1024 + i * 512 + lane * 8);
  };
  const int row0 = blockIdx.x * NWAVE + wid, rstep = gridDim.x * NWAVE;
  if (row0 < nrow) fetch(row0);
  for (int row = row0; row < nrow; row += rstep) {
    float* xo = row < NL ? olat + (size_t)row * 1024 : octx + (size_t)(row - NL) * 1024;
    const bool isl = row < NL;
    const int mr = isl ? (row >> 12) : 8;
    const int s = isl ? (row >> 12) : ((row - NL) >> 8);
    const float* md = mod + (size_t)(l * 9 + mr) * 6144;
    float mv[16];
#pragma unroll
    for (int j = 0; j < 16; ++j) mv[j] = 0.f;
    const int myrk = pfrk;
    u32x4 xcur[2];
#pragma unroll
    for (int i = 0; i < 2; ++i) xcur[i] = pfx[i];
    if (row + rstep < nrow) fetch(row + rstep);
    unsigned long long chosen = __ballot(myrk >= 0) & 0xffffull;
    while (chosen) {
      const int e0 = __builtin_ctzll(chosen); chosen &= chosen - 1;
      const int e1 = chosen ? __builtin_ctzll(chosen) : -1; if (chosen) chosen &= chosen - 1;
      const int rk0 = __shfl(myrk, e0), rk1 = e1 >= 0 ? __shfl(myrk, e1) : 0;
      const size_t slot0 = isl ? ((size_t)e0 * 8 + s) * 512 + rk0 : (size_t)NSLOT_L + ((size_t)e0 * 8 + s) * 32 + rk0;
      const size_t slot1 = e1 < 0 ? slot0 : (isl ? ((size_t)e1 * 8 + s) * 512 + rk1 : (size_t)NSLOT_L + ((size_t)e1 * 8 + s) * 32 + rk1);
      u32x4 w[4];
#pragma unroll
      for (int i = 0; i < 2; ++i) { w[i] = *(const u32x4*)(YS + slot0 * 1024 + i * 512 + lane * 8); w[2 + i] = *(const u32x4*)(YS + slot1 * 1024 + i * 512 + lane * 8); }
      const float m0 = gate[slot0], m1 = e1 >= 0 ? gate[slot1] : 0.f;
#pragma unroll
      for (int i = 0; i < 2; ++i) {
        mv[i * 8 + 0] += m0 * bflo(w[i].x) + m1 * bflo(w[2 + i].x); mv[i * 8 + 1] += m0 * bfhi(w[i].x) + m1 * bfhi(w[2 + i].x);
        mv[i * 8 + 2] += m0 * bflo(w[i].y) + m1 * bflo(w[2 + i].y); mv[i * 8 + 3] += m0 * bfhi(w[i].y) + m1 * bfhi(w[2 + i].y);
        mv[i * 8 + 4] += m0 * bflo(w[i].z) + m1 * bflo(w[2 + i].z); mv[i * 8 + 5] += m0 * bfhi(w[i].z) + m1 * bfhi(w[2 + i].z);
        mv[i * 8 + 6] += m0 * bflo(w[i].w) + m1 * bflo(w[2 + i].w); mv[i * 8 + 7] += m0 * bfhi(w[i].w) + m1 * bfhi(w[2 + i].w);
      }
    }
    float ss = 0.f;
#pragma unroll
    for (int j = 0; j < 16; ++j) ss += mv[j] * mv[j];
    ss = wave_sum(ss);
    const float rs = rsqrtf(ss * (1.0f / 1024.0f) + 1e-6f);
    float xn[16], ssn = 0.f;
#pragma unroll
    for (int i = 0; i < 2; ++i) {
      const int e = i * 512 + lane * 8;
#pragma unroll
      for (int h4 = 0; h4 < 2; ++h4) {
        const f32x4 w = *(const f32x4*)(nw3 + e + h4 * 4), g2 = *(const f32x4*)(md + 5120 + e + h4 * 4);
        f32x4 xv;
        if (h4 == 0) { xv[0] = bflo(xcur[i].x); xv[1] = bfhi(xcur[i].x); xv[2] = bflo(xcur[i].y); xv[3] = bfhi(xcur[i].y); }
        else { xv[0] = bflo(xcur[i].z); xv[1] = bfhi(xcur[i].z); xv[2] = bflo(xcur[i].w); xv[3] = bfhi(xcur[i].w); }
#pragma unroll
        for (int j = 0; j < 4; ++j) { xv[j] += g2[j] * (mv[i * 8 + h4 * 4 + j] * rs * w[j]); xn[i * 8 + h4 * 4 + j] = xv[j]; ssn += xv[j] * xv[j]; }
        if (!(l == 0 && isl)) *(f32x4*)(xo + e + h4 * 4) = xv;
      }
      if (l == 0 && isl) {
        u32x4 o;
        o.x = pk_bf16(xn[i * 8 + 0], xn[i * 8 + 1]); o.y = pk_bf16(xn[i * 8 + 2], xn[i * 8 + 3]); o.z = pk_bf16(xn[i * 8 + 4], xn[i * 8 + 5]); o.w = pk_bf16(xn[i * 8 + 6], xn[i * 8 + 7]);
        *(u32x4*)((bf16_t*)p.out + (size_t)row * 1024 + e) = o;
      }
    }
    if (l == 0) {
      ssn = wave_sum(ssn);
      const float rsn = rsqrtf(ssn * (1.0f / 1024.0f) + 1e-6f);
      const float* mdn = mod + (size_t)((l + 1) * 9 + mr) * 6144;
#pragma unroll
      for (int i = 0; i < 2; ++i) {
        const int e = i * 512 + lane * 8;
        float hv[8];
#pragma unroll
        for (int h4 = 0; h4 < 2; ++h4) {
          const f32x4 w = *(const f32x4*)(nwn + e + h4 * 4), sh = *(const f32x4*)(mdn + e + h4 * 4), sc = *(const f32x4*)(mdn + 1024 + e + h4 * 4);
#pragma unroll
          for (int j = 0; j < 4; ++j) hv[h4 * 4 + j] = xn[i * 8 + h4 * 4 + j] * rsn * w[j] * (1.0f + sc[j]) + sh[j];
        }
        u32x4 w;
        w.x = pk_bf16(hv[0], hv[1]); w.y = pk_bf16(hv[2], hv[3]); w.z = pk_bf16(hv[4], hv[5]); w.w = pk_bf16(hv[6], hv[7]);
        *(u32x4*)(H + (size_t)row * 1024 + e) = w;
      }
    }
  }
}

#define PHASE(call) do { Params q = p; asm volatile("" : "+s"(q.ws)); call; } while (0)
#ifndef PROBE_PH
#define PROBE_PH 0
#endif
#ifndef PROBE_N
#define PROBE_N 2
#endif
#define REP(id, call) do { for (int _r = 0; _r < ((PROBE_PH == (id)) ? 1 + PROBE_N : 1); ++_r) PHASE(call); } while (0)
#define SYNC() do { char* _w = p.ws; asm volatile("" : "+s"(_w)); XcdBarrier _b; _b.bar = (unsigned*)(_w + O_BAR); _b.x = xb_xcc_id(); _b.st = st; xcd_barrier(_b); } while (0)
__global__ void __launch_bounds__(NTHREADS, 2) fwd_mega(Params p) {
  extern __shared__ __attribute__((aligned(16))) char lds[];
  cg::grid_group grid = cg::this_grid();
  const int wid0 = __builtin_amdgcn_readfirstlane((int)(threadIdx.x >> 6));
  volatile PG8_LAS unsigned* st = (volatile PG8_LAS unsigned*)((PG8_LAS unsigned char*)lds + LDS_MAIN);
  if (threadIdx.x < 2) st[threadIdx.x] = 0u;
  __syncthreads();
  (void)xcd_barrier_post((unsigned*)(p.ws + O_BAR), st);
  PHASE(phase_setup(q, lds, wid0));
  PHASE(phase_conv(q, 0, lds, wid0));
  SYNC();
  PHASE(phase_rowA(q, 0, wid0));
  SYNC();
#pragma unroll 1
  for (int l = 0; l < 2; ++l) {
    REP(3, phase_gin(q, l, lds, wid0));
    SYNC();
    REP(5, phase_mix2(q, l, lds, wid0));
    SYNC();
    PHASE(phase_oa(q, l, wid0));
    SYNC();
    REP(7, phase_merge(q, l, lds, wid0));
    if (l == 0) grid.sync(); else SYNC();
    REP(8, phase_wout(q, l, lds, wid0));
    SYNC();
    if (l == 0) PHASE(phase_rowB<0>(q, lds, wid0)); else PHASE(phase_rowB<1>(q, lds, wid0));
    SYNC();
    REP(10, phase_topk(q, l, lds, wid0));
    SYNC();
    REP(11, phase_moe1(q, l, lds, wid0));
    SYNC();
    REP(12, phase_moe2(q, l, lds, wid0));
    SYNC();
    PHASE(phase_rowC(q, l, wid0));
    if (l == 0) PHASE(conv_fill(q, lds, wid0, 4, (int)blockIdx.x, (int)gridDim.x));
    if (l == 0) SYNC();
    if (PROBE_PH == 20) { for (int _r = 0; _r < 10 * PROBE_N; ++_r) SYNC(); }
  }
}

extern "C" void kernel_launch(void* const* d_in, const int* in_sizes, int n_in, void* d_out, int out_size, void* d_ws, size_t ws_size,
                              hipStream_t stream) {
  if (ws_size < WS_NEED) {
    fprintf(stderr, "kernel_launch: workspace too small: %zu < %zu\n", ws_size, (size_t)WS_NEED);
    return;
  }
  Params p{};
  p.x = (const float*)d_in[0]; p.c = (const float*)d_in[1]; p.ctx = (const float*)d_in[2]; p.c_ctx = (const float*)d_in[3];
  p.ada_w = (const float*)d_in[4]; p.ada_b = (const float*)d_in[5]; p.norm_w = (const float*)d_in[6]; p.w_in = (const float*)d_in[7];
  p.lb_raw = (const float*)d_in[8]; p.gnorm_w = (const float*)d_in[9]; p.sgu_w = (const float*)d_in[10]; p.sgu_b = (const float*)d_in[11];
  p.sgu_norm_w = (const float*)d_in[12]; p.w_branch = (const float*)d_in[13]; p.w_out = (const float*)d_in[14];
  p.router_w = (const float*)d_in[15]; p.w13 = (const float*)d_in[16]; p.w2 = (const float*)d_in[17];
  p.out = (float*)d_out;
  p.ws = (char*)d_ws;
  p.w2sep = ws_size >= WS_NEED_W2B ? 1 : 0;
  static int grid_blocks = 0;
  if (!grid_blocks) {
    int dev = 0, cus = 0, per_cu = 0;
    (void)hipGetDevice(&dev);
    (void)hipDeviceGetAttribute(&cus, hipDeviceAttributeMultiprocessorCount, dev);
    (void)hipFuncSetAttribute((const void*)fwd_mega, hipFuncAttributeMaxDynamicSharedMemorySize, LDS_TOTAL);
    (void)hipOccupancyMaxActiveBlocksPerMultiprocessor(&per_cu, fwd_mega, NTHREADS, LDS_TOTAL);
    if (per_cu > 1) per_cu = 1;
    if (per_cu < 1) fprintf(stderr, "kernel_launch: occupancy query reports %d blocks per CU\n", per_cu);
    grid_blocks = cus * (per_cu < 1 ? 1 : per_cu);
  }
  (void)hipMemsetAsync((char*)d_ws + O_BAR, 0, BAR_BYTES, stream);
  void* args[] = {&p};
  hipError_t e = hipLaunchCooperativeKernel((void*)fwd_mega, dim3(grid_blocks), dim3(NTHREADS), args, LDS_TOTAL, stream);
  if (e != hipSuccess) fprintf(stderr, "cooperative launch failed: %s (grid %d)\n", hipGetErrorString(e), grid_blocks);
}
```

```cpp
#include <hip/hip_runtime.h>
#include <hip/hip_cooperative_groups.h>
#include <cstdio>
#include <cstdint>
namespace cg = cooperative_groups;

typedef unsigned short bf16_t;
typedef short bf16x8 __attribute__((ext_vector_type(8)));
typedef float f32x4 __attribute__((ext_vector_type(4)));
typedef float f32x2 __attribute__((ext_vector_type(2)));
typedef unsigned u32x4 __attribute__((ext_vector_type(4)));
typedef unsigned u32x2 __attribute__((ext_vector_type(2)));

constexpr int D = 1024, NB = 8, TL = 4096, TCX = 256;
constexpr int NL = NB * TL, NC = NB * TCX, NT = NL + NC;
constexpr int INC = 7168;
constexpr int NSLOT_L = 16 * 8 * 512, NSLOT_C = 16 * 8 * 32, NSLOT = NSLOT_L + NSLOT_C;
constexpr int NTHREADS = 512, NWAVE = 8;
constexpr int LDS_MAIN = 147456;
constexpr int LDS_TOTAL = LDS_MAIN + 16;

constexpr size_t al(size_t x) { return (x + 255) & ~(size_t)255; }
constexpr size_t O_WIN = 0;
constexpr size_t O_WBR = O_WIN + al((size_t)INC * D * 2);
constexpr size_t O_WOUT = O_WBR + al((size_t)3 * D * 512 * 2);
constexpr size_t O_W13 = O_WOUT + al((size_t)D * D * 2);
constexpr size_t O_W2 = O_W13 + al((size_t)16 * 2048 * D * 2);
constexpr size_t O_FTL = O_W2 + al((size_t)16 * D * D * 2);
constexpr size_t O_FTC = O_FTL + al((size_t)4096 * 8192 * 2);
constexpr size_t O_CS = O_FTC + al((size_t)256 * 512 * 2);
constexpr size_t O_MOD = O_CS + al((size_t)256 * 128 * 2);
constexpr size_t O_LB = O_MOD + al((size_t)2 * 9 * 6144 * 4);
constexpr size_t O_BAR = O_LB + al((size_t)2 * 2 * 512 * 4);
constexpr size_t BAR_BYTES = 3456 * 4;
constexpr size_t O_H = O_BAR + al(BAR_BYTES);
constexpr size_t O_Y = O_H + al((size_t)NT * D * 2);
constexpr size_t O_CTXB = O_Y + al((size_t)NT * D * 2);
constexpr size_t O_AFF = O_CTXB + al((size_t)NC * D * 4);
constexpr size_t O_SEL = O_AFF + al((size_t)NT * 16 * 4);
constexpr size_t O_GATE = O_SEL + al((size_t)NT * 16 * 4);
constexpr size_t O_TOK = O_GATE + al((size_t)NSLOT * 4);
constexpr size_t O_Z = O_TOK + al((size_t)NSLOT * 4);
constexpr size_t SZ512 = al((size_t)NT * 512 * 2);
constexpr size_t O_Q = O_Z, O_LFF = O_Q + SZ512, O_LFB = O_LFF + SZ512, O_I = O_LFB + SZ512, O_GA = O_I + SZ512,
                 O_U = O_GA + SZ512, O_ZB = O_U + SZ512, O_VT = O_ZB + SZ512, O_OF = O_VT + SZ512, O_OBK = O_OF + SZ512;
constexpr size_t O_G = O_OBK + SZ512;
constexpr size_t O_ZCL = O_G + al((size_t)NT * 3072 * 2);
constexpr size_t O_ZCC = O_ZCL + al((size_t)8 * 512 * 8192 * 2);
constexpr size_t O_ZF = O_ZCC + al((size_t)8 * 512 * 512 * 2);
constexpr int KH = 2176, KF = 2 * KH;
constexpr size_t O_ZEND = O_ZF + al((size_t)8 * 512 * KF * 2);
constexpr size_t SZSLOT = al((size_t)NSLOT * 1024 * 2);
constexpr size_t O_XE = O_Z, O_HID = O_XE + SZSLOT, O_YS = O_HID + SZSLOT;
static_assert(O_YS + SZSLOT <= O_ZEND, "moe arena");
constexpr size_t O_W2B = O_ZEND;
constexpr size_t WS_NEED = O_ZEND, WS_NEED_W2B = O_W2B + al((size_t)16 * D * D * 2);

struct Params {
  const float *x, *c, *ctx, *c_ctx, *ada_w, *ada_b, *norm_w, *w_in, *lb_raw, *gnorm_w, *sgu_w, *sgu_b, *sgu_norm_w, *w_branch, *w_out,
      *router_w, *w13, *w2;
  float* out;
  char* ws;
  int w2sep;
};

typedef __bf16 bf16v2_t __attribute__((ext_vector_type(2)));
__device__ __forceinline__ unsigned pk_bf16(float lo, float hi) {
  const f32x2 v = {lo, hi};
  const bf16v2_t r = __builtin_convertvector(v, bf16v2_t);
  return __builtin_bit_cast(unsigned, r);
}
__device__ __forceinline__ bf16_t f2bf(float x) { return (bf16_t)(pk_bf16(x, 0.f) & 0xffffu); }
__device__ __forceinline__ float bf2f(bf16_t v) { return __uint_as_float(((unsigned)v) << 16); }
__device__ __forceinline__ float bflo(unsigned w) { return __uint_as_float(w << 16); }
__device__ __forceinline__ float bfhi(unsigned w) { return __uint_as_float(w & 0xffff0000u); }
__device__ __forceinline__ void st4bf(bf16_t* p, f32x4 v) {
  u32x2 w;
  w.x = pk_bf16(v[0], v[1]);
  w.y = pk_bf16(v[2], v[3]);
  *(u32x2*)p = w;
}
__device__ __forceinline__ void st8bf(bf16_t* p, f32x4 a, f32x4 b) {
  u32x4 w;
  w.x = pk_bf16(a[0], a[1]); w.y = pk_bf16(a[2], a[3]); w.z = pk_bf16(b[0], b[1]); w.w = pk_bf16(b[2], b[3]);
  *(u32x4*)p = w;
}
__device__ __forceinline__ float sigmoidf_(float x) { return __builtin_amdgcn_rcpf(1.0f + __expf(-x)); }
__device__ __forceinline__ float siluf_(float x) { return x * __builtin_amdgcn_rcpf(1.0f + __expf(-x)); }
__device__ __forceinline__ float geluf_(float v) {
  const float av = fabsf(v), t = __builtin_amdgcn_rcpf(av * 0.2316418882f + 1.0f);
  float q = t * 0.5307027145f + (-0.7265760135f);
  q = q * t + 0.7107068705f; q = q * t + (-0.142248368f); q = q * t + 0.127414796f; q = q * t;
  const float e = __builtin_amdgcn_exp2f((v * v) * (-0.72134752044f));
  const float m = v * (q * e);
  return v < 0.f ? m : v - m;
}
__device__ __forceinline__ int opaque_tid(int wid0) {
  int lane;
  asm volatile("v_mbcnt_lo_u32_b32 %0, -1, 0\n\tv_mbcnt_hi_u32_b32 %0, -1, %0" : "=v"(lane));
  return (wid0 << 6) | lane;
}
__device__ __forceinline__ float wave_sum(float v) {
#pragma unroll
  for (int o = 32; o > 0; o >>= 1) v += __shfl_xor(v, o);
  return v;
}

namespace pg8 {
#define PG8_LAS __attribute__((address_space(3)))
constexpr int BM = 256, BK = 64, HALF = 128, HTB = HALF * BK * 2, STAGE_BYTES = 8 * HTB, NXCD = 8, WGM = 8;
__device__ __forceinline__ int lds_byte(int r, int c) { const int st = (r >> 4) * 2 + (c >> 5), rr = r & 15, cc = c & 31, ob = rr * 64 + cc * 2; return st * 1024 + (ob ^ (((ob >> 9) & 1) << 5)); }
__device__ __forceinline__ void stage_rc(int b, int& R, int& C) { const int st = b / 1024, sb = b % 1024, swz = sb ^ (((sb >> 9) & 1) << 5); R = (st >> 1) * 16 + swz / 64; C = (st & 1) * 32 + (swz % 64) / 2; }
__device__ __forceinline__ int perm32(int rho) { const int n = rho >> 4, i = rho & 15; return 8 * (i >> 2) + 4 * n + (i & 3); }
struct Unit { int pm, pn, z; };
template <class T, class = void> struct gather_of { static constexpr bool v = false; };
template <class T> struct gather_of<T, decltype((void)T::GATHER)> { static constexpr bool v = T::GATHER; };

template <class Epi, class Sched>
__device__ __forceinline__ void gemm_phase(PG8_LAS unsigned char* lds, const int K, const Sched& S, const Epi& E, const int tid_in) {
  int tid = tid_in;
  asm volatile("" : "+v"(tid));
  const int wid = __builtin_amdgcn_readfirstlane(tid >> 6), lane = tid & 63, wr = wid >> 2, wc = wid & 3, fr = lane & 15, fq = lane >> 4;
  const int nt = K / BK;
  constexpr bool GA = gather_of<Sched>::v;
  unsigned voffA[2], voffB[2];
  unsigned cvA[2][2], nvA[2][2];
  int gR = 0; unsigned gC2 = 0;
#pragma unroll
  for (int i = 0; i < 2; ++i) { int R, C; stage_rc(tid * 16 + i * 8192, R, C); const int Rb = (R & ~31) + perm32(R & 31);
    if (i == 0) { gR = R; gC2 = (unsigned)C * 2u; }
    voffA[i] = (unsigned)(R * K + C) * 2u; voffB[i] = (unsigned)(Rb * K + C) * 2u; }
  const size_t kstep = (size_t)(BK * 2);
  const size_t hstep = (size_t)HALF * K * 2;
  const size_t hstepA = GA ? (size_t)0 : hstep;
  const PG8_LAS int* idxl = (const PG8_LAS int*)(lds + STAGE_BYTES);
  const unsigned ldsw = (unsigned)wid * 1024u;
  const int aoff = lds_byte(wr * 64 + fr, fq * 8), boff = lds_byte(wc * 32 + fr, fq * 8);
#define PG8_SA(b, h) (((b) * 2 + (h)) * HTB)
#define PG8_SB(b, h) ((4 + (b) * 2 + (h)) * HTB)
#define PG8_STAGE_(bufoff, gbase, voff) do { _Pragma("unroll") for (int _i = 0; _i < 2; ++_i) \
    __builtin_amdgcn_global_load_lds((const unsigned*)((const char*)(gbase) + voff[_i]), (PG8_LAS unsigned*)(lds + (bufoff) + ldsw + _i * 8192), 16, 0, 0); } while (0)
#define PG8_STAGE(bufoff, gbase) PG8_STAGE_(bufoff, gbase, voffB)
#define PG8_STAGE_A(bufoff, gbase, NX) do { _Pragma("unroll") for (int _i = 0; _i < 2; ++_i) { unsigned _vo; \
    if constexpr (GA) { _vo = (NX) ? nvA[((bufoff) / HTB) & 1][_i] : cvA[((bufoff) / HTB) & 1][_i]; } else _vo = voffA[_i]; \
    __builtin_amdgcn_global_load_lds((const unsigned*)((const char*)(gbase) + _vo), (PG8_LAS unsigned*)(lds + (bufoff) + ldsw + _i * 8192), 16, 0, 0); } } while (0)
#define PG8_LDA(dst, b, h) do { _Pragma("unroll") for (int m = 0; m < 4; ++m) _Pragma("unroll") for (int k = 0; k < 2; ++k) dst[m][k] = *(const PG8_LAS bf16x8*)(lds + PG8_SA(b, h) + aoff + m * 2048 + k * 1024); } while (0)
#define PG8_LDB(dst, b, h) do { _Pragma("unroll") for (int n = 0; n < 2; ++n) _Pragma("unroll") for (int k = 0; k < 2; ++k) dst[n][k] = *(const PG8_LAS bf16x8*)(lds + PG8_SB(b, h) + boff + n * 2048 + k * 1024); } while (0)
#define PG8_MMA(ai, bj, At, Bt) do { __builtin_amdgcn_s_setprio(1); _Pragma("unroll") for (int m = 0; m < 4; ++m) _Pragma("unroll") for (int n = 0; n < 2; ++n) _Pragma("unroll") for (int k = 0; k < 2; ++k) \
    acc[ai][bj][m][n] = __builtin_amdgcn_mfma_f32_16x16x32_bf16(Bt[n][k], At[m][k], acc[ai][bj][m][n], 0, 0, 0); __builtin_amdgcn_s_setprio(0); } while (0)
#define PG8_WAIT_V(n) asm volatile("s_waitcnt vmcnt(" #n ")" ::: "memory")
#define PG8_WAIT_L(n) asm volatile("s_waitcnt lgkmcnt(" #n ")" ::: "memory")
#define PG8_BAR __builtin_amdgcn_s_barrier()
#define PG8_SCHED __builtin_amdgcn_sched_barrier(0)
  Unit cur, nxt; int ui = 0;
  if (!S.next(0, cur)) return;
  f32x4 acc[2][2][4][2];
#pragma unroll
  for (int a = 0; a < 2; ++a)
#pragma unroll
    for (int b = 0; b < 2; ++b)
#pragma unroll
      for (int m = 0; m < 4; ++m)
#pragma unroll
        for (int n = 0; n < 2; ++n) acc[a][b][m][n] = (f32x4){0.f, 0.f, 0.f, 0.f};
  bf16x8 At[4][2], B0[2][2], B1[2][2];
  const char* cA = S.aptr(cur); const char* cB = S.bptr(cur);
  if constexpr (GA) {
    const int* tk = S.tokptr(cur);
#pragma unroll
    for (int h = 0; h < 2; ++h)
#pragma unroll
      for (int i = 0; i < 2; ++i) { cvA[h][i] = (unsigned)tk[h * 128 + i * 64 + gR] * (unsigned)(K * 2) + gC2; nvA[h][i] = cvA[h][i]; }
  }
  PG8_STAGE(PG8_SB(0, 0), cB); PG8_STAGE_A(PG8_SA(0, 0), cA, false); PG8_STAGE(PG8_SB(0, 1), cB + hstep); PG8_STAGE_A(PG8_SA(0, 1), cA + hstepA, false);
  if (wr == 1) PG8_BAR;
  PG8_WAIT_V(4); PG8_BAR;
  PG8_STAGE(PG8_SB(1, 0), cB + kstep); PG8_STAGE_A(PG8_SA(1, 0), cA + kstep, false); PG8_STAGE(PG8_SB(1, 1), cB + hstep + kstep);
  PG8_WAIT_V(6); PG8_BAR;
  for (;;) {
    const bool has_next = S.next(ui + 1, nxt);
    const char* nA = has_next ? S.aptr(nxt) : cA; const char* nB = has_next ? S.bptr(nxt) : cB;
    if constexpr (GA) {
      if (has_next && wid < 4)
        __builtin_amdgcn_global_load_lds((const unsigned*)(S.tokptr(nxt) + wid * 64 + lane), (PG8_LAS unsigned*)(lds + STAGE_BYTES + wid * 256), 4, 0, 0);
    }
    for (int t = 0; t < nt; t += 2) {
      const bool last = (t == nt - 2);
      const bool lastn = last && has_next;
      if constexpr (GA) {
#pragma unroll
        for (int h = 0; h < 2; ++h)
#pragma unroll
          for (int i = 0; i < 2; ++i) nvA[h][i] = (unsigned)idxl[h * 128 + i * 64 + gR] * (unsigned)(K * 2) + gC2;
      }
      const char* a1 = cA + (size_t)(t + 1) * kstep;
      const char* a2 = last ? nA : cA + (size_t)(t + 2) * kstep; const char* b2 = last ? nB : cB + (size_t)(t + 2) * kstep;
      const char* a3 = a2 + kstep; const char* b3 = b2 + kstep;
      PG8_LDB(B0, 0, 0); PG8_SCHED; PG8_LDA(At, 0, 0); PG8_STAGE_A(PG8_SA(1, 1), a1 + hstepA, false);
      PG8_WAIT_L(8); PG8_BAR; PG8_WAIT_L(0); PG8_MMA(0, 0, At, B0); PG8_BAR; PG8_SCHED;
      PG8_LDB(B1, 0, 1); PG8_STAGE(PG8_SB(0, 0), b2);
      PG8_BAR; PG8_WAIT_L(0); PG8_MMA(0, 1, At, B1); PG8_BAR;
      PG8_LDA(At, 0, 1); PG8_STAGE_A(PG8_SA(0, 0), a2, lastn);
      PG8_BAR; PG8_WAIT_L(0); PG8_MMA(1, 0, At, B0); PG8_BAR; PG8_SCHED;
      PG8_STAGE(PG8_SB(0, 1), b2 + hstep);
      PG8_WAIT_V(6); PG8_BAR; PG8_MMA(1, 1, At, B1); PG8_BAR;
      PG8_LDB(B0, 1, 0); PG8_SCHED; PG8_LDA(At, 1, 0); PG8_STAGE_A(PG8_SA(0, 1), a2 + hstepA, lastn);
      PG8_WAIT_L(8); PG8_BAR; PG8_WAIT_L(0); PG8_MMA(0, 0, At, B0); PG8_BAR; PG8_SCHED;
      PG8_LDB(B1, 1, 1); PG8_STAGE(PG8_SB(1, 0), b3);
      PG8_BAR; PG8_WAIT_L(0); PG8_MMA(0, 1, At, B1); PG8_BAR;
      PG8_LDA(At, 1, 1); PG8_STAGE_A(PG8_SA(1, 0), a3, lastn);
      PG8_BAR; PG8_WAIT_L(0); PG8_MMA(1, 0, At, B0); PG8_BAR; PG8_SCHED;
      PG8_STAGE(PG8_SB(1, 1), b3 + hstep);
      PG8_WAIT_V(6); PG8_BAR; PG8_MMA(1, 1, At, B1); PG8_BAR;
    }
    if (wr == 0) PG8_BAR;
    bool keep;
    { int fr2 = fr, fq2 = fq; asm volatile("" : "+v"(fr2), "+v"(fq2));
      keep = E(acc, cur, wr, wc, fr2, fq2); }
    if (!has_next) break;
    if (!keep)
#pragma unroll
    for (int a = 0; a < 2; ++a)
#pragma unroll
      for (int b = 0; b < 2; ++b)
#pragma unroll
        for (int m = 0; m < 4; ++m)
#pragma unroll
          for (int n = 0; n < 2; ++n) acc[a][b][m][n] = (f32x4){0.f, 0.f, 0.f, 0.f};
    cur = nxt; cA = nA; cB = nB; ++ui;
    if constexpr (GA) {
#pragma unroll
      for (int h = 0; h < 2; ++h)
#pragma unroll
        for (int i = 0; i < 2; ++i) cvA[h][i] = nvA[h][i];
    }
    if (wr == 1) PG8_BAR;
  }
  PG8_WAIT_V(0);
  PG8_BAR;
#undef PG8_SA
#undef PG8_SB
#undef PG8_STAGE
#undef PG8_STAGE_
#undef PG8_STAGE_A
#undef PG8_LDA
#undef PG8_LDB
#undef PG8_MMA
#undef PG8_WAIT_V
#undef PG8_WAIT_L
#undef PG8_BAR
#undef PG8_SCHED
}
template <class F>
__device__ __forceinline__ void epi_each(const f32x4 (&acc)[2][2][4][2], int wr, int wc, int fr, int fq, const F& f) {
#pragma unroll
  for (int ai = 0; ai < 2; ++ai)
#pragma unroll
    for (int m = 0; m < 4; ++m)
#pragma unroll
      for (int bj = 0; bj < 2; ++bj) f(ai * HALF + wr * 64 + m * 16 + fr, bj * HALF + wc * 32 + 8 * fq, acc[ai][bj][m][0], acc[ai][bj][m][1]);
}
struct GridSched {
  const char* A; const char* B; size_t tstep; int nM, nN, nwg, G, c, pm0;
  __device__ __forceinline__ void init(const void* A_, const void* B_, int K, int nM_, int nN_, int pm0_, int G_, int c_) {
    A = (const char*)A_; B = (const char*)B_; tstep = (size_t)BM * K * 2; nM = nM_; nN = nN_; nwg = nM * nN; G = G_; c = c_; pm0 = pm0_;
  }
  __device__ __forceinline__ bool next(int i, Unit& u) const {
    const long L = (long)i * G + c; if (L >= nwg) return false;
    int wgid = (int)L; { const int q = nwg / NXCD, r = nwg % NXCD, xcd = wgid % NXCD, off = wgid / NXCD; wgid = (xcd < r ? xcd * (q + 1) : r * (q + 1) + (xcd - r) * q) + off; }
    const int nig = WGM * nN, gid = wgid / nig, fm = gid * WGM, gsz = (nM - fm) < WGM ? (nM - fm) : WGM;
    u.pm = pm0 + fm + ((wgid % nig) % gsz); u.pn = (wgid % nig) / gsz; u.z = 0; return true;
  }
  __device__ __forceinline__ const char* aptr(const Unit& u) const { return A + (size_t)u.pm * tstep; }
  __device__ __forceinline__ const char* bptr(const Unit& u) const { return B + (size_t)u.pn * tstep; }
};
}
using pg8::Unit;


#define XB_TMO      128
#define XB_XCNT(j)  (256  + 64 * (j))
#define XB_XSUB(j)  (1280 + 64 * (j))
#define XB_XGEN(j)  (2304 + 64 * (j))
#define XB_TOP      3328
#define XB_TOPGEN   3392
#define XB_SPIN_CAP (1u << 18)
__device__ __forceinline__ unsigned xb_ld(unsigned* p)              { return __hip_atomic_load(p, __ATOMIC_RELAXED, __HIP_MEMORY_SCOPE_AGENT); }
__device__ __forceinline__ unsigned xb_add(unsigned* p, unsigned v) { return __hip_atomic_fetch_add(p, v, __ATOMIC_RELAXED, __HIP_MEMORY_SCOPE_AGENT); }
__device__ __forceinline__ unsigned xb_xcc_id() { return (unsigned)__builtin_amdgcn_s_getreg((3 << 11) | 20) & 0xFu; }
#define XB_SPIN(cond, bar) do { unsigned _sp = 0; while (cond) { __builtin_amdgcn_s_sleep(1); \
    if ((++_sp & 255u) == 0u) { if (xb_ld(&(bar)[XB_TMO])) break; if (_sp > XB_SPIN_CAP) { atomicAdd(&(bar)[XB_TMO], 1u); break; } } } } while (0)
struct XcdBarrier { unsigned* bar; unsigned x; volatile PG8_LAS unsigned* st; };
__device__ __forceinline__ XcdBarrier xcd_barrier_post(unsigned* bar, volatile PG8_LAS unsigned* st) {
  XcdBarrier b; b.bar = bar; b.x = xb_xcc_id(); b.st = st;
  if (threadIdx.x == 0) (void)xb_add(&bar[XB_XCNT(b.x)], 1u);
  return b;
}
__device__ __forceinline__ void xcd_barrier_complete(unsigned* bar, unsigned x, unsigned& nloc, unsigned& nx) {
  const unsigned G = gridDim.x * gridDim.y * gridDim.z;
  unsigned sum, cnt, mine, sp = 0u;
  for (;;) {
    sum = 0u; cnt = 0u; mine = 0u;
#pragma unroll
    for (unsigned j = 0; j < 16; ++j) { const unsigned c = xb_ld(&bar[XB_XCNT(j)]); sum += c; cnt += (c > 0u) ? 1u : 0u; mine = (j == x) ? c : mine; }
    if (sum == G) break;
    __builtin_amdgcn_s_sleep(1);
    if ((++sp & 255u) == 0u) { if (xb_ld(&bar[XB_TMO])) break; if (sp > XB_SPIN_CAP) { atomicAdd(&bar[XB_TMO], 1u); break; } }
  }
  nloc = mine > 0u ? mine : 1u; nx = cnt > 0u ? cnt : 1u;
}
__device__ __forceinline__ void xcd_barrier(const XcdBarrier& b) {
  asm volatile("s_waitcnt vmcnt(0)" ::: "memory");
  __syncthreads();
  if (threadIdx.x == 0) {
    unsigned* bar = b.bar;
    __builtin_amdgcn_s_waitcnt(0);
    unsigned nloc = b.st[0], nx = b.st[1];
    if (nloc == 0u) { xcd_barrier_complete(bar, b.x, nloc, nx); b.st[0] = nloc; b.st[1] = nx; }
    const unsigned old = xb_add(&bar[XB_XSUB(b.x)], 1u);
    const unsigned gen = old / nloc;
    if (old + 1u == (gen + 1u) * nloc) {
      __builtin_amdgcn_fence(__ATOMIC_RELEASE, "agent");
      asm volatile("s_waitcnt vmcnt(0)" ::: "memory");
      const unsigned og = xb_add(&bar[XB_TOP], 1u);
      const unsigned tg = og / nx;
      if (og + 1u == (tg + 1u) * nx) xb_add(&bar[XB_TOPGEN], 1u);
      else XB_SPIN(xb_ld(&bar[XB_TOPGEN]) == tg, bar);
      __builtin_amdgcn_fence(__ATOMIC_ACQUIRE, "agent");
      xb_add(&bar[XB_XGEN(b.x)], 1u);
      asm volatile("s_waitcnt vmcnt(0)" ::: "memory");
    } else {
      XB_SPIN(xb_ld(&bar[XB_XGEN(b.x)]) == gen, bar);
      __builtin_amdgcn_fence(__ATOMIC_ACQUIRE, "agent");
      asm volatile("s_waitcnt vmcnt(0)" ::: "memory");
    }
  }
  __syncthreads();
}


__device__ __forceinline__ void sub_barrier(unsigned* cnt, int nb) {
  asm volatile("s_waitcnt vmcnt(0)" ::: "memory");
  __syncthreads();
  if (threadIdx.x == 0) {
    __builtin_amdgcn_fence(__ATOMIC_RELEASE, "agent");
    asm volatile("s_waitcnt vmcnt(0)" ::: "memory");
    (void)xb_add(cnt, 1u);
    unsigned sp = 0;
    while (xb_ld(cnt) < (unsigned)nb && ++sp < (1u << 20)) __builtin_amdgcn_s_sleep(1);
    __builtin_amdgcn_fence(__ATOMIC_ACQUIRE, "agent");
    asm volatile("s_waitcnt vmcnt(0)" ::: "memory");
  }
  __syncthreads();
}

template <class LA, class LB>
__device__ __forceinline__ void gemm_main(f32x4 (&acc)[4][4], const int nk, const LA& la, const LB& lb, char* lds, const int t) {
  const int lane = t & 63, wid = t >> 6, fr = lane & 15, fq = lane >> 4, wr = wid >> 1, wc = wid & 1;
  const int sr = t >> 3, sc = t & 7;
  const int wofs = sr * 128 + ((sc ^ (sr & 7)) << 4);
  const int aofs = (wr * 64 + fr) * 128, bofs = 16384 + (wc * 64 + fr) * 128;
  const int x0 = ((fq) ^ (fr & 7)) << 4, x1 = ((4 + fq) ^ (fr & 7)) << 4;
  bf16x8 ra[4], rb[4];
#pragma unroll
  for (int i = 0; i < 4; ++i) { ra[i] = la(i, 0); rb[i] = lb(i, 0); }
#pragma unroll
  for (int i = 0; i < 4; ++i) { *(bf16x8*)(lds + wofs + i * 4096) = ra[i]; *(bf16x8*)(lds + 16384 + wofs + i * 4096) = rb[i]; }
  __syncthreads();
  for (int kt = 0; kt < nk; ++kt) {
    const char* cur = lds + (kt & 1) * 32768;
    const bool more = kt + 1 < nk;
    if (more) {
#pragma unroll
      for (int i = 0; i < 4; ++i) { ra[i] = la(i, (kt + 1) * 64); rb[i] = lb(i, (kt + 1) * 64); }
    }
#pragma unroll
    for (int kk = 0; kk < 2; ++kk) {
      const int xo = kk ? x1 : x0;
      bf16x8 af[4], bv[4];
#pragma unroll
      for (int m = 0; m < 4; ++m) af[m] = *(const bf16x8*)(cur + aofs + m * 2048 + xo);
#pragma unroll
      for (int n = 0; n < 4; ++n) bv[n] = *(const bf16x8*)(cur + bofs + n * 2048 + xo);
#pragma unroll
      for (int m = 0; m < 4; ++m)
#pragma unroll
        for (int n = 0; n < 4; ++n) acc[m][n] = __builtin_amdgcn_mfma_f32_16x16x32_bf16(bv[n], af[m], acc[m][n], 0, 0, 0);
    }
    if (more) {
      char* nxt = lds + ((kt + 1) & 1) * 32768;
#pragma unroll
      for (int i = 0; i < 4; ++i) { *(bf16x8*)(nxt + wofs + i * 4096) = ra[i]; *(bf16x8*)(nxt + 16384 + wofs + i * 4096) = rb[i]; }
    }
    __syncthreads();
  }
}
__device__ __forceinline__ void zero_acc(f32x4 (&acc)[4][4]) {
#pragma unroll
  for (int m = 0; m < 4; ++m)
#pragma unroll
    for (int n = 0; n < 4; ++n) acc[m][n] = (f32x4){0.f, 0.f, 0.f, 0.f};
}
template <class EP>
__device__ __forceinline__ void gemm_epi(const f32x4 (&acc)[4][4], const EP& ep, const int t) {
  const int lane = t & 63, wid = t >> 6, fr = lane & 15, fq = lane >> 4, wr = wid >> 1, wc = wid & 1;
#pragma unroll
  for (int m = 0; m < 4; ++m)
#pragma unroll
    for (int n = 0; n < 4; ++n) ep(wr * 64 + m * 16 + fr, wc * 64 + n * 16 + fq * 4, acc[m][n]);
}
struct RowLd {
  const bf16_t* p[4];
  __device__ __forceinline__ RowLd(const bf16_t* base, size_t r0, size_t ld, const int t) {
#pragma unroll
    for (int i = 0; i < 4; ++i) p[i] = base + (r0 + (t >> 3) + 32 * i) * ld + (t & 7) * 8;
  }
  __device__ __forceinline__ bf16x8 operator()(int i, int k0) const { return *(const bf16x8*)(p[i] + k0); }
};

__device__ __forceinline__ void phase_setup(const Params& p, char* lds, int wid0) {
  float* tab = (float*)lds;
  float* sv = (float*)(lds + 16384);
  float* red = (float*)(lds + 16384 + 36864);
  const int tid = opaque_tid(wid0);
  float* mod = (float*)(p.ws + O_MOD);
  bf16_t* FTL = (bf16_t*)(p.ws + O_FTL);
  bool have_tab = false;
  const int NMOD = 192, NITEM = NMOD + 4096 + 1;
  for (int item = blockIdx.x; item < NITEM; item += gridDim.x) {
    if (item < NMOD) {
      const int l = item / 96, n = (item % 96) * 64 + (tid & 63), kp = tid >> 6;
      for (int e = tid; e < 9 * 1024; e += NTHREADS) {
        const int r = e >> 10, k = e & 1023;
        const float v = r < 8 ? p.c[r * 1024 + k] : p.c_ctx[k];
        sv[e] = v / (1.0f + __expf(-v));
      }
      __syncthreads();
      float acc[9];
#pragma unroll
      for (int r = 0; r < 9; ++r) acc[r] = 0.f;
      const float* w = p.ada_w + (size_t)l * 1024 * 6144 + n;
#pragma unroll 8
      for (int k = kp * 128; k < kp * 128 + 128; ++k) {
        const float wv = w[(size_t)k * 6144];
#pragma unroll
        for (int r = 0; r < 9; ++r) acc[r] += sv[r * 1024 + k] * wv;
      }
#pragma unroll
      for (int r = 0; r < 9; ++r) red[(kp * 9 + r) * 64 + (tid & 63)] = acc[r];
      __syncthreads();
      for (int e = tid; e < 9 * 64; e += NTHREADS) {
        const int r = e >> 6, c = e & 63;
        float a = 0.f;
#pragma unroll
        for (int q8 = 0; q8 < 8; ++q8) a += red[(q8 * 9 + r) * 64 + c];
        const int nn = (item % 96) * 64 + c;
        mod[(l * 9 + r) * 6144 + nn] = a + p.ada_b[l * 6144 + nn];
      }
      __syncthreads();
    } else {
      if (!have_tab) {
        for (int j = tid; j < 4096; j += NTHREADS) tab[j] = cospif((float)j * (1.0f / 2048.0f));
        __syncthreads();
        have_tab = true;
      }
      if (item < NMOD + 4096) {
        const int k = (item - NMOD) & 2047, part = (item - NMOD) >> 11;
        const float scale = 0.0013810679320049757f;
        for (int e8 = tid; e8 < KH / 8; e8 += NTHREADS) {
          float v[8];
#pragma unroll
          for (int jx = 0; jx < 8; ++jx) {
            const int t = e8 * 8 + jx, jj = (k * t) & 4095;
            if (part == 0) v[jx] = t <= 2048 ? tab[jj] * scale : 0.f;
            else v[jx] = t < 2048 ? -tab[(jj - 1024) & 4095] * scale : 0.f;
          }
          u32x4 w;
          w.x = pk_bf16(v[0], v[1]); w.y = pk_bf16(v[2], v[3]); w.z = pk_bf16(v[4], v[5]); w.w = pk_bf16(v[6], v[7]);
          *(u32x4*)(FTL + ((size_t)part * 2048 + k) * KH + e8 * 8) = w;
        }
      } else {
        bf16_t* FTC = (bf16_t*)(p.ws + O_FTC);
        bf16_t* CS = (bf16_t*)(p.ws + O_CS);
        const float scale_c = 0.005524271728019903f;
        for (int e = tid; e < 256 * 512; e += NTHREADS) {
          const int k = e >> 9, cs = (e >> 8) & 1, t = e & 255;
          const int jj = ((k * t) & 255) * 16;
          FTC[e] = f2bf((cs == 0 ? tab[jj] : -tab[(jj - 1024) & 4095]) * scale_c);
        }
        for (int e = tid; e < 256 * 128; e += NTHREADS) {
          const int row = e >> 7, d = e & 127, cs = row >> 7, m = row & 127;
          const int jj = ((m * d) & 127) * 32;
          CS[e] = f2bf(cs == 0 ? tab[jj] : tab[(jj - 1024) & 4095]);
        }
        float* lb = (float*)(p.ws + O_LB);
        for (int e = tid; e < 2 * 512; e += NTHREADS) {
          const int dir = e >> 9, ch = e & 511;
          const float r0 = p.lb_raw[(dir * 2 + 0) * 512 + ch], r1 = p.lb_raw[(dir * 2 + 1) * 512 + ch];
          const float mx = fmaxf(r0, r1), e0 = expf(r0 - mx), e1 = expf(r1 - mx);
          const float p0 = e0 / (e0 + e1), p1 = e1 / (e0 + e1);
          lb[(dir * 2 + 0) * 512 + ch] = p0 - p0;
          lb[(dir * 2 + 1) * 512 + ch] = (p0 + p1) - p0;
        }
      }
    }
  }
  __syncthreads();
}

constexpr size_t OUT_W13B = (size_t)NL * D * 2;
template <bool VMAP>
__device__ __forceinline__ void conv_items(const Params& p, int l, char* lds, int wid0, const int lo, const int hi, const int r, const int n) {
  const int tid = opaque_tid(wid0);
  float* tile = (float*)lds;
  struct Item { const float* src; bf16_t* dst; int K, N, n0, k0, drow0; };
  auto decode = [&](int item) -> Item {
    int i = item;
    if (VMAP) {
      if (p.w2sep) i = i < 2048 ? i + 608 : i < 2496 ? i - 2048 : i < 3520 ? i + 160 : i - 3072;
      else i = i < 2048 ? i + 608 : i < 2656 ? i - 2048 : i;
    }
    Item it;
    bool w13 = false;
    if (i < 448) {
      it.src = p.w_in + (size_t)l * 1024 * INC; it.dst = (bf16_t*)(p.ws + O_WIN); it.K = 1024; it.N = INC;
    } else if ((i -= 448) < 96) {
      const int j = i / 32; i -= j * 32;
      it.src = p.w_branch + ((size_t)l * 3 + j) * 512 * 1024; it.dst = (bf16_t*)(p.ws + O_WBR) + (size_t)j * 1024 * 512; it.K = 512; it.N = 1024;
    } else if ((i -= 96) < 64) {
      it.src = p.w_out + (size_t)l * 1024 * 1024; it.dst = (bf16_t*)(p.ws + O_WOUT); it.K = 1024; it.N = 1024;
    } else if ((i -= 64) < 2048) {
      const int e = i / 128; i -= e * 128;
      it.src = p.w13 + ((size_t)l * 16 + e) * 1024 * 2048;
      it.dst = (l == 1 ? (bf16_t*)((char*)p.out + OUT_W13B) : (bf16_t*)(p.ws + O_W13)) + (size_t)e * 2048 * 1024; it.K = 1024; it.N = 2048; w13 = true;
    } else {
      i -= 2048;
      const int e = i / 64; i -= e * 64;
      it.src = p.w2 + ((size_t)l * 16 + e) * 1024 * 1024; it.dst = (bf16_t*)(p.ws + (l == 1 && p.w2sep ? O_W2B : O_W2)) + (size_t)e * 1024 * 1024; it.K = 1024; it.N = 1024;
    }
    const int nkt = it.K / 128;
    it.n0 = (i / nkt) * 128; it.k0 = (i % nkt) * 128;
    it.drow0 = w13 ? (((it.n0 & 1023) >> 7) * 256 + (it.n0 >> 10) * 128) : it.n0;
    return it;
  };
  f32x4 pf[8];
  auto fetch = [&](const Item& it) {
#pragma unroll
    for (int q = 0; q < 8; ++q) pf[q] = *(const f32x4*)(it.src + (size_t)(it.k0 + q * 16 + (tid >> 5)) * it.N + it.n0 + (tid & 31) * 4);
  };
  int rr = r; asm volatile("" : "+s"(rr));
  const int item0 = lo + rr;
  Item cur = decode(item0 < hi ? item0 : lo);
  if (item0 < hi) fetch(cur);
  for (int item = item0; item < hi; item += n) {
#pragma unroll
    for (int q = 0; q < 8; ++q) {
      const int kk = q * 16 + (tid >> 5), nn = (tid & 31) * 4;
      tile[(nn + 0) * 129 + kk] = pf[q][0]; tile[(nn + 1) * 129 + kk] = pf[q][1]; tile[(nn + 2) * 129 + kk] = pf[q][2]; tile[(nn + 3) * 129 + kk] = pf[q][3];
    }
    const Item me = cur;
    if (item + n < hi) { cur = decode(item + n); fetch(cur); }
    __syncthreads();
#pragma unroll
    for (int q2 = 0; q2 < 4; ++q2) {
      const int q = tid + q2 * 512, nn = q >> 4, kc = (q & 15) * 8;
      const float* tp = tile + nn * 129 + kc;
      u32x4 w;
      w.x = pk_bf16(tp[0], tp[1]); w.y = pk_bf16(tp[2], tp[3]); w.z = pk_bf16(tp[4], tp[5]); w.w = pk_bf16(tp[6], tp[7]);
      *(u32x4*)(me.dst + (size_t)(me.drow0 + nn) * me.K + me.k0 + kc) = w;
    }
    __syncthreads();
  }
}
__device__ __forceinline__ void phase_conv(const Params& p, int l, char* lds, int wid0) { conv_items<false>(p, l, lds, wid0, 0, 3680, blockIdx.x, gridDim.x); }
constexpr int CF_S0 = 2304, CF_S2 = 320;
__device__ __forceinline__ void conv_fill(const Params& p, char* lds, int wid0, const int slot, const int r, const int n) {
  const bool tuned = gridDim.x == 256;
  int a, b;
  int c0 = CF_S0, c2 = CF_S0 + CF_S2;
  if (!p.w2sep) { c0 = c0 < 2496 ? c0 : 2496; c2 = c2 < 2656 ? c2 : 2656; }
  if (slot == 0) { a = 0; b = c0; } else if (slot == 2) { a = c0; b = c2; } else { a = c2; b = 3680; }
  if (slot < 4) { if (!tuned) return; }
  else if (!tuned) a = 0;
  conv_items<true>(p, 1, lds, wid0, a, b, r, n);
}
__device__ __forceinline__ void phase_rowA(const Params& p, int l, int wid0) {
  const int tid = opaque_tid(wid0), wid = tid >> 6, lane = tid & 63;
  const float* xlat = l == 0 ? p.x : p.out;
  const float* xctx = l == 0 ? p.ctx : (const float*)(p.ws + O_CTXB);
  const float* mod = (const float*)(p.ws + O_MOD);
  bf16_t* H = (bf16_t*)(p.ws + O_H);
  const float* nw = p.norm_w + (size_t)(l * 4 + 0) * 1024;
  for (int row = blockIdx.x * NWAVE + wid; row < NT; row += gridDim.x * NWAVE) {
    const float* xr = row < NL ? xlat + (size_t)row * 1024 : xctx + (size_t)(row - NL) * 1024;
    const int mr = row < NL ? (row >> 12) : 8;
    const float* md = mod + (size_t)(l * 9 + mr) * 6144;
    f32x4 v[4];
    float ss = 0.f;
#pragma unroll
    for (int i = 0; i < 4; ++i) {
      v[i] = *(const f32x4*)(xr + i * 256 + lane * 4);
      ss += v[i][0] * v[i][0] + v[i][1] * v[i][1] + v[i][2] * v[i][2] + v[i][3] * v[i][3];
    }
    ss = wave_sum(ss);
    const float rs = rsqrtf(ss * (1.0f / 1024.0f) + 1e-6f);
#pragma unroll
    for (int i = 0; i < 4; ++i) {
      const int e = i * 256 + lane * 4;
      const f32x4 w = *(const f32x4*)(nw + e), sh = *(const f32x4*)(md + e), sc = *(const f32x4*)(md + 1024 + e);
      f32x4 o;
#pragma unroll
      for (int j = 0; j < 4; ++j) o[j] = v[i][j] * rs * w[j] * (1.0f + sc[j]) + sh[j];
      st4bf(H + (size_t)row * 1024 + e, o);
    }
  }
}

struct EpiGin {
  char* ws; const float* lbp; int l; int pn0;
  __device__ __forceinline__ bool operator()(f32x4 (&acc)[2][2][4][2], const Unit& u, int wr, int wc, int fr, int fq) const {
    const int pn = u.pn + pn0;
    const int sec = pn >> 1, cin0 = (pn & 1) * 256;
    const size_t row0 = (size_t)u.pm * 256;
    if (sec >= 8) {
      const int tl = (wr * 4 + wc) * 64 + fq * 16 + fr;
      unsigned char* GT = (unsigned char*)(ws + O_G) + ((size_t)u.pm * 12 + (pn - 16)) * 65536 + (size_t)tl * 8;
      auto q8 = [](float z) { return __builtin_amdgcn_rcpf(__builtin_fmaf(__expf(-z), 0.00390625f, 0.00390625f)); };
#pragma unroll
      for (int ai = 0; ai < 2; ++ai)
#pragma unroll
        for (int m = 0; m < 4; ++m)
#pragma unroll
          for (int bj = 0; bj < 2; ++bj) {
            const f32x4 a = acc[ai][bj][m][0], b = acc[ai][bj][m][1];
            u32x2 w; w.x = 0u; w.y = 0u;
#pragma unroll
            for (int j = 0; j < 4; ++j) { w.x = __builtin_amdgcn_cvt_pk_u8_f32(q8(a[j]), j, w.x); w.y = __builtin_amdgcn_cvt_pk_u8_f32(q8(b[j]), j, w.y); }
            *(u32x2*)(GT + (size_t)((ai * 4 + m) * 2 + bj) * 4096) = w;
          }
    } else if (sec == 7) {
      bf16_t* VT = (bf16_t*)(ws + O_VT);
      pg8::epi_each(acc, wr, wc, fr, fq, [&](int r, int c, f32x4 v0, f32x4 v1) {
        const int chunk = u.pm * 2 + (r >> 7), q = r & 127, g = (cin0 + c) >> 7, d = c & 127;
        bf16_t* dst = VT + (((size_t)chunk * 4 + g) * 128 + d) * 128 + q;
#pragma unroll
        for (int j = 0; j < 4; ++j) { dst[j * 128] = f2bf(geluf_(v0[j])); dst[(4 + j) * 128] = f2bf(geluf_(v1[j])); }
      });
    } else if (sec == 1 || sec == 2) {
      bf16_t* LF = (bf16_t*)(ws + (sec == 1 ? O_LFF : O_LFB)) + row0 * 512 + cin0;
      const float* lbv = lbp + ((sec - 1) * 2 + l) * 512 + cin0;
      pg8::epi_each(acc, wr, wc, fr, fq, [&](int r, int c, f32x4 v0, f32x4 v1) {
        const f32x4 b0 = *(const f32x4*)(lbv + c), b1 = *(const f32x4*)(lbv + c + 4);
        f32x4 o0, o1;
#pragma unroll
        for (int j = 0; j < 4; ++j) {
          o0[j] = 1.0f - (fmaxf(b0[j], 1e-20f) + (1.0f - b0[j]) * sigmoidf_(v0[j]));
          o1[j] = 1.0f - (fmaxf(b1[j], 1e-20f) + (1.0f - b1[j]) * sigmoidf_(v1[j]));
        }
        st8bf(LF + (size_t)r * 512 + c, o0, o1);
      });
    } else {
      const size_t off = sec == 0 ? O_Q : sec == 3 ? O_I : sec == 4 ? O_GA : sec == 5 ? O_ZB : O_U;
      bf16_t* dst = (bf16_t*)(ws + off) + row0 * 512 + cin0;
      const int act = (sec == 0 || sec == 4) ? 1 : (sec == 6 ? 2 : 0);
      pg8::epi_each(acc, wr, wc, fr, fq, [&](int r, int c, f32x4 v0, f32x4 v1) {
        f32x4 o0, o1;
#pragma unroll
        for (int j = 0; j < 4; ++j) {
          o0[j] = act == 1 ? siluf_(v0[j]) : act == 2 ? geluf_(v0[j]) : v0[j];
          o1[j] = act == 1 ? siluf_(v1[j]) : act == 2 ? geluf_(v1[j]) : v1[j];
        }
        st8bf(dst + (size_t)r * 512 + c, o0, o1);
      });
    }
    return false;
  }
};
constexpr int GIN_R0 = 0;
__device__ __forceinline__ void phase_gin(const Params& p, int l, char* lds, int wid0) {
  const int tid = opaque_tid(wid0);
  PG8_LAS unsigned char* L = (PG8_LAS unsigned char*)lds;
  EpiGin E{p.ws, (const float*)(p.ws + O_LB), l, 0};
  pg8::GridSched S;
  const int R0 = gridDim.x == 256 ? GIN_R0 : 0;
  S.init(p.ws + O_H, p.ws + O_WIN, 1024, (l == 0 ? 136 : 128) - R0, 28, R0, gridDim.x, blockIdx.x);
  pg8::gemm_phase(L, 1024, S, E, tid);
  S.init(p.ws + O_H, p.ws + O_WIN, 1024, R0, 16, 0, gridDim.x, blockIdx.x);
  pg8::gemm_phase(L, 1024, S, E, tid);
  if (l == 1) {
    S.init(p.ws + O_H, p.ws + O_WIN, 1024, 8, 8, 128, gridDim.x, (blockIdx.x + gridDim.x / 2) % gridDim.x);
    pg8::gemm_phase(L, 1024, S, E, tid);
  }
}

__device__ __forceinline__ void phase_mix1(const Params& p, int l, char* lds0, int wid0, int kind, int bfirst, int bi_o = -1, int nb_o = 0) {
  const bool last = (l == 1);
  const int tid = opaque_tid(wid0), t = tid & 255, half = tid >> 8;
  char* lds = lds0 + half * 65536;
  const bf16_t* CS = (const bf16_t*)(p.ws + O_CS);
  const bf16_t* ZB = (const bf16_t*)(p.ws + O_ZB);
  const int NF1L = 2048, NF1C = last ? 0 : 128, NCH = last ? 256 : 272;
  const int ITEM0 = kind == 0 ? 0 : NF1L + NF1C, NITEM = kind == 0 ? NF1L + NF1C : NF1L + NF1C + NCH * 4;
  const int bi = nb_o > 0 ? bi_o : (int)blockIdx.x - bfirst, nb = nb_o > 0 ? nb_o : (int)gridDim.x - bfirst;
  if (bi < 0) return;
  for (int item = ITEM0 + bi * 2 + half; item < NITEM; item += nb * 2) {
    f32x4 acc[4][4];
    zero_acc(acc);
    if (item < NF1L + NF1C) {
      const bool isl = item < NF1L;
      int i = isl ? item : item - NF1L;
      const int mh = i & 1;
      i >>= 1;
      int tt, g, b;
      if (isl) { tt = i & 31; i >>= 5; } else { tt = i & 1; i >>= 1; }
      g = i & 3; b = i >> 2;
      const size_t rowbase = isl ? (size_t)b * 4096 + tt * 128 : (size_t)NL + b * 256 + tt * 128;
      RowLd la(CS, mh * 128, 128, t), lb(ZB + g * 128, rowbase, 512, t);
      gemm_main(acc, 2, la, lb, lds, t);
      bf16_t* dst = isl ? (bf16_t*)(p.ws + O_ZCL) + ((size_t)b * 512 + g * 128) * 8192 + mh * 4096 + tt * 128
                        : (bf16_t*)(p.ws + O_ZCC) + ((size_t)b * 512 + g * 128) * 512 + mh * 256 + tt * 128;
      const size_t ld = isl ? 8192 : 512;
      gemm_epi(acc, [&](int r, int c, f32x4 v) { st4bf(dst + (size_t)r * ld + c, v); }, t);
    } else {
      const int i = item - (NF1L + NF1C), ch = i >> 2, g = i & 3;
      const bf16_t* VT = (const bf16_t*)(p.ws + O_VT) + ((size_t)ch * 4 + g) * 128 * 128;
      float* rstd = (float*)lds;
      if (t < 128) {
        float ss = 0.f;
        for (int d = 0; d < 128; ++d) {
          const float v = bf2f(VT[d * 128 + t]);
          ss += v * v;
        }
        rstd[t] = rsqrtf(ss * (1.0f / 128.0f) + 1e-6f);
      }
      __syncthreads();
      const float* wsg = p.sgu_w + ((size_t)l * 4 + g) * 128 * 128;
      const int kc = (t & 7) * 8;
      float rr[2][8];
#pragma unroll
      for (int h2 = 0; h2 < 2; ++h2)
#pragma unroll
        for (int j = 0; j < 8; ++j) rr[h2][j] = rstd[h2 * 64 + kc + j];
      __syncthreads();
      auto la = [&](int ii, int k0) -> bf16x8 {
        const float* s = wsg + (size_t)((t >> 3) + 32 * ii) * 128 + k0 + kc;
        const f32x4 a = *(const f32x4*)s, b = *(const f32x4*)(s + 4);
        const int h2 = k0 >> 6;
        u32x4 w;
        w.x = pk_bf16(a[0] * (h2 ? rr[1][0] : rr[0][0]), a[1] * (h2 ? rr[1][1] : rr[0][1]));
        w.y = pk_bf16(a[2] * (h2 ? rr[1][2] : rr[0][2]), a[3] * (h2 ? rr[1][3] : rr[0][3]));
        w.z = pk_bf16(b[0] * (h2 ? rr[1][4] : rr[0][4]), b[1] * (h2 ? rr[1][5] : rr[0][5]));
        w.w = pk_bf16(b[2] * (h2 ? rr[1][6] : rr[0][6]), b[3] * (h2 ? rr[1][7] : rr[0][7]));
        return __builtin_bit_cast(bf16x8, w);
      };
      RowLd lb(VT, 0, 128, t);
      gemm_main(acc, 2, la, lb, lds, t);
      bf16_t* U = (bf16_t*)(p.ws + O_U) + (size_t)ch * 128 * 512 + g * 128;
      const float* nwv = p.sgu_norm_w + ((size_t)l * 4 + g) * 128;
      const float* sb = p.sgu_b + ((size_t)l * 4 + g) * 128;
      gemm_epi(acc, [&](int r, int c, f32x4 v) {
        const f32x4 nw4 = *(const f32x4*)(nwv + c);
        const float bb = sb[r];
        bf16_t* up = U + (size_t)r * 512 + c;
        const u32x2 uw = *(const u32x2*)up;
        f32x4 o;
        o[0] = bflo(uw.x) * (v[0] * nw4[0] + bb);
        o[1] = bfhi(uw.x) * (v[1] * nw4[1] + bb);
        o[2] = bflo(uw.y) * (v[2] * nw4[2] + bb);
        o[3] = bfhi(uw.y) * (v[3] * nw4[3] + bb);
        st4bf(up, o);
      }, t);
    }
  }
  __syncthreads();
}

#define SCAN_BAR() do { asm volatile("s_waitcnt lgkmcnt(0)" ::: "memory"); __builtin_amdgcn_s_barrier(); asm volatile("" ::: "memory"); } while (0)
__device__ __forceinline__ void scan_item(const Params& p, int item, char* lds, const int tid) {
  const int dir = item & 1, h = (item >> 1) & 3, b = item >> 3;
  const int wv = tid >> 6, lane = tid & 63, fr = lane & 15, fq = lane >> 4;
  const bool isP = wv < 4;
  char* RAWB = lds + 69632;
  float* qsum = (float*)(lds + 143360);
  const bf16_t* Q = (const bf16_t*)(p.ws + O_Q);
  const bf16_t* LF = (const bf16_t*)(p.ws + (dir ? O_LFB : O_LFF));
  const bf16_t* I = (const bf16_t*)(p.ws + O_I);
  bf16_t* O = (bf16_t*)(p.ws + (dir ? O_OBK : O_OF));
  auto rowOf = [&](int u) -> size_t {
    if (u < 256) return (size_t)NL + b * 256 + (dir ? 255 - u : u);
    const int v = u - 256;
    return (size_t)b * 4096 + (dir ? 4095 - v : v);
  };
  const int cp = tid & 63, tq = (tid >> 6) & 3;
  const bf16_t* srcs[3] = {LF, Q, I};
  auto dma = [&](int cc) {
    PG8_LAS unsigned char* dstb = (PG8_LAS unsigned char*)RAWB + (cc % 3) * 24576;
#pragma unroll
    for (int j = 0; j < 6; ++j) {
      const int g = j * 4 + wv, arr = g >> 3, rg = g & 7;
      const size_t o = rowOf(cc * 32 + rg * 4 + (lane >> 4)) * 512 + h * 128 + (lane & 15) * 8;
      __builtin_amdgcn_global_load_lds((const unsigned*)(srcs[arr] + o), (PG8_LAS unsigned*)(dstb + arr * 8192 + rg * 1024), 16, 0, 0);
    }
  };
  unsigned wkk[8];
  auto prepA = [&](int cc) {
    const char* raw = RAWB + (cc % 3) * 24576;
#pragma unroll
    for (int i = 0; i < 8; ++i) wkk[i] = *(const unsigned*)(raw + (tq * 8 + i) * 256 + cp * 4);
    f32x2 run = {1.f, 1.f};
#pragma unroll
    for (int i = 0; i < 8; ++i) { const f32x2 kk = {bflo(wkk[i]), bfhi(wkk[i])}; run = run * (1.0f - kk); }
    *(f32x2*)(qsum + tq * 128 + cp * 2) = run;
  };
  auto prepB = [&](int cc) {
    const char* raw = RAWB + (cc % 3) * 24576;
    char* OPB = lds + (cc & 1) * 34816;
    char* QP = OPB; char* KM = OPB + 8704; char* KT = OPB + 17408; char* VT = OPB + 25600;
    float* emid = (float*)(OPB + 33792); float* eend = emid + 128;
    unsigned wq[8], wi[8];
#pragma unroll
    for (int i = 0; i < 8; ++i) { wq[i] = *(const unsigned*)(raw + 8192 + (tq * 8 + i) * 256 + cp * 4); wi[i] = *(const unsigned*)(raw + 16384 + (tq * 8 + i) * 256 + cp * 4); }
    const f32x2 q0 = *(const f32x2*)(qsum + cp * 2), q1 = *(const f32x2*)(qsum + 128 + cp * 2), q2 = *(const f32x2*)(qsum + 256 + cp * 2), q3 = *(const f32x2*)(qsum + 384 + cp * 2);
    const f32x2 one = {1.f, 1.f};
    const f32x2 pmid = q0 * q1, pend = pmid * q2 * q3;
    const f32x2 base = tq == 0 ? one : tq == 1 ? q0 : tq == 2 ? pmid : pmid * q2;
    f32x2 rmid; rmid.x = __builtin_amdgcn_rcpf(fmaxf(pmid.x, 1e-30f)); rmid.y = __builtin_amdgcn_rcpf(fmaxf(pmid.y, 1e-30f));
    f32x2 ebm = pend * rmid; ebm.x = fminf(ebm.x, 1.0f); ebm.y = fminf(ebm.y, 1.0f);
    f32x2 run = base * rmid;
    unsigned oq[8], ok[8], kt0[4], kt1[4], vt0[4], vt1[4];
    float pk0 = 0.f, pk1 = 0.f;
#pragma unroll
    for (int i = 0; i < 8; ++i) {
      const f32x2 kk = {bflo(wkk[i]), bfhi(wkk[i])}, qv = {bflo(wq[i]), bfhi(wq[i])};
      run = run * (one - kk);
      f32x2 ea; ea.x = fminf(fmaxf(run.x, 1e-26f), 1e26f); ea.y = fminf(fmaxf(run.y, 1e-26f), 1e26f);
      f32x2 er; er.x = __builtin_amdgcn_rcpf(ea.x); er.y = __builtin_amdgcn_rcpf(ea.y);
      const f32x2 km = kk * er, qp = qv * ea, kpp = km * ebm;
      oq[i] = pk_bf16(qp.x, qp.y);
      ok[i] = pk_bf16(km.x, km.y);
      if (i & 1) {
        kt0[i >> 1] = pk_bf16(pk0, kpp.x); kt1[i >> 1] = pk_bf16(pk1, kpp.y);
        vt0[i >> 1] = (wi[i - 1] & 0xffffu) | (wi[i] << 16); vt1[i >> 1] = (wi[i - 1] >> 16) | (wi[i] & 0xffff0000u);
      } else { pk0 = kpp.x; pk1 = kpp.y; }
    }
#pragma unroll
    for (int i = 0; i < 8; ++i) { *(unsigned*)(QP + (tq * 8 + i) * 272 + cp * 4) = oq[i]; *(unsigned*)(KM + (tq * 8 + i) * 272 + cp * 4) = ok[i]; }
    u32x4 w;
    w.x = kt0[0]; w.y = kt0[1]; w.z = kt0[2]; w.w = kt0[3]; *(u32x4*)(KT + (cp * 2) * 64 + tq * 16) = w;
    w.x = kt1[0]; w.y = kt1[1]; w.z = kt1[2]; w.w = kt1[3]; *(u32x4*)(KT + (cp * 2 + 1) * 64 + tq * 16) = w;
    w.x = vt0[0]; w.y = vt0[1]; w.z = vt0[2]; w.w = vt0[3]; *(u32x4*)(VT + (cp * 2) * 64 + tq * 16) = w;
    w.x = vt1[0]; w.y = vt1[1]; w.z = vt1[2]; w.w = vt1[3]; *(u32x4*)(VT + (cp * 2 + 1) * 64 + tq * 16) = w;
    if (tq == 0) { *(f32x2*)(emid + cp * 2) = pmid; *(f32x2*)(eend + cp * 2) = pend; }
  };
  const int mw = wv - 4;
  f32x4 S[2][8];
#pragma unroll
  for (int a = 0; a < 2; ++a)
#pragma unroll
    for (int m = 0; m < 8; ++m) S[a][m] = (f32x4){0.f, 0.f, 0.f, 0.f};

  if (isP) { dma(0); dma(1); dma(2); asm volatile("s_waitcnt vmcnt(12)" ::: "memory"); }
  SCAN_BAR();
  if (isP) prepA(0);
  SCAN_BAR();
  if (isP) { prepB(0); asm volatile("s_waitcnt vmcnt(6)" ::: "memory"); }
  SCAN_BAR();
  for (int c = 0; c < 136; ++c) {
    if (isP) {
      if (c + 3 < 136) dma(c + 3);
      if (c + 1 < 136) prepA(c + 1);
      SCAN_BAR();
      if (c + 1 < 136) prepB(c + 1);
      if (c + 3 < 136) asm volatile("s_waitcnt vmcnt(6)" ::: "memory");
      else asm volatile("s_waitcnt vmcnt(0)" ::: "memory");
      SCAN_BAR();
    } else {
      const char* OPB = lds + (c & 1) * 34816;
      const char* QP = OPB; const char* KM = OPB + 8704; const char* KT = OPB + 17408; const char* VT = OPB + 25600;
      const float* emid = (const float*)(OPB + 33792); const float* eend = emid + 128;
      f32x4 PT00 = (f32x4){0.f, 0.f, 0.f, 0.f}, PT01 = PT00, PT11 = PT00;
#pragma unroll
      for (int ks = 0; ks < 4; ++ks) {
        const bf16x8 X0 = *(const bf16x8*)(KM + fr * 272 + ks * 64 + fq * 16), X1 = *(const bf16x8*)(KM + (16 + fr) * 272 + ks * 64 + fq * 16);
        const bf16x8 Y0 = *(const bf16x8*)(QP + fr * 272 + ks * 64 + fq * 16), Y1 = *(const bf16x8*)(QP + (16 + fr) * 272 + ks * 64 + fq * 16);
        PT00 = __builtin_amdgcn_mfma_f32_16x16x32_bf16(X0, Y0, PT00, 0, 0, 0);
        PT01 = __builtin_amdgcn_mfma_f32_16x16x32_bf16(X0, Y1, PT01, 0, 0, 0);
        PT11 = __builtin_amdgcn_mfma_f32_16x16x32_bf16(X1, Y1, PT11, 0, 0, 0);
      }
      SCAN_BAR();
#pragma unroll
      for (int jj = 0; jj < 4; ++jj) if (fq * 4 + jj > fr) { PT00[jj] = 0.f; PT11[jj] = 0.f; }
      u32x4 x0, x1;
      x0.x = pk_bf16(PT00[0], PT00[1]); x0.y = pk_bf16(PT00[2], PT00[3]); x0.z = 0u; x0.w = 0u;
      x1.x = pk_bf16(PT01[0], PT01[1]); x1.y = pk_bf16(PT01[2], PT01[3]); x1.z = pk_bf16(PT11[0], PT11[1]); x1.w = pk_bf16(PT11[2], PT11[3]);
      const size_t orow0 = rowOf(c * 32);
      const long ostep = dir ? -512 : 512;
#pragma unroll
      for (int a = 0; a < 2; ++a) {
        const int vcol = (mw * 2 + a) * 16 + fr;
        f32x4 o0 = (f32x4){0.f, 0.f, 0.f, 0.f}, o1 = o0;
        {
          const u32x2 vlo = *(const u32x2*)(VT + vcol * 64 + fq * 8), vhi = *(const u32x2*)(VT + vcol * 64 + 32 + fq * 8);
          u32x4 yv; yv.x = vlo.x; yv.y = vlo.y; yv.z = vhi.x; yv.w = vhi.y;
          o0 = __builtin_amdgcn_mfma_f32_16x16x32_bf16(__builtin_bit_cast(bf16x8, x0), __builtin_bit_cast(bf16x8, yv), o0, 0, 0, 0);
          o1 = __builtin_amdgcn_mfma_f32_16x16x32_bf16(__builtin_bit_cast(bf16x8, x1), __builtin_bit_cast(bf16x8, yv), o1, 0, 0, 0);
        }
#pragma unroll
        for (int ks = 0; ks < 4; ++ks) {
          const f32x4 em0 = *(const f32x4*)(emid + (2 * ks) * 16 + fq * 4), em1 = *(const f32x4*)(emid + (2 * ks + 1) * 16 + fq * 4);
          u32x4 ys;
          ys.x = pk_bf16(S[a][2 * ks][0] * em0[0], S[a][2 * ks][1] * em0[1]); ys.y = pk_bf16(S[a][2 * ks][2] * em0[2], S[a][2 * ks][3] * em0[3]);
          ys.z = pk_bf16(S[a][2 * ks + 1][0] * em1[0], S[a][2 * ks + 1][1] * em1[1]); ys.w = pk_bf16(S[a][2 * ks + 1][2] * em1[2], S[a][2 * ks + 1][3] * em1[3]);
          const u32x2 a0 = *(const u32x2*)(QP + fr * 272 + ks * 64 + fq * 8), a1 = *(const u32x2*)(QP + fr * 272 + ks * 64 + 32 + fq * 8);
          const u32x2 c0 = *(const u32x2*)(QP + (16 + fr) * 272 + ks * 64 + fq * 8), c1 = *(const u32x2*)(QP + (16 + fr) * 272 + ks * 64 + 32 + fq * 8);
          u32x4 xa, xc; xa.x = a0.x; xa.y = a0.y; xa.z = a1.x; xa.w = a1.y; xc.x = c0.x; xc.y = c0.y; xc.z = c1.x; xc.w = c1.y;
          o0 = __builtin_amdgcn_mfma_f32_16x16x32_bf16(__builtin_bit_cast(bf16x8, xa), __builtin_bit_cast(bf16x8, ys), o0, 0, 0, 0);
          o1 = __builtin_amdgcn_mfma_f32_16x16x32_bf16(__builtin_bit_cast(bf16x8, xc), __builtin_bit_cast(bf16x8, ys), o1, 0, 0, 0);
        }
        bf16_t* op = O + orow0 * 512 + h * 128 + vcol;
#pragma unroll
        for (int jj = 0; jj < 4; ++jj) {
          op[(long)(fq * 4 + jj) * ostep] = f2bf(o0[jj]);
          op[(long)(16 + fq * 4 + jj) * ostep] = f2bf(o1[jj]);
        }
        {
          const bf16x8 yv2 = *(const bf16x8*)(VT + vcol * 64 + fq * 16);
#pragma unroll
          for (int m = 0; m < 8; ++m) {
            const f32x4 ee = *(const f32x4*)(eend + m * 16 + fq * 4);
            const bf16x8 xk = *(const bf16x8*)(KT + (m * 16 + fr) * 64 + fq * 16);
            S[a][m] = __builtin_amdgcn_mfma_f32_16x16x32_bf16(xk, yv2, S[a][m] * ee, 0, 0, 0);
          }
        }
      }
      SCAN_BAR();
    }
  }
  __syncthreads();
}

struct F2Sched {
  const char* FT; const char* ZF; int G, c;
  __device__ __forceinline__ bool next(int i, Unit& u) const {
    const int P = c - 64;
    if (i > 1 || P < 0 || P >= 128) return false;
    const int loc = P >> 3; u.z = (P & 7) | (i << 3); u.pm = loc >> 1; u.pn = loc & 1; return true;
  }
  __device__ __forceinline__ const char* aptr(const Unit& u) const { return FT + (size_t)((u.z >> 3) ^ 1) * ((size_t)2048 * KH * 2) + (size_t)u.pm * ((size_t)256 * KH * 2); }
  __device__ __forceinline__ const char* bptr(const Unit& u) const { return ZF + (size_t)((u.z >> 3) ^ 1) * ((size_t)4096 * KH * 2) + ((size_t)(u.z & 7) * 512 + (size_t)u.pn * 256) * ((size_t)KH * 2); }
};
struct F2CSched {
  const char* FT; const char* ZC; int c;
  __device__ __forceinline__ bool next(int i, Unit& u) const {
    const int L = c - 192; if (i != 0 || L < 0 || L >= 16) return false;
    u.z = L >> 1; u.pm = 0; u.pn = L & 1; return true;
  }
  __device__ __forceinline__ const char* aptr(const Unit&) const { return FT; }
  __device__ __forceinline__ const char* bptr(const Unit& u) const { return ZC + (size_t)u.z * (512u * 512u * 2u) + (size_t)u.pn * (256u * 512u * 2u); }
};
struct EpiF2 {
  bf16_t* OB; int ctx; float* SX;
  __device__ __forceinline__ bool operator()(f32x4 (&acc)[2][2][4][2], const Unit& u, int wr, int wc, int fr, int fq) const {
    if (ctx) {
      bf16_t* dst = OB + ((size_t)NL + (size_t)u.z * 256) * 512 + u.pn * 256;
      pg8::epi_each(acc, wr, wc, fr, fq, [&](int r, int c, f32x4 v0, f32x4 v1) { st8bf(dst + (size_t)r * 512 + c, v0, v1); });
      return false;
    }
    const int b = u.z & 7, part = u.z >> 3;
    const int tl = (wr * 4 + wc) * 64 + fq * 16 + fr;
    float* sx = SX + ((size_t)(b + 8 * (u.pm * 2 + u.pn)) * 16) * 4096 + (size_t)tl * 8;
    bf16_t* dst = OB + (size_t)b * 4096 * 512 + u.pn * 256;
#pragma unroll
    for (int ai = 0; ai < 2; ++ai)
#pragma unroll
      for (int m = 0; m < 4; ++m)
#pragma unroll
        for (int bj = 0; bj < 2; ++bj) {
          float* q = sx + (size_t)((ai * 4 + m) * 2 + bj) * 4096;
          if (part == 0) { *(f32x4*)q = acc[ai][bj][m][0]; *(f32x4*)(q + 4) = acc[ai][bj][m][1]; }
          else {
            const f32x4 s0 = *(const f32x4*)q, s1 = *(const f32x4*)(q + 4);
            const int k = u.pm * 256 + ai * 128 + wr * 64 + m * 16 + fr, c = bj * 128 + wc * 32 + 8 * fq;
            st8bf(dst + (size_t)k * 512 + c, acc[ai][bj][m][0], acc[ai][bj][m][1]);
            if (k >= 1) st8bf(dst + (size_t)(4096 - k) * 512 + c, acc[ai][bj][m][0] - 2.0f * s0, acc[ai][bj][m][1] - 2.0f * s1);
          }
        }
    return part == 0;
  }
};
__device__ __forceinline__ void phase_fold(const Params& p, char* lds, int wid0, int bfirst) {
  const int tid = opaque_tid(wid0);
  bf16_t* zrow = (bf16_t*)lds;
  const bf16_t* ZCL = (const bf16_t*)(p.ws + O_ZCL);
  bf16_t* ZF = (bf16_t*)(p.ws + O_ZF);
  bf16_t* OB = (bf16_t*)(p.ws + O_ZB);
  float* red = (float*)(lds + 16384);
  if ((int)blockIdx.x < bfirst) return;
  for (int row = (int)blockIdx.x - bfirst; row < 8 * 512; row += (int)gridDim.x - bfirst) {
    const bf16_t* src = ZCL + (size_t)row * 8192;
#pragma unroll
    for (int i = 0; i < 2; ++i) *(u32x4*)(zrow + (tid + i * 512) * 8) = *(const u32x4*)(src + (tid + i * 512) * 8);
    __syncthreads();
    float alt = 0.f;
    for (int e8 = tid; e8 < 2 * (KH / 8); e8 += NTHREADS) {
      const int part = e8 >= KH / 8 ? 1 : 0, e = part ? e8 - KH / 8 : e8;
      float v[8];
#pragma unroll
      for (int jx = 0; jx < 8; ++jx) {
        const int t = e * 8 + jx;
        if (!part) v[jx] = t > 2048 ? 0.f : (t == 0 || t == 2048) ? bf2f(zrow[t]) : bf2f(zrow[t]) + bf2f(zrow[4096 - t]);
        else v[jx] = (t == 0 || t >= 2048) ? 0.f : bf2f(zrow[4096 + t]) - bf2f(zrow[4096 + 4096 - t]);
      }
      u32x4 w;
      w.x = pk_bf16(v[0], v[1]); w.y = pk_bf16(v[2], v[3]); w.z = pk_bf16(v[4], v[5]); w.w = pk_bf16(v[6], v[7]);
      *(u32x4*)(ZF + ((size_t)part * 4096 + row) * KH + e * 8) = w;
      if (!part) alt += (bflo(w.x) - bfhi(w.x)) + (bflo(w.y) - bfhi(w.y)) + (bflo(w.z) - bfhi(w.z)) + (bflo(w.w) - bfhi(w.w));
    }
    alt = wave_sum(alt);
    if ((tid & 63) == 0) red[tid >> 6] = alt;
    __syncthreads();
    if (tid == 0) {
      float a = 0.f;
#pragma unroll
      for (int w8 = 0; w8 < 8; ++w8) a += red[w8];
      OB[((size_t)(row >> 9) * 4096 + 2048) * 512 + (row & 511)] = f2bf(a * bf2f(f2bf(0.0013810679320049757f)));
    }
  }
}
__device__ __forceinline__ void phase_mix2(const Params& p, int l, char* lds, int wid0) {
  const int tid = opaque_tid(wid0);
  if (blockIdx.x < 64) { scan_item(p, blockIdx.x, lds, tid); return; }
  unsigned* bar = (unsigned*)(p.ws + O_BAR);
  const int nb = (int)gridDim.x - 64;
  phase_mix1(p, l, lds, wid0, 0, 64);
  sub_barrier(bar + (l * 2 + 0) * 16, nb);
  phase_fold(p, lds, wid0, 64);
  sub_barrier(bar + (l * 2 + 1) * 16, nb);
  PG8_LAS unsigned char* L = (PG8_LAS unsigned char*)lds;
  {
    F2Sched S{p.ws + O_FTL, p.ws + O_ZF, (int)gridDim.x, (int)blockIdx.x};
    EpiF2 E{(bf16_t*)(p.ws + O_ZB), 0, (float*)(p.ws + O_ZCL)};
    pg8::gemm_phase(L, KH, S, E, tid);
  }
  if (l == 0) {
    F2CSched S{p.ws + O_FTC, p.ws + O_ZCC, (int)blockIdx.x};
    EpiF2 E{(bf16_t*)(p.ws + O_ZB), 1, nullptr};
    pg8::gemm_phase(L, 512, S, E, tid);
  }
  if (blockIdx.x >= 192) { for (int sh = 0; sh < 3; ++sh) phase_mix1(p, l, lds, wid0, 1, 64, ((int)blockIdx.x - 192) * 3 + sh, 512); }
  else { const int w = (int)blockIdx.x - 64, n = (w & 1) ? 2 : 3, v0 = 192 + (w >> 1) * 5 + ((w & 1) ? 3 : 0);
    for (int sh = 0; sh < n; ++sh) phase_mix1(p, l, lds, wid0, 1, 64, v0 + sh, 512); }
  if (gridDim.x == 256) {
    pg8::GridSched S;
    S.init(p.ws + O_H, p.ws + O_WIN + (size_t)16 * 256 * 1024 * 2, 1024, GIN_R0, 12, 0, (int)gridDim.x - 64, (int)blockIdx.x - 64);
    EpiGin E{p.ws, (const float*)(p.ws + O_LB), l, 16};
    pg8::gemm_phase(L, 1024, S, E, tid);
  }
}

__device__ __forceinline__ void phase_oa(const Params& p, int l, int wid0) {
  const int tid = opaque_tid(wid0), wid = tid >> 6, lane = tid & 63;
  const int nrow = (l == 1) ? NL : NT;
  const bf16_t* OF = (const bf16_t*)(p.ws + O_OF);
  const bf16_t* OK = (const bf16_t*)(p.ws + O_OBK);
  bf16_t* GA = (bf16_t*)(p.ws + O_GA);
  const float* gw = p.gnorm_w + (size_t)l * 128;
  for (int row = blockIdx.x * NWAVE + wid; row < nrow; row += gridDim.x * NWAVE) {
    const size_t o = (size_t)row * 512 + lane * 8;
    const u32x4 a = *(const u32x4*)(OF + o), b = *(const u32x4*)(OK + o), g = *(const u32x4*)(GA + o);
    float v[8];
    v[0] = bflo(a.x) + bflo(b.x); v[1] = bfhi(a.x) + bfhi(b.x);
    v[2] = bflo(a.y) + bflo(b.y); v[3] = bfhi(a.y) + bfhi(b.y);
    v[4] = bflo(a.z) + bflo(b.z); v[5] = bfhi(a.z) + bfhi(b.z);
    v[6] = bflo(a.w) + bflo(b.w); v[7] = bfhi(a.w) + bfhi(b.w);
    float ss = 0.f;
#pragma unroll
    for (int j = 0; j < 8; ++j) ss += v[j] * v[j];
    ss += __shfl_xor(ss, 1); ss += __shfl_xor(ss, 2); ss += __shfl_xor(ss, 4); ss += __shfl_xor(ss, 8);
    const float rs = rsqrtf(ss * (1.0f / 128.0f) + 1e-6f);
    const float* gwp = gw + (lane & 15) * 8;
    const f32x4 w0 = *(const f32x4*)gwp, w1 = *(const f32x4*)(gwp + 4);
    float gg[8] = {bflo(g.x), bfhi(g.x), bflo(g.y), bfhi(g.y), bflo(g.z), bfhi(g.z), bflo(g.w), bfhi(g.w)};
    u32x4 w;
    w.x = pk_bf16(v[0] * rs * w0[0] * gg[0], v[1] * rs * w0[1] * gg[1]);
    w.y = pk_bf16(v[2] * rs * w0[2] * gg[2], v[3] * rs * w0[3] * gg[3]);
    w.z = pk_bf16(v[4] * rs * w1[0] * gg[4], v[5] * rs * w1[1] * gg[5]);
    w.w = pk_bf16(v[6] * rs * w1[2] * gg[6], v[7] * rs * w1[3] * gg[7]);
    *(u32x4*)(GA + o) = w;
  }
}

#define HC_MERGE 136
#define HC_MOE1  152
__device__ __forceinline__ void hc_publish(unsigned* cnt) {
  asm volatile("s_waitcnt vmcnt(0)" ::: "memory");
  __syncthreads();
  if (threadIdx.x == 0) { __threadfence(); (void)xb_add(cnt, 1u); }
}
__device__ __forceinline__ void hc_wait(unsigned* bar, unsigned* cnt, unsigned target) {
  if (threadIdx.x == 0) { XB_SPIN(xb_ld(cnt) < target, bar); __threadfence(); }
  __syncthreads();
}
struct OneSched {
  const char* A; const char* B; int pm, pn, z;
  __device__ __forceinline__ bool next(int i, Unit& u) const { if (i) return false; u.pm = pm; u.pn = pn; u.z = z; return true; }
  __device__ __forceinline__ const char* aptr(const Unit&) const { return A; }
  __device__ __forceinline__ const char* bptr(const Unit&) const { return B; }
};
struct EpiStoreBf16 {
  bf16_t* dst; int ld;
  __device__ __forceinline__ bool operator()(f32x4 (&acc)[2][2][4][2], const Unit& u, int wr, int wc, int fr, int fq) const {
    bf16_t* d = dst + (size_t)u.pm * 256 * ld + u.pn * 256;
    pg8::epi_each(acc, wr, wc, fr, fq, [&](int r, int c, f32x4 v0, f32x4 v1) { st8bf(d + (size_t)r * ld + c, v0, v1); });
    return false;
  }
};
struct MergeSched {
  const char* ws; int ntile, G, c, fuse;
  __device__ __forceinline__ bool next(int i, Unit& u) const {
    const int xcd = c & 7, q = c >> 3;
    int rnd = i / 3;
    if (fuse && c < 32) rnd = rnd == 0 ? 2 : rnd == 2 ? 0 : rnd;
    u.pm = (rnd * (G >> 5) + (q >> 2)) * 8 + xcd; u.pn = q & 3; u.z = i % 3;
    return u.pm * 4 < ntile && (q >> 2) < (G >> 5);
  }
  __device__ __forceinline__ const char* aptr(const Unit& u) const {
    return ws + (u.z == 0 ? O_GA : u.z == 1 ? O_ZB : O_U) + (size_t)u.pm * (256u * 512u * 2u);
  }
  __device__ __forceinline__ const char* bptr(const Unit& u) const { return ws + O_WBR + (size_t)u.z * (1024u * 512u * 2u) + (size_t)u.pn * (256u * 512u * 2u); }
};
struct EpiMerge {
  char* ws; int fuse;
  __device__ __forceinline__ bool operator()(f32x4 (&acc)[2][2][4][2], const Unit& u, int wr, int wc, int fr, int fq) const {
    const int tl = (wr * 4 + wc) * 64 + fq * 16 + fr;
    const unsigned char* GT = (const unsigned char*)(ws + O_G) + ((size_t)u.pm * 12 + u.z * 4 + u.pn) * 65536 + (size_t)tl * 8;
    auto ub = [](unsigned w, int k) { return (float)((w >> (8 * k)) & 0xffu) + 0.5f; };
    bf16_t* MG = (bf16_t*)(ws + O_H) + (size_t)u.pm * 256 * 1024 + u.pn * 256;
    const bool lastj = (u.z == 2);
#pragma unroll
    for (int ai = 0; ai < 2; ++ai)
#pragma unroll
      for (int m = 0; m < 4; ++m)
#pragma unroll
        for (int bj = 0; bj < 2; ++bj) {
          const int cidx = (ai * 4 + m) * 2 + bj;
          const u32x2 gw = *(const u32x2*)(GT + (size_t)cidx * 4096);
          f32x4 g0, g1;
#pragma unroll
          for (int q = 0; q < 4; ++q) { g0[q] = ub(gw.x, q); g1[q] = ub(gw.y, q); }
          if (lastj) {
            const int r = ai * 128 + wr * 64 + m * 16 + fr, c = bj * 128 + wc * 32 + 8 * fq;
            st8bf(MG + (size_t)r * 1024 + c, acc[ai][bj][m][0] * (g0 * 0.00390625f), acc[ai][bj][m][1] * (g1 * 0.00390625f));
          } else {
            const u32x2 hw = *(const u32x2*)(GT + 4 * 65536 + (size_t)cidx * 4096);
#pragma unroll
            for (int q = 0; q < 4; ++q) {
              acc[ai][bj][m][0][q] *= g0[q] * __builtin_amdgcn_rcpf(ub(hw.x, q));
              acc[ai][bj][m][1][q] *= g1[q] * __builtin_amdgcn_rcpf(ub(hw.y, q));
            }
          }
        }
    if (fuse && lastj && u.pm >= 128) hc_publish((unsigned*)(ws + O_BAR) + HC_MERGE);
    return !lastj;
  }
};
__device__ __forceinline__ void phase_merge(const Params& p, int l, char* lds, int wid0) {
  const int tid = opaque_tid(wid0);
  const int fuse = (l == 0 && gridDim.x == 256) ? 1 : 0;
  MergeSched S{p.ws, (l == 1 ? 128 : 136) * 4, (int)gridDim.x, (int)blockIdx.x, fuse};
  EpiMerge E{p.ws, fuse};
  pg8::gemm_phase((PG8_LAS unsigned char*)lds, 512, S, E, tid);
  if (fuse) {
    const int c = (int)blockIdx.x;
    if (c >= 32 && c < 64) {
      unsigned* bar = (unsigned*)(p.ws + O_BAR);
      hc_wait(bar, bar + HC_MERGE, 32u);
      const int pm = 128 + (c & 7), pn = (c >> 3) - 4;
      OneSched S2{p.ws + O_H + (size_t)pm * (256u * 1024u * 2u), p.ws + O_WOUT + (size_t)pn * (256u * 1024u * 2u), pm, pn, 0};
      EpiStoreBf16 E2{(bf16_t*)(p.ws + O_Y), 1024};
      pg8::gemm_phase((PG8_LAS unsigned char*)lds, 1024, S2, E2, tid);
    } else if (c >= 64) conv_fill(p, lds, wid0, 0, c - 64, 192);
  }
}

__device__ __forceinline__ void phase_wout(const Params& p, int l, char* lds, int wid0) {
  const int tid = opaque_tid(wid0);
  pg8::GridSched S;
  const bool fuse = l == 0 && gridDim.x == 256;
  S.init(p.ws + O_H, p.ws + O_WOUT, 1024, (l == 1 || fuse) ? 128 : 136, 4, 0, gridDim.x, blockIdx.x);
  EpiStoreBf16 E{(bf16_t*)(p.ws + O_Y), 1024};
  pg8::gemm_phase((PG8_LAS unsigned char*)lds, 1024, S, E, tid);
}

template <int l>
__device__ __forceinline__ void phase_rowB(const Params& p, char* lds, int wid0) {
  const int tid = opaque_tid(wid0), wid = tid >> 6, lane = tid & 63;
  const int nrow = (l == 1) ? NL : NT;
  const float* xlat = l == 0 ? p.x : p.out;
  const float* xctx = l == 0 ? p.ctx : (const float*)(p.ws + O_CTXB);
  const float* mod = (const float*)(p.ws + O_MOD);
  bf16_t* Y = (bf16_t*)(p.ws + O_Y);
  bf16_t* H = (bf16_t*)(p.ws + O_H);
  float* aff = (float*)(p.ws + O_AFF);
  const float* nw1 = p.norm_w + (size_t)(l * 4 + 1) * 1024;
  const float* nw2 = p.norm_w + (size_t)(l * 4 + 2) * 1024;
  const float* rw = p.router_w + (size_t)l * 1024 * 16;
  float* rwT = (float*)lds;
  for (int i = tid; i < 16384; i += NTHREADS) rwT[(i & 15) * 1024 + (i >> 4)] = rw[i];
  __syncthreads();
  u32x4 pfy[2]; f32x4 pfx[4];
  auto fetch = [&](int row) {
    const float* xr = row < NL ? xlat + (size_t)row * 1024 : xctx + (size_t)(row - NL) * 1024;
#pragma unroll
    for (int i = 0; i < 2; ++i) {
      const int e = i * 512 + lane * 8;
      pfy[i] = *(const u32x4*)(Y + (size_t)row * 1024 + e);
      if (l == 1) pfx[i * 2] = *(const f32x4*)((const bf16_t*)p.out + (size_t)row * 1024 + e);
      else { pfx[i * 2] = *(const f32x4*)(xr + e); pfx[i * 2 + 1] = *(const f32x4*)(xr + e + 4); }
    }
  };
  const int row0 = blockIdx.x * NWAVE + wid, rstep = gridDim.x * NWAVE;
  if (row0 < nrow) fetch(row0);
  for (int row = row0; row < nrow; row += rstep) {
    const int mr = row < NL ? (row >> 12) : 8;
    const float* md = mod + (size_t)(l * 9 + mr) * 6144;
    float yv[16], xv[16];
    float ss = 0.f;
#pragma unroll
    for (int i = 0; i < 2; ++i) {
      const u32x4 w = pfy[i];
      yv[i * 8 + 0] = bflo(w.x); yv[i * 8 + 1] = bfhi(w.x); yv[i * 8 + 2] = bflo(w.y); yv[i * 8 + 3] = bfhi(w.y);
      yv[i * 8 + 4] = bflo(w.z); yv[i * 8 + 5] = bfhi(w.z); yv[i * 8 + 6] = bflo(w.w); yv[i * 8 + 7] = bfhi(w.w);
      if (l == 1) {
        const u32x4 xw = __builtin_bit_cast(u32x4, pfx[i * 2]);
        xv[i * 8 + 0] = bflo(xw.x); xv[i * 8 + 1] = bfhi(xw.x); xv[i * 8 + 2] = bflo(xw.y); xv[i * 8 + 3] = bfhi(xw.y);
        xv[i * 8 + 4] = bflo(xw.z); xv[i * 8 + 5] = bfhi(xw.z); xv[i * 8 + 6] = bflo(xw.w); xv[i * 8 + 7] = bfhi(xw.w);
      } else {
        const f32x4 a = pfx[i * 2], b = pfx[i * 2 + 1];
#pragma unroll
        for (int j = 0; j < 4; ++j) { xv[i * 8 + j] = a[j]; xv[i * 8 + 4 + j] = b[j]; }
      }
    }
    if (row + rstep < nrow) fetch(row + rstep);
#pragma unroll
    for (int j = 0; j < 16; ++j) ss += yv[j] * yv[j];
    ss = wave_sum(ss);
    const float rs = rsqrtf(ss * (1.0f / 1024.0f) + 1e-6f);
    float ss2 = 0.f;
#pragma unroll
    for (int i = 0; i < 2; ++i) {
      const int e = i * 512 + lane * 8;
#pragma unroll
      for (int h4 = 0; h4 < 2; ++h4) {
        const f32x4 w = *(const f32x4*)(nw1 + e + h4 * 4), g1 = *(const f32x4*)(md + 2048 + e + h4 * 4);
#pragma unroll
        for (int j = 0; j < 4; ++j) {
          const int q = i * 8 + h4 * 4 + j;
          xv[q] = xv[q] + g1[j] * (yv[q] * rs * w[j]);
          ss2 += xv[q] * xv[q];
        }
      }
      u32x4 o;
      o.x = pk_bf16(xv[i * 8 + 0], xv[i * 8 + 1]); o.y = pk_bf16(xv[i * 8 + 2], xv[i * 8 + 3]); o.z = pk_bf16(xv[i * 8 + 4], xv[i * 8 + 5]); o.w = pk_bf16(xv[i * 8 + 6], xv[i * 8 + 7]);
      *(u32x4*)(Y + (size_t)row * 1024 + e) = o;
    }
    ss2 = wave_sum(ss2);
    const float rs2 = rsqrtf(ss2 * (1.0f / 1024.0f) + 1e-6f);
    float lg[16];
#pragma unroll
    for (int e2 = 0; e2 < 16; ++e2) lg[e2] = 0.f;
#pragma unroll
    for (int i = 0; i < 2; ++i) {
      const int e = i * 512 + lane * 8;
      float hv[8];
#pragma unroll
      for (int h4 = 0; h4 < 2; ++h4) {
        const f32x4 w = *(const f32x4*)(nw2 + e + h4 * 4), sh = *(const f32x4*)(md + 3072 + e + h4 * 4), sc = *(const f32x4*)(md + 4096 + e + h4 * 4);
#pragma unroll
        for (int j = 0; j < 4; ++j) hv[h4 * 4 + j] = xv[i * 8 + h4 * 4 + j] * rs2 * w[j] * (1.0f + sc[j]) + sh[j];
      }
      u32x4 w;
      w.x = pk_bf16(hv[0], hv[1]); w.y = pk_bf16(hv[2], hv[3]); w.z = pk_bf16(hv[4], hv[5]); w.w = pk_bf16(hv[6], hv[7]);
      *(u32x4*)(H + (size_t)row * 1024 + e) = w;
#pragma unroll
      for (int e2 = 0; e2 < 16; ++e2) {
        const f32x4 r0 = *(const f32x4*)(rwT + e2 * 1024 + e), r1 = *(const f32x4*)(rwT + e2 * 1024 + e + 4);
        lg[e2] += hv[0] * r0[0] + hv[1] * r0[1] + hv[2] * r0[2] + hv[3] * r0[3] + hv[4] * r1[0] + hv[5] * r1[1] + hv[6] * r1[2] + hv[7] * r1[3];
        if ((e2 & 3) == 3) __builtin_amdgcn_sched_barrier(0);
      }
    }
    float a8[8], a4[4], a2[2], a1;
    {
      const bool up = (lane & 32) != 0;
#pragma unroll
      for (int j = 0; j < 8; ++j) { const float mine = up ? lg[8 + j] : lg[j], other = up ? lg[j] : lg[8 + j]; a8[j] = mine + __shfl_xor(other, 32); }
    }
    {
      const bool up = (lane & 16) != 0;
#pragma unroll
      for (int j = 0; j < 4; ++j) { const float mine = up ? a8[4 + j] : a8[j], other = up ? a8[j] : a8[4 + j]; a4[j] = mine + __shfl_xor(other, 16); }
    }
    {
      const bool up = (lane & 8) != 0;
#pragma unroll
      for (int j = 0; j < 2; ++j) { const float mine = up ? a4[2 + j] : a4[j], other = up ? a4[j] : a4[2 + j]; a2[j] = mine + __shfl_xor(other, 8); }
    }
    {
      const bool up = (lane & 4) != 0;
      const float mine = up ? a2[1] : a2[0], other = up ? a2[0] : a2[1];
      a1 = mine + __shfl_xor(other, 4);
    }
    a1 += __shfl_xor(a1, 2);
    a1 += __shfl_xor(a1, 1);
    float mx = a1;
    mx = fmaxf(mx, __shfl_xor(mx, 4)); mx = fmaxf(mx, __shfl_xor(mx, 8)); mx = fmaxf(mx, __shfl_xor(mx, 16)); mx = fmaxf(mx, __shfl_xor(mx, 32));
    const float ex = expf(a1 - mx);
    float se = ex;
    se += __shfl_xor(se, 4); se += __shfl_xor(se, 8); se += __shfl_xor(se, 16); se += __shfl_xor(se, 32);
    if ((lane & 3) == 0) {
      const int e2 = ((lane >> 5) & 1) * 8 + ((lane >> 4) & 1) * 4 + ((lane >> 3) & 1) * 2 + ((lane >> 2) & 1);
      aff[(size_t)row * 16 + e2] = ex / se;
    }
  }
}

template <int NI, int T>
__device__ __forceinline__ void topk_body(const Params& p, int s, int e, char* lds, const int tid) {
  constexpr int CAP = T / 8;
  typedef unsigned long long u64;
  int* cntw = (int*)lds;
  int* wcnt = (int*)(lds + 256);
  int* woff = (int*)(lds + 512);
  const int wid = tid >> 6, lane = tid & 63;
  const bool isl = T == 4096;
  const size_t rowbase = isl ? (size_t)s * 4096 : (size_t)NL + (size_t)(s - 8) * 256;
  const float* aff = (const float*)(p.ws + O_AFF);
  int* sel = (int*)(p.ws + O_SEL);
  float* gate = (float*)(p.ws + O_GATE);
  int* tok = (int*)(p.ws + O_TOK);
  u64 key[NI];
  float av[NI];
#pragma unroll
  for (int q = 0; q < NI; ++q) {
    const int i = tid + q * NTHREADS;
    av[q] = 0.f; key[q] = 0ull;
    if (i < T) {
      av[q] = aff[(rowbase + i) * 16 + e];
      key[q] = ((u64)__float_as_uint(av[q]) << 12) | (u64)(4095 - i);
    }
  }
  u64 prefix = 0ull;
  for (int bit = 43; bit >= 0; --bit) {
    const u64 cand = prefix | (1ull << bit);
    int c = 0;
#pragma unroll
    for (int q = 0; q < NI; ++q) c += __popcll(__ballot(key[q] >= cand));
    if (lane == 0) cntw[(bit & 1) * 8 + wid] = c;
    __syncthreads();
    int tot = 0;
#pragma unroll
    for (int w = 0; w < 8; ++w) tot += cntw[(bit & 1) * 8 + w];
    if (tot >= CAP) prefix = cand;
  }
  int before[NI];
  bool in[NI];
#pragma unroll
  for (int q = 0; q < NI; ++q) {
    in[q] = key[q] >= prefix && key[q] != 0ull;
    const u64 m = __ballot(in[q]);
    before[q] = __popcll(m & ((1ull << lane) - 1ull));
    if (lane == 0) wcnt[q * 8 + wid] = __popcll(m);
  }
  __syncthreads();
  if (tid < 64) {
    int v = tid < NI * 8 ? wcnt[tid] : 0, x = v;
#pragma unroll
    for (int o = 1; o < 64; o <<= 1) { const int y = __shfl_up(x, o); if (lane >= o) x += y; }
    if (tid < NI * 8) woff[tid] = x - v;
  }
  __syncthreads();
  const size_t slotbase = isl ? ((size_t)e * 8 + s) * CAP : (size_t)NSLOT_L + ((size_t)e * 8 + (s - 8)) * CAP;
#pragma unroll
  for (int q = 0; q < NI; ++q) {
    const int i = tid + q * NTHREADS;
    if (i < T) {
      const int slot = woff[q * 8 + wid] + before[q];
      sel[(rowbase + i) * 16 + e] = in[q] ? slot : -1;
      if (in[q]) {
        tok[slotbase + slot] = (int)(rowbase + i);
        gate[slotbase + slot] = av[q];
      }
    }
  }
  __syncthreads();
}
__device__ __forceinline__ void phase_topk(const Params& p, int l, char* lds, int wid0) {
  const int tid = opaque_tid(wid0);
  const int NITEM = (l == 1) ? 128 : 256;
  for (int item = blockIdx.x; item < NITEM; item += gridDim.x) {
    const int s = item >> 4, e = item & 15;
    if (s < 8) topk_body<8, 4096>(p, s, e, lds, tid);
    else topk_body<1, 256>(p, s, e, lds, tid);
  }
}

struct MoeSched {
  const char* A; const char* W; int nN, nunit, G, c; size_t estep; int swap = 0;
  __device__ __forceinline__ bool next(int i, Unit& u) const {
    const int xcd = c & 7, q = c >> 3, per = (G >> 3) / nN;
    int ii = i;
    if (swap && xcd < 4) ii = i == 0 ? 8 : i == 8 ? 0 : i;
    u.pn = q % nN; u.pm = (ii * 8 + xcd) * per + q / nN;
    if (q >= per * nN || u.pm * nN >= nunit) return false;
    u.z = u.pm < 256 ? (u.pm >> 4) : (u.pm - 256); return true;
  }
  __device__ __forceinline__ const char* aptr(const Unit& u) const { return A + (size_t)u.pm * (256u * 1024u * 2u); }
  __device__ __forceinline__ const char* bptr(const Unit& u) const { return W + (size_t)u.z * estep + (size_t)u.pn * (256u * 1024u * 2u); }
};
struct MoeSchedG : MoeSched {
  static constexpr bool GATHER = true;
  const int* tok;
  __device__ __forceinline__ const char* aptr(const Unit&) const { return A; }
  __device__ __forceinline__ const int* tokptr(const Unit& u) const { return tok + (size_t)u.pm * 256; }
};
struct EpiSwiglu {
  bf16_t* HID; unsigned* cnt;
  __device__ __forceinline__ bool operator()(f32x4 (&acc)[2][2][4][2], const Unit& u, int wr, int wc, int fr, int fq) const {
    bf16_t* d = HID + (size_t)u.pm * 256 * 1024 + u.pn * 128;
#pragma unroll
    for (int ai = 0; ai < 2; ++ai)
#pragma unroll
      for (int m = 0; m < 4; ++m) {
        f32x4 o0, o1;
#pragma unroll
        for (int j = 0; j < 4; ++j) { o0[j] = siluf_(acc[ai][0][m][0][j]) * acc[ai][1][m][0][j]; o1[j] = siluf_(acc[ai][0][m][1][j]) * acc[ai][1][m][1][j]; }
        st8bf(d + (size_t)(ai * 128 + wr * 64 + m * 16 + fr) * 1024 + wc * 32 + 8 * fq, o0, o1);
      }
    if (cnt && u.pm >= 256) hc_publish(cnt);
    return false;
  }
};
__device__ __forceinline__ void phase_moe1(const Params& p, int l, char* lds, int wid0) {
  const int tid = opaque_tid(wid0);
  const int nrt = (l == 1) ? 256 : 272;
  MoeSchedG S;
  S.A = p.ws + O_H; S.W = l == 1 ? (const char*)p.out + OUT_W13B : p.ws + O_W13; S.nN = 8; S.nunit = nrt * 8; S.G = (int)gridDim.x; S.c = (int)blockIdx.x; S.estep = (size_t)2048 * 1024 * 2;
  S.tok = (const int*)(p.ws + O_TOK);
  const bool fuse = l == 0 && gridDim.x == 256;
  S.swap = fuse ? 1 : 0;
  unsigned* bar = (unsigned*)(p.ws + O_BAR);
  EpiSwiglu E{(bf16_t*)(p.ws + O_HID), fuse ? bar + HC_MOE1 : nullptr};
  pg8::gemm_phase((PG8_LAS unsigned char*)lds, 1024, S, E, tid);
  if (fuse) {
    const int xcd = (int)blockIdx.x & 7, q = (int)blockIdx.x >> 3;
    if (xcd >= 4 && q < 16) {
      const int r = q * 4 + xcd - 4, e = r >> 2, pn = r & 3, pm = 256 + e;
      hc_wait(bar, bar + HC_MOE1, 128u);
      OneSched S2{p.ws + O_HID + (size_t)pm * (256u * 1024u * 2u), p.ws + O_W2 + (size_t)e * ((size_t)1024 * 1024 * 2) + (size_t)pn * (256u * 1024u * 2u), pm, pn, e};
      EpiStoreBf16 E2{(bf16_t*)(p.ws + O_YS), 1024};
      pg8::gemm_phase((PG8_LAS unsigned char*)lds, 1024, S2, E2, tid);
    } else if (xcd >= 4) conv_fill(p, lds, wid0, 2, (q - 16) * 4 + xcd - 4, 64);
  }
}
__device__ __forceinline__ void phase_moe2(const Params& p, int l, char* lds, int wid0) {
  const int tid = opaque_tid(wid0);
  const int nrt = (l == 1 || gridDim.x == 256) ? 256 : 272;
  MoeSched S{p.ws + O_HID, p.ws + (l == 1 && p.w2sep ? O_W2B : O_W2), 4, nrt * 4, (int)gridDim.x, (int)blockIdx.x, (size_t)1024 * 1024 * 2};
  EpiStoreBf16 E{(bf16_t*)(p.ws + O_YS), 1024};
  pg8::gemm_phase((PG8_LAS unsigned char*)lds, 1024, S, E, tid);
}

__device__ __forceinline__ void phase_rowC(const Params& p, int l, int wid0) {
  const int tid = opaque_tid(wid0), wid = tid >> 6, lane = tid & 63;
  const int nrow = (l == 1) ? NL : NT;
  float* olat = p.out;
  float* octx = (float*)(p.ws + O_CTXB);
  const float* mod = (const float*)(p.ws + O_MOD);
  const bf16_t* YS = (const bf16_t*)(p.ws + O_YS);
  const int* sel = (const int*)(p.ws + O_SEL);
  const float* gate = (const float*)(p.ws + O_GATE);
  const float* nw3 = p.norm_w + (size_t)(l * 4 + 3) * 1024;
  const float* nwn = p.norm_w + (size_t)((l + 1) * 4 + 0) * 1024;
  bf16_t* H = (bf16_t*)(p.ws + O_H);
  const bf16_t* X1 = (const bf16_t*)(p.ws + O_Y);
  int pfrk; u32x4 pfx[2];
  auto fetch = [&](int row) {
    pfrk = sel[(size_t)row * 16 + (lane & 15)];
#pragma unroll
    for (int i = 0; i < 2; ++i) pfx[i] = *(const u32x4*)(X1 + (size_t)row * 1024 + i * 512 + lane * 8);
  };
  const int row0 = blockIdx.x * NWAVE + wid, rstep = gridDim.x * NWAVE;
  if (row0 < nrow) fetch(row0);
  for (int row = row0; row < nrow; row += rstep) {
    float* xo = row < NL ? olat + (size_t)row * 1024 : octx + (size_t)(row - NL) * 1024;
    const bool isl = row < NL;
    const int mr = isl ? (row >> 12) : 8;
    const int s = isl ? (row >> 12) : ((row - NL) >> 8);
    const float* md = mod + (size_t)(l * 9 + mr) * 6144;
    float mv[16];
#pragma unroll
    for (int j = 0; j < 16; ++j) mv[j] = 0.f;
    const int myrk = pfrk;
    u32x4 xcur[2];
#pragma unroll
    for (int i = 0; i < 2; ++i) xcur[i] = pfx[i];
    if (row + rstep < nrow) fetch(row + rstep);
    unsigned long long chosen = __ballot(myrk >= 0) & 0xffffull;
    while (chosen) {
      const int e0 = __builtin_ctzll(chosen); chosen &= chosen - 1;
      const int e1 = chosen ? __builtin_ctzll(chosen) : -1; if (chosen) chosen &= chosen - 1;
      const int rk0 = __shfl(myrk, e0), rk1 = e1 >= 0 ? __shfl(myrk, e1) : 0;
      const size_t slot0 = isl ? ((size_t)e0 * 8 + s) * 512 + rk0 : (size_t)NSLOT_L + ((size_t)e0 * 8 + s) * 32 + rk0;
      const size_t slot1 = e1 < 0 ? slot0 : (isl ? ((size_t)e1 * 8 + s) * 512 + rk1 : (size_t)NSLOT_L + ((size_t)e1 * 8 + s) * 32 + rk1);
      u32x4 w[4];
#pragma unroll
      for (int i = 0; i < 2; ++i) { w[i] = *(const u32x4*)(YS + slot0 * 1024 + i * 512 + lane * 8); w[2 + i] = *(const u32x4*)(YS + slot1 * 1024 + i * 512 + lane * 8); }
      const float m0 = gate[slot0], m1 = e1 >= 0 ? gate[slot1] : 0.f;
#pragma unroll
      for (int i = 0; i < 2; ++i) {
        mv[i * 8 + 0] += m0 * bflo(w[i].x) + m1 * bflo(w[2 + i].x); mv[i * 8 + 1] += m0 * bfhi(w[i].x) + m1 * bfhi(w[2 + i].x);
        mv[i * 8 + 2] += m0 * bflo(w[i].y) + m1 * bflo(w[2 + i].y); mv[i * 8 + 3] += m0 * bfhi(w[i].y) + m1 * bfhi(w[2 + i].y);
        mv[i * 8 + 4] += m0 * bflo(w[i].z) + m1 * bflo(w[2 + i].z); mv[i * 8 + 5] += m0 * bfhi(w[i].z) + m1 * bfhi(w[2 + i].z);
        mv[i * 8 + 6] += m0 * bflo(w[i].w) + m1 * bflo(w[2 + i].w); mv[i * 8 + 7] += m0 * bfhi(w[i].w) + m1 * bfhi(w[2 + i].w);
      }
    }
    float ss = 0.f;
#pragma unroll
    for (int j = 0; j < 16; ++j) ss += mv[j] * mv[j];
    ss = wave_sum(ss);
    const float rs = rsqrtf(ss * (1.0f / 1024.0f) + 1e-6f);
    float xn[16], ssn = 0.f;
#pragma unroll
    for (int i = 0; i < 2; ++i) {
      const int e = i * 512 + lane * 8;
#pragma unroll
      for (int h4 = 0; h4 < 2; ++h4) {
        const f32x4 w = *(const f32x4*)(nw3 + e + h4 * 4), g2 = *(const f32x4*)(md + 5120 + e + h4 * 4);
        f32x4 xv;
        if (h4 == 0) { xv[0] = bflo(xcur[i].x); xv[1] = bfhi(xcur[i].x); xv[2] = bflo(xcur[i].y); xv[3] = bfhi(xcur[i].y); }
        else { xv[0] = bflo(xcur[i].z); xv[1] = bfhi(xcur[i].z); xv[2] = bflo(xcur[i].w); xv[3] = bfhi(xcur[i].w); }
#pragma unroll
        for (int j = 0; j < 4; ++j) { xv[j] += g2[j] * (mv[i * 8 + h4 * 4 + j] * rs * w[j]); xn[i * 8 + h4 * 4 + j] = xv[j]; ssn += xv[j] * xv[j]; }
        if (!(l == 0 && isl)) *(f32x4*)(xo + e + h4 * 4) = xv;
      }
      if (l == 0 && isl) {
        u32x4 o;
        o.x = pk_bf16(xn[i * 8 + 0], xn[i * 8 + 1]); o.y = pk_bf16(xn[i * 8 + 2], xn[i * 8 + 3]); o.z = pk_bf16(xn[i * 8 + 4], xn[i * 8 + 5]); o.w = pk_bf16(xn[i * 8 + 6], xn[i * 8 + 7]);
        *(u32x4*)((bf16_t*)p.out + (size_t)row * 1024 + e) = o;
      }
    }
    if (l == 0) {
      ssn = wave_sum(ssn);
      const float rsn = rsqrtf(ssn * (1.0f / 1024.0f) + 1e-6f);
      const float* mdn = mod + (size_t)((l + 1) * 9 + mr) * 6144;
#pragma unroll
      for (int i = 0; i < 2; ++i) {
        const int e = i * 512 + lane * 8;
        float hv[8];
#pragma unroll
        for (int h4 = 0; h4 < 2; ++h4) {
          const f32x4 w = *(const f32x4*)(nwn + e + h4 * 4), sh = *(const f32x4*)(mdn + e + h4 * 4), sc = *(const f32x4*)(mdn + 1024 + e + h4 * 4);
#pragma unroll
          for (int j = 0; j < 4; ++j) hv[h4 * 4 + j] = xn[i * 8 + h4 * 4 + j] * rsn * w[j] * (1.0f + sc[j]) + sh[j];
        }
        u32x4 w;
        w.x = pk_bf16(hv[0], hv[1]); w.y = pk_bf16(hv[2], hv[3]); w.z = pk_bf16(hv[4], hv[5]); w.w = pk_bf16(hv[6], hv[7]);
        *(u32x4*)(H + (size_t)row * 1024 + e) = w;
      }
    }
  }
}

#define PHASE(call) do { Params q = p; asm volatile("" : "+s"(q.ws)); call; } while (0)
#ifndef PROBE_PH
#define PROBE_PH 0
#endif
#ifndef PROBE_N
#define PROBE_N 2
#endif
#define REP(id, call) do { for (int _r = 0; _r < ((PROBE_PH == (id)) ? 1 + PROBE_N : 1); ++_r) PHASE(call); } while (0)
#define SYNC() do { char* _w = p.ws; asm volatile("" : "+s"(_w)); XcdBarrier _b; _b.bar = (unsigned*)(_w + O_BAR); _b.x = xb_xcc_id(); _b.st = st; xcd_barrier(_b); } while (0)
__global__ void __launch_bounds__(NTHREADS, 2) fwd_mega(Params p) {
  extern __shared__ __attribute__((aligned(16))) char lds[];
  cg::grid_group grid = cg::this_grid();
  const int wid0 = __builtin_amdgcn_readfirstlane((int)(threadIdx.x >> 6));
  volatile PG8_LAS unsigned* st = (volatile PG8_LAS unsigned*)((PG8_LAS unsigned char*)lds + LDS_MAIN);
  if (threadIdx.x < 2) st[threadIdx.x] = 0u;
  __syncthreads();
  (void)xcd_barrier_post((unsigned*)(p.ws + O_BAR), st);
  PHASE(phase_setup(q, lds, wid0));
  PHASE(phase_conv(q, 0, lds, wid0));
  SYNC();
  PHASE(phase_rowA(q, 0, wid0));
  SYNC();
#pragma unroll 1
  for (int l = 0; l < 2; ++l) {
    REP(3, phase_gin(q, l, lds, wid0));
    SYNC();
    REP(5, phase_mix2(q, l, lds, wid0));
    SYNC();
    PHASE(phase_oa(q, l, wid0));
    SYNC();
    REP(7, phase_merge(q, l, lds, wid0));
    if (l == 0) grid.sync(); else SYNC();
    REP(8, phase_wout(q, l, lds, wid0));
    SYNC();
    if (l == 0) PHASE(phase_rowB<0>(q, lds, wid0)); else PHASE(phase_rowB<1>(q, lds, wid0));
    SYNC();
    REP(10, phase_topk(q, l, lds, wid0));
    SYNC();
    REP(11, phase_moe1(q, l, lds, wid0));
    SYNC();
    REP(12, phase_moe2(q, l, lds, wid0));
    SYNC();
    PHASE(phase_rowC(q, l, wid0));
    if (l == 0) PHASE(conv_fill(q, lds, wid0, 4, (int)blockIdx.x, (int)gridDim.x));
    if (l == 0) SYNC();
    if (PROBE_PH == 20) { for (int _r = 0; _r < 10 * PROBE_N; ++_r) SYNC(); }
  }
}

extern "C" void kernel_launch(void* const* d_in, const int* in_sizes, int n_in, void* d_out, int out_size, void* d_ws, size_t ws_size,
                              hipStream_t stream) {
  if (ws_size < WS_NEED) {
    fprintf(stderr, "kernel_launch: workspace too small: %zu < %zu\n", ws_size, (size_t)WS_NEED);
    return;
  }
  Params p{};
  p.x = (const float*)d_in[0]; p.c = (const float*)d_in[1]; p.ctx = (const float*)d_in[2]; p.c_ctx = (const float*)d_in[3];
  p.ada_w = (const float*)d_in[4]; p.ada_b = (const float*)d_in[5]; p.norm_w = (const float*)d_in[6]; p.w_in = (const float*)d_in[7];
  p.lb_raw = (const float*)d_in[8]; p.gnorm_w = (const float*)d_in[9]; p.sgu_w = (const float*)d_in[10]; p.sgu_b = (const float*)d_in[11];
  p.sgu_norm_w = (const float*)d_in[12]; p.w_branch = (const float*)d_in[13]; p.w_out = (const float*)d_in[14];
  p.router_w = (const float*)d_in[15]; p.w13 = (const float*)d_in[16]; p.w2 = (const float*)d_in[17];
  p.out = (float*)d_out;
  p.ws = (char*)d_ws;
  p.w2sep = ws_size >= WS_NEED_W2B ? 1 : 0;
  static int grid_blocks = 0;
  if (!grid_blocks) {
    int dev = 0, cus = 0, per_cu = 0;
    (void)hipGetDevice(&dev);
    (void)hipDeviceGetAttribute(&cus, hipDeviceAttributeMultiprocessorCount, dev);
    (void)hipFuncSetAttribute((const void*)fwd_mega, hipFuncAttributeMaxDynamicSharedMemorySize, LDS_TOTAL);
    (void)hipOccupancyMaxActiveBlocksPerMultiprocessor(&per_cu, fwd_mega, NTHREADS, LDS_TOTAL);
    if (per_cu > 1) per_cu = 1;
    if (per_cu < 1) fprintf(stderr, "kernel_launch: occupancy query reports %d blocks per CU\n", per_cu);
    grid_blocks = cus * (per_cu < 1 ? 1 : per_cu);
  }
  (void)hipMemsetAsync((char*)d_ws + O_BAR, 0, BAR_BYTES, stream);
  void* args[] = {&p};
  hipError_t e = hipLaunchCooperativeKernel((void*)fwd_mega, dim3(grid_blocks), dim3(NTHREADS), args, LDS_TOTAL, stream);
  if (e != hipSuccess) fprintf(stderr, "cooperative launch failed: %s (grid %d)\n", hipGetErrorString(e), grid_blocks);
}
```

```cpp
#include <hip/hip_runtime.h>
#include <hip/hip_cooperative_groups.h>
#include <cstdio>
#include <cstdint>
namespace cg = cooperative_groups;

typedef unsigned short bf16_t;
typedef short bf16x8 __attribute__((ext_vector_type(8)));
typedef float f32x4 __attribute__((ext_vector_type(4)));
typedef float f32x2 __attribute__((ext_vector_type(2)));
typedef unsigned u32x4 __attribute__((ext_vector_type(4)));
typedef unsigned u32x2 __attribute__((ext_vector_type(2)));

constexpr int D = 1024, NB = 8, TL = 4096, TCX = 256;
constexpr int NL = NB * TL, NC = NB * TCX, NT = NL + NC;
constexpr int INC = 7168;
constexpr int NSLOT_L = 16 * 8 * 512, NSLOT_C = 16 * 8 * 32, NSLOT = NSLOT_L + NSLOT_C;
constexpr int NTHREADS = 512, NWAVE = 8;
constexpr int LDS_MAIN = 147456;
constexpr int LDS_TOTAL = LDS_MAIN + 16;

constexpr size_t al(size_t x) { return (x + 255) & ~(size_t)255; }
constexpr size_t O_WIN = 0;
constexpr size_t O_WBR = O_WIN + al((size_t)INC * D * 2);
constexpr size_t O_WOUT = O_WBR + al((size_t)3 * D * 512 * 2);
constexpr size_t O_W13 = O_WOUT + al((size_t)D * D * 2);
constexpr size_t O_W2 = O_W13 + al((size_t)16 * 2048 * D * 2);
constexpr size_t O_FTL = O_W2 + al((size_t)16 * D * D * 2);
constexpr size_t O_FTC = O_FTL + al((size_t)4096 * 8192 * 2);
constexpr size_t O_CS = O_FTC + al((size_t)256 * 512 * 2);
constexpr size_t O_MOD = O_CS + al((size_t)256 * 128 * 2);
constexpr size_t O_LB = O_MOD + al((size_t)2 * 9 * 6144 * 4);
constexpr size_t O_BAR = O_LB + al((size_t)2 * 2 * 512 * 4);
constexpr size_t BAR_BYTES = 3456 * 4;
constexpr size_t O_H = O_BAR + al(BAR_BYTES);
constexpr size_t O_Y = O_H + al((size_t)NT * D * 2);
constexpr size_t O_CTXB = O_Y + al((size_t)NT * D * 2);
constexpr size_t O_AFF = O_CTXB + al((size_t)NC * D * 4);
constexpr size_t O_SEL = O_AFF + al((size_t)NT * 16 * 4);
constexpr size_t O_GATE = O_SEL + al((size_t)NT * 16 * 4);
constexpr size_t O_TOK = O_GATE + al((size_t)NSLOT * 4);
constexpr size_t O_Z = O_TOK + al((size_t)NSLOT * 4);
constexpr size_t SZ512 = al((size_t)NT * 512 * 2);
constexpr size_t O_Q = O_Z, O_LFF = O_Q + SZ512, O_LFB = O_LFF + SZ512, O_I = O_LFB + SZ512, O_GA = O_I + SZ512,
                 O_U = O_GA + SZ512, O_ZB = O_U + SZ512, O_VT = O_ZB + SZ512, O_OF = O_VT + SZ512, O_OBK = O_OF + SZ512;
constexpr size_t O_G = O_OBK + SZ512;
constexpr size_t O_ZCL = O_G + al((size_t)NT * 3072 * 2);
constexpr size_t O_ZCC = O_ZCL + al((size_t)8 * 512 * 8192 * 2);
constexpr size_t O_ZF = O_ZCC + al((size_t)8 * 512 * 512 * 2);
constexpr int KH = 2176, KF = 2 * KH;
constexpr size_t O_ZEND = O_ZF + al((size_t)8 * 512 * KF * 2);
constexpr size_t SZSLOT = al((size_t)NSLOT * 1024 * 2);
constexpr size_t O_XE = O_Z, O_HID = O_XE + SZSLOT, O_YS = O_HID + SZSLOT;
static_assert(O_YS + SZSLOT <= O_ZEND, "moe arena");
constexpr size_t O_W2B = O_ZEND;
constexpr size_t WS_NEED = O_ZEND, WS_NEED_W2B = O_W2B + al((size_t)16 * D * D * 2);

struct Params {
  const float *x, *c, *ctx, *c_ctx, *ada_w, *ada_b, *norm_w, *w_in, *lb_raw, *gnorm_w, *sgu_w, *sgu_b, *sgu_norm_w, *w_branch, *w_out,
      *router_w, *w13, *w2;
  float* out;
  char* ws;
  int w2sep;
};

typedef __bf16 bf16v2_t __attribute__((ext_vector_type(2)));
__device__ __forceinline__ unsigned pk_bf16(float lo, float hi) {
  const f32x2 v = {lo, hi};
  const bf16v2_t r = __builtin_convertvector(v, bf16v2_t);
  return __builtin_bit_cast(unsigned, r);
}
__device__ __forceinline__ bf16_t f2bf(float x) { return (bf16_t)(pk_bf16(x, 0.f) & 0xffffu); }
__device__ __forceinline__ float bf2f(bf16_t v) { return __uint_as_float(((unsigned)v) << 16); }
__device__ __forceinline__ float bflo(unsigned w) { return __uint_as_float(w << 16); }
__device__ __forceinline__ float bfhi(unsigned w) { return __uint_as_float(w & 0xffff0000u); }
__device__ __forceinline__ void st4bf(bf16_t* p, f32x4 v) {
  u32x2 w;
  w.x = pk_bf16(v[0], v[1]);
  w.y = pk_bf16(v[2], v[3]);
  *(u32x2*)p = w;
}
__device__ __forceinline__ void st8bf(bf16_t* p, f32x4 a, f32x4 b) {
  u32x4 w;
  w.x = pk_bf16(a[0], a[1]); w.y = pk_bf16(a[2], a[3]); w.z = pk_bf16(b[0], b[1]); w.w = pk_bf16(b[2], b[3]);
  *(u32x4*)p = w;
}
__device__ __forceinline__ float sigmoidf_(float x) { return __builtin_amdgcn_rcpf(1.0f + __expf(-x)); }
__device__ __forceinline__ float siluf_(float x) { return x * __builtin_amdgcn_rcpf(1.0f + __expf(-x)); }
__device__ __forceinline__ float geluf_(float v) {
  const float av = fabsf(v), t = __builtin_amdgcn_rcpf(av * 0.2316418882f + 1.0f);
  float q = t * 0.5307027145f + (-0.7265760135f);
  q = q * t + 0.7107068705f; q = q * t + (-0.142248368f); q = q * t + 0.127414796f; q = q * t;
  const float e = __builtin_amdgcn_exp2f((v * v) * (-0.72134752044f));
  const float m = v * (q * e);
  return v < 0.f ? m : v - m;
}
__device__ __forceinline__ int opaque_tid(int wid0) {
  int lane;
  asm volatile("v_mbcnt_lo_u32_b32 %0, -1, 0\n\tv_mbcnt_hi_u32_b32 %0, -1, %0" : "=v"(lane));
  return (wid0 << 6) | lane;
}
__device__ __forceinline__ float wave_sum(float v) {
#pragma unroll
  for (int o = 32; o > 0; o >>= 1) v += __shfl_xor(v, o);
  return v;
}

namespace pg8 {
#define PG8_LAS __attribute__((address_space(3)))
constexpr int BM = 256, BK = 64, HALF = 128, HTB = HALF * BK * 2, STAGE_BYTES = 8 * HTB, NXCD = 8, WGM = 8;
__device__ __forceinline__ int lds_byte(int r, int c) { const int st = (r >> 4) * 2 + (c >> 5), rr = r & 15, cc = c & 31, ob = rr * 64 + cc * 2; return st * 1024 + (ob ^ (((ob >> 9) & 1) << 5)); }
__device__ __forceinline__ void stage_rc(int b, int& R, int& C) { const int st = b / 1024, sb = b % 1024, swz = sb ^ (((sb >> 9) & 1) << 5); R = (st >> 1) * 16 + swz / 64; C = (st & 1) * 32 + (swz % 64) / 2; }
__device__ __forceinline__ int perm32(int rho) { const int n = rho >> 4, i = rho & 15; return 8 * (i >> 2) + 4 * n + (i & 3); }
struct Unit { int pm, pn, z; };
template <class T, class = void> struct gather_of { static constexpr bool v = false; };
template <class T> struct gather_of<T, decltype((void)T::GATHER)> { static constexpr bool v = T::GATHER; };

template <class Epi, class Sched>
__device__ __forceinline__ void gemm_phase(PG8_LAS unsigned char* lds, const int K, const Sched& S, const Epi& E, const int tid_in) {
  int tid = tid_in;
  asm volatile("" : "+v"(tid));
  const int wid = __builtin_amdgcn_readfirstlane(tid >> 6), lane = tid & 63, wr = wid >> 2, wc = wid & 3, fr = lane & 15, fq = lane >> 4;
  const int nt = K / BK;
  constexpr bool GA = gather_of<Sched>::v;
  unsigned voffA[2], voffB[2];
  unsigned cvA[2][2], nvA[2][2];
  int gR = 0; unsigned gC2 = 0;
#pragma unroll
  for (int i = 0; i < 2; ++i) { int R, C; stage_rc(tid * 16 + i * 8192, R, C); const int Rb = (R & ~31) + perm32(R & 31);
    if (i == 0) { gR = R; gC2 = (unsigned)C * 2u; }
    voffA[i] = (unsigned)(R * K + C) * 2u; voffB[i] = (unsigned)(Rb * K + C) * 2u; }
  const size_t kstep = (size_t)(BK * 2);
  const size_t hstep = (size_t)HALF * K * 2;
  const size_t hstepA = GA ? (size_t)0 : hstep;
  const PG8_LAS int* idxl = (const PG8_LAS int*)(lds + STAGE_BYTES);
  const unsigned ldsw = (unsigned)wid * 1024u;
  const int aoff = lds_byte(wr * 64 + fr, fq * 8), boff = lds_byte(wc * 32 + fr, fq * 8);
#define PG8_SA(b, h) (((b) * 2 + (h)) * HTB)
#define PG8_SB(b, h) ((4 + (b) * 2 + (h)) * HTB)
#define PG8_STAGE_(bufoff, gbase, voff) do { _Pragma("unroll") for (int _i = 0; _i < 2; ++_i) \
    __builtin_amdgcn_global_load_lds((const unsigned*)((const char*)(gbase) + voff[_i]), (PG8_LAS unsigned*)(lds + (bufoff) + ldsw + _i * 8192), 16, 0, 0); } while (0)
#define PG8_STAGE(bufoff, gbase) PG8_STAGE_(bufoff, gbase, voffB)
#define PG8_STAGE_A(bufoff, gbase, NX) do { _Pragma("unroll") for (int _i = 0; _i < 2; ++_i) { unsigned _vo; \
    if constexpr (GA) { _vo = (NX) ? nvA[((bufoff) / HTB) & 1][_i] : cvA[((bufoff) / HTB) & 1][_i]; } else _vo = voffA[_i]; \
    __builtin_amdgcn_global_load_lds((const unsigned*)((const char*)(gbase) + _vo), (PG8_LAS unsigned*)(lds + (bufoff) + ldsw + _i * 8192), 16, 0, 0); } } while (0)
#define PG8_LDA(dst, b, h) do { _Pragma("unroll") for (int m = 0; m < 4; ++m) _Pragma("unroll") for (int k = 0; k < 2; ++k) dst[m][k] = *(const PG8_LAS bf16x8*)(lds + PG8_SA(b, h) + aoff + m * 2048 + k * 1024); } while (0)
#define PG8_LDB(dst, b, h) do { _Pragma("unroll") for (int n = 0; n < 2; ++n) _Pragma("unroll") for (int k = 0; k < 2; ++k) dst[n][k] = *(const PG8_LAS bf16x8*)(lds + PG8_SB(b, h) + boff + n * 2048 + k * 1024); } while (0)
#define PG8_MMA(ai, bj, At, Bt) do { __builtin_amdgcn_s_setprio(1); _Pragma("unroll") for (int m = 0; m < 4; ++m) _Pragma("unroll") for (int n = 0; n < 2; ++n) _Pragma("unroll") for (int k = 0; k < 2; ++k) \
    acc[ai][bj][m][n] = __builtin_amdgcn_mfma_f32_16x16x32_bf16(Bt[n][k], At[m][k], acc[ai][bj][m][n], 0, 0, 0); __builtin_amdgcn_s_setprio(0); } while (0)
#define PG8_WAIT_V(n) asm volatile("s_waitcnt vmcnt(" #n ")" ::: "memory")
#define PG8_WAIT_L(n) asm volatile("s_waitcnt lgkmcnt(" #n ")" ::: "memory")
#define PG8_BAR __builtin_amdgcn_s_barrier()
#define PG8_SCHED __builtin_amdgcn_sched_barrier(0)
  Unit cur, nxt; int ui = 0;
  if (!S.next(0, cur)) return;
  f32x4 acc[2][2][4][2];
#pragma unroll
  for (int a = 0; a < 2; ++a)
#pragma unroll
    for (int b = 0; b < 2; ++b)
#pragma unroll
      for (int m = 0; m < 4; ++m)
#pragma unroll
        for (int n = 0; n < 2; ++n) acc[a][b][m][n] = (f32x4){0.f, 0.f, 0.f, 0.f};
  bf16x8 At[4][2], B0[2][2], B1[2][2];
  const char* cA = S.aptr(cur); const char* cB = S.bptr(cur);
  if constexpr (GA) {
    const int* tk = S.tokptr(cur);
#pragma unroll
    for (int h = 0; h < 2; ++h)
#pragma unroll
      for (int i = 0; i < 2; ++i) { cvA[h][i] = (unsigned)tk[h * 128 + i * 64 + gR] * (unsigned)(K * 2) + gC2; nvA[h][i] = cvA[h][i]; }
  }
  PG8_STAGE(PG8_SB(0, 0), cB); PG8_STAGE_A(PG8_SA(0, 0), cA, false); PG8_STAGE(PG8_SB(0, 1), cB + hstep); PG8_STAGE_A(PG8_SA(0, 1), cA + hstepA, false);
  if (wr == 1) PG8_BAR;
  PG8_WAIT_V(4); PG8_BAR;
  PG8_STAGE(PG8_SB(1, 0), cB + kstep); PG8_STAGE_A(PG8_SA(1, 0), cA + kstep, false); PG8_STAGE(PG8_SB(1, 1), cB + hstep + kstep);
  PG8_WAIT_V(6); PG8_BAR;
  for (;;) {
    const bool has_next = S.next(ui + 1, nxt);
    const char* nA = has_next ? S.aptr(nxt) : cA; const char* nB = has_next ? S.bptr(nxt) : cB;
    if constexpr (GA) {
      if (has_next && wid < 4)
        __builtin_amdgcn_global_load_lds((const unsigned*)(S.tokptr(nxt) + wid * 64 + lane), (PG8_LAS unsigned*)(lds + STAGE_BYTES + wid * 256), 4, 0, 0);
    }
    for (int t = 0; t < nt; t += 2) {
      const bool last = (t == nt - 2);
      const bool lastn = last && has_next;
      if constexpr (GA) {
#pragma unroll
        for (int h = 0; h < 2; ++h)
#pragma unroll
          for (int i = 0; i < 2; ++i) nvA[h][i] = (unsigned)idxl[h * 128 + i * 64 + gR] * (unsigned)(K * 2) + gC2;
      }
      const char* a1 = cA + (size_t)(t + 1) * kstep;
      const char* a2 = last ? nA : cA + (size_t)(t + 2) * kstep; const char* b2 = last ? nB : cB + (size_t)(t + 2) * kstep;
      const char* a3 = a2 + kstep; const char* b3 = b2 + kstep;
      PG8_LDB(B0, 0, 0); PG8_SCHED; PG8_LDA(At, 0, 0); PG8_STAGE_A(PG8_SA(1, 1), a1 + hstepA, false);
      PG8_WAIT_L(8); PG8_BAR; PG8_WAIT_L(0); PG8_MMA(0, 0, At, B0); PG8_BAR; PG8_SCHED;
      PG8_LDB(B1, 0, 1); PG8_STAGE(PG8_SB(0, 0), b2);
      PG8_BAR; PG8_WAIT_L(0); PG8_MMA(0, 1, At, B1); PG8_BAR;
      PG8_LDA(At, 0, 1); PG8_STAGE_A(PG8_SA(0, 0), a2, lastn);
      PG8_BAR; PG8_WAIT_L(0); PG8_MMA(1, 0, At, B0); PG8_BAR; PG8_SCHED;
      PG8_STAGE(PG8_SB(0, 1), b2 + hstep);
      PG8_WAIT_V(6); PG8_BAR; PG8_MMA(1, 1, At, B1); PG8_BAR;
      PG8_LDB(B0, 1, 0); PG8_SCHED; PG8_LDA(At, 1, 0); PG8_STAGE_A(PG8_SA(0, 1), a2 + hstepA, lastn);
      PG8_WAIT_L(8); PG8_BAR; PG8_WAIT_L(0); PG8_MMA(0, 0, At, B0); PG8_BAR; PG8_SCHED;
      PG8_LDB(B1, 1, 1); PG8_STAGE(PG8_SB(1, 0), b3);
      PG8_BAR; PG8_WAIT_L(0); PG8_MMA(0, 1, At, B1); PG8_BAR;
      PG8_LDA(At, 1, 1); PG8_STAGE_A(PG8_SA(1, 0), a3, lastn);
      PG8_BAR; PG8_WAIT_L(0); PG8_MMA(1, 0, At, B0); PG8_BAR; PG8_SCHED;
      PG8_STAGE(PG8_SB(1, 1), b3 + hstep);
      PG8_WAIT_V(6); PG8_BAR; PG8_MMA(1, 1, At, B1); PG8_BAR;
    }
    if (wr == 0) PG8_BAR;
    bool keep;
    { int fr2 = fr, fq2 = fq; asm volatile("" : "+v"(fr2), "+v"(fq2));
      keep = E(acc, cur, wr, wc, fr2, fq2); }
    if (!has_next) break;
    if (!keep)
#pragma unroll
    for (int a = 0; a < 2; ++a)
#pragma unroll
      for (int b = 0; b < 2; ++b)
#pragma unroll
        for (int m = 0; m < 4; ++m)
#pragma unroll
          for (int n = 0; n < 2; ++n) acc[a][b][m][n] = (f32x4){0.f, 0.f, 0.f, 0.f};
    cur = nxt; cA = nA; cB = nB; ++ui;
    if constexpr (GA) {
#pragma unroll
      for (int h = 0; h < 2; ++h)
#pragma unroll
        for (int i = 0; i < 2; ++i) cvA[h][i] = nvA[h][i];
    }
    if (wr == 1) PG8_BAR;
  }
  PG8_WAIT_V(0);
  PG8_BAR;
#undef PG8_SA
#undef PG8_SB
#undef PG8_STAGE
#undef PG8_STAGE_
#undef PG8_STAGE_A
#undef PG8_LDA
#undef PG8_LDB
#undef PG8_MMA
#undef PG8_WAIT_V
#undef PG8_WAIT_L
#undef PG8_BAR
#undef PG8_SCHED
}
template <class F>
__device__ __forceinline__ void epi_each(const f32x4 (&acc)[2][2][4][2], int wr, int wc, int fr, int fq, const F& f) {
#pragma unroll
  for (int ai = 0; ai < 2; ++ai)
#pragma unroll
    for (int m = 0; m < 4; ++m)
#pragma unroll
      for (int bj = 0; bj < 2; ++bj) f(ai * HALF + wr * 64 + m * 16 + fr, bj * HALF + wc * 32 + 8 * fq, acc[ai][bj][m][0], acc[ai][bj][m][1]);
}
struct GridSched {
  const char* A; const char* B; size_t tstep; int nM, nN, nwg, G, c, pm0;
  __device__ __forceinline__ void init(const void* A_, const void* B_, int K, int nM_, int nN_, int pm0_, int G_, int c_) {
    A = (const char*)A_; B = (const char*)B_; tstep = (size_t)BM * K * 2; nM = nM_; nN = nN_; nwg = nM * nN; G = G_; c = c_; pm0 = pm0_;
  }
  __device__ __forceinline__ bool next(int i, Unit& u) const {
    const long L = (long)i * G + c; if (L >= nwg) return false;
    int wgid = (int)L; { const int q = nwg / NXCD, r = nwg % NXCD, xcd = wgid % NXCD, off = wgid / NXCD; wgid = (xcd < r ? xcd * (q + 1) : r * (q + 1) + (xcd - r) * q) + off; }
    const int nig = WGM * nN, gid = wgid / nig, fm = gid * WGM, gsz = (nM - fm) < WGM ? (nM - fm) : WGM;
    u.pm = pm0 + fm + ((wgid % nig) % gsz); u.pn = (wgid % nig) / gsz; u.z = 0; return true;
  }
  __device__ __forceinline__ const char* aptr(const Unit& u) const { return A + (size_t)u.pm * tstep; }
  __device__ __forceinline__ const char* bptr(const Unit& u) const { return B + (size_t)u.pn * tstep; }
};
}
using pg8::Unit;


#define XB_TMO      128
#define XB_XCNT(j)  (256  + 64 * (j))
#define XB_XSUB(j)  (1280 + 64 * (j))
#define XB_XGEN(j)  (2304 + 64 * (j))
#define XB_TOP      3328
#define XB_TOPGEN   3392
#define XB_SPIN_CAP (1u << 18)
__device__ __forceinline__ unsigned xb_ld(unsigned* p)              { return __hip_atomic_load(p, __ATOMIC_RELAXED, __HIP_MEMORY_SCOPE_AGENT); }
__device__ __forceinline__ unsigned xb_add(unsigned* p, unsigned v) { return __hip_atomic_fetch_add(p, v, __ATOMIC_RELAXED, __HIP_MEMORY_SCOPE_AGENT); }
__device__ __forceinline__ unsigned xb_xcc_id() { return (unsigned)__builtin_amdgcn_s_getreg((3 << 11) | 20) & 0xFu; }
#define XB_SPIN(cond, bar) do { unsigned _sp = 0; while (cond) { __builtin_amdgcn_s_sleep(1); \
    if ((++_sp & 255u) == 0u) { if (xb_ld(&(bar)[XB_TMO])) break; if (_sp > XB_SPIN_CAP) { atomicAdd(&(bar)[XB_TMO], 1u); break; } } } } while (0)
struct XcdBarrier { unsigned* bar; unsigned x; volatile PG8_LAS unsigned* st; };
__device__ __forceinline__ XcdBarrier xcd_barrier_post(unsigned* bar, volatile PG8_LAS unsigned* st) {
  XcdBarrier b; b.bar = bar; b.x = xb_xcc_id(); b.st = st;
  if (threadIdx.x == 0) (void)xb_add(&bar[XB_XCNT(b.x)], 1u);
  return b;
}
__device__ __forceinline__ void xcd_barrier_complete(unsigned* bar, unsigned x, unsigned& nloc, unsigned& nx) {
  const unsigned G = gridDim.x * gridDim.y * gridDim.z;
  unsigned sum, cnt, mine, sp = 0u;
  for (;;) {
    sum = 0u; cnt = 0u; mine = 0u;
#pragma unroll
    for (unsigned j = 0; j < 16; ++j) { const unsigned c = xb_ld(&bar[XB_XCNT(j)]); sum += c; cnt += (c > 0u) ? 1u : 0u; mine = (j == x) ? c : mine; }
    if (sum == G) break;
    __builtin_amdgcn_s_sleep(1);
    if ((++sp & 255u) == 0u) { if (xb_ld(&bar[XB_TMO])) break; if (sp > XB_SPIN_CAP) { atomicAdd(&bar[XB_TMO], 1u); break; } }
  }
  nloc = mine > 0u ? mine : 1u; nx = cnt > 0u ? cnt : 1u;
}
__device__ __forceinline__ void xcd_barrier(const XcdBarrier& b) {
  asm volatile("s_waitcnt vmcnt(0)" ::: "memory");
  __syncthreads();
  if (threadIdx.x == 0) {
    unsigned* bar = b.bar;
    __builtin_amdgcn_s_waitcnt(0);
    unsigned nloc = b.st[0], nx = b.st[1];
    if (nloc == 0u) { xcd_barrier_complete(bar, b.x, nloc, nx); b.st[0] = nloc; b.st[1] = nx; }
    const unsigned old = xb_add(&bar[XB_XSUB(b.x)], 1u);
    const unsigned gen = old / nloc;
    if (old + 1u == (gen + 1u) * nloc) {
      __builtin_amdgcn_fence(__ATOMIC_RELEASE, "agent");
      asm volatile("s_waitcnt vmcnt(0)" ::: "memory");
      const unsigned og = xb_add(&bar[XB_TOP], 1u);
      const unsigned tg = og / nx;
      if (og + 1u == (tg + 1u) * nx) xb_add(&bar[XB_TOPGEN], 1u);
      else XB_SPIN(xb_ld(&bar[XB_TOPGEN]) == tg, bar);
      __builtin_amdgcn_fence(__ATOMIC_ACQUIRE, "agent");
      xb_add(&bar[XB_XGEN(b.x)], 1u);
      asm volatile("s_waitcnt vmcnt(0)" ::: "memory");
    } else {
      XB_SPIN(xb_ld(&bar[XB_XGEN(b.x)]) == gen, bar);
      __builtin_amdgcn_fence(__ATOMIC_ACQUIRE, "agent");
      asm volatile("s_waitcnt vmcnt(0)" ::: "memory");
    }
  }
  __syncthreads();
}


__device__ __forceinline__ void sub_barrier(unsigned* cnt, int nb) {
  asm volatile("s_waitcnt vmcnt(0)" ::: "memory");
  __syncthreads();
  if (threadIdx.x == 0) {
    __builtin_amdgcn_fence(__ATOMIC_RELEASE, "agent");
    asm volatile("s_waitcnt vmcnt(0)" ::: "memory");
    (void)xb_add(cnt, 1u);
    unsigned sp = 0;
    while (xb_ld(cnt) < (unsigned)nb && ++sp < (1u << 20)) __builtin_amdgcn_s_sleep(1);
    __builtin_amdgcn_fence(__ATOMIC_ACQUIRE, "agent");
    asm volatile("s_waitcnt vmcnt(0)" ::: "memory");
  }
  __syncthreads();
}

template <class LA, class LB>
__device__ __forceinline__ void gemm_main(f32x4 (&acc)[4][4], const int nk, const LA& la, const LB& lb, char* lds, const int t) {
  const int lane = t & 63, wid = t >> 6, fr = lane & 15, fq = lane >> 4, wr = wid >> 1, wc = wid & 1;
  const int sr = t >> 3, sc = t & 7;
  const int wofs = sr * 128 + ((sc ^ (sr & 7)) << 4);
  const int aofs = (wr * 64 + fr) * 128, bofs = 16384 + (wc * 64 + fr) * 128;
  const int x0 = ((fq) ^ (fr & 7)) << 4, x1 = ((4 + fq) ^ (fr & 7)) << 4;
  bf16x8 ra[4], rb[4];
#pragma unroll
  for (int i = 0; i < 4; ++i) { ra[i] = la(i, 0); rb[i] = lb(i, 0); }
#pragma unroll
  for (int i = 0; i < 4; ++i) { *(bf16x8*)(lds + wofs + i * 4096) = ra[i]; *(bf16x8*)(lds + 16384 + wofs + i * 4096) = rb[i]; }
  __syncthreads();
  for (int kt = 0; kt < nk; ++kt) {
    const char* cur = lds + (kt & 1) * 32768;
    const bool more = kt + 1 < nk;
    if (more) {
#pragma unroll
      for (int i = 0; i < 4; ++i) { ra[i] = la(i, (kt + 1) * 64); rb[i] = lb(i, (kt + 1) * 64); }
    }
#pragma unroll
    for (int kk = 0; kk < 2; ++kk) {
      const int xo = kk ? x1 : x0;
      bf16x8 af[4], bv[4];
#pragma unroll
      for (int m = 0; m < 4; ++m) af[m] = *(const bf16x8*)(cur + aofs + m * 2048 + xo);
#pragma unroll
      for (int n = 0; n < 4; ++n) bv[n] = *(const bf16x8*)(cur + bofs + n * 2048 + xo);
#pragma unroll
      for (int m = 0; m < 4; ++m)
#pragma unroll
        for (int n = 0; n < 4; ++n) acc[m][n] = __builtin_amdgcn_mfma_f32_16x16x32_bf16(bv[n], af[m], acc[m][n], 0, 0, 0);
    }
    if (more) {
      char* nxt = lds + ((kt + 1) & 1) * 32768;
#pragma unroll
      for (int i = 0; i < 4; ++i) { *(bf16x8*)(nxt + wofs + i * 4096) = ra[i]; *(bf16x8*)(nxt + 16384 + wofs + i * 4096) = rb[i]; }
    }
    __syncthreads();
  }
}
__device__ __forceinline__ void zero_acc(f32x4 (&acc)[4][4]) {
#pragma unroll
  for (int m = 0; m < 4; ++m)
#pragma unroll
    for (int n = 0; n < 4; ++n) acc[m][n] = (f32x4){0.f, 0.f, 0.f, 0.f};
}
template <class EP>
__device__ __forceinline__ void gemm_epi(const f32x4 (&acc)[4][4], const EP& ep, const int t) {
  const int lane = t & 63, wid = t >> 6, fr = lane & 15, fq = lane >> 4, wr = wid >> 1, wc = wid & 1;
#pragma unroll
  for (int m = 0; m < 4; ++m)
#pragma unroll
    for (int n = 0; n < 4; ++n) ep(wr * 64 + m * 16 + fr, wc * 64 + n * 16 + fq * 4, acc[m][n]);
}
struct RowLd {
  const bf16_t* p[4];
  __device__ __forceinline__ RowLd(const bf16_t* base, size_t r0, size_t ld, const int t) {
#pragma unroll
    for (int i = 0; i < 4; ++i) p[i] = base + (r0 + (t >> 3) + 32 * i) * ld + (t & 7) * 8;
  }
  __device__ __forceinline__ bf16x8 operator()(int i, int k0) const { return *(const bf16x8*)(p[i] + k0); }
};

__device__ __forceinline__ void phase_setup(const Params& p, char* lds, int wid0) {
  float* tab = (float*)lds;
  float* sv = (float*)(lds + 16384);
  float* red = (float*)(lds + 16384 + 36864);
  const int tid = opaque_tid(wid0);
  float* mod = (float*)(p.ws + O_MOD);
  bf16_t* FTL = (bf16_t*)(p.ws + O_FTL);
  bool have_tab = false;
  const int NMOD = 192, NITEM = NMOD + 4096 + 1;
  for (int item = blockIdx.x; item < NITEM; item += gridDim.x) {
    if (item < NMOD) {
      const int l = item / 96, n = (item % 96) * 64 + (tid & 63), kp = tid >> 6;
      for (int e = tid; e < 9 * 1024; e += NTHREADS) {
        const int r = e >> 10, k = e & 1023;
        const float v = r < 8 ? p.c[r * 1024 + k] : p.c_ctx[k];
        sv[e] = v / (1.0f + __expf(-v));
      }
      __syncthreads();
      float acc[9];
#pragma unroll
      for (int r = 0; r < 9; ++r) acc[r] = 0.f;
      const float* w = p.ada_w + (size_t)l * 1024 * 6144 + n;
#pragma unroll 8
      for (int k = kp * 128; k < kp * 128 + 128; ++k) {
        const float wv = w[(size_t)k * 6144];
#pragma unroll
        for (int r = 0; r < 9; ++r) acc[r] += sv[r * 1024 + k] * wv;
      }
#pragma unroll
      for (int r = 0; r < 9; ++r) red[(kp * 9 + r) * 64 + (tid & 63)] = acc[r];
      __syncthreads();
      for (int e = tid; e < 9 * 64; e += NTHREADS) {
        const int r = e >> 6, c = e & 63;
        float a = 0.f;
#pragma unroll
        for (int q8 = 0; q8 < 8; ++q8) a += red[(q8 * 9 + r) * 64 + c];
        const int nn = (item % 96) * 64 + c;
        mod[(l * 9 + r) * 6144 + nn] = a + p.ada_b[l * 6144 + nn];
      }
      __syncthreads();
    } else {
      if (!have_tab) {
        for (int j = tid; j < 4096; j += NTHREADS) tab[j] = cospif((float)j * (1.0f / 2048.0f));
        __syncthreads();
        have_tab = true;
      }
      if (item < NMOD + 4096) {
        const int k = (item - NMOD) & 2047, part = (item - NMOD) >> 11;
        const float scale = 0.0013810679320049757f;
        for (int e8 = tid; e8 < KH / 8; e8 += NTHREADS) {
          float v[8];
#pragma unroll
          for (int jx = 0; jx < 8; ++jx) {
            const int t = e8 * 8 + jx, jj = (k * t) & 4095;
            if (part == 0) v[jx] = t <= 2048 ? tab[jj] * scale : 0.f;
            else v[jx] = t < 2048 ? -tab[(jj - 1024) & 4095] * scale : 0.f;
          }
          u32x4 w;
          w.x = pk_bf16(v[0], v[1]); w.y = pk_bf16(v[2], v[3]); w.z = pk_bf16(v[4], v[5]); w.w = pk_bf16(v[6], v[7]);
          *(u32x4*)(FTL + ((size_t)part * 2048 + k) * KH + e8 * 8) = w;
        }
      } else {
        bf16_t* FTC = (bf16_t*)(p.ws + O_FTC);
        bf16_t* CS = (bf16_t*)(p.ws + O_CS);
        const float scale_c = 0.005524271728019903f;
        for (int e = tid; e < 256 * 512; e += NTHREADS) {
          const int k = e >> 9, cs = (e >> 8) & 1, t = e & 255;
          const int jj = ((k * t) & 255) * 16;
          FTC[e] = f2bf((cs == 0 ? tab[jj] : -tab[(jj - 1024) & 4095]) * scale_c);
        }
        for (int e = tid; e < 256 * 128; e += NTHREADS) {
          const int row = e >> 7, d = e & 127, cs = row >> 7, m = row & 127;
          const int jj = ((m * d) & 127) * 32;
          CS[e] = f2bf(cs == 0 ? tab[jj] : tab[(jj - 1024) & 4095]);
        }
        float* lb = (float*)(p.ws + O_LB);
        for (int e = tid; e < 2 * 512; e += NTHREADS) {
          const int dir = e >> 9, ch = e & 511;
          const float r0 = p.lb_raw[(dir * 2 + 0) * 512 + ch], r1 = p.lb_raw[(dir * 2 + 1) * 512 + ch];
          const float mx = fmaxf(r0, r1), e0 = expf(r0 - mx), e1 = expf(r1 - mx);
          const float p0 = e0 / (e0 + e1), p1 = e1 / (e0 + e1);
          lb[(dir * 2 + 0) * 512 + ch] = p0 - p0;
          lb[(dir * 2 + 1) * 512 + ch] = (p0 + p1) - p0;
        }
      }
    }
  }
  __syncthreads();
}

constexpr size_t OUT_W13B = (size_t)NL * D * 2;
template <bool VMAP>
__device__ __forceinline__ void conv_items(const Params& p, int l, char* lds, int wid0, const int lo, const int hi, const int r, const int n) {
  const int tid = opaque_tid(wid0);
  float* tile = (float*)lds;
  struct Item { const float* src; bf16_t* dst; int K, N, n0, k0, drow0; };
  auto decode = [&](int item) -> Item {
    int i = item;
    if (VMAP) {
      if (p.w2sep) i = i < 2048 ? i + 608 : i < 2496 ? i - 2048 : i < 3520 ? i + 160 : i - 3072;
      else i = i < 2048 ? i + 608 : i < 2656 ? i - 2048 : i;
    }
    Item it;
    bool w13 = false;
    if (i < 448) {
      it.src = p.w_in + (size_t)l * 1024 * INC; it.dst = (bf16_t*)(p.ws + O_WIN); it.K = 1024; it.N = INC;
    } else if ((i -= 448) < 96) {
      const int j = i / 32; i -= j * 32;
      it.src = p.w_branch + ((size_t)l * 3 + j) * 512 * 1024; it.dst = (bf16_t*)(p.ws + O_WBR) + (size_t)j * 1024 * 512; it.K = 512; it.N = 1024;
    } else if ((i -= 96) < 64) {
      it.src = p.w_out + (size_t)l * 1024 * 1024; it.dst = (bf16_t*)(p.ws + O_WOUT); it.K = 1024; it.N = 1024;
    } else if ((i -= 64) < 2048) {
      const int e = i / 128; i -= e * 128;
      it.src = p.w13 + ((size_t)l * 16 + e) * 1024 * 2048;
      it.dst = (l == 1 ? (bf16_t*)((char*)p.out + OUT_W13B) : (bf16_t*)(p.ws + O_W13)) + (size_t)e * 2048 * 1024; it.K = 1024; it.N = 2048; w13 = true;
    } else {
      i -= 2048;
      const int e = i / 64; i -= e * 64;
      it.src = p.w2 + ((size_t)l * 16 + e) * 1024 * 1024; it.dst = (bf16_t*)(p.ws + (l == 1 && p.w2sep ? O_W2B : O_W2)) + (size_t)e * 1024 * 1024; it.K = 1024; it.N = 1024;
    }
    const int nkt = it.K / 128;
    it.n0 = (i / nkt) * 128; it.k0 = (i % nkt) * 128;
    it.drow0 = w13 ? (((it.n0 & 1023) >> 7) * 256 + (it.n0 >> 10) * 128) : it.n0;
    return it;
  };
  f32x4 pf[8];
  auto fetch = [&](const Item& it) {
#pragma unroll
    for (int q = 0; q < 8; ++q) pf[q] = *(const f32x4*)(it.src + (size_t)(it.k0 + q * 16 + (tid >> 5)) * it.N + it.n0 + (tid & 31) * 4);
  };
  int rr = r; asm volatile("" : "+s"(rr));
  const int item0 = lo + rr;
  Item cur = decode(item0 < hi ? item0 : lo);
  if (item0 < hi) fetch(cur);
  for (int item = item0; item < hi; item += n) {
#pragma unroll
    for (int q = 0; q < 8; ++q) {
      const int kk = q * 16 + (tid >> 5), nn = (tid & 31) * 4;
      tile[(nn + 0) * 129 + kk] = pf[q][0]; tile[(nn + 1) * 129 + kk] = pf[q][1]; tile[(nn + 2) * 129 + kk] = pf[q][2]; tile[(nn + 3) * 129 + kk] = pf[q][3];
    }
    const Item me = cur;
    if (item + n < hi) { cur = decode(item + n); fetch(cur); }
    __syncthreads();
#pragma unroll
    for (int q2 = 0; q2 < 4; ++q2) {
      const int q = tid + q2 * 512, nn = q >> 4, kc = (q & 15) * 8;
      const float* tp = tile + nn * 129 + kc;
      u32x4 w;
      w.x = pk_bf16(tp[0], tp[1]); w.y = pk_bf16(tp[2], tp[3]); w.z = pk_bf16(tp[4], tp[5]); w.w = pk_bf16(tp[6], tp[7]);
      *(u32x4*)(me.dst + (size_t)(me.drow0 + nn) * me.K + me.k0 + kc) = w;
    }
    __syncthreads();
  }
}
__device__ __forceinline__ void phase_conv(const Params& p, int l, char* lds, int wid0) { conv_items<false>(p, l, lds, wid0, 0, 3680, blockIdx.x, gridDim.x); }
constexpr int CF_S0 = 2304, CF_S2 = 320;
__device__ __forceinline__ void conv_fill(const Params& p, char* lds, int wid0, const int slot, const int r, const int n) {
  const bool tuned = gridDim.x == 256;
  int a, b;
  int c0 = CF_S0, c2 = CF_S0 + CF_S2;
  if (!p.w2sep) { c0 = c0 < 2496 ? c0 : 2496; c2 = c2 < 2656 ? c2 : 2656; }
  if (slot == 0) { a = 0; b = c0; } else if (slot == 2) { a = c0; b = c2; } else { a = c2; b = 3680; }
  if (slot < 4) { if (!tuned) return; }
  else if (!tuned) a = 0;
  conv_items<true>(p, 1, lds, wid0, a, b, r, n);
}
__device__ __forceinline__ void phase_rowA(const Params& p, int l, int wid0) {
  const int tid = opaque_tid(wid0), wid = tid >> 6, lane = tid & 63;
  const float* xlat = l == 0 ? p.x : p.out;
  const float* xctx = l == 0 ? p.ctx : (const float*)(p.ws + O_CTXB);
  const float* mod = (const float*)(p.ws + O_MOD);
  bf16_t* H = (bf16_t*)(p.ws + O_H);
  const float* nw = p.norm_w + (size_t)(l * 4 + 0) * 1024;
  for (int row = blockIdx.x * NWAVE + wid; row < NT; row += gridDim.x * NWAVE) {
    const float* xr = row < NL ? xlat + (size_t)row * 1024 : xctx + (size_t)(row - NL) * 1024;
    const int mr = row < NL ? (row >> 12) : 8;
    const float* md = mod + (size_t)(l * 9 + mr) * 6144;
    f32x4 v[4];
    float ss = 0.f;
#pragma unroll
    for (int i = 0; i < 4; ++i) {
      v[i] = *(const f32x4*)(xr + i * 256 + lane * 4);
      ss += v[i][0] * v[i][0] + v[i][1] * v[i][1] + v[i][2] * v[i][2] + v[i][3] * v[i][3];
    }
    ss = wave_sum(ss);
    const float rs = rsqrtf(ss * (1.0f / 1024.0f) + 1e-6f);
#pragma unroll
    for (int i = 0; i < 4; ++i) {
      const int e = i * 256 + lane * 4;
      const f32x4 w = *(const f32x4*)(nw + e), sh = *(const f32x4*)(md + e), sc = *(const f32x4*)(md + 1024 + e);
      f32x4 o;
#pragma unroll
      for (int j = 0; j < 4; ++j) o[j] = v[i][j] * rs * w[j] * (1.0f + sc[j]) + sh[j];
      st4bf(H + (size_t)row * 1024 + e, o);
    }
  }
}

struct EpiGin {
  char* ws; const float* lbp; int l; int pn0;
  __device__ __forceinline__ bool operator()(f32x4 (&acc)[2][2][4][2], const Unit& u, int wr, int wc, int fr, int fq) const {
    const int pn = u.pn + pn0;
    const int sec = pn >> 1, cin0 = (pn & 1) * 256;
    const size_t row0 = (size_t)u.pm * 256;
    if (sec >= 8) {
      const int tl = (wr * 4 + wc) * 64 + fq * 16 + fr;
      unsigned char* GT = (unsigned char*)(ws + O_G) + ((size_t)u.pm * 12 + (pn - 16)) * 65536 + (size_t)tl * 8;
      auto q8 = [](float z) { return __builtin_amdgcn_rcpf(__builtin_fmaf(__expf(-z), 0.00390625f, 0.00390625f)); };
#pragma unroll
      for (int ai = 0; ai < 2; ++ai)
#pragma unroll
        for (int m = 0; m < 4; ++m)
#pragma unroll
          for (int bj = 0; bj < 2; ++bj) {
            const f32x4 a = acc[ai][bj][m][0], b = acc[ai][bj][m][1];
            u32x2 w; w.x = 0u; w.y = 0u;
#pragma unroll
            for (int j = 0; j < 4; ++j) { w.x = __builtin_amdgcn_cvt_pk_u8_f32(q8(a[j]), j, w.x); w.y = __builtin_amdgcn_cvt_pk_u8_f32(q8(b[j]), j, w.y); }
            *(u32x2*)(GT + (size_t)((ai * 4 + m) * 2 + bj) * 4096) = w;
          }
    } else if (sec == 7) {
      bf16_t* VT = (bf16_t*)(ws + O_VT);
      pg8::epi_each(acc, wr, wc, fr, fq, [&](int r, int c, f32x4 v0, f32x4 v1) {
        const int chunk = u.pm * 2 + (r >> 7), q = r & 127, g = (cin0 + c) >> 7, d = c & 127;
        bf16_t* dst = VT + (((size_t)chunk * 4 + g) * 128 + d) * 128 + q;
#pragma unroll
        for (int j = 0; j < 4; ++j) { dst[j * 128] = f2bf(geluf_(v0[j])); dst[(4 + j) * 128] = f2bf(geluf_(v1[j])); }
      });
    } else if (sec == 1 || sec == 2) {
      bf16_t* LF = (bf16_t*)(ws + (sec == 1 ? O_LFF : O_LFB)) + row0 * 512 + cin0;
      const float* lbv = lbp + ((sec - 1) * 2 + l) * 512 + cin0;
      pg8::epi_each(acc, wr, wc, fr, fq, [&](int r, int c, f32x4 v0, f32x4 v1) {
        const f32x4 b0 = *(const f32x4*)(lbv + c), b1 = *(const f32x4*)(lbv + c + 4);
        f32x4 o0, o1;
#pragma unroll
        for (int j = 0; j < 4; ++j) {
          o0[j] = 1.0f - (fmaxf(b0[j], 1e-20f) + (1.0f - b0[j]) * sigmoidf_(v0[j]));
          o1[j] = 1.0f - (fmaxf(b1[j], 1e-20f) + (1.0f - b1[j]) * sigmoidf_(v1[j]));
        }
        st8bf(LF + (size_t)r * 512 + c, o0, o1);
      });
    } else {
      const size_t off = sec == 0 ? O_Q : sec == 3 ? O_I : sec == 4 ? O_GA : sec == 5 ? O_ZB : O_U;
      bf16_t* dst = (bf16_t*)(ws + off) + row0 * 512 + cin0;
      const int act = (sec == 0 || sec == 4) ? 1 : (sec == 6 ? 2 : 0);
      pg8::epi_each(acc, wr, wc, fr, fq, [&](int r, int c, f32x4 v0, f32x4 v1) {
        f32x4 o0, o1;
#pragma unroll
        for (int j = 0; j < 4; ++j) {
          o0[j] = act == 1 ? siluf_(v0[j]) : act == 2 ? geluf_(v0[j]) : v0[j];
          o1[j] = act == 1 ? siluf_(v1[j]) : act == 2 ? geluf_(v1[j]) : v1[j];
        }
        st8bf(dst + (size_t)r * 512 + c, o0, o1);
      });
    }
    return false;
  }
};
constexpr int GIN_R0 = 0;
__device__ __forceinline__ void phase_gin(const Params& p, int l, char* lds, int wid0) {
  const int tid = opaque_tid(wid0);
  PG8_LAS unsigned char* L = (PG8_LAS unsigned char*)lds;
  EpiGin E{p.ws, (const float*)(p.ws + O_LB), l, 0};
  pg8::GridSched S;
  const int R0 = gridDim.x == 256 ? GIN_R0 : 0;
  S.init(p.ws + O_H, p.ws + O_WIN, 1024, (l == 0 ? 136 : 128) - R0, 28, R0, gridDim.x, blockIdx.x);
  pg8::gemm_phase(L, 1024, S, E, tid);
  S.init(p.ws + O_H, p.ws + O_WIN, 1024, R0, 16, 0, gridDim.x, blockIdx.x);
  pg8::gemm_phase(L, 1024, S, E, tid);
  if (l == 1) {
    S.init(p.ws + O_H, p.ws + O_WIN, 1024, 8, 8, 128, gridDim.x, (blockIdx.x + gridDim.x / 2) % gridDim.x);
    pg8::gemm_phase(L, 1024, S, E, tid);
  }
}

__device__ __forceinline__ void phase_mix1(const Params& p, int l, char* lds0, int wid0, int kind, int bfirst, int bi_o = -1, int nb_o = 0) {
  const bool last = (l == 1);
  const int tid = opaque_tid(wid0), t = tid & 255, half = tid >> 8;
  char* lds = lds0 + half * 65536;
  const bf16_t* CS = (const bf16_t*)(p.ws + O_CS);
  const bf16_t* ZB = (const bf16_t*)(p.ws + O_ZB);
  const int NF1L = 2048, NF1C = last ? 0 : 128, NCH = last ? 256 : 272;
  const int ITEM0 = kind == 0 ? 0 : NF1L + NF1C, NITEM = kind == 0 ? NF1L + NF1C : NF1L + NF1C + NCH * 4;
  const int bi = nb_o > 0 ? bi_o : (int)blockIdx.x - bfirst, nb = nb_o > 0 ? nb_o : (int)gridDim.x - bfirst;
  if (bi < 0) return;
  for (int item = ITEM0 + bi * 2 + half; item < NITEM; item += nb * 2) {
    f32x4 acc[4][4];
    zero_acc(acc);
    if (item < NF1L + NF1C) {
      const bool isl = item < NF1L;
      int i = isl ? item : item - NF1L;
      const int mh = i & 1;
      i >>= 1;
      int tt, g, b;
      if (isl) { tt = i & 31; i >>= 5; } else { tt = i & 1; i >>= 1; }
      g = i & 3; b = i >> 2;
      const size_t rowbase = isl ? (size_t)b * 4096 + tt * 128 : (size_t)NL + b * 256 + tt * 128;
      RowLd la(CS, mh * 128, 128, t), lb(ZB + g * 128, rowbase, 512, t);
      gemm_main(acc, 2, la, lb, lds, t);
      bf16_t* dst = isl ? (bf16_t*)(p.ws + O_ZCL) + ((size_t)b * 512 + g * 128) * 8192 + mh * 4096 + tt * 128
                        : (bf16_t*)(p.ws + O_ZCC) + ((size_t)b * 512 + g * 128) * 512 + mh * 256 + tt * 128;
      const size_t ld = isl ? 8192 : 512;
      gemm_epi(acc, [&](int r, int c, f32x4 v) { st4bf(dst + (size_t)r * ld + c, v); }, t);
    } else {
      const int i = item - (NF1L + NF1C), ch = i >> 2, g = i & 3;
      const bf16_t* VT = (const bf16_t*)(p.ws + O_VT) + ((size_t)ch * 4 + g) * 128 * 128;
      float* rstd = (float*)lds;
      if (t < 128) {
        float ss = 0.f;
        for (int d = 0; d < 128; ++d) {
          const float v = bf2f(VT[d * 128 + t]);
          ss += v * v;
        }
        rstd[t] = rsqrtf(ss * (1.0f / 128.0f) + 1e-6f);
      }
      __syncthreads();
      const float* wsg = p.sgu_w + ((size_t)l * 4 + g) * 128 * 128;
      const int kc = (t & 7) * 8;
      float rr[2][8];
#pragma unroll
      for (int h2 = 0; h2 < 2; ++h2)
#pragma unroll
        for (int j = 0; j < 8; ++j) rr[h2][j] = rstd[h2 * 64 + kc + j];
      __syncthreads();
      auto la = [&](int ii, int k0) -> bf16x8 {
        const float* s = wsg + (size_t)((t >> 3) + 32 * ii) * 128 + k0 + kc;
        const f32x4 a = *(const f32x4*)s, b = *(const f32x4*)(s + 4);
        const int h2 = k0 >> 6;
        u32x4 w;
        w.x = pk_bf16(a[0] * (h2 ? rr[1][0] : rr[0][0]), a[1] * (h2 ? rr[1][1] : rr[0][1]));
        w.y = pk_bf16(a[2] * (h2 ? rr[1][2] : rr[0][2]), a[3] * (h2 ? rr[1][3] : rr[0][3]));
        w.z = pk_bf16(b[0] * (h2 ? rr[1][4] : rr[0][4]), b[1] * (h2 ? rr[1][5] : rr[0][5]));
        w.w = pk_bf16(b[2] * (h2 ? rr[1][6] : rr[0][6]), b[3] * (h2 ? rr[1][7] : rr[0][7]));
        return __builtin_bit_cast(bf16x8, w);
      };
      RowLd lb(VT, 0, 128, t);
      gemm_main(acc, 2, la, lb, lds, t);
      bf16_t* U = (bf16_t*)(p.ws + O_U) + (size_t)ch * 128 * 512 + g * 128;
      const float* nwv = p.sgu_norm_w + ((size_t)l * 4 + g) * 128;
      const float* sb = p.sgu_b + ((size_t)l * 4 + g) * 128;
      gemm_epi(acc, [&](int r, int c, f32x4 v) {
        const f32x4 nw4 = *(const f32x4*)(nwv + c);
        const float bb = sb[r];
        bf16_t* up = U + (size_t)r * 512 + c;
        const u32x2 uw = *(const u32x2*)up;
        f32x4 o;
        o[0] = bflo(uw.x) * (v[0] * nw4[0] + bb);
        o[1] = bfhi(uw.x) * (v[1] * nw4[1] + bb);
        o[2] = bflo(uw.y) * (v[2] * nw4[2] + bb);
        o[3] = bfhi(uw.y) * (v[3] * nw4[3] + bb);
        st4bf(up, o);
      }, t);
    }
  }
  __syncthreads();
}

#define SCAN_BAR() do { asm volatile("s_waitcnt lgkmcnt(0)" ::: "memory"); __builtin_amdgcn_s_barrier(); asm volatile("" ::: "memory"); } while (0)
__device__ __forceinline__ void scan_item(const Params& p, int item, char* lds, const int tid) {
  const int dir = item & 1, h = (item >> 1) & 3, b = item >> 3;
  const int wv = tid >> 6, lane = tid & 63, fr = lane & 15, fq = lane >> 4;
  const bool isP = wv < 4;
  char* RAWB = lds + 69632;
  float* qsum = (float*)(lds + 143360);
  const bf16_t* Q = (const bf16_t*)(p.ws + O_Q);
  const bf16_t* LF = (const bf16_t*)(p.ws + (dir ? O_LFB : O_LFF));
  const bf16_t* I = (const bf16_t*)(p.ws + O_I);
  bf16_t* O = (bf16_t*)(p.ws + (dir ? O_OBK : O_OF));
  auto rowOf = [&](int u) -> size_t {
    if (u < 256) return (size_t)NL + b * 256 + (dir ? 255 - u : u);
    const int v = u - 256;
    return (size_t)b * 4096 + (dir ? 4095 - v : v);
  };
  const int cp = tid & 63, tq = (tid >> 6) & 3;
  const bf16_t* srcs[3] = {LF, Q, I};
  auto dma = [&](int cc) {
    PG8_LAS unsigned char* dstb = (PG8_LAS unsigned char*)RAWB + (cc % 3) * 24576;
#pragma unroll
    for (int j = 0; j < 6; ++j) {
      const int g = j * 4 + wv, arr = g >> 3, rg = g & 7;
      const size_t o = rowOf(cc * 32 + rg * 4 + (lane >> 4)) * 512 + h * 128 + (lane & 15) * 8;
      __builtin_amdgcn_global_load_lds((const unsigned*)(srcs[arr] + o), (PG8_LAS unsigned*)(dstb + arr * 8192 + rg * 1024), 16, 0, 0);
    }
  };
  unsigned wkk[8];
  auto prepA = [&](int cc) {
    const char* raw = RAWB + (cc % 3) * 24576;
#pragma unroll
    for (int i = 0; i < 8; ++i) wkk[i] = *(const unsigned*)(raw + (tq * 8 + i) * 256 + cp * 4);
    f32x2 run = {1.f, 1.f};
#pragma unroll
    for (int i = 0; i < 8; ++i) { const f32x2 kk = {bflo(wkk[i]), bfhi(wkk[i])}; run = run * (1.0f - kk); }
    *(f32x2*)(qsum + tq * 128 + cp * 2) = run;
  };
  auto prepB = [&](int cc) {
    const char* raw = RAWB + (cc % 3) * 24576;
    char* OPB = lds + (cc & 1) * 34816;
    char* QP = OPB; char* KM = OPB + 8704; char* KT = OPB + 17408; char* VT = OPB + 25600;
    float* emid = (float*)(OPB + 33792); float* eend = emid + 128;
    unsigned wq[8], wi[8];
#pragma unroll
    for (int i = 0; i < 8; ++i) { wq[i] = *(const unsigned*)(raw + 8192 + (tq * 8 + i) * 256 + cp * 4); wi[i] = *(const unsigned*)(raw + 16384 + (tq * 8 + i) * 256 + cp * 4); }
    const f32x2 q0 = *(const f32x2*)(qsum + cp * 2), q1 = *(const f32x2*)(qsum + 128 + cp * 2), q2 = *(const f32x2*)(qsum + 256 + cp * 2), q3 = *(const f32x2*)(qsum + 384 + cp * 2);
    const f32x2 one = {1.f, 1.f};
    const f32x2 pmid = q0 * q1, pend = pmid * q2 * q3;
    const f32x2 base = tq == 0 ? one : tq == 1 ? q0 : tq == 2 ? pmid : pmid * q2;
    f32x2 rmid; rmid.x = __builtin_amdgcn_rcpf(fmaxf(pmid.x, 1e-30f)); rmid.y = __builtin_amdgcn_rcpf(fmaxf(pmid.y, 1e-30f));
    f32x2 ebm = pend * rmid; ebm.x = fminf(ebm.x, 1.0f); ebm.y = fminf(ebm.y, 1.0f);
    f32x2 run = base * rmid;
    unsigned oq[8], ok[8], kt0[4], kt1[4], vt0[4], vt1[4];
    float pk0 = 0.f, pk1 = 0.f;
#pragma unroll
    for (int i = 0; i < 8; ++i) {
      const f32x2 kk = {bflo(wkk[i]), bfhi(wkk[i])}, qv = {bflo(wq[i]), bfhi(wq[i])};
      run = run * (one - kk);
      f32x2 ea; ea.x = fminf(fmaxf(run.x, 1e-26f), 1e26f); ea.y = fminf(fmaxf(run.y, 1e-26f), 1e26f);
      f32x2 er; er.x = __builtin_amdgcn_rcpf(ea.x); er.y = __builtin_amdgcn_rcpf(ea.y);
      const f32x2 km = kk * er, qp = qv * ea, kpp = km * ebm;
      oq[i] = pk_bf16(qp.x, qp.y);
      ok[i] = pk_bf16(km.x, km.y);
      if (i & 1) {
        kt0[i >> 1] = pk_bf16(pk0, kpp.x); kt1[i >> 1] = pk_bf16(pk1, kpp.y);
        vt0[i >> 1] = (wi[i - 1] & 0xffffu) | (wi[i] << 16); vt1[i >> 1] = (wi[i - 1] >> 16) | (wi[i] & 0xffff0000u);
      } else { pk0 = kpp.x; pk1 = kpp.y; }
    }
#pragma unroll
    for (int i = 0; i < 8; ++i) { *(unsigned*)(QP + (tq * 8 + i) * 272 + cp * 4) = oq[i]; *(unsigned*)(KM + (tq * 8 + i) * 272 + cp * 4) = ok[i]; }
    u32x4 w;
    w.x = kt0[0]; w.y = kt0[1]; w.z = kt0[2]; w.w = kt0[3]; *(u32x4*)(KT + (cp * 2) * 64 + tq * 16) = w;
    w.x = kt1[0]; w.y = kt1[1]; w.z = kt1[2]; w.w = kt1[3]; *(u32x4*)(KT + (cp * 2 + 1) * 64 + tq * 16) = w;
    w.x = vt0[0]; w.y = vt0[1]; w.z = vt0[2]; w.w = vt0[3]; *(u32x4*)(VT + (cp * 2) * 64 + tq * 16) = w;
    w.x = vt1[0]; w.y = vt1[1]; w.z = vt1[2]; w.w = vt1[3]; *(u32x4*)(VT + (cp * 2 + 1) * 64 + tq * 16) = w;
    if (tq == 0) { *(f32x2*)(emid + cp * 2) = pmid; *(f32x2*)(eend + cp * 2) = pend; }
  };
  const int mw = wv - 4;
  f32x4 S[2][8];
#pragma unroll
  for (int a = 0; a < 2; ++a)
#pragma unroll
    for (int m = 0; m < 8; ++m) S[a][m] = (f32x4){0.f, 0.f, 0.f, 0.f};

  if (isP) { dma(0); dma(1); dma(2); asm volatile("s_waitcnt vmcnt(12)" ::: "memory"); }
  SCAN_BAR();
  if (isP) prepA(0);
  SCAN_BAR();
  if (isP) { prepB(0); asm volatile("s_waitcnt vmcnt(6)" ::: "memory"); }
  SCAN_BAR();
  for (int c = 0; c < 136; ++c) {
    if (isP) {
      if (c + 3 < 136) dma(c + 3);
      if (c + 1 < 136) prepA(c + 1);
      SCAN_BAR();
      if (c + 1 < 136) prepB(c + 1);
      if (c + 3 < 136) asm volatile("s_waitcnt vmcnt(6)" ::: "memory");
      else asm volatile("s_waitcnt vmcnt(0)" ::: "memory");
      SCAN_BAR();
    } else {
      const char* OPB = lds + (c & 1) * 34816;
      const char* QP = OPB; const char* KM = OPB + 8704; const char* KT = OPB + 17408; const char* VT = OPB + 25600;
      const float* emid = (const float*)(OPB + 33792); const float* eend = emid + 128;
      f32x4 PT00 = (f32x4){0.f, 0.f, 0.f, 0.f}, PT01 = PT00, PT11 = PT00;
#pragma unroll
      for (int ks = 0; ks < 4; ++ks) {
        const bf16x8 X0 = *(const bf16x8*)(KM + fr * 272 + ks * 64 + fq * 16), X1 = *(const bf16x8*)(KM + (16 + fr) * 272 + ks * 64 + fq * 16);
        const bf16x8 Y0 = *(const bf16x8*)(QP + fr * 272 + ks * 64 + fq * 16), Y1 = *(const bf16x8*)(QP + (16 + fr) * 272 + ks * 64 + fq * 16);
        PT00 = __builtin_amdgcn_mfma_f32_16x16x32_bf16(X0, Y0, PT00, 0, 0, 0);
        PT01 = __builtin_amdgcn_mfma_f32_16x16x32_bf16(X0, Y1, PT01, 0, 0, 0);
        PT11 = __builtin_amdgcn_mfma_f32_16x16x32_bf16(X1, Y1, PT11, 0, 0, 0);
      }
      SCAN_BAR();
#pragma unroll
      for (int jj = 0; jj < 4; ++jj) if (fq * 4 + jj > fr) { PT00[jj] = 0.f; PT11[jj] = 0.f; }
      u32x4 x0, x1;
      x0.x = pk_bf16(PT00[0], PT00[1]); x0.y = pk_bf16(PT00[2], PT00[3]); x0.z = 0u; x0.w = 0u;
      x1.x = pk_bf16(PT01[0], PT01[1]); x1.y = pk_bf16(PT01[2], PT01[3]); x1.z = pk_bf16(PT11[0], PT11[1]); x1.w = pk_bf16(PT11[2], PT11[3]);
      const size_t orow0 = rowOf(c * 32);
      const long ostep = dir ? -512 : 512;
#pragma unroll
      for (int a = 0; a < 2; ++a) {
        const int vcol = (mw * 2 + a) * 16 + fr;
        f32x4 o0 = (f32x4){0.f, 0.f, 0.f, 0.f}, o1 = o0;
        {
          const u32x2 vlo = *(const u32x2*)(VT + vcol * 64 + fq * 8), vhi = *(const u32x2*)(VT + vcol * 64 + 32 + fq * 8);
          u32x4 yv; yv.x = vlo.x; yv.y = vlo.y; yv.z = vhi.x; yv.w = vhi.y;
          o0 = __builtin_amdgcn_mfma_f32_16x16x32_bf16(__builtin_bit_cast(bf16x8, x0), __builtin_bit_cast(bf16x8, yv), o0, 0, 0, 0);
          o1 = __builtin_amdgcn_mfma_f32_16x16x32_bf16(__builtin_bit_cast(bf16x8, x1), __builtin_bit_cast(bf16x8, yv), o1, 0, 0, 0);
        }
#pragma unroll
        for (int ks = 0; ks < 4; ++ks) {
          const f32x4 em0 = *(const f32x4*)(emid + (2 * ks) * 16 + fq * 4), em1 = *(const f32x4*)(emid + (2 * ks + 1) * 16 + fq * 4);
          u32x4 ys;
          ys.x = pk_bf16(S[a][2 * ks][0] * em0[0], S[a][2 * ks][1] * em0[1]); ys.y = pk_bf16(S[a][2 * ks][2] * em0[2], S[a][2 * ks][3] * em0[3]);
          ys.z = pk_bf16(S[a][2 * ks + 1][0] * em1[0], S[a][2 * ks + 1][1] * em1[1]); ys.w = pk_bf16(S[a][2 * ks + 1][2] * em1[2], S[a][2 * ks + 1][3] * em1[3]);
          const u32x2 a0 = *(const u32x2*)(QP + fr * 272 + ks * 64 + fq * 8), a1 = *(const u32x2*)(QP + fr * 272 + ks * 64 + 32 + fq * 8);
          const u32x2 c0 = *(const u32x2*)(QP + (16 + fr) * 272 + ks * 64 + fq * 8), c1 = *(const u32x2*)(QP + (16 + fr) * 272 + ks * 64 + 32 + fq * 8);
          u32x4 xa, xc; xa.x = a0.x; xa.y = a0.y; xa.z = a1.x; xa.w = a1.y; xc.x = c0.x; xc.y = c0.y; xc.z = c1.x; xc.w = c1.y;
          o0 = __builtin_amdgcn_mfma_f32_16x16x32_bf16(__builtin_bit_cast(bf16x8, xa), __builtin_bit_cast(bf16x8, ys), o0, 0, 0, 0);
          o1 = __builtin_amdgcn_mfma_f32_16x16x32_bf16(__builtin_bit_cast(bf16x8, xc), __builtin_bit_cast(bf16x8, ys), o1, 0, 0, 0);
        }
        bf16_t* op = O + orow0 * 512 + h * 128 + vcol;
#pragma unroll
        for (int jj = 0; jj < 4; ++jj) {
          op[(long)(fq * 4 + jj) * ostep] = f2bf(o0[jj]);
          op[(long)(16 + fq * 4 + jj) * ostep] = f2bf(o1[jj]);
        }
        {
          const bf16x8 yv2 = *(const bf16x8*)(VT + vcol * 64 + fq * 16);
#pragma unroll
          for (int m = 0; m < 8; ++m) {
            const f32x4 ee = *(const f32x4*)(eend + m * 16 + fq * 4);
            const bf16x8 xk = *(const bf16x8*)(KT + (m * 16 + fr) * 64 + fq * 16);
            S[a][m] = __builtin_amdgcn_mfma_f32_16x16x32_bf16(xk, yv2, S[a][m] * ee, 0, 0, 0);
          }
        }
      }
      SCAN_BAR();
    }
  }
  __syncthreads();
}

struct F2Sched {
  const char* FT; const char* ZF; int G, c;
  __device__ __forceinline__ bool next(int i, Unit& u) const {
    const int P = c - 64;
    if (i > 1 || P < 0 || P >= 128) return false;
    const int loc = P >> 3; u.z = (P & 7) | (i << 3); u.pm = loc >> 1; u.pn = loc & 1; return true;
  }
  __device__ __forceinline__ const char* aptr(const Unit& u) const { return FT + (size_t)((u.z >> 3) ^ 1) * ((size_t)2048 * KH * 2) + (size_t)u.pm * ((size_t)256 * KH * 2); }
  __device__ __forceinline__ const char* bptr(const Unit& u) const { return ZF + (size_t)((u.z >> 3) ^ 1) * ((size_t)4096 * KH * 2) + ((size_t)(u.z & 7) * 512 + (size_t)u.pn * 256) * ((size_t)KH * 2); }
};
struct F2CSched {
  const char* FT; const char* ZC; int c;
  __device__ __forceinline__ bool next(int i, Unit& u) const {
    const int L = c - 192; if (i != 0 || L < 0 || L >= 16) return false;
    u.z = L >> 1; u.pm = 0; u.pn = L & 1; return true;
  }
  __device__ __forceinline__ const char* aptr(const Unit&) const { return FT; }
  __device__ __forceinline__ const char* bptr(const Unit& u) const { return ZC + (size_t)u.z * (512u * 512u * 2u) + (size_t)u.pn * (256u * 512u * 2u); }
};
struct EpiF2 {
  bf16_t* OB; int ctx; float* SX;
  __device__ __forceinline__ bool operator()(f32x4 (&acc)[2][2][4][2], const Unit& u, int wr, int wc, int fr, int fq) const {
    if (ctx) {
      bf16_t* dst = OB + ((size_t)NL + (size_t)u.z * 256) * 512 + u.pn * 256;
      pg8::epi_each(acc, wr, wc, fr, fq, [&](int r, int c, f32x4 v0, f32x4 v1) { st8bf(dst + (size_t)r * 512 + c, v0, v1); });
      return false;
    }
    const int b = u.z & 7, part = u.z >> 3;
    const int tl = (wr * 4 + wc) * 64 + fq * 16 + fr;
    float* sx = SX + ((size_t)(b + 8 * (u.pm * 2 + u.pn)) * 16) * 4096 + (size_t)tl * 8;
    bf16_t* dst = OB + (size_t)b * 4096 * 512 + u.pn * 256;
#pragma unroll
    for (int ai = 0; ai < 2; ++ai)
#pragma unroll
      for (int m = 0; m < 4; ++m)
#pragma unroll
        for (int bj = 0; bj < 2; ++bj) {
          float* q = sx + (size_t)((ai * 4 + m) * 2 + bj) * 4096;
          if (part == 0) { *(f32x4*)q = acc[ai][bj][m][0]; *(f32x4*)(q + 4) = acc[ai][bj][m][1]; }
          else {
            const f32x4 s0 = *(const f32x4*)q, s1 = *(const f32x4*)(q + 4);
            const int k = u.pm * 256 + ai * 128 + wr * 64 + m * 16 + fr, c = bj * 128 + wc * 32 + 8 * fq;
            st8bf(dst + (size_t)k * 512 + c, acc[ai][bj][m][0], acc[ai][bj][m][1]);
            if (k >= 1) st8bf(dst + (size_t)(4096 - k) * 512 + c, acc[ai][bj][m][0] - 2.0f * s0, acc[ai][bj][m][1] - 2.0f * s1);
          }
        }
    return part == 0;
  }
};
__device__ __forceinline__ void phase_fold(const Params& p, char* lds, int wid0, int bfirst) {
  const int tid = opaque_tid(wid0);
  bf16_t* zrow = (bf16_t*)lds;
  const bf16_t* ZCL = (const bf16_t*)(p.ws + O_ZCL);
  bf16_t* ZF = (bf16_t*)(p.ws + O_ZF);
  bf16_t* OB = (bf16_t*)(p.ws + O_ZB);
  float* red = (float*)(lds + 16384);
  if ((int)blockIdx.x < bfirst) return;
  for (int row = (int)blockIdx.x - bfirst; row < 8 * 512; row += (int)gridDim.x - bfirst) {
    const bf16_t* src = ZCL + (size_t)row * 8192;
#pragma unroll
    for (int i = 0; i < 2; ++i) *(u32x4*)(zrow + (tid + i * 512) * 8) = *(const u32x4*)(src + (tid + i * 512) * 8);
    __syncthreads();
    float alt = 0.f;
    for (int e8 = tid; e8 < 2 * (KH / 8); e8 += NTHREADS) {
      const int part = e8 >= KH / 8 ? 1 : 0, e = part ? e8 - KH / 8 : e8;
      float v[8];
#pragma unroll
      for (int jx = 0; jx < 8; ++jx) {
        const int t = e * 8 + jx;
        if (!part) v[jx] = t > 2048 ? 0.f : (t == 0 || t == 2048) ? bf2f(zrow[t]) : bf2f(zrow[t]) + bf2f(zrow[4096 - t]);
        else v[jx] = (t == 0 || t >= 2048) ? 0.f : bf2f(zrow[4096 + t]) - bf2f(zrow[4096 + 4096 - t]);
      }
      u32x4 w;
      w.x = pk_bf16(v[0], v[1]); w.y = pk_bf16(v[2], v[3]); w.z = pk_bf16(v[4], v[5]); w.w = pk_bf16(v[6], v[7]);
      *(u32x4*)(ZF + ((size_t)part * 4096 + row) * KH + e * 8) = w;
      if (!part) alt += (bflo(w.x) - bfhi(w.x)) + (bflo(w.y) - bfhi(w.y)) + (bflo(w.z) - bfhi(w.z)) + (bflo(w.w) - bfhi(w.w));
    }
    alt = wave_sum(alt);
    if ((tid & 63) == 0) red[tid >> 6] = alt;
    __syncthreads();
    if (tid == 0) {
      float a = 0.f;
#pragma unroll
      for (int w8 = 0; w8 < 8; ++w8) a += red[w8];
      OB[((size_t)(row >> 9) * 4096 + 2048) * 512 + (row & 511)] = f2bf(a * bf2f(f2bf(0.0013810679320049757f)));
    }
  }
}
__device__ __forceinline__ void phase_mix2(const Params& p, int l, char* lds, int wid0) {
  const int tid = opaque_tid(wid0);
  if (blockIdx.x < 64) { scan_item(p, blockIdx.x, lds, tid); return; }
  unsigned* bar = (unsigned*)(p.ws + O_BAR);
  const int nb = (int)gridDim.x - 64;
  phase_mix1(p, l, lds, wid0, 0, 64);
  sub_barrier(bar + (l * 2 + 0) * 16, nb);
  phase_fold(p, lds, wid0, 64);
  sub_barrier(bar + (l * 2 + 1) * 16, nb);
  PG8_LAS unsigned char* L = (PG8_LAS unsigned char*)lds;
  {
    F2Sched S{p.ws + O_FTL, p.ws + O_ZF, (int)gridDim.x, (int)blockIdx.x};
    EpiF2 E{(bf16_t*)(p.ws + O_ZB), 0, (float*)(p.ws + O_ZCL)};
    pg8::gemm_phase(L, KH, S, E, tid);
  }
  if (l == 0) {
    F2CSched S{p.ws + O_FTC, p.ws + O_ZCC, (int)blockIdx.x};
    EpiF2 E{(bf16_t*)(p.ws + O_ZB), 1, nullptr};
    pg8::gemm_phase(L, 512, S, E, tid);
  }
  if (blockIdx.x >= 192) { for (int sh = 0; sh < 2; ++sh) phase_mix1(p, l, lds, wid0, 1, 64, ((int)blockIdx.x - 192) * 2 + sh, 512); }
  else { for (int sh = 0; sh < 3; ++sh) phase_mix1(p, l, lds, wid0, 1, 64, 128 + ((int)blockIdx.x - 64) * 3 + sh, 512); }
  if (gridDim.x == 256) {
    pg8::GridSched S;
    S.init(p.ws + O_H, p.ws + O_WIN + (size_t)16 * 256 * 1024 * 2, 1024, GIN_R0, 12, 0, (int)gridDim.x - 64, (int)blockIdx.x - 64);
    EpiGin E{p.ws, (const float*)(p.ws + O_LB), l, 16};
    pg8::gemm_phase(L, 1024, S, E, tid);
  }
}

__device__ __forceinline__ void phase_oa(const Params& p, int l, int wid0) {
  const int tid = opaque_tid(wid0), wid = tid >> 6, lane = tid & 63;
  const int nrow = (l == 1) ? NL : NT;
  const bf16_t* OF = (const bf16_t*)(p.ws + O_OF);
  const bf16_t* OK = (const bf16_t*)(p.ws + O_OBK);
  bf16_t* GA = (bf16_t*)(p.ws + O_GA);
  const float* gw = p.gnorm_w + (size_t)l * 128;
  for (int row = blockIdx.x * NWAVE + wid; row < nrow; row += gridDim.x * NWAVE) {
    const size_t o = (size_t)row * 512 + lane * 8;
    const u32x4 a = *(const u32x4*)(OF + o), b = *(const u32x4*)(OK + o), g = *(const u32x4*)(GA + o);
    float v[8];
    v[0] = bflo(a.x) + bflo(b.x); v[1] = bfhi(a.x) + bfhi(b.x);
    v[2] = bflo(a.y) + bflo(b.y); v[3] = bfhi(a.y) + bfhi(b.y);
    v[4] = bflo(a.z) + bflo(b.z); v[5] = bfhi(a.z) + bfhi(b.z);
    v[6] = bflo(a.w) + bflo(b.w); v[7] = bfhi(a.w) + bfhi(b.w);
    float ss = 0.f;
#pragma unroll
    for (int j = 0; j < 8; ++j) ss += v[j] * v[j];
    ss += __shfl_xor(ss, 1); ss += __shfl_xor(ss, 2); ss += __shfl_xor(ss, 4); ss += __shfl_xor(ss, 8);
    const float rs = rsqrtf(ss * (1.0f / 128.0f) + 1e-6f);
    const float* gwp = gw + (lane & 15) * 8;
    const f32x4 w0 = *(const f32x4*)gwp, w1 = *(const f32x4*)(gwp + 4);
    float gg[8] = {bflo(g.x), bfhi(g.x), bflo(g.y), bfhi(g.y), bflo(g.z), bfhi(g.z), bflo(g.w), bfhi(g.w)};
    u32x4 w;
    w.x = pk_bf16(v[0] * rs * w0[0] * gg[0], v[1] * rs * w0[1] * gg[1]);
    w.y = pk_bf16(v[2] * rs * w0[2] * gg[2], v[3] * rs * w0[3] * gg[3]);
    w.z = pk_bf16(v[4] * rs * w1[0] * gg[4], v[5] * rs * w1[1] * gg[5]);
    w.w = pk_bf16(v[6] * rs * w1[2] * gg[6], v[7] * rs * w1[3] * gg[7]);
    *(u32x4*)(GA + o) = w;
  }
}

#define HC_MERGE 136
#define HC_MOE1  152
__device__ __forceinline__ void hc_publish(unsigned* cnt) {
  asm volatile("s_waitcnt vmcnt(0)" ::: "memory");
  __syncthreads();
  if (threadIdx.x == 0) { __threadfence(); (void)xb_add(cnt, 1u); }
}
__device__ __forceinline__ void hc_wait(unsigned* bar, unsigned* cnt, unsigned target) {
  if (threadIdx.x == 0) { XB_SPIN(xb_ld(cnt) < target, bar); __threadfence(); }
  __syncthreads();
}
struct OneSched {
  const char* A; const char* B; int pm, pn, z;
  __device__ __forceinline__ bool next(int i, Unit& u) const { if (i) return false; u.pm = pm; u.pn = pn; u.z = z; return true; }
  __device__ __forceinline__ const char* aptr(const Unit&) const { return A; }
  __device__ __forceinline__ const char* bptr(const Unit&) const { return B; }
};
struct EpiStoreBf16 {
  bf16_t* dst; int ld;
  __device__ __forceinline__ bool operator()(f32x4 (&acc)[2][2][4][2], const Unit& u, int wr, int wc, int fr, int fq) const {
    bf16_t* d = dst + (size_t)u.pm * 256 * ld + u.pn * 256;
    pg8::epi_each(acc, wr, wc, fr, fq, [&](int r, int c, f32x4 v0, f32x4 v1) { st8bf(d + (size_t)r * ld + c, v0, v1); });
    return false;
  }
};
struct MergeSched {
  const char* ws; int ntile, G, c, fuse;
  __device__ __forceinline__ bool next(int i, Unit& u) const {
    const int xcd = c & 7, q = c >> 3;
    int rnd = i / 3;
    if (fuse && c < 32) rnd = rnd == 0 ? 2 : rnd == 2 ? 0 : rnd;
    u.pm = (rnd * (G >> 5) + (q >> 2)) * 8 + xcd; u.pn = q & 3; u.z = i % 3;
    return u.pm * 4 < ntile && (q >> 2) < (G >> 5);
  }
  __device__ __forceinline__ const char* aptr(const Unit& u) const {
    return ws + (u.z == 0 ? O_GA : u.z == 1 ? O_ZB : O_U) + (size_t)u.pm * (256u * 512u * 2u);
  }
  __device__ __forceinline__ const char* bptr(const Unit& u) const { return ws + O_WBR + (size_t)u.z * (1024u * 512u * 2u) + (size_t)u.pn * (256u * 512u * 2u); }
};
struct EpiMerge {
  char* ws; int fuse;
  __device__ __forceinline__ bool operator()(f32x4 (&acc)[2][2][4][2], const Unit& u, int wr, int wc, int fr, int fq) const {
    const int tl = (wr * 4 + wc) * 64 + fq * 16 + fr;
    const unsigned char* GT = (const unsigned char*)(ws + O_G) + ((size_t)u.pm * 12 + u.z * 4 + u.pn) * 65536 + (size_t)tl * 8;
    auto ub = [](unsigned w, int k) { return (float)((w >> (8 * k)) & 0xffu) + 0.5f; };
    bf16_t* MG = (bf16_t*)(ws + O_H) + (size_t)u.pm * 256 * 1024 + u.pn * 256;
    const bool lastj = (u.z == 2);
#pragma unroll
    for (int ai = 0; ai < 2; ++ai)
#pragma unroll
      for (int m = 0; m < 4; ++m)
#pragma unroll
        for (int bj = 0; bj < 2; ++bj) {
          const int cidx = (ai * 4 + m) * 2 + bj;
          const u32x2 gw = *(const u32x2*)(GT + (size_t)cidx * 4096);
          f32x4 g0, g1;
#pragma unroll
          for (int q = 0; q < 4; ++q) { g0[q] = ub(gw.x, q); g1[q] = ub(gw.y, q); }
          if (lastj) {
            const int r = ai * 128 + wr * 64 + m * 16 + fr, c = bj * 128 + wc * 32 + 8 * fq;
            st8bf(MG + (size_t)r * 1024 + c, acc[ai][bj][m][0] * (g0 * 0.00390625f), acc[ai][bj][m][1] * (g1 * 0.00390625f));
          } else {
            const u32x2 hw = *(const u32x2*)(GT + 4 * 65536 + (size_t)cidx * 4096);
#pragma unroll
            for (int q = 0; q < 4; ++q) {
              acc[ai][bj][m][0][q] *= g0[q] * __builtin_amdgcn_rcpf(ub(hw.x, q));
              acc[ai][bj][m][1][q] *= g1[q] * __builtin_amdgcn_rcpf(ub(hw.y, q));
            }
          }
        }
    if (fuse && lastj && u.pm >= 128) hc_publish((unsigned*)(ws + O_BAR) + HC_MERGE);
    return !lastj;
  }
};
__device__ __forceinline__ void phase_merge(const Params& p, int l, char* lds, int wid0) {
  const int tid = opaque_tid(wid0);
  const int fuse = (l == 0 && gridDim.x == 256) ? 1 : 0;
  MergeSched S{p.ws, (l == 1 ? 128 : 136) * 4, (int)gridDim.x, (int)blockIdx.x, fuse};
  EpiMerge E{p.ws, fuse};
  pg8::gemm_phase((PG8_LAS unsigned char*)lds, 512, S, E, tid);
  if (fuse) {
    const int c = (int)blockIdx.x;
    if (c >= 32 && c < 64) {
      unsigned* bar = (unsigned*)(p.ws + O_BAR);
      hc_wait(bar, bar + HC_MERGE, 32u);
      const int pm = 128 + (c & 7), pn = (c >> 3) - 4;
      OneSched S2{p.ws + O_H + (size_t)pm * (256u * 1024u * 2u), p.ws + O_WOUT + (size_t)pn * (256u * 1024u * 2u), pm, pn, 0};
      EpiStoreBf16 E2{(bf16_t*)(p.ws + O_Y), 1024};
      pg8::gemm_phase((PG8_LAS unsigned char*)lds, 1024, S2, E2, tid);
    } else if (c >= 64) conv_fill(p, lds, wid0, 0, c - 64, 192);
  }
}

__device__ __forceinline__ void phase_wout(const Params& p, int l, char* lds, int wid0) {
  const int tid = opaque_tid(wid0);
  pg8::GridSched S;
  const bool fuse = l == 0 && gridDim.x == 256;
  S.init(p.ws + O_H, p.ws + O_WOUT, 1024, (l == 1 || fuse) ? 128 : 136, 4, 0, gridDim.x, blockIdx.x);
  EpiStoreBf16 E{(bf16_t*)(p.ws + O_Y), 1024};
  pg8::gemm_phase((PG8_LAS unsigned char*)lds, 1024, S, E, tid);
}

template <int l>
__device__ __forceinline__ void phase_rowB(const Params& p, char* lds, int wid0) {
  const int tid = opaque_tid(wid0), wid = tid >> 6, lane = tid & 63;
  const int nrow = (l == 1) ? NL : NT;
  const float* xlat = l == 0 ? p.x : p.out;
  const float* xctx = l == 0 ? p.ctx : (const float*)(p.ws + O_CTXB);
  const float* mod = (const float*)(p.ws + O_MOD);
  bf16_t* Y = (bf16_t*)(p.ws + O_Y);
  bf16_t* H = (bf16_t*)(p.ws + O_H);
  float* aff = (float*)(p.ws + O_AFF);
  const float* nw1 = p.norm_w + (size_t)(l * 4 + 1) * 1024;
  const float* nw2 = p.norm_w + (size_t)(l * 4 + 2) * 1024;
  const float* rw = p.router_w + (size_t)l * 1024 * 16;
  float* rwT = (float*)lds;
  for (int i = tid; i < 16384; i += NTHREADS) rwT[(i & 15) * 1024 + (i >> 4)] = rw[i];
  __syncthreads();
  u32x4 pfy[2]; f32x4 pfx[4];
  auto fetch = [&](int row) {
    const float* xr = row < NL ? xlat + (size_t)row * 1024 : xctx + (size_t)(row - NL) * 1024;
#pragma unroll
    for (int i = 0; i < 2; ++i) {
      const int e = i * 512 + lane * 8;
      pfy[i] = *(const u32x4*)(Y + (size_t)row * 1024 + e);
      if (l == 1) pfx[i * 2] = *(const f32x4*)((const bf16_t*)p.out + (size_t)row * 1024 + e);
      else { pfx[i * 2] = *(const f32x4*)(xr + e); pfx[i * 2 + 1] = *(const f32x4*)(xr + e + 4); }
    }
  };
  const int row0 = blockIdx.x * NWAVE + wid, rstep = gridDim.x * NWAVE;
  if (row0 < nrow) fetch(row0);
  for (int row = row0; row < nrow; row += rstep) {
    const int mr = row < NL ? (row >> 12) : 8;
    const float* md = mod + (size_t)(l * 9 + mr) * 6144;
    float yv[16], xv[16];
    float ss = 0.f;
#pragma unroll
    for (int i = 0; i < 2; ++i) {
      const u32x4 w = pfy[i];
      yv[i * 8 + 0] = bflo(w.x); yv[i * 8 + 1] = bfhi(w.x); yv[i * 8 + 2] = bflo(w.y); yv[i * 8 + 3] = bfhi(w.y);
      yv[i * 8 + 4] = bflo(w.z); yv[i * 8 + 5] = bfhi(w.z); yv[i * 8 + 6] = bflo(w.w); yv[i * 8 + 7] = bfhi(w.w);
      if (l == 1) {
        const u32x4 xw = __builtin_bit_cast(u32x4, pfx[i * 2]);
        xv[i * 8 + 0] = bflo(xw.x); xv[i * 8 + 1] = bfhi(xw.x); xv[i * 8 + 2] = bflo(xw.y); xv[i * 8 + 3] = bfhi(xw.y);
        xv[i * 8 + 4] = bflo(xw.z); xv[i * 8 + 5] = bfhi(xw.z); xv[i * 8 + 6] = bflo(xw.w); xv[i * 8 + 7] = bfhi(xw.w);
      } else {
        const f32x4 a = pfx[i * 2], b = pfx[i * 2 + 1];
#pragma unroll
        for (int j = 0; j < 4; ++j) { xv[i * 8 + j] = a[j]; xv[i * 8 + 4 + j] = b[j]; }
      }
    }
    if (row + rstep < nrow) fetch(row + rstep);
#pragma unroll
    for (int j = 0; j < 16; ++j) ss += yv[j] * yv[j];
    ss = wave_sum(ss);
    const float rs = rsqrtf(ss * (1.0f / 1024.0f) + 1e-6f);
    float ss2 = 0.f;
#pragma unroll
    for (int i = 0; i < 2; ++i) {
      const int e = i * 512 + lane * 8;
#pragma unroll
      for (int h4 = 0; h4 < 2; ++h4) {
        const f32x4 w = *(const f32x4*)(nw1 + e + h4 * 4), g1 = *(const f32x4*)(md + 2048 + e + h4 * 4);
#pragma unroll
        for (int j = 0; j < 4; ++j) {
          const int q = i * 8 + h4 * 4 + j;
          xv[q] = xv[q] + g1[j] * (yv[q] * rs * w[j]);
          ss2 += xv[q] * xv[q];
        }
      }
      u32x4 o;
      o.x = pk_bf16(xv[i * 8 + 0], xv[i * 8 + 1]); o.y = pk_bf16(xv[i * 8 + 2], xv[i * 8 + 3]); o.z = pk_bf16(xv[i * 8 + 4], xv[i * 8 + 5]); o.w = pk_bf16(xv[i * 8 + 6], xv[i * 8 + 7]);
      *(u32x4*)(Y + (size_t)row * 1024 + e) = o;
    }
    ss2 = wave_sum(ss2);
    const float rs2 = rsqrtf(ss2 * (1.0f / 1024.0f) + 1e-6f);
    float lg[16];
#pragma unroll
    for (int e2 = 0; e2 < 16; ++e2) lg[e2] = 0.f;
#pragma unroll
    for (int i = 0; i < 2; ++i) {
      const int e = i * 512 + lane * 8;
      float hv[8];
#pragma unroll
      for (int h4 = 0; h4 < 2; ++h4) {
        const f32x4 w = *(const f32x4*)(nw2 + e + h4 * 4), sh = *(const f32x4*)(md + 3072 + e + h4 * 4), sc = *(const f32x4*)(md + 4096 + e + h4 * 4);
#pragma unroll
        for (int j = 0; j < 4; ++j) hv[h4 * 4 + j] = xv[i * 8 + h4 * 4 + j] * rs2 * w[j] * (1.0f + sc[j]) + sh[j];
      }
      u32x4 w;
      w.x = pk_bf16(hv[0], hv[1]); w.y = pk_bf16(hv[2], hv[3]); w.z = pk_bf16(hv[4], hv[5]); w.w = pk_bf16(hv[6], hv[7]);
      *(u32x4*)(H + (size_t)row * 1024 + e) = w;
#pragma unroll
      for (int e2 = 0; e2 < 16; ++e2) {
        const f32x4 r0 = *(const f32x4*)(rwT + e2 * 1024 + e), r1 = *(const f32x4*)(rwT + e2 * 1024 + e + 4);
        lg[e2] += hv[0] * r0[0] + hv[1] * r0[1] + hv[2] * r0[2] + hv[3] * r0[3] + hv[4] * r1[0] + hv[5] * r1[1] + hv[6] * r1[2] + hv[7] * r1[3];
        if ((e2 & 3) == 3) __builtin_amdgcn_sched_barrier(0);
      }
    }
    float a8[8], a4[4], a2[2], a1;
    {
      const bool up = (lane & 32) != 0;
#pragma unroll
      for (int j = 0; j < 8; ++j) { const float mine = up ? lg[8 + j] : lg[j], other = up ? lg[j] : lg[8 + j]; a8[j] = mine + __shfl_xor(other, 32); }
    }
    {
      const bool up = (lane & 16) != 0;
#pragma unroll
      for (int j = 0; j < 4; ++j) { const float mine = up ? a8[4 + j] : a8[j], other = up ? a8[j] : a8[4 + j]; a4[j] = mine + __shfl_xor(other, 16); }
    }
    {
      const bool up = (lane & 8) != 0;
#pragma unroll
      for (int j = 0; j < 2; ++j) { const float mine = up ? a4[2 + j] : a4[j], other = up ? a4[j] : a4[2 + j]; a2[j] = mine + __shfl_xor(other, 8); }
    }
    {
      const bool up = (lane & 4) != 0;
      const float mine = up ? a2[1] : a2[0], other = up ? a2[0] : a2[1];
      a1 = mine + __shfl_xor(other, 4);
    }
    a1 += __shfl_xor(a1, 2);
    a1 += __shfl_xor(a1, 1);
    float mx = a1;
    mx = fmaxf(mx, __shfl_xor(mx, 4)); mx = fmaxf(mx, __shfl_xor(mx, 8)); mx = fmaxf(mx, __shfl_xor(mx, 16)); mx = fmaxf(mx, __shfl_xor(mx, 32));
    const float ex = expf(a1 - mx);
    float se = ex;
    se += __shfl_xor(se, 4); se += __shfl_xor(se, 8); se += __shfl_xor(se, 16); se += __shfl_xor(se, 32);
    if ((lane & 3) == 0) {
      const int e2 = ((lane >> 5) & 1) * 8 + ((lane >> 4) & 1) * 4 + ((lane >> 3) & 1) * 2 + ((lane >> 2) & 1);
      aff[(size_t)row * 16 + e2] = ex / se;
    }
  }
}

template <int NI, int T>
__device__ __forceinline__ void topk_body(const Params& p, int s, int e, char* lds, const int tid) {
  constexpr int CAP = T / 8;
  typedef unsigned long long u64;
  int* cntw = (int*)lds;
  int* wcnt = (int*)(lds + 256);
  int* woff = (int*)(lds + 512);
  const int wid = tid >> 6, lane = tid & 63;
  const bool isl = T == 4096;
  const size_t rowbase = isl ? (size_t)s * 4096 : (size_t)NL + (size_t)(s - 8) * 256;
  const float* aff = (const float*)(p.ws + O_AFF);
  int* sel = (int*)(p.ws + O_SEL);
  float* gate = (float*)(p.ws + O_GATE);
  int* tok = (int*)(p.ws + O_TOK);
  u64 key[NI];
  float av[NI];
#pragma unroll
  for (int q = 0; q < NI; ++q) {
    const int i = tid + q * NTHREADS;
    av[q] = 0.f; key[q] = 0ull;
    if (i < T) {
      av[q] = aff[(rowbase + i) * 16 + e];
      key[q] = ((u64)__float_as_uint(av[q]) << 12) | (u64)(4095 - i);
    }
  }
  u64 prefix = 0ull;
  for (int bit = 43; bit >= 0; --bit) {
    const u64 cand = prefix | (1ull << bit);
    int c = 0;
#pragma unroll
    for (int q = 0; q < NI; ++q) c += __popcll(__ballot(key[q] >= cand));
    if (lane == 0) cntw[(bit & 1) * 8 + wid] = c;
    __syncthreads();
    int tot = 0;
#pragma unroll
    for (int w = 0; w < 8; ++w) tot += cntw[(bit & 1) * 8 + w];
    if (tot >= CAP) prefix = cand;
  }
  int before[NI];
  bool in[NI];
#pragma unroll
  for (int q = 0; q < NI; ++q) {
    in[q] = key[q] >= prefix && key[q] != 0ull;
    const u64 m = __ballot(in[q]);
    before[q] = __popcll(m & ((1ull << lane) - 1ull));
    if (lane == 0) wcnt[q * 8 + wid] = __popcll(m);
  }
  __syncthreads();
  if (tid < 64) {
    int v = tid < NI * 8 ? wcnt[tid] : 0, x = v;
#pragma unroll
    for (int o = 1; o < 64; o <<= 1) { const int y = __shfl_up(x, o); if (lane >= o) x += y; }
    if (tid < NI * 8) woff[tid] = x - v;
  }
  __syncthreads();
  const size_t slotbase = isl ? ((size_t)e * 8 + s) * CAP : (size_t)NSLOT_L + ((size_t)e * 8 + (s - 8)) * CAP;
#pragma unroll
  for (int q = 0; q < NI; ++q) {
    const int i = tid + q * NTHREADS;
    if (i < T) {
      const int slot = woff[q * 8 + wid] + before[q];
      sel[(rowbase + i) * 16 + e] = in[q] ? slot : -1;
      if (in[q]) {
        tok[slotbase + slot] = (int)(rowbase + i);
        gate[slotbase + slot] = av[q];
      }
    }
  }
  __syncthreads();
}
__device__ __forceinline__ void phase_topk(const Params& p, int l, char* lds, int wid0) {
  const int tid = opaque_tid(wid0);
  const int NITEM = (l == 1) ? 128 : 256;
  for (int item = blockIdx.x; item < NITEM; item += gridDim.x) {
    const int s = item >> 4, e = item & 15;
    if (s < 8) topk_body<8, 4096>(p, s, e, lds, tid);
    else topk_body<1, 256>(p, s, e, lds, tid);
  }
}

struct MoeSched {
  const char* A; const char* W; int nN, nunit, G, c; size_t estep; int swap = 0;
  __device__ __forceinline__ bool next(int i, Unit& u) const {
    const int xcd = c & 7, q = c >> 3, per = (G >> 3) / nN;
    int ii = i;
    if (swap && xcd < 4) ii = i == 0 ? 8 : i == 8 ? 0 : i;
    u.pn = q % nN; u.pm = (ii * 8 + xcd) * per + q / nN;
    if (q >= per * nN || u.pm * nN >= nunit) return false;
    u.z = u.pm < 256 ? (u.pm >> 4) : (u.pm - 256); return true;
  }
  __device__ __forceinline__ const char* aptr(const Unit& u) const { return A + (size_t)u.pm * (256u * 1024u * 2u); }
  __device__ __forceinline__ const char* bptr(const Unit& u) const { return W + (size_t)u.z * estep + (size_t)u.pn * (256u * 1024u * 2u); }
};
struct MoeSchedG : MoeSched {
  static constexpr bool GATHER = true;
  const int* tok;
  __device__ __forceinline__ const char* aptr(const Unit&) const { return A; }
  __device__ __forceinline__ const int* tokptr(const Unit& u) const { return tok + (size_t)u.pm * 256; }
};
struct EpiSwiglu {
  bf16_t* HID; unsigned* cnt;
  __device__ __forceinline__ bool operator()(f32x4 (&acc)[2][2][4][2], const Unit& u, int wr, int wc, int fr, int fq) const {
    bf16_t* d = HID + (size_t)u.pm * 256 * 1024 + u.pn * 128;
#pragma unroll
    for (int ai = 0; ai < 2; ++ai)
#pragma unroll
      for (int m = 0; m < 4; ++m) {
        f32x4 o0, o1;
#pragma unroll
        for (int j = 0; j < 4; ++j) { o0[j] = siluf_(acc[ai][0][m][0][j]) * acc[ai][1][m][0][j]; o1[j] = siluf_(acc[ai][0][m][1][j]) * acc[ai][1][m][1][j]; }
        st8bf(d + (size_t)(ai * 128 + wr * 64 + m * 16 + fr) * 1024 + wc * 32 + 8 * fq, o0, o1);
      }
    if (cnt && u.pm >= 256) hc_publish(cnt);
    return false;
  }
};
__device__ __forceinline__ void phase_moe1(const Params& p, int l, char* lds, int wid0) {
  const int tid = opaque_tid(wid0);
  const int nrt = (l == 1) ? 256 : 272;
  MoeSchedG S;
  S.A = p.ws + O_H; S.W = l == 1 ? (const char*)p.out + OUT_W13B : p.ws + O_W13; S.nN = 8; S.nunit = nrt * 8; S.G = (int)gridDim.x; S.c = (int)blockIdx.x; S.estep = (size_t)2048 * 1024 * 2;
  S.tok = (const int*)(p.ws + O_TOK);
  const bool fuse = l == 0 && gridDim.x == 256;
  S.swap = fuse ? 1 : 0;
  unsigned* bar = (unsigned*)(p.ws + O_BAR);
  EpiSwiglu E{(bf16_t*)(p.ws + O_HID), fuse ? bar + HC_MOE1 : nullptr};
  pg8::gemm_phase((PG8_LAS unsigned char*)lds, 1024, S, E, tid);
  if (fuse) {
    const int xcd = (int)blockIdx.x & 7, q = (int)blockIdx.x >> 3;
    if (xcd >= 4 && q < 16) {
      const int r = q * 4 + xcd - 4, e = r >> 2, pn = r & 3, pm = 256 + e;
      hc_wait(bar, bar + HC_MOE1, 128u);
      OneSched S2{p.ws + O_HID + (size_t)pm * (256u * 1024u * 2u), p.ws + O_W2 + (size_t)e * ((size_t)1024 * 1024 * 2) + (size_t)pn * (256u * 1024u * 2u), pm, pn, e};
      EpiStoreBf16 E2{(bf16_t*)(p.ws + O_YS), 1024};
      pg8::gemm_phase((PG8_LAS unsigned char*)lds, 1024, S2, E2, tid);
    } else if (xcd >= 4) conv_fill(p, lds, wid0, 2, (q - 16) * 4 + xcd - 4, 64);
  }
}
__device__ __forceinline__ void phase_moe2(const Params& p, int l, char* lds, int wid0) {
  const int tid = opaque_tid(wid0);
  const int nrt = (l == 1 || gridDim.x == 256) ? 256 : 272;
  MoeSched S{p.ws + O_HID, p.ws + (l == 1 && p.w2sep ? O_W2B : O_W2), 4, nrt * 4, (int)gridDim.x, (int)blockIdx.x, (size_t)1024 * 1024 * 2};
  EpiStoreBf16 E{(bf16_t*)(p.ws + O_YS), 1024};
  pg8::gemm_phase((PG8_LAS unsigned char*)lds, 1024, S, E, tid);
}

__device__ __forceinline__ void phase_rowC(const Params& p, int l, int wid0) {
  const int tid = opaque_tid(wid0), wid = tid >> 6, lane = tid & 63;
  const int nrow = (l == 1) ? NL : NT;
  float* olat = p.out;
  float* octx = (float*)(p.ws + O_CTXB);
  const float* mod = (const float*)(p.ws + O_MOD);
  const bf16_t* YS = (const bf16_t*)(p.ws + O_YS);
  const int* sel = (const int*)(p.ws + O_SEL);
  const float* gate = (const float*)(p.ws + O_GATE);
  const float* nw3 = p.norm_w + (size_t)(l * 4 + 3) * 1024;
  const float* nwn = p.norm_w + (size_t)((l + 1) * 4 + 0) * 1024;
  bf16_t* H = (bf16_t*)(p.ws + O_H);
  const bf16_t* X1 = (const bf16_t*)(p.ws + O_Y);
  int pfrk; u32x4 pfx[2];
  auto fetch = [&](int row) {
    pfrk = sel[(size_t)row * 16 + (lane & 15)];
#pragma unroll
    for (int i = 0; i < 2; ++i) pfx[i] = *(const u32x4*)(X1 + (size_t)row * 1024 + i * 512 + lane * 8);
  };
  const int row0 = blockIdx.x * NWAVE + wid, rstep = gridDim.x * NWAVE;
  if (row0 < nrow) fetch(row0);
  for (int row = row0; row < nrow; row += rstep) {
    float* xo = row < NL ? olat + (size_t)row * 1024 : octx + (size_t)(row - NL) * 1024;
    const bool isl = row < NL;
    const int mr = isl ? (row >> 12) : 8;
    const int s = isl ? (row >> 12) : ((row - NL) >> 8);
    const float* md = mod + (size_t)(l * 9 + mr) * 6144;
    float mv[16];
#pragma unroll
    for (int j = 0; j < 16; ++j) mv[j] = 0.f;
    const int myrk = pfrk;
    u32x4 xcur[2];
#pragma unroll
    for (int i = 0; i < 2; ++i) xcur[i] = pfx[i];
    if (row + rstep < nrow) fetch(row + rstep);
    unsigned long long chosen = __ballot(myrk >= 0) & 0xffffull;
    while (chosen) {
      const int e0 = __builtin_ctzll(chosen); chosen &= chosen - 1;
      const int e1 = chosen ? __builtin_ctzll(chosen) : -1; if (chosen) chosen &= chosen - 1;
      const int rk0 = __shfl(myrk, e0), rk1 = e1 >= 0 ? __shfl(myrk, e1) : 0;
      const size_t slot0 = isl ? ((size_t)e0 * 8 + s) * 512 + rk0 : (size_t)NSLOT_L + ((size_t)e0 * 8 + s) * 32 + rk0;
      const size_t slot1 = e1 < 0 ? slot0 : (isl ? ((size_t)e1 * 8 + s) * 512 + rk1 : (size_t)NSLOT_L + ((size_t)e1 * 8 + s) * 32 + rk1);
      u32x4 w[4];
#pragma unroll
      for (int i = 0; i < 2; ++i) { w[i] = *(const u32x4*)(YS + slot0 * 1024 + i * 512 + lane * 8); w[2 + i] = *(const u32x4*)(YS + slot1 * 1024 + i * 512 + lane * 8); }
      const float m0 = gate[slot0], m1 = e1 >= 0 ? gate[slot1] : 0.f;
#pragma unroll
      for (int i = 0; i < 2; ++i) {
        mv[i * 8 + 0] += m0 * bflo(w[i].x) + m1 * bflo(w[2 + i].x); mv[i * 8 + 1] += m0 * bfhi(w[i].x) + m1 * bfhi(w[2 + i].x);
        mv[i * 8 + 2] += m0 * bflo(w[i].y) + m1 * bflo(w[2 + i].y); mv[i * 8 + 3] += m0 * bfhi(w[i].y) + m1 * bfhi(w[2 + i].y);
        mv[i * 8 + 4] += m0 * bflo(w[i].z) + m1 * bflo(w[2 + i].z); mv[i * 8 + 5] += m0 * bfhi(w[i].z) + m1 * bfhi(w[2 + i].z);
        mv[i * 8 + 6] += m0 * bflo(w[i].w) + m1 * bflo(w[2 + i].w); mv[i * 8 + 7] += m0 * bfhi(w[i].w) + m1 * bfhi(w[2 + i].w);
      }
    }
    float ss = 0.f;
#pragma unroll
    for (int j = 0; j < 16; ++j) ss += mv[j] * mv[j];
    ss = wave_sum(ss);
    const float rs = rsqrtf(ss * (1.0f / 1024.0f) + 1e-6f);
    float xn[16], ssn = 0.f;
#pragma unroll
    for (int i = 0; i < 2; ++i) {
      const int e = i * 512 + lane * 8;
#pragma unroll
      for (int h4 = 0; h4 < 2; ++h4) {
        const f32x4 w = *(const f32x4*)(nw3 + e + h4 * 4), g2 = *(const f32x4*)(md + 5120 + e + h4 * 4);
        f32x4 xv;
        if (h4 == 0) { xv[0] = bflo(xcur[i].x); xv[1] = bfhi(xcur[i].x); xv[2] = bflo(xcur[i].y); xv[3] = bfhi(xcur[i].y); }
        else { xv[0] = bflo(xcur[i].z); xv[1] = bfhi(xcur[i].z); xv[2] = bflo(xcur[i].w); xv[3] = bfhi(xcur[i].w); }
#pragma unroll
        for (int j = 0; j < 4; ++j) { xv[j] += g2[j] * (mv[i * 8 + h4 * 4 + j] * rs * w[j]); xn[i * 8 + h4 * 4 + j] = xv[j]; ssn += xv[j] * xv[j]; }
        if (!(l == 0 && isl)) *(f32x4*)(xo + e + h4 * 4) = xv;
      }
      if (l == 0 && isl) {
        u32x4 o;
        o.x = pk_bf16(xn[i * 8 + 0], xn[i * 8 + 1]); o.y = pk_bf16(xn[i * 8 + 2], xn[i * 8 + 3]); o.z = pk_bf16(xn[i * 8 + 4], xn[i * 8 + 5]); o.w = pk_bf16(xn[i * 8 + 6], xn[i * 8 + 7]);
        *(u32x4*)((bf16_t*)p.out + (size_t)row * 1024 + e) = o;
      }
    }
    if (l == 0) {
      ssn = wave_sum(ssn);
      const float rsn = rsqrtf(ssn * (1.0f / 1024.0f) + 1e-6f);
      const float* mdn = mod + (size_t)((l + 1) * 9 + mr) * 6144;
#pragma unroll
      for (int i = 0; i < 2; ++i) {
        const int e = i * 512 + lane * 8;
        float hv[8];
#pragma unroll
        for (int h4 = 0; h4 < 2; ++h4) {
          const f32x4 w = *(const f32x4*)(nwn + e + h4 * 4), sh = *(const f32x4*)(mdn + e + h4 * 4), sc = *(const f32x4*)(mdn + 1024 + e + h4 * 4);
#pragma unroll
          for (int j = 0; j < 4; ++j) hv[h4 * 4 + j] = xn[i * 8 + h4 * 4 + j] * rsn * w[j] * (1.0f + sc[j]) + sh[j];
        }
        u32x4 w;
        w.x = pk_bf16(hv[0], hv[1]); w.y = pk_bf16(hv[2], hv[3]); w.z = pk_bf16(hv[4], hv[5]); w.w = pk_bf16(hv[6], hv[7]);
        *(u32x4*)(H + (size_t)row * 1024 + e) = w;
      }
    }
  }
}

#define PHASE(call) do { Params q = p; asm volatile("" : "+s"(q.ws)); call; } while (0)
#ifndef PROBE_PH
#define PROBE_PH 0
#endif
#ifndef PROBE_N
#define PROBE_N 2
#endif
#define REP(id, call) do { for (int _r = 0; _r < ((PROBE_PH == (id)) ? 1 + PROBE_N : 1); ++_r) PHASE(call); } while (0)
#define SYNC() do { char* _w = p.ws; asm volatile("" : "+s"(_w)); XcdBarrier _b; _b.bar = (unsigned*)(_w + O_BAR); _b.x = xb_xcc_id(); _b.st = st; xcd_barrier(_b); } while (0)
__global__ void __launch_bounds__(NTHREADS, 2) fwd_mega(Params p) {
  extern __shared__ __attribute__((aligned(16))) char lds[];
  cg::grid_group grid = cg::this_grid();
  const int wid0 = __builtin_amdgcn_readfirstlane((int)(threadIdx.x >> 6));
  volatile PG8_LAS unsigned* st = (volatile PG8_LAS unsigned*)((PG8_LAS unsigned char*)lds + LDS_MAIN);
  if (threadIdx.x < 2) st[threadIdx.x] = 0u;
  __syncthreads();
  (void)xcd_barrier_post((unsigned*)(p.ws + O_BAR), st);
  PHASE(phase_setup(q, lds, wid0));
  PHASE(phase_conv(q, 0, lds, wid0));
  SYNC();
  PHASE(phase_rowA(q, 0, wid0));
  SYNC();
#pragma unroll 1
  for (int l = 0; l < 2; ++l) {
    REP(3, phase_gin(q, l, lds, wid0));
    SYNC();
    REP(5, phase_mix2(q, l, lds, wid0));
    SYNC();
    PHASE(phase_oa(q, l, wid0));
    SYNC();
    REP(7, phase_merge(q, l, lds, wid0));
    if (l == 0) grid.sync(); else SYNC();
    REP(8, phase_wout(q, l, lds, wid0));
    SYNC();
    if (l == 0) PHASE(phase_rowB<0>(q, lds, wid0)); else PHASE(phase_rowB<1>(q, lds, wid0));
    SYNC();
    REP(10, phase_topk(q, l, lds, wid0));
    SYNC();
    REP(11, phase_moe1(q, l, lds, wid0));
    SYNC();
    REP(12, phase_moe2(q, l, lds, wid0));
    SYNC();
    PHASE(phase_rowC(q, l, wid0));
    if (l == 0) PHASE(conv_fill(q, lds, wid0, 4, (int)blockIdx.x, (int)gridDim.x));
    if (l == 0) SYNC();
    if (PROBE_PH == 20) { for (int _r = 0; _r < 10 * PROBE_N; ++_r) SYNC(); }
  }
}

extern "C" void kernel_launch(void* const* d_in, const int* in_sizes, int n_in, void* d_out, int out_size, void* d_ws, size_t ws_size,
                              hipStream_t stream) {
  if (ws_size < WS_NEED) {
    fprintf(stderr, "kernel_launch: workspace too small: %zu < %zu\n", ws_size, (size_t)WS_NEED);
    return;
  }
  Params p{};
  p.x = (const float*)d_in[0]; p.c = (const float*)d_in[1]; p.ctx = (const float*)d_in[2]; p.c_ctx = (const float*)d_in[3];
  p.ada_w = (const float*)d_in[4]; p.ada_b = (const float*)d_in[5]; p.norm_w = (const float*)d_in[6]; p.w_in = (const float*)d_in[7];
  p.lb_raw = (const float*)d_in[8]; p.gnorm_w = (const float*)d_in[9]; p.sgu_w = (const float*)d_in[10]; p.sgu_b = (const float*)d_in[11];
  p.sgu_norm_w = (const float*)d_in[12]; p.w_branch = (const float*)d_in[13]; p.w_out = (const float*)d_in[14];
  p.router_w = (const float*)d_in[15]; p.w13 = (const float*)d_in[16]; p.w2 = (const float*)d_in[17];
  p.out = (float*)d_out;
  p.ws = (char*)d_ws;
  p.w2sep = ws_size >= WS_NEED_W2B ? 1 : 0;
  static int grid_blocks = 0;
  if (!grid_blocks) {
    int dev = 0, cus = 0, per_cu = 0;
    (void)hipGetDevice(&dev);
    (void)hipDeviceGetAttribute(&cus, hipDeviceAttributeMultiprocessorCount, dev);
    (void)hipFuncSetAttribute((const void*)fwd_mega, hipFuncAttributeMaxDynamicSharedMemorySize, LDS_TOTAL);
    (void)hipOccupancyMaxActiveBlocksPerMultiprocessor(&per_cu, fwd_mega, NTHREADS, LDS_TOTAL);
    if (per_cu > 1) per_cu = 1;
    if (per_cu < 1) fprintf(stderr, "kernel_launch: occupancy query reports %d blocks per CU\n", per_cu);
    grid_blocks = cus * (per_cu < 1 ? 1 : per_cu);
  }
  (void)hipMemsetAsync((char*)d_ws + O_BAR, 0, BAR_BYTES, stream);
  void* args[] = {&p};
  hipError_t e = hipLaunchCooperativeKernel((void*)fwd_mega, dim3(grid_blocks), dim3(NTHREADS), args, LDS_TOTAL, stream);
  if (e != hipSuccess) fprintf(stderr, "cooperative launch failed: %s (grid %d)\n", hipGetErrorString(e), grid_blocks);
}
```

```cpp
#include <hip/hip_runtime.h>
#include <hip/hip_cooperative_groups.h>
#include <cstdio>
#include <cstdint>
namespace cg = cooperative_groups;

typedef unsigned short bf16_t;
typedef short bf16x8 __attribute__((ext_vector_type(8)));
typedef float f32x4 __attribute__((ext_vector_type(4)));
typedef float f32x2 __attribute__((ext_vector_type(2)));
typedef unsigned u32x4 __attribute__((ext_vector_type(4)));
typedef unsigned u32x2 __attribute__((ext_vector_type(2)));

constexpr int D = 1024, NB = 8, TL = 4096, TCX = 256;
constexpr int NL = NB * TL, NC = NB * TCX, NT = NL + NC;
constexpr int INC = 7168;
constexpr int NSLOT_L = 16 * 8 * 512, NSLOT_C = 16 * 8 * 32, NSLOT = NSLOT_L + NSLOT_C;
constexpr int NTHREADS = 512, NWAVE = 8;
constexpr int LDS_MAIN = 147456;
constexpr int LDS_TOTAL = LDS_MAIN + 16;

constexpr size_t al(size_t x) { return (x + 255) & ~(size_t)255; }
constexpr size_t O_WIN = 0;
constexpr size_t O_WBR = O_WIN + al((size_t)INC * D * 2);
constexpr size_t O_WOUT = O_WBR + al((size_t)3 * D * 512 * 2);
constexpr size_t O_W13 = O_WOUT + al((size_t)D * D * 2);
constexpr size_t O_W2 = O_W13 + al((size_t)16 * 2048 * D * 2);
constexpr size_t O_FTL = O_W2 + al((size_t)16 * D * D * 2);
constexpr size_t O_FTC = O_FTL + al((size_t)4096 * 8192 * 2);
constexpr size_t O_CS = O_FTC + al((size_t)256 * 512 * 2);
constexpr size_t O_MOD = O_CS + al((size_t)256 * 128 * 2);
constexpr size_t O_LB = O_MOD + al((size_t)2 * 9 * 6144 * 4);
constexpr size_t O_BAR = O_LB + al((size_t)2 * 2 * 512 * 4);
constexpr size_t BAR_BYTES = 3456 * 4;
constexpr size_t O_H = O_BAR + al(BAR_BYTES);
constexpr size_t O_Y = O_H + al((size_t)NT * D * 2);
constexpr size_t O_CTXB = O_Y + al((size_t)NT * D * 2);
constexpr size_t O_AFF = O_CTXB + al((size_t)NC * D * 4);
constexpr size_t O_SEL = O_AFF + al((size_t)NT * 16 * 4);
constexpr size_t O_GATE = O_SEL + al((size_t)NT * 16 * 4);
constexpr size_t O_TOK = O_GATE + al((size_t)NSLOT * 4);
constexpr size_t O_Z = O_TOK + al((size_t)NSLOT * 4);
constexpr size_t SZ512 = al((size_t)NT * 512 * 2);
constexpr size_t O_Q = O_Z, O_LFF = O_Q + SZ512, O_LFB = O_LFF + SZ512, O_I = O_LFB + SZ512, O_GA = O_I + SZ512,
                 O_U = O_GA + SZ512, O_ZB = O_U + SZ512, O_VT = O_ZB + SZ512, O_OF = O_VT + SZ512, O_OBK = O_OF + SZ512;
constexpr size_t O_G = O_OBK + SZ512;
constexpr size_t O_ZCL = O_G + al((size_t)NT * 3072 * 2);
constexpr size_t O_ZCC = O_ZCL + al((size_t)8 * 512 * 8192 * 2);
constexpr size_t O_ZF = O_ZCC + al((size_t)8 * 512 * 512 * 2);
constexpr int KH = 2176, KF = 2 * KH;
constexpr size_t O_ZEND = O_ZF + al((size_t)8 * 512 * KF * 2);
constexpr size_t SZSLOT = al((size_t)NSLOT * 1024 * 2);
constexpr size_t O_XE = O_Z, O_HID = O_XE + SZSLOT, O_YS = O_HID + SZSLOT;
static_assert(O_YS + SZSLOT <= O_ZEND, "moe arena");
constexpr size_t O_W2B = O_ZEND;
constexpr size_t WS_NEED = O_ZEND, WS_NEED_W2B = O_W2B + al((size_t)16 * D * D * 2);

struct Params {
  const float *x, *c, *ctx, *c_ctx, *ada_w, *ada_b, *norm_w, *w_in, *lb_raw, *gnorm_w, *sgu_w, *sgu_b, *sgu_norm_w, *w_branch, *w_out,
      *router_w, *w13, *w2;
  float* out;
  char* ws;
  int w2sep;
};

typedef __bf16 bf16v2_t __attribute__((ext_vector_type(2)));
__device__ __forceinline__ unsigned pk_bf16(float lo, float hi) {
  const f32x2 v = {lo, hi};
  const bf16v2_t r = __builtin_convertvector(v, bf16v2_t);
  return __builtin_bit_cast(unsigned, r);
}
__device__ __forceinline__ bf16_t f2bf(float x) { return (bf16_t)(pk_bf16(x, 0.f) & 0xffffu); }
__device__ __forceinline__ float bf2f(bf16_t v) { return __uint_as_float(((unsigned)v) << 16); }
__device__ __forceinline__ float bflo(unsigned w) { return __uint_as_float(w << 16); }
__device__ __forceinline__ float bfhi(unsigned w) { return __uint_as_float(w & 0xffff0000u); }
__device__ __forceinline__ void st4bf(bf16_t* p, f32x4 v) {
  u32x2 w;
  w.x = pk_bf16(v[0], v[1]);
  w.y = pk_bf16(v[2], v[3]);
  *(u32x2*)p = w;
}
__device__ __forceinline__ void st8bf(bf16_t* p, f32x4 a, f32x4 b) {
  u32x4 w;
  w.x = pk_bf16(a[0], a[1]); w.y = pk_bf16(a[2], a[3]); w.z = pk_bf16(b[0], b[1]); w.w = pk_bf16(b[2], b[3]);
  *(u32x4*)p = w;
}
__device__ __forceinline__ float sigmoidf_(float x) { return __builtin_amdgcn_rcpf(1.0f + __expf(-x)); }
__device__ __forceinline__ float siluf_(float x) { return x * __builtin_amdgcn_rcpf(1.0f + __expf(-x)); }
__device__ __forceinline__ float geluf_(float v) {
  const float av = fabsf(v), t = __builtin_amdgcn_rcpf(av * 0.2316418882f + 1.0f);
  float q = t * 0.5307027145f + (-0.7265760135f);
  q = q * t + 0.7107068705f; q = q * t + (-0.142248368f); q = q * t + 0.127414796f; q = q * t;
  const float e = __builtin_amdgcn_exp2f((v * v) * (-0.72134752044f));
  const float m = v * (q * e);
  return v < 0.f ? m : v - m;
}
__device__ __forceinline__ int opaque_tid(int wid0) {
  int lane;
  asm volatile("v_mbcnt_lo_u32_b32 %0, -1, 0\n\tv_mbcnt_hi_u32_b32 %0, -1, %0" : "=v"(lane));
  return (wid0 << 6) | lane;
}
__device__ __forceinline__ float wave_sum(float v) {
#pragma unroll
  for (int o = 32; o > 0; o >>= 1) v += __shfl_xor(v, o);
  return v;
}

namespace pg8 {
#define PG8_LAS __attribute__((address_space(3)))
constexpr int BM = 256, BK = 64, HALF = 128, HTB = HALF * BK * 2, STAGE_BYTES = 8 * HTB, NXCD = 8, WGM = 8;
__device__ __forceinline__ int lds_byte(int r, int c) { const int st = (r >> 4) * 2 + (c >> 5), rr = r & 15, cc = c & 31, ob = rr * 64 + cc * 2; return st * 1024 + (ob ^ (((ob >> 9) & 1) << 5)); }
__device__ __forceinline__ void stage_rc(int b, int& R, int& C) { const int st = b / 1024, sb = b % 1024, swz = sb ^ (((sb >> 9) & 1) << 5); R = (st >> 1) * 16 + swz / 64; C = (st & 1) * 32 + (swz % 64) / 2; }
__device__ __forceinline__ int perm32(int rho) { const int n = rho >> 4, i = rho & 15; return 8 * (i >> 2) + 4 * n + (i & 3); }
struct Unit { int pm, pn, z; };
template <class T, class = void> struct gather_of { static constexpr bool v = false; };
template <class T> struct gather_of<T, decltype((void)T::GATHER)> { static constexpr bool v = T::GATHER; };

template <class Epi, class Sched>
__device__ __forceinline__ void gemm_phase(PG8_LAS unsigned char* lds, const int K, const Sched& S, const Epi& E, const int tid_in) {
  int tid = tid_in;
  asm volatile("" : "+v"(tid));
  const int wid = __builtin_amdgcn_readfirstlane(tid >> 6), lane = tid & 63, wr = wid >> 2, wc = wid & 3, fr = lane & 15, fq = lane >> 4;
  const int nt = K / BK;
  constexpr bool GA = gather_of<Sched>::v;
  unsigned voffA[2], voffB[2];
  unsigned cvA[2][2], nvA[2][2];
  int gR = 0; unsigned gC2 = 0;
#pragma unroll
  for (int i = 0; i < 2; ++i) { int R, C; stage_rc(tid * 16 + i * 8192, R, C); const int Rb = (R & ~31) + perm32(R & 31);
    if (i == 0) { gR = R; gC2 = (unsigned)C * 2u; }
    voffA[i] = (unsigned)(R * K + C) * 2u; voffB[i] = (unsigned)(Rb * K + C) * 2u; }
  const size_t kstep = (size_t)(BK * 2);
  const size_t hstep = (size_t)HALF * K * 2;
  const size_t hstepA = GA ? (size_t)0 : hstep;
  const PG8_LAS int* idxl = (const PG8_LAS int*)(lds + STAGE_BYTES);
  const unsigned ldsw = (unsigned)wid * 1024u;
  const int aoff = lds_byte(wr * 64 + fr, fq * 8), boff = lds_byte(wc * 32 + fr, fq * 8);
#define PG8_SA(b, h) (((b) * 2 + (h)) * HTB)
#define PG8_SB(b, h) ((4 + (b) * 2 + (h)) * HTB)
#define PG8_STAGE_(bufoff, gbase, voff) do { _Pragma("unroll") for (int _i = 0; _i < 2; ++_i) \
    __builtin_amdgcn_global_load_lds((const unsigned*)((const char*)(gbase) + voff[_i]), (PG8_LAS unsigned*)(lds + (bufoff) + ldsw + _i * 8192), 16, 0, 0); } while (0)
#define PG8_STAGE(bufoff, gbase) PG8_STAGE_(bufoff, gbase, voffB)
#define PG8_STAGE_A(bufoff, gbase, NX) do { _Pragma("unroll") for (int _i = 0; _i < 2; ++_i) { unsigned _vo; \
    if constexpr (GA) { _vo = (NX) ? nvA[((bufoff) / HTB) & 1][_i] : cvA[((bufoff) / HTB) & 1][_i]; } else _vo = voffA[_i]; \
    __builtin_amdgcn_global_load_lds((const unsigned*)((const char*)(gbase) + _vo), (PG8_LAS unsigned*)(lds + (bufoff) + ldsw + _i * 8192), 16, 0, 0); } } while (0)
#define PG8_LDA(dst, b, h) do { _Pragma("unroll") for (int m = 0; m < 4; ++m) _Pragma("unroll") for (int k = 0; k < 2; ++k) dst[m][k] = *(const PG8_LAS bf16x8*)(lds + PG8_SA(b, h) + aoff + m * 2048 + k * 1024); } while (0)
#define PG8_LDB(dst, b, h) do { _Pragma("unroll") for (int n = 0; n < 2; ++n) _Pragma("unroll") for (int k = 0; k < 2; ++k) dst[n][k] = *(const PG8_LAS bf16x8*)(lds + PG8_SB(b, h) + boff + n * 2048 + k * 1024); } while (0)
#define PG8_MMA(ai, bj, At, Bt) do { __builtin_amdgcn_s_setprio(1); _Pragma("unroll") for (int m = 0; m < 4; ++m) _Pragma("unroll") for (int n = 0; n < 2; ++n) _Pragma("unroll") for (int k = 0; k < 2; ++k) \
    acc[ai][bj][m][n] = __builtin_amdgcn_mfma_f32_16x16x32_bf16(Bt[n][k], At[m][k], acc[ai][bj][m][n], 0, 0, 0); __builtin_amdgcn_s_setprio(0); } while (0)
#define PG8_WAIT_V(n) asm volatile("s_waitcnt vmcnt(" #n ")" ::: "memory")
#define PG8_WAIT_L(n) asm volatile("s_waitcnt lgkmcnt(" #n ")" ::: "memory")
#define PG8_BAR __builtin_amdgcn_s_barrier()
#define PG8_SCHED __builtin_amdgcn_sched_barrier(0)
  Unit cur, nxt; int ui = 0;
  if (!S.next(0, cur)) return;
  f32x4 acc[2][2][4][2];
#pragma unroll
  for (int a = 0; a < 2; ++a)
#pragma unroll
    for (int b = 0; b < 2; ++b)
#pragma unroll
      for (int m = 0; m < 4; ++m)
#pragma unroll
        for (int n = 0; n < 2; ++n) acc[a][b][m][n] = (f32x4){0.f, 0.f, 0.f, 0.f};
  bf16x8 At[4][2], B0[2][2], B1[2][2];
  const char* cA = S.aptr(cur); const char* cB = S.bptr(cur);
  if constexpr (GA) {
    const int* tk = S.tokptr(cur);
#pragma unroll
    for (int h = 0; h < 2; ++h)
#pragma unroll
      for (int i = 0; i < 2; ++i) { cvA[h][i] = (unsigned)tk[h * 128 + i * 64 + gR] * (unsigned)(K * 2) + gC2; nvA[h][i] = cvA[h][i]; }
  }
  PG8_STAGE(PG8_SB(0, 0), cB); PG8_STAGE_A(PG8_SA(0, 0), cA, false); PG8_STAGE(PG8_SB(0, 1), cB + hstep); PG8_STAGE_A(PG8_SA(0, 1), cA + hstepA, false);
  if (wr == 1) PG8_BAR;
  PG8_WAIT_V(4); PG8_BAR;
  PG8_STAGE(PG8_SB(1, 0), cB + kstep); PG8_STAGE_A(PG8_SA(1, 0), cA + kstep, false); PG8_STAGE(PG8_SB(1, 1), cB + hstep + kstep);
  PG8_WAIT_V(6); PG8_BAR;
  for (;;) {
    const bool has_next = S.next(ui + 1, nxt);
    const char* nA = has_next ? S.aptr(nxt) : cA; const char* nB = has_next ? S.bptr(nxt) : cB;
    if constexpr (GA) {
      if (has_next && wid < 4)
        __builtin_amdgcn_global_load_lds((const unsigned*)(S.tokptr(nxt) + wid * 64 + lane), (PG8_LAS unsigned*)(lds + STAGE_BYTES + wid * 256), 4, 0, 0);
    }
    for (int t = 0; t < nt; t += 2) {
      const bool last = (t == nt - 2);
      const bool lastn = last && has_next;
      if constexpr (GA) {
#pragma unroll
        for (int h = 0; h < 2; ++h)
#pragma unroll
          for (int i = 0; i < 2; ++i) nvA[h][i] = (unsigned)idxl[h * 128 + i * 64 + gR] * (unsigned)(K * 2) + gC2;
      }
      const char* a1 = cA + (size_t)(t + 1) * kstep;
      const char* a2 = last ? nA : cA + (size_t)(t + 2) * kstep; const char* b2 = last ? nB : cB + (size_t)(t + 2) * kstep;
      const char* a3 = a2 + kstep; const char* b3 = b2 + kstep;
      PG8_LDB(B0, 0, 0); PG8_SCHED; PG8_LDA(At, 0, 0); PG8_STAGE_A(PG8_SA(1, 1), a1 + hstepA, false);
      PG8_WAIT_L(8); PG8_BAR; PG8_WAIT_L(0); PG8_MMA(0, 0, At, B0); PG8_BAR; PG8_SCHED;
      PG8_LDB(B1, 0, 1); PG8_STAGE(PG8_SB(0, 0), b2);
      PG8_BAR; PG8_WAIT_L(0); PG8_MMA(0, 1, At, B1); PG8_BAR;
      PG8_LDA(At, 0, 1); PG8_STAGE_A(PG8_SA(0, 0), a2, lastn);
      PG8_BAR; PG8_WAIT_L(0); PG8_MMA(1, 0, At, B0); PG8_BAR; PG8_SCHED;
      PG8_STAGE(PG8_SB(0, 1), b2 + hstep);
      PG8_WAIT_V(6); PG8_BAR; PG8_MMA(1, 1, At, B1); PG8_BAR;
      PG8_LDB(B0, 1, 0); PG8_SCHED; PG8_LDA(At, 1, 0); PG8_STAGE_A(PG8_SA(0, 1), a2 + hstepA, lastn);
      PG8_WAIT_L(8); PG8_BAR; PG8_WAIT_L(0); PG8_MMA(0, 0, At, B0); PG8_BAR; PG8_SCHED;
      PG8_LDB(B1, 1, 1); PG8_STAGE(PG8_SB(1, 0), b3);
      PG8_BAR; PG8_WAIT_L(0); PG8_MMA(0, 1, At, B1); PG8_BAR;
      PG8_LDA(At, 1, 1); PG8_STAGE_A(PG8_SA(1, 0), a3, lastn);
      PG8_BAR; PG8_WAIT_L(0); PG8_MMA(1, 0, At, B0); PG8_BAR; PG8_SCHED;
      PG8_STAGE(PG8_SB(1, 1), b3 + hstep);
      PG8_WAIT_V(6); PG8_BAR; PG8_MMA(1, 1, At, B1); PG8_BAR;
    }
    if (wr == 0) PG8_BAR;
    bool keep;
    { int fr2 = fr, fq2 = fq; asm volatile("" : "+v"(fr2), "+v"(fq2));
      keep = E(acc, cur, wr, wc, fr2, fq2); }
    if (!has_next) break;
    if (!keep)
#pragma unroll
    for (int a = 0; a < 2; ++a)
#pragma unroll
      for (int b = 0; b < 2; ++b)
#pragma unroll
        for (int m = 0; m < 4; ++m)
#pragma unroll
          for (int n = 0; n < 2; ++n) acc[a][b][m][n] = (f32x4){0.f, 0.f, 0.f, 0.f};
    cur = nxt; cA = nA; cB = nB; ++ui;
    if constexpr (GA) {
#pragma unroll
      for (int h = 0; h < 2; ++h)
#pragma unroll
        for (int i = 0; i < 2; ++i) cvA[h][i] = nvA[h][i];
    }
    if (wr == 1) PG8_BAR;
  }
  PG8_WAIT_V(0);
  PG8_BAR;
#undef PG8_SA
#undef PG8_SB
#undef PG8_STAGE
#undef PG8_STAGE_
#undef PG8_STAGE_A
#undef PG8_LDA
#undef PG8_LDB
#undef PG8_MMA
#undef PG8_WAIT_V
#undef PG8_WAIT_L
#undef PG8_BAR
#undef PG8_SCHED
}
template <class F>
__device__ __forceinline__ void epi_each(const f32x4 (&acc)[2][2][4][2], int wr, int wc, int fr, int fq, const F& f) {
#pragma unroll
  for (int ai = 0; ai < 2; ++ai)
#pragma unroll
    for (int m = 0; m < 4; ++m)
#pragma unroll
      for (int bj = 0; bj < 2; ++bj) f(ai * HALF + wr * 64 + m * 16 + fr, bj * HALF + wc * 32 + 8 * fq, acc[ai][bj][m][0], acc[ai][bj][m][1]);
}
struct GridSched {
  const char* A; const char* B; size_t tstep; int nM, nN, nwg, G, c, pm0;
  __device__ __forceinline__ void init(const void* A_, const void* B_, int K, int nM_, int nN_, int pm0_, int G_, int c_) {
    A = (const char*)A_; B = (const char*)B_; tstep = (size_t)BM * K * 2; nM = nM_; nN = nN_; nwg = nM * nN; G = G_; c = c_; pm0 = pm0_;
  }
  __device__ __forceinline__ bool next(int i, Unit& u) const {
    const long L = (long)i * G + c; if (L >= nwg) return false;
    int wgid = (int)L; { const int q = nwg / NXCD, r = nwg % NXCD, xcd = wgid % NXCD, off = wgid / NXCD; wgid = (xcd < r ? xcd * (q + 1) : r * (q + 1) + (xcd - r) * q) + off; }
    const int nig = WGM * nN, gid = wgid / nig, fm = gid * WGM, gsz = (nM - fm) < WGM ? (nM - fm) : WGM;
    u.pm = pm0 + fm + ((wgid % nig) % gsz); u.pn = (wgid % nig) / gsz; u.z = 0; return true;
  }
  __device__ __forceinline__ const char* aptr(const Unit& u) const { return A + (size_t)u.pm * tstep; }
  __device__ __forceinline__ const char* bptr(const Unit& u) const { return B + (size_t)u.pn * tstep; }
};
}
using pg8::Unit;


#define XB_TMO      128
#define XB_XCNT(j)  (256  + 64 * (j))
#define XB_XSUB(j)  (1280 + 64 * (j))
#define XB_XGEN(j)  (2304 + 64 * (j))
#define XB_TOP      3328
#define XB_TOPGEN   3392
#define XB_SPIN_CAP (1u << 18)
__device__ __forceinline__ unsigned xb_ld(unsigned* p)              { return __hip_atomic_load(p, __ATOMIC_RELAXED, __HIP_MEMORY_SCOPE_AGENT); }
__device__ __forceinline__ unsigned xb_add(unsigned* p, unsigned v) { return __hip_atomic_fetch_add(p, v, __ATOMIC_RELAXED, __HIP_MEMORY_SCOPE_AGENT); }
__device__ __forceinline__ unsigned xb_xcc_id() { return (unsigned)__builtin_amdgcn_s_getreg((3 << 11) | 20) & 0xFu; }
#define XB_SPIN(cond, bar) do { unsigned _sp = 0; while (cond) { __builtin_amdgcn_s_sleep(1); \
    if ((++_sp & 255u) == 0u) { if (xb_ld(&(bar)[XB_TMO])) break; if (_sp > XB_SPIN_CAP) { atomicAdd(&(bar)[XB_TMO], 1u); break; } } } } while (0)
struct XcdBarrier { unsigned* bar; unsigned x; volatile PG8_LAS unsigned* st; };
__device__ __forceinline__ XcdBarrier xcd_barrier_post(unsigned* bar, volatile PG8_LAS unsigned* st) {
  XcdBarrier b; b.bar = bar; b.x = xb_xcc_id(); b.st = st;
  if (threadIdx.x == 0) (void)xb_add(&bar[XB_XCNT(b.x)], 1u);
  return b;
}
__device__ __forceinline__ void xcd_barrier_complete(unsigned* bar, unsigned x, unsigned& nloc, unsigned& nx) {
  const unsigned G = gridDim.x * gridDim.y * gridDim.z;
  unsigned sum, cnt, mine, sp = 0u;
  for (;;) {
    sum = 0u; cnt = 0u; mine = 0u;
#pragma unroll
    for (unsigned j = 0; j < 16; ++j) { const unsigned c = xb_ld(&bar[XB_XCNT(j)]); sum += c; cnt += (c > 0u) ? 1u : 0u; mine = (j == x) ? c : mine; }
    if (sum == G) break;
    __builtin_amdgcn_s_sleep(1);
    if ((++sp & 255u) == 0u) { if (xb_ld(&bar[XB_TMO])) break; if (sp > XB_SPIN_CAP) { atomicAdd(&bar[XB_TMO], 1u); break; } }
  }
  nloc = mine > 0u ? mine : 1u; nx = cnt > 0u ? cnt : 1u;
}
__device__ __forceinline__ void xcd_barrier(const XcdBarrier& b) {
  asm volatile("s_waitcnt vmcnt(0)" ::: "memory");
  __syncthreads();
  if (threadIdx.x == 0) {
    unsigned* bar = b.bar;
    __builtin_amdgcn_s_waitcnt(0);
    unsigned nloc = b.st[0], nx = b.st[1];
    if (nloc == 0u) { xcd_barrier_complete(bar, b.x, nloc, nx); b.st[0] = nloc; b.st[1] = nx; }
    const unsigned old = xb_add(&bar[XB_XSUB(b.x)], 1u);
    const unsigned gen = old / nloc;
    if (old + 1u == (gen + 1u) * nloc) {
      __builtin_amdgcn_fence(__ATOMIC_RELEASE, "agent");
      asm volatile("s_waitcnt vmcnt(0)" ::: "memory");
      const unsigned og = xb_add(&bar[XB_TOP], 1u);
      const unsigned tg = og / nx;
      if (og + 1u == (tg + 1u) * nx) xb_add(&bar[XB_TOPGEN], 1u);
      else XB_SPIN(xb_ld(&bar[XB_TOPGEN]) == tg, bar);
      __builtin_amdgcn_fence(__ATOMIC_ACQUIRE, "agent");
      xb_add(&bar[XB_XGEN(b.x)], 1u);
      asm volatile("s_waitcnt vmcnt(0)" ::: "memory");
    } else {
      XB_SPIN(xb_ld(&bar[XB_XGEN(b.x)]) == gen, bar);
      __builtin_amdgcn_fence(__ATOMIC_ACQUIRE, "agent");
      asm volatile("s_waitcnt vmcnt(0)" ::: "memory");
    }
  }
  __syncthreads();
}


__device__ __forceinline__ void sub_barrier(unsigned* cnt, int nb) {
  asm volatile("s_waitcnt vmcnt(0)" ::: "memory");
  __syncthreads();
  if (threadIdx.x == 0) {
    __builtin_amdgcn_fence(__ATOMIC_RELEASE, "agent");
    asm volatile("s_waitcnt vmcnt(0)" ::: "memory");
    (void)xb_add(cnt, 1u);
    unsigned sp = 0;
    while (xb_ld(cnt) < (unsigned)nb && ++sp < (1u << 20)) __builtin_amdgcn_s_sleep(1);
    __builtin_amdgcn_fence(__ATOMIC_ACQUIRE, "agent");
    asm volatile("s_waitcnt vmcnt(0)" ::: "memory");
  }
  __syncthreads();
}

template <class LA, class LB>
__device__ __forceinline__ void gemm_main(f32x4 (&acc)[4][4], const int nk, const LA& la, const LB& lb, char* lds, const int t) {
  const int lane = t & 63, wid = t >> 6, fr = lane & 15, fq = lane >> 4, wr = wid >> 1, wc = wid & 1;
  const int sr = t >> 3, sc = t & 7;
  const int wofs = sr * 128 + ((sc ^ (sr & 7)) << 4);
  const int aofs = (wr * 64 + fr) * 128, bofs = 16384 + (wc * 64 + fr) * 128;
  const int x0 = ((fq) ^ (fr & 7)) << 4, x1 = ((4 + fq) ^ (fr & 7)) << 4;
  bf16x8 ra[4], rb[4];
#pragma unroll
  for (int i = 0; i < 4; ++i) { ra[i] = la(i, 0); rb[i] = lb(i, 0); }
#pragma unroll
  for (int i = 0; i < 4; ++i) { *(bf16x8*)(lds + wofs + i * 4096) = ra[i]; *(bf16x8*)(lds + 16384 + wofs + i * 4096) = rb[i]; }
  __syncthreads();
  for (int kt = 0; kt < nk; ++kt) {
    const char* cur = lds + (kt & 1) * 32768;
    const bool more = kt + 1 < nk;
    if (more) {
#pragma unroll
      for (int i = 0; i < 4; ++i) { ra[i] = la(i, (kt + 1) * 64); rb[i] = lb(i, (kt + 1) * 64); }
    }
#pragma unroll
    for (int kk = 0; kk < 2; ++kk) {
      const int xo = kk ? x1 : x0;
      bf16x8 af[4], bv[4];
#pragma unroll
      for (int m = 0; m < 4; ++m) af[m] = *(const bf16x8*)(cur + aofs + m * 2048 + xo);
#pragma unroll
      for (int n = 0; n < 4; ++n) bv[n] = *(const bf16x8*)(cur + bofs + n * 2048 + xo);
#pragma unroll
      for (int m = 0; m < 4; ++m)
#pragma unroll
        for (int n = 0; n < 4; ++n) acc[m][n] = __builtin_amdgcn_mfma_f32_16x16x32_bf16(bv[n], af[m], acc[m][n], 0, 0, 0);
    }
    if (more) {
      char* nxt = lds + ((kt + 1) & 1) * 32768;
#pragma unroll
      for (int i = 0; i < 4; ++i) { *(bf16x8*)(nxt + wofs + i * 4096) = ra[i]; *(bf16x8*)(nxt + 16384 + wofs + i * 4096) = rb[i]; }
    }
    __syncthreads();
  }
}
__device__ __forceinline__ void zero_acc(f32x4 (&acc)[4][4]) {
#pragma unroll
  for (int m = 0; m < 4; ++m)
#pragma unroll
    for (int n = 0; n < 4; ++n) acc[m][n] = (f32x4){0.f, 0.f, 0.f, 0.f};
}
template <class EP>
__device__ __forceinline__ void gemm_epi(const f32x4 (&acc)[4][4], const EP& ep, const int t) {
  const int lane = t & 63, wid = t >> 6, fr = lane & 15, fq = lane >> 4, wr = wid >> 1, wc = wid & 1;
#pragma unroll
  for (int m = 0; m < 4; ++m)
#pragma unroll
    for (int n = 0; n < 4; ++n) ep(wr * 64 + m * 16 + fr, wc * 64 + n * 16 + fq * 4, acc[m][n]);
}
struct RowLd {
  const bf16_t* p[4];
  __device__ __forceinline__ RowLd(const bf16_t* base, size_t r0, size_t ld, const int t) {
#pragma unroll
    for (int i = 0; i < 4; ++i) p[i] = base + (r0 + (t >> 3) + 32 * i) * ld + (t & 7) * 8;
  }
  __device__ __forceinline__ bf16x8 operator()(int i, int k0) const { return *(const bf16x8*)(p[i] + k0); }
};

__device__ __forceinline__ void phase_setup(const Params& p, char* lds, int wid0) {
  float* tab = (float*)lds;
  float* sv = (float*)(lds + 16384);
  float* red = (float*)(lds + 16384 + 36864);
  const int tid = opaque_tid(wid0);
  float* mod = (float*)(p.ws + O_MOD);
  bf16_t* FTL = (bf16_t*)(p.ws + O_FTL);
  bool have_tab = false;
  const int NMOD = 192, NITEM = NMOD + 4096 + 1;
  for (int item = blockIdx.x; item < NITEM; item += gridDim.x) {
    if (item < NMOD) {
      const int l = item / 96, n = (item % 96) * 64 + (tid & 63), kp = tid >> 6;
      for (int e = tid; e < 9 * 1024; e += NTHREADS) {
        const int r = e >> 10, k = e & 1023;
        const float v = r < 8 ? p.c[r * 1024 + k] : p.c_ctx[k];
        sv[e] = v / (1.0f + __expf(-v));
      }
      __syncthreads();
      float acc[9];
#pragma unroll
      for (int r = 0; r < 9; ++r) acc[r] = 0.f;
      const float* w = p.ada_w + (size_t)l * 1024 * 6144 + n;
#pragma unroll 8
      for (int k = kp * 128; k < kp * 128 + 128; ++k) {
        const float wv = w[(size_t)k * 6144];
#pragma unroll
        for (int r = 0; r < 9; ++r) acc[r] += sv[r * 1024 + k] * wv;
      }
#pragma unroll
      for (int r = 0; r < 9; ++r) red[(kp * 9 + r) * 64 + (tid & 63)] = acc[r];
      __syncthreads();
      for (int e = tid; e < 9 * 64; e += NTHREADS) {
        const int r = e >> 6, c = e & 63;
        float a = 0.f;
#pragma unroll
        for (int q8 = 0; q8 < 8; ++q8) a += red[(q8 * 9 + r) * 64 + c];
        const int nn = (item % 96) * 64 + c;
        mod[(l * 9 + r) * 6144 + nn] = a + p.ada_b[l * 6144 + nn];
      }
      __syncthreads();
    } else {
      if (!have_tab) {
        for (int j = tid; j < 4096; j += NTHREADS) tab[j] = cospif((float)j * (1.0f / 2048.0f));
        __syncthreads();
        have_tab = true;
      }
      if (item < NMOD + 4096) {
        const int k = (item - NMOD) & 2047, part = (item - NMOD) >> 11;
        const float scale = 0.0013810679320049757f;
        for (int e8 = tid; e8 < KH / 8; e8 += NTHREADS) {
          float v[8];
#pragma unroll
          for (int jx = 0; jx < 8; ++jx) {
            const int t = e8 * 8 + jx, jj = (k * t) & 4095;
            if (part == 0) v[jx] = t <= 2048 ? tab[jj] * scale : 0.f;
            else v[jx] = t < 2048 ? -tab[(jj - 1024) & 4095] * scale : 0.f;
          }
          u32x4 w;
          w.x = pk_bf16(v[0], v[1]); w.y = pk_bf16(v[2], v[3]); w.z = pk_bf16(v[4], v[5]); w.w = pk_bf16(v[6], v[7]);
          *(u32x4*)(FTL + ((size_t)part * 2048 + k) * KH + e8 * 8) = w;
        }
      } else {
        bf16_t* FTC = (bf16_t*)(p.ws + O_FTC);
        bf16_t* CS = (bf16_t*)(p.ws + O_CS);
        const float scale_c = 0.005524271728019903f;
        for (int e = tid; e < 256 * 512; e += NTHREADS) {
          const int k = e >> 9, cs = (e >> 8) & 1, t = e & 255;
          const int jj = ((k * t) & 255) * 16;
          FTC[e] = f2bf((cs == 0 ? tab[jj] : -tab[(jj - 1024) & 4095]) * scale_c);
        }
        for (int e = tid; e < 256 * 128; e += NTHREADS) {
          const int row = e >> 7, d = e & 127, cs = row >> 7, m = row & 127;
          const int jj = ((m * d) & 127) * 32;
          CS[e] = f2bf(cs == 0 ? tab[jj] : tab[(jj - 1024) & 4095]);
        }
        float* lb = (float*)(p.ws + O_LB);
        for (int e = tid; e < 2 * 512; e += NTHREADS) {
          const int dir = e >> 9, ch = e & 511;
          const float r0 = p.lb_raw[(dir * 2 + 0) * 512 + ch], r1 = p.lb_raw[(dir * 2 + 1) * 512 + ch];
          const float mx = fmaxf(r0, r1), e0 = expf(r0 - mx), e1 = expf(r1 - mx);
          const float p0 = e0 / (e0 + e1), p1 = e1 / (e0 + e1);
          lb[(dir * 2 + 0) * 512 + ch] = p0 - p0;
          lb[(dir * 2 + 1) * 512 + ch] = (p0 + p1) - p0;
        }
      }
    }
  }
  __syncthreads();
}

constexpr size_t OUT_W13B = (size_t)NL * D * 2;
template <bool VMAP>
__device__ __forceinline__ void conv_items(const Params& p, int l, char* lds, int wid0, const int lo, const int hi, const int r, const int n) {
  const int tid = opaque_tid(wid0);
  float* tile = (float*)lds;
  struct Item { const float* src; bf16_t* dst; int K, N, n0, k0, drow0; };
  auto decode = [&](int item) -> Item {
    int i = item;
    if (VMAP) {
      if (p.w2sep) i = i < 2048 ? i + 608 : i < 2496 ? i - 2048 : i < 3520 ? i + 160 : i - 3072;
      else i = i < 2048 ? i + 608 : i < 2656 ? i - 2048 : i;
    }
    Item it;
    bool w13 = false;
    if (i < 448) {
      it.src = p.w_in + (size_t)l * 1024 * INC; it.dst = (bf16_t*)(p.ws + O_WIN); it.K = 1024; it.N = INC;
    } else if ((i -= 448) < 96) {
      const int j = i / 32; i -= j * 32;
      it.src = p.w_branch + ((size_t)l * 3 + j) * 512 * 1024; it.dst = (bf16_t*)(p.ws + O_WBR) + (size_t)j * 1024 * 512; it.K = 512; it.N = 1024;
    } else if ((i -= 96) < 64) {
      it.src = p.w_out + (size_t)l * 1024 * 1024; it.dst = (bf16_t*)(p.ws + O_WOUT); it.K = 1024; it.N = 1024;
    } else if ((i -= 64) < 2048) {
      const int e = i / 128; i -= e * 128;
      it.src = p.w13 + ((size_t)l * 16 + e) * 1024 * 2048;
      it.dst = (l == 1 ? (bf16_t*)((char*)p.out + OUT_W13B) : (bf16_t*)(p.ws + O_W13)) + (size_t)e * 2048 * 1024; it.K = 1024; it.N = 2048; w13 = true;
    } else {
      i -= 2048;
      const int e = i / 64; i -= e * 64;
      it.src = p.w2 + ((size_t)l * 16 + e) * 1024 * 1024; it.dst = (bf16_t*)(p.ws + (l == 1 && p.w2sep ? O_W2B : O_W2)) + (size_t)e * 1024 * 1024; it.K = 1024; it.N = 1024;
    }
    const int nkt = it.K / 128;
    it.n0 = (i / nkt) * 128; it.k0 = (i % nkt) * 128;
    it.drow0 = w13 ? (((it.n0 & 1023) >> 7) * 256 + (it.n0 >> 10) * 128) : it.n0;
    return it;
  };
  f32x4 pf[8];
  auto fetch = [&](const Item& it) {
#pragma unroll
    for (int q = 0; q < 8; ++q) pf[q] = *(const f32x4*)(it.src + (size_t)(it.k0 + q * 16 + (tid >> 5)) * it.N + it.n0 + (tid & 31) * 4);
  };
  int rr = r; asm volatile("" : "+s"(rr));
  const int item0 = lo + rr;
  Item cur = decode(item0 < hi ? item0 : lo);
  if (item0 < hi) fetch(cur);
  for (int item = item0; item < hi; item += n) {
#pragma unroll
    for (int q = 0; q < 8; ++q) {
      const int kk = q * 16 + (tid >> 5), nn = (tid & 31) * 4;
      tile[(nn + 0) * 129 + kk] = pf[q][0]; tile[(nn + 1) * 129 + kk] = pf[q][1]; tile[(nn + 2) * 129 + kk] = pf[q][2]; tile[(nn + 3) * 129 + kk] = pf[q][3];
    }
    const Item me = cur;
    if (item + n < hi) { cur = decode(item + n); fetch(cur); }
    __syncthreads();
#pragma unroll
    for (int q2 = 0; q2 < 4; ++q2) {
      const int q = tid + q2 * 512, nn = q >> 4, kc = (q & 15) * 8;
      const float* tp = tile + nn * 129 + kc;
      u32x4 w;
      w.x = pk_bf16(tp[0], tp[1]); w.y = pk_bf16(tp[2], tp[3]); w.z = pk_bf16(tp[4], tp[5]); w.w = pk_bf16(tp[6], tp[7]);
      *(u32x4*)(me.dst + (size_t)(me.drow0 + nn) * me.K + me.k0 + kc) = w;
    }
    __syncthreads();
  }
}
__device__ __forceinline__ void phase_conv(const Params& p, int l, char* lds, int wid0) { conv_items<false>(p, l, lds, wid0, 0, 3680, blockIdx.x, gridDim.x); }
constexpr int CF_S0 = 2304, CF_S2 = 320;
__device__ __forceinline__ void conv_fill(const Params& p, char* lds, int wid0, const int slot, const int r, const int n) {
  const bool tuned = gridDim.x == 256;
  int a, b;
  int c0 = CF_S0, c2 = CF_S0 + CF_S2;
  if (!p.w2sep) { c0 = c0 < 2496 ? c0 : 2496; c2 = c2 < 2656 ? c2 : 2656; }
  if (slot == 0) { a = 0; b = c0; } else if (slot == 2) { a = c0; b = c2; } else { a = c2; b = 3680; }
  if (slot < 4) { if (!tuned) return; }
  else if (!tuned) a = 0;
  conv_items<true>(p, 1, lds, wid0, a, b, r, n);
}
__device__ __forceinline__ void phase_rowA(const Params& p, int l, int wid0) {
  const int tid = opaque_tid(wid0), wid = tid >> 6, lane = tid & 63;
  const float* xlat = l == 0 ? p.x : p.out;
  const float* xctx = l == 0 ? p.ctx : (const float*)(p.ws + O_CTXB);
  const float* mod = (const float*)(p.ws + O_MOD);
  bf16_t* H = (bf16_t*)(p.ws + O_H);
  const float* nw = p.norm_w + (size_t)(l * 4 + 0) * 1024;
  for (int row = blockIdx.x * NWAVE + wid; row < NT; row += gridDim.x * NWAVE) {
    const float* xr = row < NL ? xlat + (size_t)row * 1024 : xctx + (size_t)(row - NL) * 1024;
    const int mr = row < NL ? (row >> 12) : 8;
    const float* md = mod + (size_t)(l * 9 + mr) * 6144;
    f32x4 v[4];
    float ss = 0.f;
#pragma unroll
    for (int i = 0; i < 4; ++i) {
      v[i] = *(const f32x4*)(xr + i * 256 + lane * 4);
      ss += v[i][0] * v[i][0] + v[i][1] * v[i][1] + v[i][2] * v[i][2] + v[i][3] * v[i][3];
    }
    ss = wave_sum(ss);
    const float rs = rsqrtf(ss * (1.0f / 1024.0f) + 1e-6f);
#pragma unroll
    for (int i = 0; i < 4; ++i) {
      const int e = i * 256 + lane * 4;
      const f32x4 w = *(const f32x4*)(nw + e), sh = *(const f32x4*)(md + e), sc = *(const f32x4*)(md + 1024 + e);
      f32x4 o;
#pragma unroll
      for (int j = 0; j < 4; ++j) o[j] = v[i][j] * rs * w[j] * (1.0f + sc[j]) + sh[j];
      st4bf(H + (size_t)row * 1024 + e, o);
    }
  }
}

struct EpiGin {
  char* ws; const float* lbp; int l; int pn0;
  __device__ __forceinline__ bool operator()(f32x4 (&acc)[2][2][4][2], const Unit& u, int wr, int wc, int fr, int fq) const {
    const int pn = u.pn + pn0;
    const int sec = pn >> 1, cin0 = (pn & 1) * 256;
    const size_t row0 = (size_t)u.pm * 256;
    if (sec >= 8) {
      const int tl = (wr * 4 + wc) * 64 + fq * 16 + fr;
      unsigned char* GT = (unsigned char*)(ws + O_G) + ((size_t)u.pm * 12 + (pn - 16)) * 65536 + (size_t)tl * 8;
      auto q8 = [](float z) { return __builtin_amdgcn_rcpf(__builtin_fmaf(__expf(-z), 0.00390625f, 0.00390625f)); };
#pragma unroll
      for (int ai = 0; ai < 2; ++ai)
#pragma unroll
        for (int m = 0; m < 4; ++m)
#pragma unroll
          for (int bj = 0; bj < 2; ++bj) {
            const f32x4 a = acc[ai][bj][m][0], b = acc[ai][bj][m][1];
            u32x2 w; w.x = 0u; w.y = 0u;
#pragma unroll
            for (int j = 0; j < 4; ++j) { w.x = __builtin_amdgcn_cvt_pk_u8_f32(q8(a[j]), j, w.x); w.y = __builtin_amdgcn_cvt_pk_u8_f32(q8(b[j]), j, w.y); }
            *(u32x2*)(GT + (size_t)((ai * 4 + m) * 2 + bj) * 4096) = w;
          }
    } else if (sec == 7) {
      bf16_t* VT = (bf16_t*)(ws + O_VT);
      pg8::epi_each(acc, wr, wc, fr, fq, [&](int r, int c, f32x4 v0, f32x4 v1) {
        const int chunk = u.pm * 2 + (r >> 7), q = r & 127, g = (cin0 + c) >> 7, d = c & 127;
        bf16_t* dst = VT + (((size_t)chunk * 4 + g) * 128 + d) * 128 + q;
#pragma unroll
        for (int j = 0; j < 4; ++j) { dst[j * 128] = f2bf(geluf_(v0[j])); dst[(4 + j) * 128] = f2bf(geluf_(v1[j])); }
      });
    } else if (sec == 1 || sec == 2) {
      bf16_t* LF = (bf16_t*)(ws + (sec == 1 ? O_LFF : O_LFB)) + row0 * 512 + cin0;
      const float* lbv = lbp + ((sec - 1) * 2 + l) * 512 + cin0;
      pg8::epi_each(acc, wr, wc, fr, fq, [&](int r, int c, f32x4 v0, f32x4 v1) {
        const f32x4 b0 = *(const f32x4*)(lbv + c), b1 = *(const f32x4*)(lbv + c + 4);
        f32x4 o0, o1;
#pragma unroll
        for (int j = 0; j < 4; ++j) {
          o0[j] = 1.0f - (fmaxf(b0[j], 1e-20f) + (1.0f - b0[j]) * sigmoidf_(v0[j]));
          o1[j] = 1.0f - (fmaxf(b1[j], 1e-20f) + (1.0f - b1[j]) * sigmoidf_(v1[j]));
        }
        st8bf(LF + (size_t)r * 512 + c, o0, o1);
      });
    } else {
      const size_t off = sec == 0 ? O_Q : sec == 3 ? O_I : sec == 4 ? O_GA : sec == 5 ? O_ZB : O_U;
      bf16_t* dst = (bf16_t*)(ws + off) + row0 * 512 + cin0;
      const int act = (sec == 0 || sec == 4) ? 1 : (sec == 6 ? 2 : 0);
      pg8::epi_each(acc, wr, wc, fr, fq, [&](int r, int c, f32x4 v0, f32x4 v1) {
        f32x4 o0, o1;
#pragma unroll
        for (int j = 0; j < 4; ++j) {
          o0[j] = act == 1 ? siluf_(v0[j]) : act == 2 ? geluf_(v0[j]) : v0[j];
          o1[j] = act == 1 ? siluf_(v1[j]) : act == 2 ? geluf_(v1[j]) : v1[j];
        }
        st8bf(dst + (size_t)r * 512 + c, o0, o1);
      });
    }
    return false;
  }
};
constexpr int GIN_R0 = 0;
__device__ __forceinline__ void phase_gin(const Params& p, int l, char* lds, int wid0) {
  const int tid = opaque_tid(wid0);
  PG8_LAS unsigned char* L = (PG8_LAS unsigned char*)lds;
  EpiGin E{p.ws, (const float*)(p.ws + O_LB), l, 0};
  pg8::GridSched S;
  const int R0 = gridDim.x == 256 ? GIN_R0 : 0;
  S.init(p.ws + O_H, p.ws + O_WIN, 1024, (l == 0 ? 136 : 128) - R0, 28, R0, gridDim.x, blockIdx.x);
  pg8::gemm_phase(L, 1024, S, E, tid);
  S.init(p.ws + O_H, p.ws + O_WIN, 1024, R0, 16, 0, gridDim.x, blockIdx.x);
  pg8::gemm_phase(L, 1024, S, E, tid);
  if (l == 1) {
    S.init(p.ws + O_H, p.ws + O_WIN, 1024, 8, 8, 128, gridDim.x, (blockIdx.x + gridDim.x / 2) % gridDim.x);
    pg8::gemm_phase(L, 1024, S, E, tid);
  }
}

__device__ __forceinline__ void phase_mix1(const Params& p, int l, char* lds0, int wid0, int kind, int bfirst, int bi_o = -1, int nb_o = 0) {
  const bool last = (l == 1);
  const int tid = opaque_tid(wid0), t = tid & 255, half = tid >> 8;
  char* lds = lds0 + half * 65536;
  const bf16_t* CS = (const bf16_t*)(p.ws + O_CS);
  const bf16_t* ZB = (const bf16_t*)(p.ws + O_ZB);
  const int NF1L = 2048, NF1C = last ? 0 : 128, NCH = last ? 256 : 272;
  const int ITEM0 = kind == 0 ? 0 : NF1L + NF1C, NITEM = kind == 0 ? NF1L + NF1C : NF1L + NF1C + NCH * 4;
  const int bi = nb_o > 0 ? bi_o : (int)blockIdx.x - bfirst, nb = nb_o > 0 ? nb_o : (int)gridDim.x - bfirst;
  if (bi < 0) return;
  for (int item = ITEM0 + bi * 2 + half; item < NITEM; item += nb * 2) {
    f32x4 acc[4][4];
    zero_acc(acc);
    if (item < NF1L + NF1C) {
      const bool isl = item < NF1L;
      int i = isl ? item : item - NF1L;
      const int mh = i & 1;
      i >>= 1;
      int tt, g, b;
      if (isl) { tt = i & 31; i >>= 5; } else { tt = i & 1; i >>= 1; }
      g = i & 3; b = i >> 2;
      const size_t rowbase = isl ? (size_t)b * 4096 + tt * 128 : (size_t)NL + b * 256 + tt * 128;
      RowLd la(CS, mh * 128, 128, t), lb(ZB + g * 128, rowbase, 512, t);
      gemm_main(acc, 2, la, lb, lds, t);
      bf16_t* dst = isl ? (bf16_t*)(p.ws + O_ZCL) + ((size_t)b * 512 + g * 128) * 8192 + mh * 4096 + tt * 128
                        : (bf16_t*)(p.ws + O_ZCC) + ((size_t)b * 512 + g * 128) * 512 + mh * 256 + tt * 128;
      const size_t ld = isl ? 8192 : 512;
      gemm_epi(acc, [&](int r, int c, f32x4 v) { st4bf(dst + (size_t)r * ld + c, v); }, t);
    } else {
      const int i = item - (NF1L + NF1C), ch = i >> 2, g = i & 3;
      const bf16_t* VT = (const bf16_t*)(p.ws + O_VT) + ((size_t)ch * 4 + g) * 128 * 128;
      float* rstd = (float*)lds;
      {
        float* part = (float*)(lds + 1024);
        const int dg = t >> 4, q8 = (t & 15) * 8;
        float ps[8];
#pragma unroll
        for (int j = 0; j < 8; ++j) ps[j] = 0.f;
#pragma unroll
        for (int i = 0; i < 8; ++i) {
          const u32x4 w = *(const u32x4*)(VT + (size_t)(i * 16 + dg) * 128 + q8);
          const float v0 = bflo(w.x), v1 = bfhi(w.x), v2 = bflo(w.y), v3 = bfhi(w.y), v4 = bflo(w.z), v5 = bfhi(w.z), v6 = bflo(w.w), v7 = bfhi(w.w);
          ps[0] += v0 * v0; ps[1] += v1 * v1; ps[2] += v2 * v2; ps[3] += v3 * v3; ps[4] += v4 * v4; ps[5] += v5 * v5; ps[6] += v6 * v6; ps[7] += v7 * v7;
        }
        *(f32x4*)(part + dg * 128 + q8) = (f32x4){ps[0], ps[1], ps[2], ps[3]};
        *(f32x4*)(part + dg * 128 + q8 + 4) = (f32x4){ps[4], ps[5], ps[6], ps[7]};
        __syncthreads();
        if (t < 128) {
          float ss = 0.f;
#pragma unroll
          for (int g2 = 0; g2 < 16; ++g2) ss += part[g2 * 128 + t];
          rstd[t] = rsqrtf(ss * (1.0f / 128.0f) + 1e-6f);
        }
      }
      __syncthreads();
      const float* wsg = p.sgu_w + ((size_t)l * 4 + g) * 128 * 128;
      const int kc = (t & 7) * 8;
      float rr[2][8];
#pragma unroll
      for (int h2 = 0; h2 < 2; ++h2)
#pragma unroll
        for (int j = 0; j < 8; ++j) rr[h2][j] = rstd[h2 * 64 + kc + j];
      __syncthreads();
      auto la = [&](int ii, int k0) -> bf16x8 {
        const float* s = wsg + (size_t)((t >> 3) + 32 * ii) * 128 + k0 + kc;
        const f32x4 a = *(const f32x4*)s, b = *(const f32x4*)(s + 4);
        const int h2 = k0 >> 6;
        u32x4 w;
        w.x = pk_bf16(a[0] * (h2 ? rr[1][0] : rr[0][0]), a[1] * (h2 ? rr[1][1] : rr[0][1]));
        w.y = pk_bf16(a[2] * (h2 ? rr[1][2] : rr[0][2]), a[3] * (h2 ? rr[1][3] : rr[0][3]));
        w.z = pk_bf16(b[0] * (h2 ? rr[1][4] : rr[0][4]), b[1] * (h2 ? rr[1][5] : rr[0][5]));
        w.w = pk_bf16(b[2] * (h2 ? rr[1][6] : rr[0][6]), b[3] * (h2 ? rr[1][7] : rr[0][7]));
        return __builtin_bit_cast(bf16x8, w);
      };
      RowLd lb(VT, 0, 128, t);
      gemm_main(acc, 2, la, lb, lds, t);
      bf16_t* U = (bf16_t*)(p.ws + O_U) + (size_t)ch * 128 * 512 + g * 128;
      const float* nwv = p.sgu_norm_w + ((size_t)l * 4 + g) * 128;
      const float* sb = p.sgu_b + ((size_t)l * 4 + g) * 128;
      gemm_epi(acc, [&](int r, int c, f32x4 v) {
        const f32x4 nw4 = *(const f32x4*)(nwv + c);
        const float bb = sb[r];
        bf16_t* up = U + (size_t)r * 512 + c;
        const u32x2 uw = *(const u32x2*)up;
        f32x4 o;
        o[0] = bflo(uw.x) * (v[0] * nw4[0] + bb);
        o[1] = bfhi(uw.x) * (v[1] * nw4[1] + bb);
        o[2] = bflo(uw.y) * (v[2] * nw4[2] + bb);
        o[3] = bfhi(uw.y) * (v[3] * nw4[3] + bb);
        st4bf(up, o);
      }, t);
    }
  }
  __syncthreads();
}

#define SCAN_BAR() do { asm volatile("s_waitcnt lgkmcnt(0)" ::: "memory"); __builtin_amdgcn_s_barrier(); asm volatile("" ::: "memory"); } while (0)
__device__ __forceinline__ void scan_item(const Params& p, int item, char* lds, const int tid) {
  const int dir = item & 1, h = (item >> 1) & 3, b = item >> 3;
  const int wv = tid >> 6, lane = tid & 63, fr = lane & 15, fq = lane >> 4;
  const bool isP = wv < 4;
  char* RAWB = lds + 69632;
  float* qsum = (float*)(lds + 143360);
  const bf16_t* Q = (const bf16_t*)(p.ws + O_Q);
  const bf16_t* LF = (const bf16_t*)(p.ws + (dir ? O_LFB : O_LFF));
  const bf16_t* I = (const bf16_t*)(p.ws + O_I);
  bf16_t* O = (bf16_t*)(p.ws + (dir ? O_OBK : O_OF));
  auto rowOf = [&](int u) -> size_t {
    if (u < 256) return (size_t)NL + b * 256 + (dir ? 255 - u : u);
    const int v = u - 256;
    return (size_t)b * 4096 + (dir ? 4095 - v : v);
  };
  const int cp = tid & 63, tq = (tid >> 6) & 3;
  const bf16_t* srcs[3] = {LF, Q, I};
  auto dma = [&](int cc) {
    PG8_LAS unsigned char* dstb = (PG8_LAS unsigned char*)RAWB + (cc % 3) * 24576;
#pragma unroll
    for (int j = 0; j < 6; ++j) {
      const int g = j * 4 + wv, arr = g >> 3, rg = g & 7;
      const size_t o = rowOf(cc * 32 + rg * 4 + (lane >> 4)) * 512 + h * 128 + (lane & 15) * 8;
      __builtin_amdgcn_global_load_lds((const unsigned*)(srcs[arr] + o), (PG8_LAS unsigned*)(dstb + arr * 8192 + rg * 1024), 16, 0, 0);
    }
  };
  unsigned wkk[8];
  auto prepA = [&](int cc) {
    const char* raw = RAWB + (cc % 3) * 24576;
#pragma unroll
    for (int i = 0; i < 8; ++i) wkk[i] = *(const unsigned*)(raw + (tq * 8 + i) * 256 + cp * 4);
    f32x2 run = {1.f, 1.f};
#pragma unroll
    for (int i = 0; i < 8; ++i) { const f32x2 kk = {bflo(wkk[i]), bfhi(wkk[i])}; run = run * (1.0f - kk); }
    *(f32x2*)(qsum + tq * 128 + cp * 2) = run;
  };
  auto prepB = [&](int cc) {
    const char* raw = RAWB + (cc % 3) * 24576;
    char* OPB = lds + (cc & 1) * 34816;
    char* QP = OPB; char* KM = OPB + 8704; char* KT = OPB + 17408; char* VT = OPB + 25600;
    float* emid = (float*)(OPB + 33792); float* eend = emid + 128;
    unsigned wq[8], wi[8];
#pragma unroll
    for (int i = 0; i < 8; ++i) { wq[i] = *(const unsigned*)(raw + 8192 + (tq * 8 + i) * 256 + cp * 4); wi[i] = *(const unsigned*)(raw + 16384 + (tq * 8 + i) * 256 + cp * 4); }
    const f32x2 q0 = *(const f32x2*)(qsum + cp * 2), q1 = *(const f32x2*)(qsum + 128 + cp * 2), q2 = *(const f32x2*)(qsum + 256 + cp * 2), q3 = *(const f32x2*)(qsum + 384 + cp * 2);
    const f32x2 one = {1.f, 1.f};
    const f32x2 pmid = q0 * q1, pend = pmid * q2 * q3;
    const f32x2 base = tq == 0 ? one : tq == 1 ? q0 : tq == 2 ? pmid : pmid * q2;
    f32x2 rmid; rmid.x = __builtin_amdgcn_rcpf(fmaxf(pmid.x, 1e-30f)); rmid.y = __builtin_amdgcn_rcpf(fmaxf(pmid.y, 1e-30f));
    f32x2 ebm = pend * rmid; ebm.x = fminf(ebm.x, 1.0f); ebm.y = fminf(ebm.y, 1.0f);
    f32x2 run = base * rmid;
    unsigned oq[8], ok[8], kt0[4], kt1[4], vt0[4], vt1[4];
    float pk0 = 0.f, pk1 = 0.f;
#pragma unroll
    for (int i = 0; i < 8; ++i) {
      const f32x2 kk = {bflo(wkk[i]), bfhi(wkk[i])}, qv = {bflo(wq[i]), bfhi(wq[i])};
      run = run * (one - kk);
      f32x2 ea; ea.x = fminf(fmaxf(run.x, 1e-26f), 1e26f); ea.y = fminf(fmaxf(run.y, 1e-26f), 1e26f);
      f32x2 er; er.x = __builtin_amdgcn_rcpf(ea.x); er.y = __builtin_amdgcn_rcpf(ea.y);
      const f32x2 km = kk * er, qp = qv * ea, kpp = km * ebm;
      oq[i] = pk_bf16(qp.x, qp.y);
      ok[i] = pk_bf16(km.x, km.y);
      if (i & 1) {
        kt0[i >> 1] = pk_bf16(pk0, kpp.x); kt1[i >> 1] = pk_bf16(pk1, kpp.y);
        vt0[i >> 1] = (wi[i - 1] & 0xffffu) | (wi[i] << 16); vt1[i >> 1] = (wi[i - 1] >> 16) | (wi[i] & 0xffff0000u);
      } else { pk0 = kpp.x; pk1 = kpp.y; }
    }
#pragma unroll
    for (int i = 0; i < 8; ++i) { *(unsigned*)(QP + (tq * 8 + i) * 272 + cp * 4) = oq[i]; *(unsigned*)(KM + (tq * 8 + i) * 272 + cp * 4) = ok[i]; }
    u32x4 w;
    w.x = kt0[0]; w.y = kt0[1]; w.z = kt0[2]; w.w = kt0[3]; *(u32x4*)(KT + (cp * 2) * 64 + tq * 16) = w;
    w.x = kt1[0]; w.y = kt1[1]; w.z = kt1[2]; w.w = kt1[3]; *(u32x4*)(KT + (cp * 2 + 1) * 64 + tq * 16) = w;
    w.x = vt0[0]; w.y = vt0[1]; w.z = vt0[2]; w.w = vt0[3]; *(u32x4*)(VT + (cp * 2) * 64 + tq * 16) = w;
    w.x = vt1[0]; w.y = vt1[1]; w.z = vt1[2]; w.w = vt1[3]; *(u32x4*)(VT + (cp * 2 + 1) * 64 + tq * 16) = w;
    if (tq == 0) { *(f32x2*)(emid + cp * 2) = pmid; *(f32x2*)(eend + cp * 2) = pend; }
  };
  const int mw = wv - 4;
  f32x4 S[2][8];
#pragma unroll
  for (int a = 0; a < 2; ++a)
#pragma unroll
    for (int m = 0; m < 8; ++m) S[a][m] = (f32x4){0.f, 0.f, 0.f, 0.f};

  if (isP) { dma(0); dma(1); dma(2); asm volatile("s_waitcnt vmcnt(12)" ::: "memory"); }
  SCAN_BAR();
  if (isP) prepA(0);
  SCAN_BAR();
  if (isP) { prepB(0); asm volatile("s_waitcnt vmcnt(6)" ::: "memory"); }
  SCAN_BAR();
  for (int c = 0; c < 136; ++c) {
    if (isP) {
      if (c + 3 < 136) dma(c + 3);
      if (c + 1 < 136) prepA(c + 1);
      SCAN_BAR();
      if (c + 1 < 136) prepB(c + 1);
      if (c + 3 < 136) asm volatile("s_waitcnt vmcnt(6)" ::: "memory");
      else asm volatile("s_waitcnt vmcnt(0)" ::: "memory");
      SCAN_BAR();
    } else {
      const char* OPB = lds + (c & 1) * 34816;
      const char* QP = OPB; const char* KM = OPB + 8704; const char* KT = OPB + 17408; const char* VT = OPB + 25600;
      const float* emid = (const float*)(OPB + 33792); const float* eend = emid + 128;
      f32x4 PT00 = (f32x4){0.f, 0.f, 0.f, 0.f}, PT01 = PT00, PT11 = PT00;
#pragma unroll
      for (int ks = 0; ks < 4; ++ks) {
        const bf16x8 X0 = *(const bf16x8*)(KM + fr * 272 + ks * 64 + fq * 16), X1 = *(const bf16x8*)(KM + (16 + fr) * 272 + ks * 64 + fq * 16);
        const bf16x8 Y0 = *(const bf16x8*)(QP + fr * 272 + ks * 64 + fq * 16), Y1 = *(const bf16x8*)(QP + (16 + fr) * 272 + ks * 64 + fq * 16);
        PT00 = __builtin_amdgcn_mfma_f32_16x16x32_bf16(X0, Y0, PT00, 0, 0, 0);
        PT01 = __builtin_amdgcn_mfma_f32_16x16x32_bf16(X0, Y1, PT01, 0, 0, 0);
        PT11 = __builtin_amdgcn_mfma_f32_16x16x32_bf16(X1, Y1, PT11, 0, 0, 0);
      }
      SCAN_BAR();
#pragma unroll
      for (int jj = 0; jj < 4; ++jj) if (fq * 4 + jj > fr) { PT00[jj] = 0.f; PT11[jj] = 0.f; }
      u32x4 x0, x1;
      x0.x = pk_bf16(PT00[0], PT00[1]); x0.y = pk_bf16(PT00[2], PT00[3]); x0.z = 0u; x0.w = 0u;
      x1.x = pk_bf16(PT01[0], PT01[1]); x1.y = pk_bf16(PT01[2], PT01[3]); x1.z = pk_bf16(PT11[0], PT11[1]); x1.w = pk_bf16(PT11[2], PT11[3]);
      const size_t orow0 = rowOf(c * 32);
      const long ostep = dir ? -512 : 512;
#pragma unroll
      for (int a = 0; a < 2; ++a) {
        const int vcol = (mw * 2 + a) * 16 + fr;
        f32x4 o0 = (f32x4){0.f, 0.f, 0.f, 0.f}, o1 = o0;
        {
          const u32x2 vlo = *(const u32x2*)(VT + vcol * 64 + fq * 8), vhi = *(const u32x2*)(VT + vcol * 64 + 32 + fq * 8);
          u32x4 yv; yv.x = vlo.x; yv.y = vlo.y; yv.z = vhi.x; yv.w = vhi.y;
          o0 = __builtin_amdgcn_mfma_f32_16x16x32_bf16(__builtin_bit_cast(bf16x8, x0), __builtin_bit_cast(bf16x8, yv), o0, 0, 0, 0);
          o1 = __builtin_amdgcn_mfma_f32_16x16x32_bf16(__builtin_bit_cast(bf16x8, x1), __builtin_bit_cast(bf16x8, yv), o1, 0, 0, 0);
        }
#pragma unroll
        for (int ks = 0; ks < 4; ++ks) {
          const f32x4 em0 = *(const f32x4*)(emid + (2 * ks) * 16 + fq * 4), em1 = *(const f32x4*)(emid + (2 * ks + 1) * 16 + fq * 4);
          u32x4 ys;
          ys.x = pk_bf16(S[a][2 * ks][0] * em0[0], S[a][2 * ks][1] * em0[1]); ys.y = pk_bf16(S[a][2 * ks][2] * em0[2], S[a][2 * ks][3] * em0[3]);
          ys.z = pk_bf16(S[a][2 * ks + 1][0] * em1[0], S[a][2 * ks + 1][1] * em1[1]); ys.w = pk_bf16(S[a][2 * ks + 1][2] * em1[2], S[a][2 * ks + 1][3] * em1[3]);
          const u32x2 a0 = *(const u32x2*)(QP + fr * 272 + ks * 64 + fq * 8), a1 = *(const u32x2*)(QP + fr * 272 + ks * 64 + 32 + fq * 8);
          const u32x2 c0 = *(const u32x2*)(QP + (16 + fr) * 272 + ks * 64 + fq * 8), c1 = *(const u32x2*)(QP + (16 + fr) * 272 + ks * 64 + 32 + fq * 8);
          u32x4 xa, xc; xa.x = a0.x; xa.y = a0.y; xa.z = a1.x; xa.w = a1.y; xc.x = c0.x; xc.y = c0.y; xc.z = c1.x; xc.w = c1.y;
          o0 = __builtin_amdgcn_mfma_f32_16x16x32_bf16(__builtin_bit_cast(bf16x8, xa), __builtin_bit_cast(bf16x8, ys), o0, 0, 0, 0);
          o1 = __builtin_amdgcn_mfma_f32_16x16x32_bf16(__builtin_bit_cast(bf16x8, xc), __builtin_bit_cast(bf16x8, ys), o1, 0, 0, 0);
        }
        bf16_t* op = O + orow0 * 512 + h * 128 + vcol;
#pragma unroll
        for (int jj = 0; jj < 4; ++jj) {
          op[(long)(fq * 4 + jj) * ostep] = f2bf(o0[jj]);
          op[(long)(16 + fq * 4 + jj) * ostep] = f2bf(o1[jj]);
        }
        {
          const bf16x8 yv2 = *(const bf16x8*)(VT + vcol * 64 + fq * 16);
#pragma unroll
          for (int m = 0; m < 8; ++m) {
            const f32x4 ee = *(const f32x4*)(eend + m * 16 + fq * 4);
            const bf16x8 xk = *(const bf16x8*)(KT + (m * 16 + fr) * 64 + fq * 16);
            S[a][m] = __builtin_amdgcn_mfma_f32_16x16x32_bf16(xk, yv2, S[a][m] * ee, 0, 0, 0);
          }
        }
      }
      SCAN_BAR();
    }
  }
  __syncthreads();
}

struct F2Sched {
  const char* FT; const char* ZF; int G, c;
  __device__ __forceinline__ bool next(int i, Unit& u) const {
    const int P = c - 64;
    if (i > 1 || P < 0 || P >= 128) return false;
    const int loc = P >> 3; u.z = (P & 7) | (i << 3); u.pm = loc >> 1; u.pn = loc & 1; return true;
  }
  __device__ __forceinline__ const char* aptr(const Unit& u) const { return FT + (size_t)((u.z >> 3) ^ 1) * ((size_t)2048 * KH * 2) + (size_t)u.pm * ((size_t)256 * KH * 2); }
  __device__ __forceinline__ const char* bptr(const Unit& u) const { return ZF + (size_t)((u.z >> 3) ^ 1) * ((size_t)4096 * KH * 2) + ((size_t)(u.z & 7) * 512 + (size_t)u.pn * 256) * ((size_t)KH * 2); }
};
struct F2CSched {
  const char* FT; const char* ZC; int c;
  __device__ __forceinline__ bool next(int i, Unit& u) const {
    const int L = c - 192; if (i != 0 || L < 0 || L >= 16) return false;
    u.z = L >> 1; u.pm = 0; u.pn = L & 1; return true;
  }
  __device__ __forceinline__ const char* aptr(const Unit&) const { return FT; }
  __device__ __forceinline__ const char* bptr(const Unit& u) const { return ZC + (size_t)u.z * (512u * 512u * 2u) + (size_t)u.pn * (256u * 512u * 2u); }
};
struct EpiF2 {
  bf16_t* OB; int ctx; float* SX;
  __device__ __forceinline__ bool operator()(f32x4 (&acc)[2][2][4][2], const Unit& u, int wr, int wc, int fr, int fq) const {
    if (ctx) {
      bf16_t* dst = OB + ((size_t)NL + (size_t)u.z * 256) * 512 + u.pn * 256;
      pg8::epi_each(acc, wr, wc, fr, fq, [&](int r, int c, f32x4 v0, f32x4 v1) { st8bf(dst + (size_t)r * 512 + c, v0, v1); });
      return false;
    }
    const int b = u.z & 7, part = u.z >> 3;
    const int tl = (wr * 4 + wc) * 64 + fq * 16 + fr;
    float* sx = SX + ((size_t)(b + 8 * (u.pm * 2 + u.pn)) * 16) * 4096 + (size_t)tl * 8;
    bf16_t* dst = OB + (size_t)b * 4096 * 512 + u.pn * 256;
#pragma unroll
    for (int ai = 0; ai < 2; ++ai)
#pragma unroll
      for (int m = 0; m < 4; ++m)
#pragma unroll
        for (int bj = 0; bj < 2; ++bj) {
          float* q = sx + (size_t)((ai * 4 + m) * 2 + bj) * 4096;
          if (part == 0) { *(f32x4*)q = acc[ai][bj][m][0]; *(f32x4*)(q + 4) = acc[ai][bj][m][1]; }
          else {
            const f32x4 s0 = *(const f32x4*)q, s1 = *(const f32x4*)(q + 4);
            const int k = u.pm * 256 + ai * 128 + wr * 64 + m * 16 + fr, c = bj * 128 + wc * 32 + 8 * fq;
            st8bf(dst + (size_t)k * 512 + c, acc[ai][bj][m][0], acc[ai][bj][m][1]);
            if (k >= 1) st8bf(dst + (size_t)(4096 - k) * 512 + c, acc[ai][bj][m][0] - 2.0f * s0, acc[ai][bj][m][1] - 2.0f * s1);
          }
        }
    return part == 0;
  }
};
__device__ __forceinline__ void phase_fold(const Params& p, char* lds, int wid0, int bfirst) {
  const int tid = opaque_tid(wid0);
  bf16_t* zrow = (bf16_t*)lds;
  const bf16_t* ZCL = (const bf16_t*)(p.ws + O_ZCL);
  bf16_t* ZF = (bf16_t*)(p.ws + O_ZF);
  bf16_t* OB = (bf16_t*)(p.ws + O_ZB);
  float* red = (float*)(lds + 16384);
  if ((int)blockIdx.x < bfirst) return;
  for (int row = (int)blockIdx.x - bfirst; row < 8 * 512; row += (int)gridDim.x - bfirst) {
    const bf16_t* src = ZCL + (size_t)row * 8192;
#pragma unroll
    for (int i = 0; i < 2; ++i) *(u32x4*)(zrow + (tid + i * 512) * 8) = *(const u32x4*)(src + (tid + i * 512) * 8);
    __syncthreads();
    float alt = 0.f;
    for (int e8 = tid; e8 < 2 * (KH / 8); e8 += NTHREADS) {
      const int part = e8 >= KH / 8 ? 1 : 0, e = part ? e8 - KH / 8 : e8;
      float v[8];
#pragma unroll
      for (int jx = 0; jx < 8; ++jx) {
        const int t = e * 8 + jx;
        if (!part) v[jx] = t > 2048 ? 0.f : (t == 0 || t == 2048) ? bf2f(zrow[t]) : bf2f(zrow[t]) + bf2f(zrow[4096 - t]);
        else v[jx] = (t == 0 || t >= 2048) ? 0.f : bf2f(zrow[4096 + t]) - bf2f(zrow[4096 + 4096 - t]);
      }
      u32x4 w;
      w.x = pk_bf16(v[0], v[1]); w.y = pk_bf16(v[2], v[3]); w.z = pk_bf16(v[4], v[5]); w.w = pk_bf16(v[6], v[7]);
      *(u32x4*)(ZF + ((size_t)part * 4096 + row) * KH + e * 8) = w;
      if (!part) alt += (bflo(w.x) - bfhi(w.x)) + (bflo(w.y) - bfhi(w.y)) + (bflo(w.z) - bfhi(w.z)) + (bflo(w.w) - bfhi(w.w));
    }
    alt = wave_sum(alt);
    if ((tid & 63) == 0) red[tid >> 6] = alt;
    __syncthreads();
    if (tid == 0) {
      float a = 0.f;
#pragma unroll
      for (int w8 = 0; w8 < 8; ++w8) a += red[w8];
      OB[((size_t)(row >> 9) * 4096 + 2048) * 512 + (row & 511)] = f2bf(a * bf2f(f2bf(0.0013810679320049757f)));
    }
  }
}
__device__ __forceinline__ void phase_mix2(const Params& p, int l, char* lds, int wid0) {
  const int tid = opaque_tid(wid0);
  if (blockIdx.x < 64) { scan_item(p, blockIdx.x, lds, tid); return; }
  unsigned* bar = (unsigned*)(p.ws + O_BAR);
  const int nb = (int)gridDim.x - 64;
  phase_mix1(p, l, lds, wid0, 0, 64);
  sub_barrier(bar + (l * 2 + 0) * 16, nb);
  phase_fold(p, lds, wid0, 64);
  sub_barrier(bar + (l * 2 + 1) * 16, nb);
  PG8_LAS unsigned char* L = (PG8_LAS unsigned char*)lds;
  {
    F2Sched S{p.ws + O_FTL, p.ws + O_ZF, (int)gridDim.x, (int)blockIdx.x};
    EpiF2 E{(bf16_t*)(p.ws + O_ZB), 0, (float*)(p.ws + O_ZCL)};
    pg8::gemm_phase(L, KH, S, E, tid);
  }
  if (l == 0) {
    F2CSched S{p.ws + O_FTC, p.ws + O_ZCC, (int)blockIdx.x};
    EpiF2 E{(bf16_t*)(p.ws + O_ZB), 1, nullptr};
    pg8::gemm_phase(L, 512, S, E, tid);
  }
  if (blockIdx.x >= 192) { for (int sh = 0; sh < 2; ++sh) phase_mix1(p, l, lds, wid0, 1, 64, ((int)blockIdx.x - 192) * 2 + sh, 512); }
  else { for (int sh = 0; sh < 3; ++sh) phase_mix1(p, l, lds, wid0, 1, 64, 128 + ((int)blockIdx.x - 64) * 3 + sh, 512); }
  if (gridDim.x == 256) {
    pg8::GridSched S;
    S.init(p.ws + O_H, p.ws + O_WIN + (size_t)16 * 256 * 1024 * 2, 1024, GIN_R0, 12, 0, (int)gridDim.x - 64, (int)blockIdx.x - 64);
    EpiGin E{p.ws, (const float*)(p.ws + O_LB), l, 16};
    pg8::gemm_phase(L, 1024, S, E, tid);
  }
}

__device__ __forceinline__ void phase_oa(const Params& p, int l, int wid0) {
  const int tid = opaque_tid(wid0), wid = tid >> 6, lane = tid & 63;
  const int nrow = (l == 1) ? NL : NT;
  const bf16_t* OF = (const bf16_t*)(p.ws + O_OF);
  const bf16_t* OK = (const bf16_t*)(p.ws + O_OBK);
  bf16_t* GA = (bf16_t*)(p.ws + O_GA);
  const float* gw = p.gnorm_w + (size_t)l * 128;
  for (int row = blockIdx.x * NWAVE + wid; row < nrow; row += gridDim.x * NWAVE) {
    const size_t o = (size_t)row * 512 + lane * 8;
    const u32x4 a = *(const u32x4*)(OF + o), b = *(const u32x4*)(OK + o), g = *(const u32x4*)(GA + o);
    float v[8];
    v[0] = bflo(a.x) + bflo(b.x); v[1] = bfhi(a.x) + bfhi(b.x);
    v[2] = bflo(a.y) + bflo(b.y); v[3] = bfhi(a.y) + bfhi(b.y);
    v[4] = bflo(a.z) + bflo(b.z); v[5] = bfhi(a.z) + bfhi(b.z);
    v[6] = bflo(a.w) + bflo(b.w); v[7] = bfhi(a.w) + bfhi(b.w);
    float ss = 0.f;
#pragma unroll
    for (int j = 0; j < 8; ++j) ss += v[j] * v[j];
    ss += __shfl_xor(ss, 1); ss += __shfl_xor(ss, 2); ss += __shfl_xor(ss, 4); ss += __shfl_xor(ss, 8);
    const float rs = rsqrtf(ss * (1.0f / 128.0f) + 1e-6f);
    const float* gwp = gw + (lane & 15) * 8;
    const f32x4 w0 = *(const f32x4*)gwp, w1 = *(const f32x4*)(gwp + 4);
    float gg[8] = {bflo(g.x), bfhi(g.x), bflo(g.y), bfhi(g.y), bflo(g.z), bfhi(g.z), bflo(g.w), bfhi(g.w)};
    u32x4 w;
    w.x = pk_bf16(v[0] * rs * w0[0] * gg[0], v[1] * rs * w0[1] * gg[1]);
    w.y = pk_bf16(v[2] * rs * w0[2] * gg[2], v[3] * rs * w0[3] * gg[3]);
    w.z = pk_bf16(v[4] * rs * w1[0] * gg[4], v[5] * rs * w1[1] * gg[5]);
    w.w = pk_bf16(v[6] * rs * w1[2] * gg[6], v[7] * rs * w1[3] * gg[7]);
    *(u32x4*)(GA + o) = w;
  }
}

#define HC_MERGE 136
#define HC_MOE1  152
__device__ __forceinline__ void hc_publish(unsigned* cnt) {
  asm volatile("s_waitcnt vmcnt(0)" ::: "memory");
  __syncthreads();
  if (threadIdx.x == 0) { __threadfence(); (void)xb_add(cnt, 1u); }
}
__device__ __forceinline__ void hc_wait(unsigned* bar, unsigned* cnt, unsigned target) {
  if (threadIdx.x == 0) { XB_SPIN(xb_ld(cnt) < target, bar); __threadfence(); }
  __syncthreads();
}
struct OneSched {
  const char* A; const char* B; int pm, pn, z;
  __device__ __forceinline__ bool next(int i, Unit& u) const { if (i) return false; u.pm = pm; u.pn = pn; u.z = z; return true; }
  __device__ __forceinline__ const char* aptr(const Unit&) const { return A; }
  __device__ __forceinline__ const char* bptr(const Unit&) const { return B; }
};
struct EpiStoreBf16 {
  bf16_t* dst; int ld;
  __device__ __forceinline__ bool operator()(f32x4 (&acc)[2][2][4][2], const Unit& u, int wr, int wc, int fr, int fq) const {
    bf16_t* d = dst + (size_t)u.pm * 256 * ld + u.pn * 256;
    pg8::epi_each(acc, wr, wc, fr, fq, [&](int r, int c, f32x4 v0, f32x4 v1) { st8bf(d + (size_t)r * ld + c, v0, v1); });
    return false;
  }
};
struct MergeSched {
  const char* ws; int ntile, G, c, fuse;
  __device__ __forceinline__ bool next(int i, Unit& u) const {
    const int xcd = c & 7, q = c >> 3;
    int rnd = i / 3;
    if (fuse && c < 32) rnd = rnd == 0 ? 2 : rnd == 2 ? 0 : rnd;
    u.pm = (rnd * (G >> 5) + (q >> 2)) * 8 + xcd; u.pn = q & 3; u.z = i % 3;
    return u.pm * 4 < ntile && (q >> 2) < (G >> 5);
  }
  __device__ __forceinline__ const char* aptr(const Unit& u) const {
    return ws + (u.z == 0 ? O_GA : u.z == 1 ? O_ZB : O_U) + (size_t)u.pm * (256u * 512u * 2u);
  }
  __device__ __forceinline__ const char* bptr(const Unit& u) const { return ws + O_WBR + (size_t)u.z * (1024u * 512u * 2u) + (size_t)u.pn * (256u * 512u * 2u); }
};
struct EpiMerge {
  char* ws; int fuse;
  __device__ __forceinline__ bool operator()(f32x4 (&acc)[2][2][4][2], const Unit& u, int wr, int wc, int fr, int fq) const {
    const int tl = (wr * 4 + wc) * 64 + fq * 16 + fr;
    const unsigned char* GT = (const unsigned char*)(ws + O_G) + ((size_t)u.pm * 12 + u.z * 4 + u.pn) * 65536 + (size_t)tl * 8;
    auto ub = [](unsigned w, int k) { return (float)((w >> (8 * k)) & 0xffu) + 0.5f; };
    bf16_t* MG = (bf16_t*)(ws + O_H) + (size_t)u.pm * 256 * 1024 + u.pn * 256;
    const bool lastj = (u.z == 2);
#pragma unroll
    for (int ai = 0; ai < 2; ++ai)
#pragma unroll
      for (int m = 0; m < 4; ++m)
#pragma unroll
        for (int bj = 0; bj < 2; ++bj) {
          const int cidx = (ai * 4 + m) * 2 + bj;
          const u32x2 gw = *(const u32x2*)(GT + (size_t)cidx * 4096);
          f32x4 g0, g1;
#pragma unroll
          for (int q = 0; q < 4; ++q) { g0[q] = ub(gw.x, q); g1[q] = ub(gw.y, q); }
          if (lastj) {
            const int r = ai * 128 + wr * 64 + m * 16 + fr, c = bj * 128 + wc * 32 + 8 * fq;
            st8bf(MG + (size_t)r * 1024 + c, acc[ai][bj][m][0] * (g0 * 0.00390625f), acc[ai][bj][m][1] * (g1 * 0.00390625f));
          } else {
            const u32x2 hw = *(const u32x2*)(GT + 4 * 65536 + (size_t)cidx * 4096);
#pragma unroll
            for (int q = 0; q < 4; ++q) {
              acc[ai][bj][m][0][q] *= g0[q] * __builtin_amdgcn_rcpf(ub(hw.x, q));
              acc[ai][bj][m][1][q] *= g1[q] * __builtin_amdgcn_rcpf(ub(hw.y, q));
            }
          }
        }
    if (fuse && lastj && u.pm >= 128) hc_publish((unsigned*)(ws + O_BAR) + HC_MERGE);
    return !lastj;
  }
};
__device__ __forceinline__ void phase_merge(const Params& p, int l, char* lds, int wid0) {
  const int tid = opaque_tid(wid0);
  const int fuse = (l == 0 && gridDim.x == 256) ? 1 : 0;
  MergeSched S{p.ws, (l == 1 ? 128 : 136) * 4, (int)gridDim.x, (int)blockIdx.x, fuse};
  EpiMerge E{p.ws, fuse};
  pg8::gemm_phase((PG8_LAS unsigned char*)lds, 512, S, E, tid);
  if (fuse) {
    const int c = (int)blockIdx.x;
    if (c >= 32 && c < 64) {
      unsigned* bar = (unsigned*)(p.ws + O_BAR);
      hc_wait(bar, bar + HC_MERGE, 32u);
      const int pm = 128 + (c & 7), pn = (c >> 3) - 4;
      OneSched S2{p.ws + O_H + (size_t)pm * (256u * 1024u * 2u), p.ws + O_WOUT + (size_t)pn * (256u * 1024u * 2u), pm, pn, 0};
      EpiStoreBf16 E2{(bf16_t*)(p.ws + O_Y), 1024};
      pg8::gemm_phase((PG8_LAS unsigned char*)lds, 1024, S2, E2, tid);
    } else if (c >= 64) conv_fill(p, lds, wid0, 0, c - 64, 192);
  }
}

__device__ __forceinline__ void phase_wout(const Params& p, int l, char* lds, int wid0) {
  const int tid = opaque_tid(wid0);
  pg8::GridSched S;
  const bool fuse = l == 0 && gridDim.x == 256;
  S.init(p.ws + O_H, p.ws + O_WOUT, 1024, (l == 1 || fuse) ? 128 : 136, 4, 0, gridDim.x, blockIdx.x);
  EpiStoreBf16 E{(bf16_t*)(p.ws + O_Y), 1024};
  pg8::gemm_phase((PG8_LAS unsigned char*)lds, 1024, S, E, tid);
}

template <int l>
__device__ __forceinline__ void phase_rowB(const Params& p, char* lds, int wid0) {
  const int tid = opaque_tid(wid0), wid = tid >> 6, lane = tid & 63;
  const int nrow = (l == 1) ? NL : NT;
  const float* xlat = l == 0 ? p.x : p.out;
  const float* xctx = l == 0 ? p.ctx : (const float*)(p.ws + O_CTXB);
  const float* mod = (const float*)(p.ws + O_MOD);
  bf16_t* Y = (bf16_t*)(p.ws + O_Y);
  bf16_t* H = (bf16_t*)(p.ws + O_H);
  float* aff = (float*)(p.ws + O_AFF);
  const float* nw1 = p.norm_w + (size_t)(l * 4 + 1) * 1024;
  const float* nw2 = p.norm_w + (size_t)(l * 4 + 2) * 1024;
  const float* rw = p.router_w + (size_t)l * 1024 * 16;
  float* rwT = (float*)lds;
  for (int i = tid; i < 16384; i += NTHREADS) rwT[(i & 15) * 1024 + (i >> 4)] = rw[i];
  __syncthreads();
  u32x4 pfy[2]; f32x4 pfx[4];
  auto fetch = [&](int row) {
    const float* xr = row < NL ? xlat + (size_t)row * 1024 : xctx + (size_t)(row - NL) * 1024;
#pragma unroll
    for (int i = 0; i < 2; ++i) {
      const int e = i * 512 + lane * 8;
      pfy[i] = *(const u32x4*)(Y + (size_t)row * 1024 + e);
      if (l == 1) pfx[i * 2] = *(const f32x4*)((const bf16_t*)p.out + (size_t)row * 1024 + e);
      else { pfx[i * 2] = *(const f32x4*)(xr + e); pfx[i * 2 + 1] = *(const f32x4*)(xr + e + 4); }
    }
  };
  const int row0 = blockIdx.x * NWAVE + wid, rstep = gridDim.x * NWAVE;
  if (row0 < nrow) fetch(row0);
  for (int row = row0; row < nrow; row += rstep) {
    const int mr = row < NL ? (row >> 12) : 8;
    const float* md = mod + (size_t)(l * 9 + mr) * 6144;
    float yv[16], xv[16];
    float ss = 0.f;
#pragma unroll
    for (int i = 0; i < 2; ++i) {
      const u32x4 w = pfy[i];
      yv[i * 8 + 0] = bflo(w.x); yv[i * 8 + 1] = bfhi(w.x); yv[i * 8 + 2] = bflo(w.y); yv[i * 8 + 3] = bfhi(w.y);
      yv[i * 8 + 4] = bflo(w.z); yv[i * 8 + 5] = bfhi(w.z); yv[i * 8 + 6] = bflo(w.w); yv[i * 8 + 7] = bfhi(w.w);
      if (l == 1) {
        const u32x4 xw = __builtin_bit_cast(u32x4, pfx[i * 2]);
        xv[i * 8 + 0] = bflo(xw.x); xv[i * 8 + 1] = bfhi(xw.x); xv[i * 8 + 2] = bflo(xw.y); xv[i * 8 + 3] = bfhi(xw.y);
        xv[i * 8 + 4] = bflo(xw.z); xv[i * 8 + 5] = bfhi(xw.z); xv[i * 8 + 6] = bflo(xw.w); xv[i * 8 + 7] = bfhi(xw.w);
      } else {
        const f32x4 a = pfx[i * 2], b = pfx[i * 2 + 1];
#pragma unroll
        for (int j = 0; j < 4; ++j) { xv[i * 8 + j] = a[j]; xv[i * 8 + 4 + j] = b[j]; }
      }
    }
    if (row + rstep < nrow) fetch(row + rstep);
#pragma unroll
    for (int j = 0; j < 16; ++j) ss += yv[j] * yv[j];
    ss = wave_sum(ss);
    const float rs = rsqrtf(ss * (1.0f / 1024.0f) + 1e-6f);
    float ss2 = 0.f;
#pragma unroll
    for (int i = 0; i < 2; ++i) {
      const int e = i * 512 + lane * 8;
#pragma unroll
      for (int h4 = 0; h4 < 2; ++h4) {
        const f32x4 w = *(const f32x4*)(nw1 + e + h4 * 4), g1 = *(const f32x4*)(md + 2048 + e + h4 * 4);
#pragma unroll
        for (int j = 0; j < 4; ++j) {
          const int q = i * 8 + h4 * 4 + j;
          xv[q] = xv[q] + g1[j] * (yv[q] * rs * w[j]);
          ss2 += xv[q] * xv[q];
        }
      }
      u32x4 o;
      o.x = pk_bf16(xv[i * 8 + 0], xv[i * 8 + 1]); o.y = pk_bf16(xv[i * 8 + 2], xv[i * 8 + 3]); o.z = pk_bf16(xv[i * 8 + 4], xv[i * 8 + 5]); o.w = pk_bf16(xv[i * 8 + 6], xv[i * 8 + 7]);
      *(u32x4*)(Y + (size_t)row * 1024 + e) = o;
    }
    ss2 = wave_sum(ss2);
    const float rs2 = rsqrtf(ss2 * (1.0f / 1024.0f) + 1e-6f);
    float lg[16];
#pragma unroll
    for (int e2 = 0; e2 < 16; ++e2) lg[e2] = 0.f;
#pragma unroll
    for (int i = 0; i < 2; ++i) {
      const int e = i * 512 + lane * 8;
      float hv[8];
#pragma unroll
      for (int h4 = 0; h4 < 2; ++h4) {
        const f32x4 w = *(const f32x4*)(nw2 + e + h4 * 4), sh = *(const f32x4*)(md + 3072 + e + h4 * 4), sc = *(const f32x4*)(md + 4096 + e + h4 * 4);
#pragma unroll
        for (int j = 0; j < 4; ++j) hv[h4 * 4 + j] = xv[i * 8 + h4 * 4 + j] * rs2 * w[j] * (1.0f + sc[j]) + sh[j];
      }
      u32x4 w;
      w.x = pk_bf16(hv[0], hv[1]); w.y = pk_bf16(hv[2], hv[3]); w.z = pk_bf16(hv[4], hv[5]); w.w = pk_bf16(hv[6], hv[7]);
      *(u32x4*)(H + (size_t)row * 1024 + e) = w;
#pragma unroll
      for (int e2 = 0; e2 < 16; ++e2) {
        const f32x4 r0 = *(const f32x4*)(rwT + e2 * 1024 + e), r1 = *(const f32x4*)(rwT + e2 * 1024 + e + 4);
        lg[e2] += hv[0] * r0[0] + hv[1] * r0[1] + hv[2] * r0[2] + hv[3] * r0[3] + hv[4] * r1[0] + hv[5] * r1[1] + hv[6] * r1[2] + hv[7] * r1[3];
        if ((e2 & 3) == 3) __builtin_amdgcn_sched_barrier(0);
      }
    }
    float a8[8], a4[4], a2[2], a1;
    {
      const bool up = (lane & 32) != 0;
#pragma unroll
      for (int j = 0; j < 8; ++j) { const float mine = up ? lg[8 + j] : lg[j], other = up ? lg[j] : lg[8 + j]; a8[j] = mine + __shfl_xor(other, 32); }
    }
    {
      const bool up = (lane & 16) != 0;
#pragma unroll
      for (int j = 0; j < 4; ++j) { const float mine = up ? a8[4 + j] : a8[j], other = up ? a8[j] : a8[4 + j]; a4[j] = mine + __shfl_xor(other, 16); }
    }
    {
      const bool up = (lane & 8) != 0;
#pragma unroll
      for (int j = 0; j < 2; ++j) { const float mine = up ? a4[2 + j] : a4[j], other = up ? a4[j] : a4[2 + j]; a2[j] = mine + __shfl_xor(other, 8); }
    }
    {
      const bool up = (lane & 4) != 0;
      const float mine = up ? a2[1] : a2[0], other = up ? a2[0] : a2[1];
      a1 = mine + __shfl_xor(other, 4);
    }
    a1 += __shfl_xor(a1, 2);
    a1 += __shfl_xor(a1, 1);
    float mx = a1;
    mx = fmaxf(mx, __shfl_xor(mx, 4)); mx = fmaxf(mx, __shfl_xor(mx, 8)); mx = fmaxf(mx, __shfl_xor(mx, 16)); mx = fmaxf(mx, __shfl_xor(mx, 32));
    const float ex = expf(a1 - mx);
    float se = ex;
    se += __shfl_xor(se, 4); se += __shfl_xor(se, 8); se += __shfl_xor(se, 16); se += __shfl_xor(se, 32);
    if ((lane & 3) == 0) {
      const int e2 = ((lane >> 5) & 1) * 8 + ((lane >> 4) & 1) * 4 + ((lane >> 3) & 1) * 2 + ((lane >> 2) & 1);
      aff[(size_t)row * 16 + e2] = ex / se;
    }
  }
}

template <int NI, int T>
__device__ __forceinline__ void topk_body(const Params& p, int s, int e, char* lds, const int tid) {
  constexpr int CAP = T / 8;
  typedef unsigned long long u64;
  int* cntw = (int*)lds;
  int* wcnt = (int*)(lds + 256);
  int* woff = (int*)(lds + 512);
  const int wid = tid >> 6, lane = tid & 63;
  const bool isl = T == 4096;
  const size_t rowbase = isl ? (size_t)s * 4096 : (size_t)NL + (size_t)(s - 8) * 256;
  const float* aff = (const float*)(p.ws + O_AFF);
  int* sel = (int*)(p.ws + O_SEL);
  float* gate = (float*)(p.ws + O_GATE);
  int* tok = (int*)(p.ws + O_TOK);
  u64 key[NI];
  float av[NI];
#pragma unroll
  for (int q = 0; q < NI; ++q) {
    const int i = tid + q * NTHREADS;
    av[q] = 0.f; key[q] = 0ull;
    if (i < T) {
      av[q] = aff[(rowbase + i) * 16 + e];
      key[q] = ((u64)__float_as_uint(av[q]) << 12) | (u64)(4095 - i);
    }
  }
  u64 prefix = 0ull;
  for (int bit = 43; bit >= 0; --bit) {
    const u64 cand = prefix | (1ull << bit);
    int c = 0;
#pragma unroll
    for (int q = 0; q < NI; ++q) c += __popcll(__ballot(key[q] >= cand));
    if (lane == 0) cntw[(bit & 1) * 8 + wid] = c;
    __syncthreads();
    int tot = 0;
#pragma unroll
    for (int w = 0; w < 8; ++w) tot += cntw[(bit & 1) * 8 + w];
    if (tot >= CAP) prefix = cand;
  }
  int before[NI];
  bool in[NI];
#pragma unroll
  for (int q = 0; q < NI; ++q) {
    in[q] = key[q] >= prefix && key[q] != 0ull;
    const u64 m = __ballot(in[q]);
    before[q] = __popcll(m & ((1ull << lane) - 1ull));
    if (lane == 0) wcnt[q * 8 + wid] = __popcll(m);
  }
  __syncthreads();
  if (tid < 64) {
    int v = tid < NI * 8 ? wcnt[tid] : 0, x = v;
#pragma unroll
    for (int o = 1; o < 64; o <<= 1) { const int y = __shfl_up(x, o); if (lane >= o) x += y; }
    if (tid < NI * 8) woff[tid] = x - v;
  }
  __syncthreads();
  const size_t slotbase = isl ? ((size_t)e * 8 + s) * CAP : (size_t)NSLOT_L + ((size_t)e * 8 + (s - 8)) * CAP;
#pragma unroll
  for (int q = 0; q < NI; ++q) {
    const int i = tid + q * NTHREADS;
    if (i < T) {
      const int slot = woff[q * 8 + wid] + before[q];
      sel[(rowbase + i) * 16 + e] = in[q] ? slot : -1;
      if (in[q]) {
        tok[slotbase + slot] = (int)(rowbase + i);
        gate[slotbase + slot] = av[q];
      }
    }
  }
  __syncthreads();
}
__device__ __forceinline__ void phase_topk(const Params& p, int l, char* lds, int wid0) {
  const int tid = opaque_tid(wid0);
  const int NITEM = (l == 1) ? 128 : 256;
  for (int item = blockIdx.x; item < NITEM; item += gridDim.x) {
    const int s = item >> 4, e = item & 15;
    if (s < 8) topk_body<8, 4096>(p, s, e, lds, tid);
    else topk_body<1, 256>(p, s, e, lds, tid);
  }
}

struct MoeSched {
  const char* A; const char* W; int nN, nunit, G, c; size_t estep; int swap = 0;
  __device__ __forceinline__ bool next(int i, Unit& u) const {
    const int xcd = c & 7, q = c >> 3, per = (G >> 3) / nN;
    int ii = i;
    if (swap && xcd < 4) ii = i == 0 ? 8 : i == 8 ? 0 : i;
    u.pn = q % nN; u.pm = (ii * 8 + xcd) * per + q / nN;
    if (q >= per * nN || u.pm * nN >= nunit) return false;
    u.z = u.pm < 256 ? (u.pm >> 4) : (u.pm - 256); return true;
  }
  __device__ __forceinline__ const char* aptr(const Unit& u) const { return A + (size_t)u.pm * (256u * 1024u * 2u); }
  __device__ __forceinline__ const char* bptr(const Unit& u) const { return W + (size_t)u.z * estep + (size_t)u.pn * (256u * 1024u * 2u); }
};
struct MoeSchedG : MoeSched {
  static constexpr bool GATHER = true;
  const int* tok;
  __device__ __forceinline__ const char* aptr(const Unit&) const { return A; }
  __device__ __forceinline__ const int* tokptr(const Unit& u) const { return tok + (size_t)u.pm * 256; }
};
struct EpiSwiglu {
  bf16_t* HID; unsigned* cnt;
  __device__ __forceinline__ bool operator()(f32x4 (&acc)[2][2][4][2], const Unit& u, int wr, int wc, int fr, int fq) const {
    bf16_t* d = HID + (size_t)u.pm * 256 * 1024 + u.pn * 128;
#pragma unroll
    for (int ai = 0; ai < 2; ++ai)
#pragma unroll
      for (int m = 0; m < 4; ++m) {
        f32x4 o0, o1;
#pragma unroll
        for (int j = 0; j < 4; ++j) { o0[j] = siluf_(acc[ai][0][m][0][j]) * acc[ai][1][m][0][j]; o1[j] = siluf_(acc[ai][0][m][1][j]) * acc[ai][1][m][1][j]; }
        st8bf(d + (size_t)(ai * 128 + wr * 64 + m * 16 + fr) * 1024 + wc * 32 + 8 * fq, o0, o1);
      }
    if (cnt && u.pm >= 256) hc_publish(cnt);
    return false;
  }
};
__device__ __forceinline__ void phase_moe1(const Params& p, int l, char* lds, int wid0) {
  const int tid = opaque_tid(wid0);
  const int nrt = (l == 1) ? 256 : 272;
  MoeSchedG S;
  S.A = p.ws + O_H; S.W = l == 1 ? (const char*)p.out + OUT_W13B : p.ws + O_W13; S.nN = 8; S.nunit = nrt * 8; S.G = (int)gridDim.x; S.c = (int)blockIdx.x; S.estep = (size_t)2048 * 1024 * 2;
  S.tok = (const int*)(p.ws + O_TOK);
  const bool fuse = l == 0 && gridDim.x == 256;
  S.swap = fuse ? 1 : 0;
  unsigned* bar = (unsigned*)(p.ws + O_BAR);
  EpiSwiglu E{(bf16_t*)(p.ws + O_HID), fuse ? bar + HC_MOE1 : nullptr};
  pg8::gemm_phase((PG8_LAS unsigned char*)lds, 1024, S, E, tid);
  if (fuse) {
    const int xcd = (int)blockIdx.x & 7, q = (int)blockIdx.x >> 3;
    if (xcd >= 4 && q < 16) {
      const int r = q * 4 + xcd - 4, e = r >> 2, pn = r & 3, pm = 256 + e;
      hc_wait(bar, bar + HC_MOE1, 128u);
      OneSched S2{p.ws + O_HID + (size_t)pm * (256u * 1024u * 2u), p.ws + O_W2 + (size_t)e * ((size_t)1024 * 1024 * 2) + (size_t)pn * (256u * 1024u * 2u), pm, pn, e};
      EpiStoreBf16 E2{(bf16_t*)(p.ws + O_YS), 1024};
      pg8::gemm_phase((PG8_LAS unsigned char*)lds, 1024, S2, E2, tid);
    } else if (xcd >= 4) conv_fill(p, lds, wid0, 2, (q - 16) * 4 + xcd - 4, 64);
  }
}
__device__ __forceinline__ void phase_moe2(const Params& p, int l, char* lds, int wid0) {
  const int tid = opaque_tid(wid0);
  const int nrt = (l == 1 || gridDim.x == 256) ? 256 : 272;
  MoeSched S{p.ws + O_HID, p.ws + (l == 1 && p.w2sep ? O_W2B : O_W2), 4, nrt * 4, (int)gridDim.x, (int)blockIdx.x, (size_t)1024 * 1024 * 2};
  EpiStoreBf16 E{(bf16_t*)(p.ws + O_YS), 1024};
  pg8::gemm_phase((PG8_LAS unsigned char*)lds, 1024, S, E, tid);
}

__device__ __forceinline__ void phase_rowC(const Params& p, int l, int wid0) {
  const int tid = opaque_tid(wid0), wid = tid >> 6, lane = tid & 63;
  const int nrow = (l == 1) ? NL : NT;
  float* olat = p.out;
  float* octx = (float*)(p.ws + O_CTXB);
  const float* mod = (const float*)(p.ws + O_MOD);
  const bf16_t* YS = (const bf16_t*)(p.ws + O_YS);
  const int* sel = (const int*)(p.ws + O_SEL);
  const float* gate = (const float*)(p.ws + O_GATE);
  const float* nw3 = p.norm_w + (size_t)(l * 4 + 3) * 1024;
  const float* nwn = p.norm_w + (size_t)((l + 1) * 4 + 0) * 1024;
  bf16_t* H = (bf16_t*)(p.ws + O_H);
  const bf16_t* X1 = (const bf16_t*)(p.ws + O_Y);
  int pfrk; u32x4 pfx[2];
  auto fetch = [&](int row) {
    pfrk = sel[(size_t)row * 16 + (lane & 15)];
#pragma unroll
    for (int i = 0; i < 2; ++i) pfx[i] = *(const u32x4*)(X1 + (size_t)row * 1024 + i * 512 + lane * 8);
  };
  const int row0 = blockIdx.x * NWAVE + wid, rstep = gridDim.x * NWAVE;
  if (row0 < nrow) fetch(row0);
  for (int row = row0; row < nrow; row += rstep) {
    float* xo = row < NL ? olat + (size_t)row * 1024 : octx + (size_t)(row - NL) * 1024;
    const bool isl = row < NL;
    const int mr = isl ? (row >> 12) : 8;
    const int s = isl ? (row >> 12) : ((row - NL) >> 8);
    const float* md = mod + (size_t)(l * 9 + mr) * 6144;
    float mv[16];
#pragma unroll
    for (int j = 0; j < 16; ++j) mv[j] = 0.f;
    const int myrk = pfrk;
    u32x4 xcur[2];
#pragma unroll
    for (int i = 0; i < 2; ++i) xcur[i] = pfx[i];
    if (row + rstep < nrow) fetch(row + rstep);
    unsigned long long chosen = __ballot(myrk >= 0) & 0xffffull;
    while (chosen) {
      const int e0 = __builtin_ctzll(chosen); chosen &= chosen - 1;
      const int e1 = chosen ? __builtin_ctzll(chosen) : -1; if (chosen) chosen &= chosen - 1;
      const int rk0 = __shfl(myrk, e0), rk1 = e1 >= 0 ? __shfl(myrk, e1) : 0;
      const size_t slot0 = isl ? ((size_t)e0 * 8 + s) * 512 + rk0 : (size_t)NSLOT_L + ((size_t)e0 * 8 + s) * 32 + rk0;
      const size_t slot1 = e1 < 0 ? slot0 : (isl ? ((size_t)e1 * 8 + s) * 512 + rk1 : (size_t)NSLOT_L + ((size_t)e1 * 8 + s) * 32 + rk1);
      u32x4 w[4];
#pragma unroll
      for (int i = 0; i < 2; ++i) { w[i] = *(const u32x4*)(YS + slot0 * 1024 + i * 512 + lane * 8); w[2 + i] = *(const u32x4*)(YS + slot1 * 1024 + i * 512 + lane * 8); }
      const float m0 = gate[slot0], m1 = e1 >= 0 ? gate[slot1] : 0.f;
#pragma unroll
      for (int i = 0; i < 2; ++i) {
        mv[i * 8 + 0] += m0 * bflo(w[i].x) + m1 * bflo(w[2 + i].x); mv[i * 8 + 1] += m0 * bfhi(w[i].x) + m1 * bfhi(w[2 + i].x);
        mv[i * 8 + 2] += m0 * bflo(w[i].y) + m1 * bflo(w[2 + i].y); mv[i * 8 + 3] += m0 * bfhi(w[i].y) + m1 * bfhi(w[2 + i].y);
        mv[i * 8 + 4] += m0 * bflo(w[i].z) + m1 * bflo(w[2 + i].z); mv[i * 8 + 5] += m0 * bfhi(w[i].z) + m1 * bfhi(w[2 + i].z);
        mv[i * 8 + 6] += m0 * bflo(w[i].w) + m1 * bflo(w[2 + i].w); mv[i * 8 + 7] += m0 * bfhi(w[i].w) + m1 * bfhi(w[2 + i].w);
      }
    }
    float ss = 0.f;
#pragma unroll
    for (int j = 0; j < 16; ++j) ss += mv[j] * mv[j];
    ss = wave_sum(ss);
    const float rs = rsqrtf(ss * (1.0f / 1024.0f) + 1e-6f);
    float xn[16], ssn = 0.f;
#pragma unroll
    for (int i = 0; i < 2; ++i) {
      const int e = i * 512 + lane * 8;
#pragma unroll
      for (int h4 = 0; h4 < 2; ++h4) {
        const f32x4 w = *(const f32x4*)(nw3 + e + h4 * 4), g2 = *(const f32x4*)(md + 5120 + e + h4 * 4);
        f32x4 xv;
        if (h4 == 0) { xv[0] = bflo(xcur[i].x); xv[1] = bfhi(xcur[i].x); xv[2] = bflo(xcur[i].y); xv[3] = bfhi(xcur[i].y); }
        else { xv[0] = bflo(xcur[i].z); xv[1] = bfhi(xcur[i].z); xv[2] = bflo(xcur[i].w); xv[3] = bfhi(xcur[i].w); }
#pragma unroll
        for (int j = 0; j < 4; ++j) { xv[j] += g2[j] * (mv[i * 8 + h4 * 4 + j] * rs * w[j]); xn[i * 8 + h4 * 4 + j] = xv[j]; ssn += xv[j] * xv[j]; }
        if (!(l == 0 && isl)) *(f32x4*)(xo + e + h4 * 4) = xv;
      }
      if (l == 0 && isl) {
        u32x4 o;
        o.x = pk_bf16(xn[i * 8 + 0], xn[i * 8 + 1]); o.y = pk_bf16(xn[i * 8 + 2], xn[i * 8 + 3]); o.z = pk_bf16(xn[i * 8 + 4], xn[i * 8 + 5]); o.w = pk_bf16(xn[i * 8 + 6], xn[i * 8 + 7]);
        *(u32x4*)((bf16_t*)p.out + (size_t)row * 1024 + e) = o;
      }
    }
    if (l == 0) {
      ssn = wave_sum(ssn);
      const float rsn = rsqrtf(ssn * (1.0f / 1024.0f) + 1e-6f);
      const float* mdn = mod + (size_t)((l + 1) * 9 + mr) * 6144;
#pragma unroll
      for (int i = 0; i < 2; ++i) {
        const int e = i * 512 + lane * 8;
        float hv[8];
#pragma unroll
        for (int h4 = 0; h4 < 2; ++h4) {
          const f32x4 w = *(const f32x4*)(nwn + e + h4 * 4), sh = *(const f32x4*)(mdn + e + h4 * 4), sc = *(const f32x4*)(mdn + 1024 + e + h4 * 4);
#pragma unroll
          for (int j = 0; j < 4; ++j) hv[h4 * 4 + j] = xn[i * 8 + h4 * 4 + j] * rsn * w[j] * (1.0f + sc[j]) + sh[j];
        }
        u32x4 w;
        w.x = pk_bf16(hv[0], hv[1]); w.y = pk_bf16(hv[2], hv[3]); w.z = pk_bf16(hv[4], hv[5]); w.w = pk_bf16(hv[6], hv[7]);
        *(u32x4*)(H + (size_t)row * 1024 + e) = w;
      }
    }
  }
}

#define PHASE(call) do { Params q = p; asm volatile("" : "+s"(q.ws)); call; } while (0)
#ifndef PROBE_PH
#define PROBE_PH 0
#endif
#ifndef PROBE_N
#define PROBE_N 2
#endif
#define REP(id, call) do { for (int _r = 0; _r < ((PROBE_PH == (id)) ? 1 + PROBE_N : 1); ++_r) PHASE(call); } while (0)
#define SYNC() do { char* _w = p.ws; asm volatile("" : "+s"(_w)); XcdBarrier _b; _b.bar = (unsigned*)(_w + O_BAR); _b.x = xb_xcc_id(); _b.st = st; xcd_barrier(_b); } while (0)
__global__ void __launch_bounds__(NTHREADS, 2) fwd_mega(Params p) {
  extern __shared__ __attribute__((aligned(16))) char lds[];
  cg::grid_group grid = cg::this_grid();
  const int wid0 = __builtin_amdgcn_readfirstlane((int)(threadIdx.x >> 6));
  volatile PG8_LAS unsigned* st = (volatile PG8_LAS unsigned*)((PG8_LAS unsigned char*)lds + LDS_MAIN);
  if (threadIdx.x < 2) st[threadIdx.x] = 0u;
  __syncthreads();
  (void)xcd_barrier_post((unsigned*)(p.ws + O_BAR), st);
  PHASE(phase_setup(q, lds, wid0));
  PHASE(phase_conv(q, 0, lds, wid0));
  SYNC();
  PHASE(phase_rowA(q, 0, wid0));
  SYNC();
#pragma unroll 1
  for (int l = 0; l < 2; ++l) {
    REP(3, phase_gin(q, l, lds, wid0));
    SYNC();
    REP(5, phase_mix2(q, l, lds, wid0));
    SYNC();
    PHASE(phase_oa(q, l, wid0));
    SYNC();
    REP(7, phase_merge(q, l, lds, wid0));
    if (l == 0) grid.sync(); else SYNC();
    REP(8, phase_wout(q, l, lds, wid0));
    SYNC();
    if (l == 0) PHASE(phase_rowB<0>(q, lds, wid0)); else PHASE(phase_rowB<1>(q, lds, wid0));
    SYNC();
    REP(10, phase_topk(q, l, lds, wid0));
    SYNC();
    REP(11, phase_moe1(q, l, lds, wid0));
    SYNC();
    REP(12, phase_moe2(q, l, lds, wid0));
    SYNC();
    PHASE(phase_rowC(q, l, wid0));
    if (l == 0) PHASE(conv_fill(q, lds, wid0, 4, (int)blockIdx.x, (int)gridDim.x));
    if (l == 0) SYNC();
    if (PROBE_PH == 20) { for (int _r = 0; _r < 10 * PROBE_N; ++_r) SYNC(); }
  }
}

extern "C" void kernel_launch(void* const* d_in, const int* in_sizes, int n_in, void* d_out, int out_size, void* d_ws, size_t ws_size,
                              hipStream_t stream) {
  if (ws_size < WS_NEED) {
    fprintf(stderr, "kernel_launch: workspace too small: %zu < %zu\n", ws_size, (size_t)WS_NEED);
    return;
  }
  Params p{};
  p.x = (const float*)d_in[0]; p.c = (const float*)d_in[1]; p.ctx = (const float*)d_in[2]; p.c_ctx = (const float*)d_in[3];
  p.ada_w = (const float*)d_in[4]; p.ada_b = (const float*)d_in[5]; p.norm_w = (const float*)d_in[6]; p.w_in = (const float*)d_in[7];
  p.lb_raw = (const float*)d_in[8]; p.gnorm_w = (const float*)d_in[9]; p.sgu_w = (const float*)d_in[10]; p.sgu_b = (const float*)d_in[11];
  p.sgu_norm_w = (const float*)d_in[12]; p.w_branch = (const float*)d_in[13]; p.w_out = (const float*)d_in[14];
  p.router_w = (const float*)d_in[15]; p.w13 = (const float*)d_in[16]; p.w2 = (const float*)d_in[17];
  p.out = (float*)d_out;
  p.ws = (char*)d_ws;
  p.w2sep = ws_size >= WS_NEED_W2B ? 1 : 0;
  static int grid_blocks = 0;
  if (!grid_blocks) {
    int dev = 0, cus = 0, per_cu = 0;
    (void)hipGetDevice(&dev);
    (void)hipDeviceGetAttribute(&cus, hipDeviceAttributeMultiprocessorCount, dev);
    (void)hipFuncSetAttribute((const void*)fwd_mega, hipFuncAttributeMaxDynamicSharedMemorySize, LDS_TOTAL);
    (void)hipOccupancyMaxActiveBlocksPerMultiprocessor(&per_cu, fwd_mega, NTHREADS, LDS_TOTAL);
    if (per_cu > 1) per_cu = 1;
    if (per_cu < 1) fprintf(stderr, "kernel_launch: occupancy query reports %d blocks per CU\n", per_cu);
    grid_blocks = cus * (per_cu < 1 ? 1 : per_cu);
  }
  (void)hipMemsetAsync((char*)d_ws + O_BAR, 0, BAR_BYTES, stream);
  void* args[] = {&p};
  hipError_t e = hipLaunchCooperativeKernel((void*)fwd_mega, dim3(grid_blocks), dim3(NTHREADS), args, LDS_TOTAL, stream);
  if (e != hipSuccess) fprintf(stderr, "cooperative launch failed: %s (grid %d)\n", hipGetErrorString(e), grid_blocks);
}
```

```cpp
#include <hip/hip_runtime.h>
#include <hip/hip_cooperative_groups.h>
#include <cstdio>
#include <cstdint>
namespace cg = cooperative_groups;

typedef unsigned short bf16_t;
typedef short bf16x8 __attribute__((ext_vector_type(8)));
typedef float f32x4 __attribute__((ext_vector_type(4)));
typedef float f32x2 __attribute__((ext_vector_type(2)));
typedef unsigned u32x4 __attribute__((ext_vector_type(4)));
typedef unsigned u32x2 __attribute__((ext_vector_type(2)));

constexpr int D = 1024, NB = 8, TL = 4096, TCX = 256;
constexpr int NL = NB * TL, NC = NB * TCX, NT = NL + NC;
constexpr int INC = 7168;
constexpr int NSLOT_L = 16 * 8 * 512, NSLOT_C = 16 * 8 * 32, NSLOT = NSLOT_L + NSLOT_C;
constexpr int NTHREADS = 512, NWAVE = 8;
constexpr int LDS_MAIN = 147456;
constexpr int LDS_TOTAL = LDS_MAIN + 16;

constexpr size_t al(size_t x) { return (x + 255) & ~(size_t)255; }
constexpr size_t O_WIN = 0;
constexpr size_t O_WBR = O_WIN + al((size_t)INC * D * 2);
constexpr size_t O_WOUT = O_WBR + al((size_t)3 * D * 512 * 2);
constexpr size_t O_W13 = O_WOUT + al((size_t)D * D * 2);
constexpr size_t O_W2 = O_W13 + al((size_t)16 * 2048 * D * 2);
constexpr size_t O_FTL = O_W2 + al((size_t)16 * D * D * 2);
constexpr size_t O_FTC = O_FTL + al((size_t)4096 * 8192 * 2);
constexpr size_t O_CS = O_FTC + al((size_t)256 * 512 * 2);
constexpr size_t O_MOD = O_CS + al((size_t)256 * 128 * 2);
constexpr size_t O_LB = O_MOD + al((size_t)2 * 9 * 6144 * 4);
constexpr size_t O_BAR = O_LB + al((size_t)2 * 2 * 512 * 4);
constexpr size_t BAR_BYTES = 3456 * 4;
constexpr size_t O_H = O_BAR + al(BAR_BYTES);
constexpr size_t O_Y = O_H + al((size_t)NT * D * 2);
constexpr size_t O_CTXB = O_Y + al((size_t)NT * D * 2);
constexpr size_t O_AFF = O_CTXB + al((size_t)NC * D * 4);
constexpr size_t O_SEL = O_AFF + al((size_t)NT * 16 * 4);
constexpr size_t O_GATE = O_SEL + al((size_t)NT * 16 * 4);
constexpr size_t O_TOK = O_GATE + al((size_t)NSLOT * 4);
constexpr size_t O_Z = O_TOK + al((size_t)NSLOT * 4);
constexpr size_t SZ512 = al((size_t)NT * 512 * 2);
constexpr size_t O_Q = O_Z, O_LFF = O_Q + SZ512, O_LFB = O_LFF + SZ512, O_I = O_LFB + SZ512, O_GA = O_I + SZ512,
                 O_U = O_GA + SZ512, O_ZB = O_U + SZ512, O_VT = O_ZB + SZ512, O_OF = O_VT + SZ512, O_OBK = O_OF + SZ512;
constexpr size_t O_G = O_OBK + SZ512;
constexpr size_t O_ZCL = O_G + al((size_t)NT * 3072 * 2);
constexpr size_t O_ZCC = O_ZCL + al((size_t)8 * 512 * 8192 * 2);
constexpr size_t O_ZF = O_ZCC + al((size_t)8 * 512 * 512 * 2);
constexpr int KH = 2176, KF = 2 * KH;
constexpr size_t O_ZEND = O_ZF + al((size_t)8 * 512 * KF * 2);
constexpr size_t SZSLOT = al((size_t)NSLOT * 1024 * 2);
constexpr size_t O_XE = O_Z, O_HID = O_XE + SZSLOT, O_YS = O_HID + SZSLOT;
static_assert(O_YS + SZSLOT <= O_ZEND, "moe arena");
constexpr size_t O_W2B = O_ZEND;
constexpr size_t WS_NEED = O_ZEND, WS_NEED_W2B = O_W2B + al((size_t)16 * D * D * 2);

struct Params {
  const float *x, *c, *ctx, *c_ctx, *ada_w, *ada_b, *norm_w, *w_in, *lb_raw, *gnorm_w, *sgu_w, *sgu_b, *sgu_norm_w, *w_branch, *w_out,
      *router_w, *w13, *w2;
  float* out;
  char* ws;
  int w2sep;
};

typedef __bf16 bf16v2_t __attribute__((ext_vector_type(2)));
__device__ __forceinline__ unsigned pk_bf16(float lo, float hi) {
  const f32x2 v = {lo, hi};
  const bf16v2_t r = __builtin_convertvector(v, bf16v2_t);
  return __builtin_bit_cast(unsigned, r);
}
__device__ __forceinline__ bf16_t f2bf(float x) { return (bf16_t)(pk_bf16(x, 0.f) & 0xffffu); }
__device__ __forceinline__ float bf2f(bf16_t v) { return __uint_as_float(((unsigned)v) << 16); }
__device__ __forceinline__ float bflo(unsigned w) { return __uint_as_float(w << 16); }
__device__ __forceinline__ float bfhi(unsigned w) { return __uint_as_float(w & 0xffff0000u); }
__device__ __forceinline__ void st4bf(bf16_t* p, f32x4 v) {
  u32x2 w;
  w.x = pk_bf16(v[0], v[1]);
  w.y = pk_bf16(v[2], v[3]);
  *(u32x2*)p = w;
}
__device__ __forceinline__ void st8bf(bf16_t* p, f32x4 a, f32x4 b) {
  u32x4 w;
  w.x = pk_bf16(a[0], a[1]); w.y = pk_bf16(a[2], a[3]); w.z = pk_bf16(b[0], b[1]); w.w = pk_bf16(b[2], b[3]);
  *(u32x4*)p = w;
}
__device__ __forceinline__ float sigmoidf_(float x) { return __builtin_amdgcn_rcpf(1.0f + __expf(-x)); }
__device__ __forceinline__ float siluf_(float x) { return x * __builtin_amdgcn_rcpf(1.0f + __expf(-x)); }
__device__ __forceinline__ float geluf_(float v) {
  const float av = fabsf(v), t = __builtin_amdgcn_rcpf(av * 0.2316418882f + 1.0f);
  float q = t * 0.5307027145f + (-0.7265760135f);
  q = q * t + 0.7107068705f; q = q * t + (-0.142248368f); q = q * t + 0.127414796f; q = q * t;
  const float e = __builtin_amdgcn_exp2f((v * v) * (-0.72134752044f));
  const float m = v * (q * e);
  return v < 0.f ? m : v - m;
}
__device__ __forceinline__ int opaque_tid(int wid0) {
  int lane;
  asm volatile("v_mbcnt_lo_u32_b32 %0, -1, 0\n\tv_mbcnt_hi_u32_b32 %0, -1, %0" : "=v"(lane));
  return (wid0 << 6) | lane;
}
__device__ __forceinline__ float wave_sum(float v) {
#pragma unroll
  for (int o = 32; o > 0; o >>= 1) v += __shfl_xor(v, o);
  return v;
}

namespace pg8 {
#define PG8_LAS __attribute__((address_space(3)))
constexpr int BM = 256, BK = 64, HALF = 128, HTB = HALF * BK * 2, STAGE_BYTES = 8 * HTB, NXCD = 8, WGM = 8;
__device__ __forceinline__ int lds_byte(int r, int c) { const int st = (r >> 4) * 2 + (c >> 5), rr = r & 15, cc = c & 31, ob = rr * 64 + cc * 2; return st * 1024 + (ob ^ (((ob >> 9) & 1) << 5)); }
__device__ __forceinline__ void stage_rc(int b, int& R, int& C) { const int st = b / 1024, sb = b % 1024, swz = sb ^ (((sb >> 9) & 1) << 5); R = (st >> 1) * 16 + swz / 64; C = (st & 1) * 32 + (swz % 64) / 2; }
__device__ __forceinline__ int perm32(int rho) { const int n = rho >> 4, i = rho & 15; return 8 * (i >> 2) + 4 * n + (i & 3); }
struct Unit { int pm, pn, z; };
template <class T, class = void> struct gather_of { static constexpr bool v = false; };
template <class T> struct gather_of<T, decltype((void)T::GATHER)> { static constexpr bool v = T::GATHER; };

template <class Epi, class Sched>
__device__ __forceinline__ void gemm_phase(PG8_LAS unsigned char* lds, const int K, const Sched& S, const Epi& E, const int tid_in) {
  int tid = tid_in;
  asm volatile("" : "+v"(tid));
  const int wid = __builtin_amdgcn_readfirstlane(tid >> 6), lane = tid & 63, wr = wid >> 2, wc = wid & 3, fr = lane & 15, fq = lane >> 4;
  const int nt = K / BK;
  constexpr bool GA = gather_of<Sched>::v;
  unsigned voffA[2], voffB[2];
  unsigned cvA[2][2], nvA[2][2];
  int gR = 0; unsigned gC2 = 0;
#pragma unroll
  for (int i = 0; i < 2; ++i) { int R, C; stage_rc(tid * 16 + i * 8192, R, C); const int Rb = (R & ~31) + perm32(R & 31);
    if (i == 0) { gR = R; gC2 = (unsigned)C * 2u; }
    voffA[i] = (unsigned)(R * K + C) * 2u; voffB[i] = (unsigned)(Rb * K + C) * 2u; }
  const size_t kstep = (size_t)(BK * 2);
  const size_t hstep = (size_t)HALF * K * 2;
  const size_t hstepA = GA ? (size_t)0 : hstep;
  const PG8_LAS int* idxl = (const PG8_LAS int*)(lds + STAGE_BYTES);
  const unsigned ldsw = (unsigned)wid * 1024u;
  const int aoff = lds_byte(wr * 64 + fr, fq * 8), boff = lds_byte(wc * 32 + fr, fq * 8);
#define PG8_SA(b, h) (((b) * 2 + (h)) * HTB)
#define PG8_SB(b, h) ((4 + (b) * 2 + (h)) * HTB)
#define PG8_STAGE_(bufoff, gbase, voff) do { _Pragma("unroll") for (int _i = 0; _i < 2; ++_i) \
    __builtin_amdgcn_global_load_lds((const unsigned*)((const char*)(gbase) + voff[_i]), (PG8_LAS unsigned*)(lds + (bufoff) + ldsw + _i * 8192), 16, 0, 0); } while (0)
#define PG8_STAGE(bufoff, gbase) PG8_STAGE_(bufoff, gbase, voffB)
#define PG8_STAGE_A(bufoff, gbase, NX) do { _Pragma("unroll") for (int _i = 0; _i < 2; ++_i) { unsigned _vo; \
    if constexpr (GA) { _vo = (NX) ? nvA[((bufoff) / HTB) & 1][_i] : cvA[((bufoff) / HTB) & 1][_i]; } else _vo = voffA[_i]; \
    __builtin_amdgcn_global_load_lds((const unsigned*)((const char*)(gbase) + _vo), (PG8_LAS unsigned*)(lds + (bufoff) + ldsw + _i * 8192), 16, 0, 0); } } while (0)
#define PG8_LDA(dst, b, h) do { _Pragma("unroll") for (int m = 0; m < 4; ++m) _Pragma("unroll") for (int k = 0; k < 2; ++k) dst[m][k] = *(const PG8_LAS bf16x8*)(lds + PG8_SA(b, h) + aoff + m * 2048 + k * 1024); } while (0)
#define PG8_LDB(dst, b, h) do { _Pragma("unroll") for (int n = 0; n < 2; ++n) _Pragma("unroll") for (int k = 0; k < 2; ++k) dst[n][k] = *(const PG8_LAS bf16x8*)(lds + PG8_SB(b, h) + boff + n * 2048 + k * 1024); } while (0)
#define PG8_MMA(ai, bj, At, Bt) do { __builtin_amdgcn_s_setprio(1); _Pragma("unroll") for (int m = 0; m < 4; ++m) _Pragma("unroll") for (int n = 0; n < 2; ++n) _Pragma("unroll") for (int k = 0; k < 2; ++k) \
    acc[ai][bj][m][n] = __builtin_amdgcn_mfma_f32_16x16x32_bf16(Bt[n][k], At[m][k], acc[ai][bj][m][n], 0, 0, 0); __builtin_amdgcn_s_setprio(0); } while (0)
#define PG8_WAIT_V(n) asm volatile("s_waitcnt vmcnt(" #n ")" ::: "memory")
#define PG8_WAIT_L(n) asm volatile("s_waitcnt lgkmcnt(" #n ")" ::: "memory")
#define PG8_BAR __builtin_amdgcn_s_barrier()
#define PG8_SCHED __builtin_amdgcn_sched_barrier(0)
  Unit cur, nxt; int ui = 0;
  if (!S.next(0, cur)) return;
  f32x4 acc[2][2][4][2];
#pragma unroll
  for (int a = 0; a < 2; ++a)
#pragma unroll
    for (int b = 0; b < 2; ++b)
#pragma unroll
      for (int m = 0; m < 4; ++m)
#pragma unroll
        for (int n = 0; n < 2; ++n) acc[a][b][m][n] = (f32x4){0.f, 0.f, 0.f, 0.f};
  bf16x8 At[4][2], B0[2][2], B1[2][2];
  const char* cA = S.aptr(cur); const char* cB = S.bptr(cur);
  if constexpr (GA) {
    const int* tk = S.tokptr(cur);
#pragma unroll
    for (int h = 0; h < 2; ++h)
#pragma unroll
      for (int i = 0; i < 2; ++i) { cvA[h][i] = (unsigned)tk[h * 128 + i * 64 + gR] * (unsigned)(K * 2) + gC2; nvA[h][i] = cvA[h][i]; }
  }
  PG8_STAGE(PG8_SB(0, 0), cB); PG8_STAGE_A(PG8_SA(0, 0), cA, false); PG8_STAGE(PG8_SB(0, 1), cB + hstep); PG8_STAGE_A(PG8_SA(0, 1), cA + hstepA, false);
  if (wr == 1) PG8_BAR;
  PG8_WAIT_V(4); PG8_BAR;
  PG8_STAGE(PG8_SB(1, 0), cB + kstep); PG8_STAGE_A(PG8_SA(1, 0), cA + kstep, false); PG8_STAGE(PG8_SB(1, 1), cB + hstep + kstep);
  PG8_WAIT_V(6); PG8_BAR;
  for (;;) {
    const bool has_next = S.next(ui + 1, nxt);
    const char* nA = has_next ? S.aptr(nxt) : cA; const char* nB = has_next ? S.bptr(nxt) : cB;
    if constexpr (GA) {
      if (has_next && wid < 4)
        __builtin_amdgcn_global_load_lds((const unsigned*)(S.tokptr(nxt) + wid * 64 + lane), (PG8_LAS unsigned*)(lds + STAGE_BYTES + wid * 256), 4, 0, 0);
    }
    for (int t = 0; t < nt; t += 2) {
      const bool last = (t == nt - 2);
      const bool lastn = last && has_next;
      if constexpr (GA) {
#pragma unroll
        for (int h = 0; h < 2; ++h)
#pragma unroll
          for (int i = 0; i < 2; ++i) nvA[h][i] = (unsigned)idxl[h * 128 + i * 64 + gR] * (unsigned)(K * 2) + gC2;
      }
      const char* a1 = cA + (size_t)(t + 1) * kstep;
      const char* a2 = last ? nA : cA + (size_t)(t + 2) * kstep; const char* b2 = last ? nB : cB + (size_t)(t + 2) * kstep;
      const char* a3 = a2 + kstep; const char* b3 = b2 + kstep;
      PG8_LDB(B0, 0, 0); PG8_SCHED; PG8_LDA(At, 0, 0); PG8_STAGE_A(PG8_SA(1, 1), a1 + hstepA, false);
      PG8_WAIT_L(8); PG8_BAR; PG8_WAIT_L(0); PG8_MMA(0, 0, At, B0); PG8_BAR; PG8_SCHED;
      PG8_LDB(B1, 0, 1); PG8_STAGE(PG8_SB(0, 0), b2);
      PG8_BAR; PG8_WAIT_L(0); PG8_MMA(0, 1, At, B1); PG8_BAR;
      PG8_LDA(At, 0, 1); PG8_STAGE_A(PG8_SA(0, 0), a2, lastn);
      PG8_BAR; PG8_WAIT_L(0); PG8_MMA(1, 0, At, B0); PG8_BAR; PG8_SCHED;
      PG8_STAGE(PG8_SB(0, 1), b2 + hstep);
      PG8_WAIT_V(6); PG8_BAR; PG8_MMA(1, 1, At, B1); PG8_BAR;
      PG8_LDB(B0, 1, 0); PG8_SCHED; PG8_LDA(At, 1, 0); PG8_STAGE_A(PG8_SA(0, 1), a2 + hstepA, lastn);
      PG8_WAIT_L(8); PG8_BAR; PG8_WAIT_L(0); PG8_MMA(0, 0, At, B0); PG8_BAR; PG8_SCHED;
      PG8_LDB(B1, 1, 1); PG8_STAGE(PG8_SB(1, 0), b3);
      PG8_BAR; PG8_WAIT_L(0); PG8_MMA(0, 1, At, B1); PG8_BAR;
      PG8_LDA(At, 1, 1); PG8_STAGE_A(PG8_SA(1, 0), a3, lastn);
      PG8_BAR; PG8_WAIT_L(0); PG8_MMA(1, 0, At, B0); PG8_BAR; PG8_SCHED;
      PG8_STAGE(PG8_SB(1, 1), b3 + hstep);
      PG8_WAIT_V(6); PG8_BAR; PG8_MMA(1, 1, At, B1); PG8_BAR;
    }
    if (wr == 0) PG8_BAR;
    bool keep;
    { int fr2 = fr, fq2 = fq; asm volatile("" : "+v"(fr2), "+v"(fq2));
      keep = E(acc, cur, wr, wc, fr2, fq2); }
    if (!has_next) break;
    if (!keep)
#pragma unroll
    for (int a = 0; a < 2; ++a)
#pragma unroll
      for (int b = 0; b < 2; ++b)
#pragma unroll
        for (int m = 0; m < 4; ++m)
#pragma unroll
          for (int n = 0; n < 2; ++n) acc[a][b][m][n] = (f32x4){0.f, 0.f, 0.f, 0.f};
    cur = nxt; cA = nA; cB = nB; ++ui;
    if constexpr (GA) {
#pragma unroll
      for (int h = 0; h < 2; ++h)
#pragma unroll
        for (int i = 0; i < 2; ++i) cvA[h][i] = nvA[h][i];
    }
    if (wr == 1) PG8_BAR;
  }
  PG8_WAIT_V(0);
  PG8_BAR;
#undef PG8_SA
#undef PG8_SB
#undef PG8_STAGE
#undef PG8_STAGE_
#undef PG8_STAGE_A
#undef PG8_LDA
#undef PG8_LDB
#undef PG8_MMA
#undef PG8_WAIT_V
#undef PG8_WAIT_L
#undef PG8_BAR
#undef PG8_SCHED
}
template <class F>
__device__ __forceinline__ void epi_each(const f32x4 (&acc)[2][2][4][2], int wr, int wc, int fr, int fq, const F& f) {
#pragma unroll
  for (int ai = 0; ai < 2; ++ai)
#pragma unroll
    for (int m = 0; m < 4; ++m)
#pragma unroll
      for (int bj = 0; bj < 2; ++bj) f(ai * HALF + wr * 64 + m * 16 + fr, bj * HALF + wc * 32 + 8 * fq, acc[ai][bj][m][0], acc[ai][bj][m][1]);
}
struct GridSched {
  const char* A; const char* B; size_t tstep; int nM, nN, nwg, G, c, pm0;
  __device__ __forceinline__ void init(const void* A_, const void* B_, int K, int nM_, int nN_, int pm0_, int G_, int c_) {
    A = (const char*)A_; B = (const char*)B_; tstep = (size_t)BM * K * 2; nM = nM_; nN = nN_; nwg = nM * nN; G = G_; c = c_; pm0 = pm0_;
  }
  __device__ __forceinline__ bool next(int i, Unit& u) const {
    const long L = (long)i * G + c; if (L >= nwg) return false;
    int wgid = (int)L; { const int q = nwg / NXCD, r = nwg % NXCD, xcd = wgid % NXCD, off = wgid / NXCD; wgid = (xcd < r ? xcd * (q + 1) : r * (q + 1) + (xcd - r) * q) + off; }
    const int nig = WGM * nN, gid = wgid / nig, fm = gid * WGM, gsz = (nM - fm) < WGM ? (nM - fm) : WGM;
    u.pm = pm0 + fm + ((wgid % nig) % gsz); u.pn = (wgid % nig) / gsz; u.z = 0; return true;
  }
  __device__ __forceinline__ const char* aptr(const Unit& u) const { return A + (size_t)u.pm * tstep; }
  __device__ __forceinline__ const char* bptr(const Unit& u) const { return B + (size_t)u.pn * tstep; }
};
}
using pg8::Unit;


#define XB_TMO      128
#define XB_XCNT(j)  (256  + 64 * (j))
#define XB_XSUB(j)  (1280 + 64 * (j))
#define XB_XGEN(j)  (2304 + 64 * (j))
#define XB_TOP      3328
#define XB_TOPGEN   3392
#define XB_SPIN_CAP (1u << 18)
__device__ __forceinline__ unsigned xb_ld(unsigned* p)              { return __hip_atomic_load(p, __ATOMIC_RELAXED, __HIP_MEMORY_SCOPE_AGENT); }
__device__ __forceinline__ unsigned xb_add(unsigned* p, unsigned v) { return __hip_atomic_fetch_add(p, v, __ATOMIC_RELAXED, __HIP_MEMORY_SCOPE_AGENT); }
__device__ __forceinline__ unsigned xb_xcc_id() { return (unsigned)__builtin_amdgcn_s_getreg((3 << 11) | 20) & 0xFu; }
#define XB_SPIN(cond, bar) do { unsigned _sp = 0; while (cond) { __builtin_amdgcn_s_sleep(1); \
    if ((++_sp & 255u) == 0u) { if (xb_ld(&(bar)[XB_TMO])) break; if (_sp > XB_SPIN_CAP) { atomicAdd(&(bar)[XB_TMO], 1u); break; } } } } while (0)
struct XcdBarrier { unsigned* bar; unsigned x; volatile PG8_LAS unsigned* st; };
__device__ __forceinline__ XcdBarrier xcd_barrier_post(unsigned* bar, volatile PG8_LAS unsigned* st) {
  XcdBarrier b; b.bar = bar; b.x = xb_xcc_id(); b.st = st;
  if (threadIdx.x == 0) (void)xb_add(&bar[XB_XCNT(b.x)], 1u);
  return b;
}
__device__ __forceinline__ void xcd_barrier_complete(unsigned* bar, unsigned x, unsigned& nloc, unsigned& nx) {
  const unsigned G = gridDim.x * gridDim.y * gridDim.z;
  unsigned sum, cnt, mine, sp = 0u;
  for (;;) {
    sum = 0u; cnt = 0u; mine = 0u;
#pragma unroll
    for (unsigned j = 0; j < 16; ++j) { const unsigned c = xb_ld(&bar[XB_XCNT(j)]); sum += c; cnt += (c > 0u) ? 1u : 0u; mine = (j == x) ? c : mine; }
    if (sum == G) break;
    __builtin_amdgcn_s_sleep(1);
    if ((++sp & 255u) == 0u) { if (xb_ld(&bar[XB_TMO])) break; if (sp > XB_SPIN_CAP) { atomicAdd(&bar[XB_TMO], 1u); break; } }
  }
  nloc = mine > 0u ? mine : 1u; nx = cnt > 0u ? cnt : 1u;
}
__device__ __forceinline__ void xcd_barrier(const XcdBarrier& b) {
  asm volatile("s_waitcnt vmcnt(0)" ::: "memory");
  __syncthreads();
  if (threadIdx.x == 0) {
    unsigned* bar = b.bar;
    __builtin_amdgcn_s_waitcnt(0);
    unsigned nloc = b.st[0], nx = b.st[1];
    if (nloc == 0u) { xcd_barrier_complete(bar, b.x, nloc, nx); b.st[0] = nloc; b.st[1] = nx; }
    const unsigned old = xb_add(&bar[XB_XSUB(b.x)], 1u);
    const unsigned gen = old / nloc;
    if (old + 1u == (gen + 1u) * nloc) {
      __builtin_amdgcn_fence(__ATOMIC_RELEASE, "agent");
      asm volatile("s_waitcnt vmcnt(0)" ::: "memory");
      const unsigned og = xb_add(&bar[XB_TOP], 1u);
      const unsigned tg = og / nx;
      if (og + 1u == (tg + 1u) * nx) xb_add(&bar[XB_TOPGEN], 1u);
      else XB_SPIN(xb_ld(&bar[XB_TOPGEN]) == tg, bar);
      __builtin_amdgcn_fence(__ATOMIC_ACQUIRE, "agent");
      xb_add(&bar[XB_XGEN(b.x)], 1u);
      asm volatile("s_waitcnt vmcnt(0)" ::: "memory");
    } else {
      XB_SPIN(xb_ld(&bar[XB_XGEN(b.x)]) == gen, bar);
      __builtin_amdgcn_fence(__ATOMIC_ACQUIRE, "agent");
      asm volatile("s_waitcnt vmcnt(0)" ::: "memory");
    }
  }
  __syncthreads();
}


__device__ __forceinline__ void sub_barrier(unsigned* cnt, int nb) {
  asm volatile("s_waitcnt vmcnt(0)" ::: "memory");
  __syncthreads();
  if (threadIdx.x == 0) {
    __builtin_amdgcn_fence(__ATOMIC_RELEASE, "agent");
    asm volatile("s_waitcnt vmcnt(0)" ::: "memory");
    (void)xb_add(cnt, 1u);
    unsigned sp = 0;
    while (xb_ld(cnt) < (unsigned)nb && ++sp < (1u << 20)) __builtin_amdgcn_s_sleep(1);
    __builtin_amdgcn_fence(__ATOMIC_ACQUIRE, "agent");
    asm volatile("s_waitcnt vmcnt(0)" ::: "memory");
  }
  __syncthreads();
}

template <class LA, class LB>
__device__ __forceinline__ void gemm_main(f32x4 (&acc)[4][4], const int nk, const LA& la, const LB& lb, char* lds, const int t) {
  const int lane = t & 63, wid = t >> 6, fr = lane & 15, fq = lane >> 4, wr = wid >> 1, wc = wid & 1;
  const int sr = t >> 3, sc = t & 7;
  const int wofs = sr * 128 + ((sc ^ (sr & 7)) << 4);
  const int aofs = (wr * 64 + fr) * 128, bofs = 16384 + (wc * 64 + fr) * 128;
  const int x0 = ((fq) ^ (fr & 7)) << 4, x1 = ((4 + fq) ^ (fr & 7)) << 4;
  bf16x8 ra[4], rb[4];
#pragma unroll
  for (int i = 0; i < 4; ++i) { ra[i] = la(i, 0); rb[i] = lb(i, 0); }
#pragma unroll
  for (int i = 0; i < 4; ++i) { *(bf16x8*)(lds + wofs + i * 4096) = ra[i]; *(bf16x8*)(lds + 16384 + wofs + i * 4096) = rb[i]; }
  __syncthreads();
  for (int kt = 0; kt < nk; ++kt) {
    const char* cur = lds + (kt & 1) * 32768;
    const bool more = kt + 1 < nk;
    if (more) {
#pragma unroll
      for (int i = 0; i < 4; ++i) { ra[i] = la(i, (kt + 1) * 64); rb[i] = lb(i, (kt + 1) * 64); }
    }
#pragma unroll
    for (int kk = 0; kk < 2; ++kk) {
      const int xo = kk ? x1 : x0;
      bf16x8 af[4], bv[4];
#pragma unroll
      for (int m = 0; m < 4; ++m) af[m] = *(const bf16x8*)(cur + aofs + m * 2048 + xo);
#pragma unroll
      for (int n = 0; n < 4; ++n) bv[n] = *(const bf16x8*)(cur + bofs + n * 2048 + xo);
#pragma unroll
      for (int m = 0; m < 4; ++m)
#pragma unroll
        for (int n = 0; n < 4; ++n) acc[m][n] = __builtin_amdgcn_mfma_f32_16x16x32_bf16(bv[n], af[m], acc[m][n], 0, 0, 0);
    }
    if (more) {
      char* nxt = lds + ((kt + 1) & 1) * 32768;
#pragma unroll
      for (int i = 0; i < 4; ++i) { *(bf16x8*)(nxt + wofs + i * 4096) = ra[i]; *(bf16x8*)(nxt + 16384 + wofs + i * 4096) = rb[i]; }
    }
    __syncthreads();
  }
}
__device__ __forceinline__ void zero_acc(f32x4 (&acc)[4][4]) {
#pragma unroll
  for (int m = 0; m < 4; ++m)
#pragma unroll
    for (int n = 0; n < 4; ++n) acc[m][n] = (f32x4){0.f, 0.f, 0.f, 0.f};
}
template <class EP>
__device__ __forceinline__ void gemm_epi(const f32x4 (&acc)[4][4], const EP& ep, const int t) {
  const int lane = t & 63, wid = t >> 6, fr = lane & 15, fq = lane >> 4, wr = wid >> 1, wc = wid & 1;
#pragma unroll
  for (int m = 0; m < 4; ++m)
#pragma unroll
    for (int n = 0; n < 4; ++n) ep(wr * 64 + m * 16 + fr, wc * 64 + n * 16 + fq * 4, acc[m][n]);
}
struct RowLd {
  const bf16_t* p[4];
  __device__ __forceinline__ RowLd(const bf16_t* base, size_t r0, size_t ld, const int t) {
#pragma unroll
    for (int i = 0; i < 4; ++i) p[i] = base + (r0 + (t >> 3) + 32 * i) * ld + (t & 7) * 8;
  }
  __device__ __forceinline__ bf16x8 operator()(int i, int k0) const { return *(const bf16x8*)(p[i] + k0); }
};

__device__ __forceinline__ void phase_setup(const Params& p, char* lds, int wid0) {
  float* tab = (float*)lds;
  float* sv = (float*)(lds + 16384);
  float* red = (float*)(lds + 16384 + 36864);
  const int tid = opaque_tid(wid0);
  float* mod = (float*)(p.ws + O_MOD);
  bf16_t* FTL = (bf16_t*)(p.ws + O_FTL);
  bool have_tab = false;
  const int NMOD = 192, NITEM = NMOD + 4096 + 1;
  for (int item = blockIdx.x; item < NITEM; item += gridDim.x) {
    if (item < NMOD) {
      const int l = item / 96, n = (item % 96) * 64 + (tid & 63), kp = tid >> 6;
      for (int e = tid; e < 9 * 1024; e += NTHREADS) {
        const int r = e >> 10, k = e & 1023;
        const float v = r < 8 ? p.c[r * 1024 + k] : p.c_ctx[k];
        sv[e] = v / (1.0f + __expf(-v));
      }
      __syncthreads();
      float acc[9];
#pragma unroll
      for (int r = 0; r < 9; ++r) acc[r] = 0.f;
      const float* w = p.ada_w + (size_t)l * 1024 * 6144 + n;
#pragma unroll 8
      for (int k = kp * 128; k < kp * 128 + 128; ++k) {
        const float wv = w[(size_t)k * 6144];
#pragma unroll
        for (int r = 0; r < 9; ++r) acc[r] += sv[r * 1024 + k] * wv;
      }
#pragma unroll
      for (int r = 0; r < 9; ++r) red[(kp * 9 + r) * 64 + (tid & 63)] = acc[r];
      __syncthreads();
      for (int e = tid; e < 9 * 64; e += NTHREADS) {
        const int r = e >> 6, c = e & 63;
        float a = 0.f;
#pragma unroll
        for (int q8 = 0; q8 < 8; ++q8) a += red[(q8 * 9 + r) * 64 + c];
        const int nn = (item % 96) * 64 + c;
        mod[(l * 9 + r) * 6144 + nn] = a + p.ada_b[l * 6144 + nn];
      }
      __syncthreads();
    } else {
      if (!have_tab) {
        for (int j = tid; j < 4096; j += NTHREADS) tab[j] = cospif((float)j * (1.0f / 2048.0f));
        __syncthreads();
        have_tab = true;
      }
      if (item < NMOD + 4096) {
        const int k = (item - NMOD) & 2047, part = (item - NMOD) >> 11;
        const float scale = 0.0013810679320049757f;
        for (int e8 = tid; e8 < KH / 8; e8 += NTHREADS) {
          float v[8];
#pragma unroll
          for (int jx = 0; jx < 8; ++jx) {
            const int t = e8 * 8 + jx, jj = (k * t) & 4095;
            if (part == 0) v[jx] = t <= 2048 ? tab[jj] * scale : 0.f;
            else v[jx] = t < 2048 ? -tab[(jj - 1024) & 4095] * scale : 0.f;
          }
          u32x4 w;
          w.x = pk_bf16(v[0], v[1]); w.y = pk_bf16(v[2], v[3]); w.z = pk_bf16(v[4], v[5]); w.w = pk_bf16(v[6], v[7]);
          *(u32x4*)(FTL + ((size_t)part * 2048 + k) * KH + e8 * 8) = w;
        }
      } else {
        bf16_t* FTC = (bf16_t*)(p.ws + O_FTC);
        bf16_t* CS = (bf16_t*)(p.ws + O_CS);
        const float scale_c = 0.005524271728019903f;
        for (int e = tid; e < 256 * 512; e += NTHREADS) {
          const int k = e >> 9, cs = (e >> 8) & 1, t = e & 255;
          const int jj = ((k * t) & 255) * 16;
          FTC[e] = f2bf((cs == 0 ? tab[jj] : -tab[(jj - 1024) & 4095]) * scale_c);
        }
        for (int e = tid; e < 256 * 128; e += NTHREADS) {
          const int row = e >> 7, d = e & 127, cs = row >> 7, m = row & 127;
          const int jj = ((m * d) & 127) * 32;
          CS[e] = f2bf(cs == 0 ? tab[jj] : tab[(jj - 1024) & 4095]);
        }
        float* lb = (float*)(p.ws + O_LB);
        for (int e = tid; e < 2 * 512; e += NTHREADS) {
          const int dir = e >> 9, ch = e & 511;
          const float r0 = p.lb_raw[(dir * 2 + 0) * 512 + ch], r1 = p.lb_raw[(dir * 2 + 1) * 512 + ch];
          const float mx = fmaxf(r0, r1), e0 = expf(r0 - mx), e1 = expf(r1 - mx);
          const float p0 = e0 / (e0 + e1), p1 = e1 / (e0 + e1);
          lb[(dir * 2 + 0) * 512 + ch] = p0 - p0;
          lb[(dir * 2 + 1) * 512 + ch] = (p0 + p1) - p0;
        }
      }
    }
  }
  __syncthreads();
}

constexpr size_t OUT_W13B = (size_t)NL * D * 2;
template <bool VMAP>
__device__ __forceinline__ void conv_items(const Params& p, int l, char* lds, int wid0, const int lo, const int hi, const int r, const int n) {
  const int tid = opaque_tid(wid0);
  float* tile = (float*)lds;
  struct Item { const float* src; bf16_t* dst; int K, N, n0, k0, drow0; };
  auto decode = [&](int item) -> Item {
    int i = item;
    if (VMAP) {
      if (p.w2sep) i = i < 2048 ? i + 608 : i < 2496 ? i - 2048 : i < 3520 ? i + 160 : i - 3072;
      else i = i < 2048 ? i + 608 : i < 2656 ? i - 2048 : i;
    }
    Item it;
    bool w13 = false;
    if (i < 448) {
      it.src = p.w_in + (size_t)l * 1024 * INC; it.dst = (bf16_t*)(p.ws + O_WIN); it.K = 1024; it.N = INC;
    } else if ((i -= 448) < 96) {
      const int j = i / 32; i -= j * 32;
      it.src = p.w_branch + ((size_t)l * 3 + j) * 512 * 1024; it.dst = (bf16_t*)(p.ws + O_WBR) + (size_t)j * 1024 * 512; it.K = 512; it.N = 1024;
    } else if ((i -= 96) < 64) {
      it.src = p.w_out + (size_t)l * 1024 * 1024; it.dst = (bf16_t*)(p.ws + O_WOUT); it.K = 1024; it.N = 1024;
    } else if ((i -= 64) < 2048) {
      const int e = i / 128; i -= e * 128;
      it.src = p.w13 + ((size_t)l * 16 + e) * 1024 * 2048;
      it.dst = (l == 1 ? (bf16_t*)((char*)p.out + OUT_W13B) : (bf16_t*)(p.ws + O_W13)) + (size_t)e * 2048 * 1024; it.K = 1024; it.N = 2048; w13 = true;
    } else {
      i -= 2048;
      const int e = i / 64; i -= e * 64;
      it.src = p.w2 + ((size_t)l * 16 + e) * 1024 * 1024; it.dst = (bf16_t*)(p.ws + (l == 1 && p.w2sep ? O_W2B : O_W2)) + (size_t)e * 1024 * 1024; it.K = 1024; it.N = 1024;
    }
    const int nkt = it.K / 128;
    it.n0 = (i / nkt) * 128; it.k0 = (i % nkt) * 128;
    it.drow0 = w13 ? (((it.n0 & 1023) >> 7) * 256 + (it.n0 >> 10) * 128) : it.n0;
    return it;
  };
  f32x4 pf[8];
  auto fetch = [&](const Item& it) {
#pragma unroll
    for (int q = 0; q < 8; ++q) pf[q] = *(const f32x4*)(it.src + (size_t)(it.k0 + q * 16 + (tid >> 5)) * it.N + it.n0 + (tid & 31) * 4);
  };
  int rr = r; asm volatile("" : "+s"(rr));
  const int item0 = lo + rr;
  Item cur = decode(item0 < hi ? item0 : lo);
  if (item0 < hi) fetch(cur);
  for (int item = item0; item < hi; item += n) {
#pragma unroll
    for (int q = 0; q < 8; ++q) {
      const int kk = q * 16 + (tid >> 5), nn = (tid & 31) * 4;
      tile[(nn + 0) * 129 + kk] = pf[q][0]; tile[(nn + 1) * 129 + kk] = pf[q][1]; tile[(nn + 2) * 129 + kk] = pf[q][2]; tile[(nn + 3) * 129 + kk] = pf[q][3];
    }
    const Item me = cur;
    if (item + n < hi) { cur = decode(item + n); fetch(cur); }
    __syncthreads();
#pragma unroll
    for (int q2 = 0; q2 < 4; ++q2) {
      const int q = tid + q2 * 512, nn = q >> 4, kc = (q & 15) * 8;
      const float* tp = tile + nn * 129 + kc;
      u32x4 w;
      w.x = pk_bf16(tp[0], tp[1]); w.y = pk_bf16(tp[2], tp[3]); w.z = pk_bf16(tp[4], tp[5]); w.w = pk_bf16(tp[6], tp[7]);
      *(u32x4*)(me.dst + (size_t)(me.drow0 + nn) * me.K + me.k0 + kc) = w;
    }
    __syncthreads();
  }
}
__device__ __forceinline__ void phase_conv(const Params& p, int l, char* lds, int wid0) { conv_items<false>(p, l, lds, wid0, 0, 3680, blockIdx.x, gridDim.x); }
constexpr int CF_S0 = 2304, CF_S2 = 320;
__device__ __forceinline__ void conv_fill(const Params& p, char* lds, int wid0, const int slot, const int r, const int n) {
  const bool tuned = gridDim.x == 256;
  int a, b;
  int c0 = CF_S0, c2 = CF_S0 + CF_S2;
  if (!p.w2sep) { c0 = c0 < 2496 ? c0 : 2496; c2 = c2 < 2656 ? c2 : 2656; }
  if (slot == 0) { a = 0; b = c0; } else if (slot == 2) { a = c0; b = c2; } else { a = c2; b = 3680; }
  if (slot < 4) { if (!tuned) return; }
  else if (!tuned) a = 0;
  conv_items<true>(p, 1, lds, wid0, a, b, r, n);
}
__device__ __forceinline__ void phase_rowA(const Params& p, int l, int wid0) {
  const int tid = opaque_tid(wid0), wid = tid >> 6, lane = tid & 63;
  const float* xlat = l == 0 ? p.x : p.out;
  const float* xctx = l == 0 ? p.ctx : (const float*)(p.ws + O_CTXB);
  const float* mod = (const float*)(p.ws + O_MOD);
  bf16_t* H = (bf16_t*)(p.ws + O_H);
  const float* nw = p.norm_w + (size_t)(l * 4 + 0) * 1024;
  for (int row = blockIdx.x * NWAVE + wid; row < NT; row += gridDim.x * NWAVE) {
    const float* xr = row < NL ? xlat + (size_t)row * 1024 : xctx + (size_t)(row - NL) * 1024;
    const int mr = row < NL ? (row >> 12) : 8;
    const float* md = mod + (size_t)(l * 9 + mr) * 6144;
    f32x4 v[4];
    float ss = 0.f;
#pragma unroll
    for (int i = 0; i < 4; ++i) {
      v[i] = *(const f32x4*)(xr + i * 256 + lane * 4);
      ss += v[i][0] * v[i][0] + v[i][1] * v[i][1] + v[i][2] * v[i][2] + v[i][3] * v[i][3];
    }
    ss = wave_sum(ss);
    const float rs = rsqrtf(ss * (1.0f / 1024.0f) + 1e-6f);
#pragma unroll
    for (int i = 0; i < 4; ++i) {
      const int e = i * 256 + lane * 4;
      const f32x4 w = *(const f32x4*)(nw + e), sh = *(const f32x4*)(md + e), sc = *(const f32x4*)(md + 1024 + e);
      f32x4 o;
#pragma unroll
      for (int j = 0; j < 4; ++j) o[j] = v[i][j] * rs * w[j] * (1.0f + sc[j]) + sh[j];
      st4bf(H + (size_t)row * 1024 + e, o);
    }
  }
}

struct EpiGin {
  char* ws; const float* lbp; int l; int pn0;
  __device__ __forceinline__ bool operator()(f32x4 (&acc)[2][2][4][2], const Unit& u, int wr, int wc, int fr, int fq) const {
    const int pn = u.pn + pn0;
    const int sec = pn >> 1, cin0 = (pn & 1) * 256;
    const size_t row0 = (size_t)u.pm * 256;
    if (sec >= 8) {
      const int tl = (wr * 4 + wc) * 64 + fq * 16 + fr;
      unsigned char* GT = (unsigned char*)(ws + O_G) + ((size_t)u.pm * 12 + (pn - 16)) * 65536 + (size_t)tl * 8;
      auto q8 = [](float z) { return __builtin_amdgcn_rcpf(__builtin_fmaf(__expf(-z), 0.00390625f, 0.00390625f)); };
#pragma unroll
      for (int ai = 0; ai < 2; ++ai)
#pragma unroll
        for (int m = 0; m < 4; ++m)
#pragma unroll
          for (int bj = 0; bj < 2; ++bj) {
            const f32x4 a = acc[ai][bj][m][0], b = acc[ai][bj][m][1];
            u32x2 w; w.x = 0u; w.y = 0u;
#pragma unroll
            for (int j = 0; j < 4; ++j) { w.x = __builtin_amdgcn_cvt_pk_u8_f32(q8(a[j]), j, w.x); w.y = __builtin_amdgcn_cvt_pk_u8_f32(q8(b[j]), j, w.y); }
            *(u32x2*)(GT + (size_t)((ai * 4 + m) * 2 + bj) * 4096) = w;
          }
    } else if (sec == 7) {
      bf16_t* VT = (bf16_t*)(ws + O_VT);
      pg8::epi_each(acc, wr, wc, fr, fq, [&](int r, int c, f32x4 v0, f32x4 v1) {
        const int chunk = u.pm * 2 + (r >> 7), q = r & 127, g = (cin0 + c) >> 7, d = c & 127;
        bf16_t* dst = VT + (((size_t)chunk * 4 + g) * 128 + d) * 128 + q;
#pragma unroll
        for (int j = 0; j < 4; ++j) { dst[j * 128] = f2bf(geluf_(v0[j])); dst[(4 + j) * 128] = f2bf(geluf_(v1[j])); }
      });
    } else if (sec == 1 || sec == 2) {
      bf16_t* LF = (bf16_t*)(ws + (sec == 1 ? O_LFF : O_LFB)) + row0 * 512 + cin0;
      const float* lbv = lbp + ((sec - 1) * 2 + l) * 512 + cin0;
      pg8::epi_each(acc, wr, wc, fr, fq, [&](int r, int c, f32x4 v0, f32x4 v1) {
        const f32x4 b0 = *(const f32x4*)(lbv + c), b1 = *(const f32x4*)(lbv + c + 4);
        f32x4 o0, o1;
#pragma unroll
        for (int j = 0; j < 4; ++j) {
          o0[j] = 1.0f - (fmaxf(b0[j], 1e-20f) + (1.0f - b0[j]) * sigmoidf_(v0[j]));
          o1[j] = 1.0f - (fmaxf(b1[j], 1e-20f) + (1.0f - b1[j]) * sigmoidf_(v1[j]));
        }
        st8bf(LF + (size_t)r * 512 + c, o0, o1);
      });
    } else {
      const size_t off = sec == 0 ? O_Q : sec == 3 ? O_I : sec == 4 ? O_GA : sec == 5 ? O_ZB : O_U;
      bf16_t* dst = (bf16_t*)(ws + off) + row0 * 512 + cin0;
      const int act = (sec == 0 || sec == 4) ? 1 : (sec == 6 ? 2 : 0);
      pg8::epi_each(acc, wr, wc, fr, fq, [&](int r, int c, f32x4 v0, f32x4 v1) {
        f32x4 o0, o1;
#pragma unroll
        for (int j = 0; j < 4; ++j) {
          o0[j] = act == 1 ? siluf_(v0[j]) : act == 2 ? geluf_(v0[j]) : v0[j];
          o1[j] = act == 1 ? siluf_(v1[j]) : act == 2 ? geluf_(v1[j]) : v1[j];
        }
        st8bf(dst + (size_t)r * 512 + c, o0, o1);
      });
    }
    return false;
  }
};
constexpr int GIN_R0 = 0;
__device__ __forceinline__ void phase_gin(const Params& p, int l, char* lds, int wid0) {
  const int tid = opaque_tid(wid0);
  PG8_LAS unsigned char* L = (PG8_LAS unsigned char*)lds;
  EpiGin E{p.ws, (const float*)(p.ws + O_LB), l, 0};
  pg8::GridSched S;
  const int R0 = gridDim.x == 256 ? GIN_R0 : 0;
  S.init(p.ws + O_H, p.ws + O_WIN, 1024, (l == 0 ? 136 : 128) - R0, 28, R0, gridDim.x, blockIdx.x);
  pg8::gemm_phase(L, 1024, S, E, tid);
  S.init(p.ws + O_H, p.ws + O_WIN, 1024, R0, 16, 0, gridDim.x, blockIdx.x);
  pg8::gemm_phase(L, 1024, S, E, tid);
  if (l == 1) {
    S.init(p.ws + O_H, p.ws + O_WIN, 1024, 8, 8, 128, gridDim.x, (blockIdx.x + gridDim.x / 2) % gridDim.x);
    pg8::gemm_phase(L, 1024, S, E, tid);
  }
}

__device__ __forceinline__ void phase_mix1(const Params& p, int l, char* lds0, int wid0, int kind, int bfirst, int bi_o = -1, int nb_o = 0) {
  const bool last = (l == 1);
  const int tid = opaque_tid(wid0), t = tid & 255, half = tid >> 8;
  char* lds = lds0 + half * 65536;
  const bf16_t* CS = (const bf16_t*)(p.ws + O_CS);
  const bf16_t* ZB = (const bf16_t*)(p.ws + O_ZB);
  const int NF1L = 2048, NF1C = last ? 0 : 128, NCH = last ? 256 : 272;
  const int ITEM0 = kind == 0 ? 0 : NF1L + NF1C, NITEM = kind == 0 ? NF1L + NF1C : NF1L + NF1C + NCH * 4;
  const int bi = nb_o > 0 ? bi_o : (int)blockIdx.x - bfirst, nb = nb_o > 0 ? nb_o : (int)gridDim.x - bfirst;
  if (bi < 0) return;
  for (int item = ITEM0 + bi * 2 + half; item < NITEM; item += nb * 2) {
    f32x4 acc[4][4];
    zero_acc(acc);
    if (item < NF1L + NF1C) {
      const bool isl = item < NF1L;
      int i = isl ? item : item - NF1L;
      const int mh = i & 1;
      i >>= 1;
      int tt, g, b;
      if (isl) { tt = i & 31; i >>= 5; } else { tt = i & 1; i >>= 1; }
      g = i & 3; b = i >> 2;
      const size_t rowbase = isl ? (size_t)b * 4096 + tt * 128 : (size_t)NL + b * 256 + tt * 128;
      RowLd la(CS, mh * 128, 128, t), lb(ZB + g * 128, rowbase, 512, t);
      gemm_main(acc, 2, la, lb, lds, t);
      bf16_t* dst = isl ? (bf16_t*)(p.ws + O_ZCL) + ((size_t)b * 512 + g * 128) * 8192 + mh * 4096 + tt * 128
                        : (bf16_t*)(p.ws + O_ZCC) + ((size_t)b * 512 + g * 128) * 512 + mh * 256 + tt * 128;
      const size_t ld = isl ? 8192 : 512;
      gemm_epi(acc, [&](int r, int c, f32x4 v) { st4bf(dst + (size_t)r * ld + c, v); }, t);
    } else {
      const int i = item - (NF1L + NF1C), ch = i >> 2, g = i & 3;
      const bf16_t* VT = (const bf16_t*)(p.ws + O_VT) + ((size_t)ch * 4 + g) * 128 * 128;
      float* rstd = (float*)lds;
      {
        float* part = (float*)(lds + 1024);
        const int dg = t >> 4, q8 = (t & 15) * 8;
        float ps[8];
#pragma unroll
        for (int j = 0; j < 8; ++j) ps[j] = 0.f;
#pragma unroll
        for (int i = 0; i < 8; ++i) {
          const u32x4 w = *(const u32x4*)(VT + (size_t)(i * 16 + dg) * 128 + q8);
          const float v0 = bflo(w.x), v1 = bfhi(w.x), v2 = bflo(w.y), v3 = bfhi(w.y), v4 = bflo(w.z), v5 = bfhi(w.z), v6 = bflo(w.w), v7 = bfhi(w.w);
          ps[0] += v0 * v0; ps[1] += v1 * v1; ps[2] += v2 * v2; ps[3] += v3 * v3; ps[4] += v4 * v4; ps[5] += v5 * v5; ps[6] += v6 * v6; ps[7] += v7 * v7;
        }
        *(f32x4*)(part + dg * 128 + q8) = (f32x4){ps[0], ps[1], ps[2], ps[3]};
        *(f32x4*)(part + dg * 128 + q8 + 4) = (f32x4){ps[4], ps[5], ps[6], ps[7]};
        __syncthreads();
        if (t < 128) {
          float ss = 0.f;
#pragma unroll
          for (int g2 = 0; g2 < 16; ++g2) ss += part[g2 * 128 + t];
          rstd[t] = rsqrtf(ss * (1.0f / 128.0f) + 1e-6f);
        }
      }
      __syncthreads();
      const float* wsg = p.sgu_w + ((size_t)l * 4 + g) * 128 * 128;
      const int kc = (t & 7) * 8;
      float rr[2][8];
#pragma unroll
      for (int h2 = 0; h2 < 2; ++h2)
#pragma unroll
        for (int j = 0; j < 8; ++j) rr[h2][j] = rstd[h2 * 64 + kc + j];
      __syncthreads();
      auto la = [&](int ii, int k0) -> bf16x8 {
        const float* s = wsg + (size_t)((t >> 3) + 32 * ii) * 128 + k0 + kc;
        const f32x4 a = *(const f32x4*)s, b = *(const f32x4*)(s + 4);
        const int h2 = k0 >> 6;
        u32x4 w;
        w.x = pk_bf16(a[0] * (h2 ? rr[1][0] : rr[0][0]), a[1] * (h2 ? rr[1][1] : rr[0][1]));
        w.y = pk_bf16(a[2] * (h2 ? rr[1][2] : rr[0][2]), a[3] * (h2 ? rr[1][3] : rr[0][3]));
        w.z = pk_bf16(b[0] * (h2 ? rr[1][4] : rr[0][4]), b[1] * (h2 ? rr[1][5] : rr[0][5]));
        w.w = pk_bf16(b[2] * (h2 ? rr[1][6] : rr[0][6]), b[3] * (h2 ? rr[1][7] : rr[0][7]));
        return __builtin_bit_cast(bf16x8, w);
      };
      RowLd lb(VT, 0, 128, t);
      gemm_main(acc, 2, la, lb, lds, t);
      bf16_t* U = (bf16_t*)(p.ws + O_U) + (size_t)ch * 128 * 512 + g * 128;
      const float* nwv = p.sgu_norm_w + ((size_t)l * 4 + g) * 128;
      const float* sb = p.sgu_b + ((size_t)l * 4 + g) * 128;
      {
        const int lane = t & 63, wid = t >> 6, fr = lane & 15, fq = lane >> 4, wr = wid >> 1, wc = wid & 1;
        bf16_t* ub = U + (size_t)(wr * 64 + fr) * 512 + wc * 64 + fq * 4;
        u32x2 uw[4][4];
#pragma unroll
        for (int m = 0; m < 4; ++m)
#pragma unroll
          for (int n = 0; n < 4; ++n) uw[m][n] = *(const u32x2*)(ub + (size_t)m * 16 * 512 + n * 16);
#pragma unroll
        for (int m = 0; m < 4; ++m) {
          const float bb = sb[wr * 64 + m * 16 + fr];
#pragma unroll
          for (int n = 0; n < 4; ++n) {
            const f32x4 nw4 = *(const f32x4*)(nwv + wc * 64 + n * 16 + fq * 4);
            const f32x4 v = acc[m][n];
            f32x4 o;
            o[0] = bflo(uw[m][n].x) * (v[0] * nw4[0] + bb);
            o[1] = bfhi(uw[m][n].x) * (v[1] * nw4[1] + bb);
            o[2] = bflo(uw[m][n].y) * (v[2] * nw4[2] + bb);
            o[3] = bfhi(uw[m][n].y) * (v[3] * nw4[3] + bb);
            st4bf(ub + (size_t)m * 16 * 512 + n * 16, o);
          }
        }
      }
    }
  }
  __syncthreads();
}

#define SCAN_BAR() do { asm volatile("s_waitcnt lgkmcnt(0)" ::: "memory"); __builtin_amdgcn_s_barrier(); asm volatile("" ::: "memory"); } while (0)
__device__ __forceinline__ void scan_item(const Params& p, int item, char* lds, const int tid) {
  const int dir = item & 1, h = (item >> 1) & 3, b = item >> 3;
  const int wv = tid >> 6, lane = tid & 63, fr = lane & 15, fq = lane >> 4;
  const bool isP = wv < 4;
  char* RAWB = lds + 69632;
  float* qsum = (float*)(lds + 143360);
  const bf16_t* Q = (const bf16_t*)(p.ws + O_Q);
  const bf16_t* LF = (const bf16_t*)(p.ws + (dir ? O_LFB : O_LFF));
  const bf16_t* I = (const bf16_t*)(p.ws + O_I);
  bf16_t* O = (bf16_t*)(p.ws + (dir ? O_OBK : O_OF));
  auto rowOf = [&](int u) -> size_t {
    if (u < 256) return (size_t)NL + b * 256 + (dir ? 255 - u : u);
    const int v = u - 256;
    return (size_t)b * 4096 + (dir ? 4095 - v : v);
  };
  const int cp = tid & 63, tq = (tid >> 6) & 3;
  const bf16_t* srcs[3] = {LF, Q, I};
  auto dma = [&](int cc) {
    PG8_LAS unsigned char* dstb = (PG8_LAS unsigned char*)RAWB + (cc % 3) * 24576;
#pragma unroll
    for (int j = 0; j < 6; ++j) {
      const int g = j * 4 + wv, arr = g >> 3, rg = g & 7;
      const size_t o = rowOf(cc * 32 + rg * 4 + (lane >> 4)) * 512 + h * 128 + (lane & 15) * 8;
      __builtin_amdgcn_global_load_lds((const unsigned*)(srcs[arr] + o), (PG8_LAS unsigned*)(dstb + arr * 8192 + rg * 1024), 16, 0, 0);
    }
  };
  unsigned wkk[8];
  auto prepA = [&](int cc) {
    const char* raw = RAWB + (cc % 3) * 24576;
#pragma unroll
    for (int i = 0; i < 8; ++i) wkk[i] = *(const unsigned*)(raw + (tq * 8 + i) * 256 + cp * 4);
    f32x2 run = {1.f, 1.f};
#pragma unroll
    for (int i = 0; i < 8; ++i) { const f32x2 kk = {bflo(wkk[i]), bfhi(wkk[i])}; run = run * (1.0f - kk); }
    *(f32x2*)(qsum + tq * 128 + cp * 2) = run;
  };
  auto prepB = [&](int cc) {
    const char* raw = RAWB + (cc % 3) * 24576;
    char* OPB = lds + (cc & 1) * 34816;
    char* QP = OPB; char* KM = OPB + 8704; char* KT = OPB + 17408; char* VT = OPB + 25600;
    float* emid = (float*)(OPB + 33792); float* eend = emid + 128;
    unsigned wq[8], wi[8];
#pragma unroll
    for (int i = 0; i < 8; ++i) { wq[i] = *(const unsigned*)(raw + 8192 + (tq * 8 + i) * 256 + cp * 4); wi[i] = *(const unsigned*)(raw + 16384 + (tq * 8 + i) * 256 + cp * 4); }
    const f32x2 q0 = *(const f32x2*)(qsum + cp * 2), q1 = *(const f32x2*)(qsum + 128 + cp * 2), q2 = *(const f32x2*)(qsum + 256 + cp * 2), q3 = *(const f32x2*)(qsum + 384 + cp * 2);
    const f32x2 one = {1.f, 1.f};
    const f32x2 pmid = q0 * q1, pend = pmid * q2 * q3;
    const f32x2 base = tq == 0 ? one : tq == 1 ? q0 : tq == 2 ? pmid : pmid * q2;
    f32x2 rmid; rmid.x = __builtin_amdgcn_rcpf(fmaxf(pmid.x, 1e-30f)); rmid.y = __builtin_amdgcn_rcpf(fmaxf(pmid.y, 1e-30f));
    f32x2 ebm = pend * rmid; ebm.x = fminf(ebm.x, 1.0f); ebm.y = fminf(ebm.y, 1.0f);
    f32x2 run = base * rmid;
    unsigned oq[8], ok[8], kt0[4], kt1[4], vt0[4], vt1[4];
    float pk0 = 0.f, pk1 = 0.f;
#pragma unroll
    for (int i = 0; i < 8; ++i) {
      const f32x2 kk = {bflo(wkk[i]), bfhi(wkk[i])}, qv = {bflo(wq[i]), bfhi(wq[i])};
      run = run * (one - kk);
      f32x2 ea; ea.x = fminf(fmaxf(run.x, 1e-26f), 1e26f); ea.y = fminf(fmaxf(run.y, 1e-26f), 1e26f);
      f32x2 er; er.x = __builtin_amdgcn_rcpf(ea.x); er.y = __builtin_amdgcn_rcpf(ea.y);
      const f32x2 km = kk * er, qp = qv * ea, kpp = km * ebm;
      oq[i] = pk_bf16(qp.x, qp.y);
      ok[i] = pk_bf16(km.x, km.y);
      if (i & 1) {
        kt0[i >> 1] = pk_bf16(pk0, kpp.x); kt1[i >> 1] = pk_bf16(pk1, kpp.y);
        vt0[i >> 1] = (wi[i - 1] & 0xffffu) | (wi[i] << 16); vt1[i >> 1] = (wi[i - 1] >> 16) | (wi[i] & 0xffff0000u);
      } else { pk0 = kpp.x; pk1 = kpp.y; }
    }
#pragma unroll
    for (int i = 0; i < 8; ++i) { *(unsigned*)(QP + (tq * 8 + i) * 272 + cp * 4) = oq[i]; *(unsigned*)(KM + (tq * 8 + i) * 272 + cp * 4) = ok[i]; }
    u32x4 w;
    w.x = kt0[0]; w.y = kt0[1]; w.z = kt0[2]; w.w = kt0[3]; *(u32x4*)(KT + (cp * 2) * 64 + tq * 16) = w;
    w.x = kt1[0]; w.y = kt1[1]; w.z = kt1[2]; w.w = kt1[3]; *(u32x4*)(KT + (cp * 2 + 1) * 64 + tq * 16) = w;
    w.x = vt0[0]; w.y = vt0[1]; w.z = vt0[2]; w.w = vt0[3]; *(u32x4*)(VT + (cp * 2) * 64 + tq * 16) = w;
    w.x = vt1[0]; w.y = vt1[1]; w.z = vt1[2]; w.w = vt1[3]; *(u32x4*)(VT + (cp * 2 + 1) * 64 + tq * 16) = w;
    if (tq == 0) { *(f32x2*)(emid + cp * 2) = pmid; *(f32x2*)(eend + cp * 2) = pend; }
  };
  const int mw = wv - 4;
  f32x4 S[2][8];
#pragma unroll
  for (int a = 0; a < 2; ++a)
#pragma unroll
    for (int m = 0; m < 8; ++m) S[a][m] = (f32x4){0.f, 0.f, 0.f, 0.f};

  if (isP) { dma(0); dma(1); dma(2); asm volatile("s_waitcnt vmcnt(12)" ::: "memory"); }
  SCAN_BAR();
  if (isP) prepA(0);
  SCAN_BAR();
  if (isP) { prepB(0); asm volatile("s_waitcnt vmcnt(6)" ::: "memory"); }
  SCAN_BAR();
  for (int c = 0; c < 136; ++c) {
    if (isP) {
      if (c + 3 < 136) dma(c + 3);
      if (c + 1 < 136) prepA(c + 1);
      SCAN_BAR();
      if (c + 1 < 136) prepB(c + 1);
      if (c + 3 < 136) asm volatile("s_waitcnt vmcnt(6)" ::: "memory");
      else asm volatile("s_waitcnt vmcnt(0)" ::: "memory");
      SCAN_BAR();
    } else {
      const char* OPB = lds + (c & 1) * 34816;
      const char* QP = OPB; const char* KM = OPB + 8704; const char* KT = OPB + 17408; const char* VT = OPB + 25600;
      const float* emid = (const float*)(OPB + 33792); const float* eend = emid + 128;
      f32x4 PT00 = (f32x4){0.f, 0.f, 0.f, 0.f}, PT01 = PT00, PT11 = PT00;
#pragma unroll
      for (int ks = 0; ks < 4; ++ks) {
        const bf16x8 X0 = *(const bf16x8*)(KM + fr * 272 + ks * 64 + fq * 16), X1 = *(const bf16x8*)(KM + (16 + fr) * 272 + ks * 64 + fq * 16);
        const bf16x8 Y0 = *(const bf16x8*)(QP + fr * 272 + ks * 64 + fq * 16), Y1 = *(const bf16x8*)(QP + (16 + fr) * 272 + ks * 64 + fq * 16);
        PT00 = __builtin_amdgcn_mfma_f32_16x16x32_bf16(X0, Y0, PT00, 0, 0, 0);
        PT01 = __builtin_amdgcn_mfma_f32_16x16x32_bf16(X0, Y1, PT01, 0, 0, 0);
        PT11 = __builtin_amdgcn_mfma_f32_16x16x32_bf16(X1, Y1, PT11, 0, 0, 0);
      }
      SCAN_BAR();
#pragma unroll
      for (int jj = 0; jj < 4; ++jj) if (fq * 4 + jj > fr) { PT00[jj] = 0.f; PT11[jj] = 0.f; }
      u32x4 x0, x1;
      x0.x = pk_bf16(PT00[0], PT00[1]); x0.y = pk_bf16(PT00[2], PT00[3]); x0.z = 0u; x0.w = 0u;
      x1.x = pk_bf16(PT01[0], PT01[1]); x1.y = pk_bf16(PT01[2], PT01[3]); x1.z = pk_bf16(PT11[0], PT11[1]); x1.w = pk_bf16(PT11[2], PT11[3]);
      const size_t orow0 = rowOf(c * 32);
      const long ostep = dir ? -512 : 512;
#pragma unroll
      for (int a = 0; a < 2; ++a) {
        const int vcol = (mw * 2 + a) * 16 + fr;
        f32x4 o0 = (f32x4){0.f, 0.f, 0.f, 0.f}, o1 = o0;
        {
          const u32x2 vlo = *(const u32x2*)(VT + vcol * 64 + fq * 8), vhi = *(const u32x2*)(VT + vcol * 64 + 32 + fq * 8);
          u32x4 yv; yv.x = vlo.x; yv.y = vlo.y; yv.z = vhi.x; yv.w = vhi.y;
          o0 = __builtin_amdgcn_mfma_f32_16x16x32_bf16(__builtin_bit_cast(bf16x8, x0), __builtin_bit_cast(bf16x8, yv), o0, 0, 0, 0);
          o1 = __builtin_amdgcn_mfma_f32_16x16x32_bf16(__builtin_bit_cast(bf16x8, x1), __builtin_bit_cast(bf16x8, yv), o1, 0, 0, 0);
        }
#pragma unroll
        for (int ks = 0; ks < 4; ++ks) {
          const f32x4 em0 = *(const f32x4*)(emid + (2 * ks) * 16 + fq * 4), em1 = *(const f32x4*)(emid + (2 * ks + 1) * 16 + fq * 4);
          u32x4 ys;
          ys.x = pk_bf16(S[a][2 * ks][0] * em0[0], S[a][2 * ks][1] * em0[1]); ys.y = pk_bf16(S[a][2 * ks][2] * em0[2], S[a][2 * ks][3] * em0[3]);
          ys.z = pk_bf16(S[a][2 * ks + 1][0] * em1[0], S[a][2 * ks + 1][1] * em1[1]); ys.w = pk_bf16(S[a][2 * ks + 1][2] * em1[2], S[a][2 * ks + 1][3] * em1[3]);
          const u32x2 a0 = *(const u32x2*)(QP + fr * 272 + ks * 64 + fq * 8), a1 = *(const u32x2*)(QP + fr * 272 + ks * 64 + 32 + fq * 8);
          const u32x2 c0 = *(const u32x2*)(QP + (16 + fr) * 272 + ks * 64 + fq * 8), c1 = *(const u32x2*)(QP + (16 + fr) * 272 + ks * 64 + 32 + fq * 8);
          u32x4 xa, xc; xa.x = a0.x; xa.y = a0.y; xa.z = a1.x; xa.w = a1.y; xc.x = c0.x; xc.y = c0.y; xc.z = c1.x; xc.w = c1.y;
          o0 = __builtin_amdgcn_mfma_f32_16x16x32_bf16(__builtin_bit_cast(bf16x8, xa), __builtin_bit_cast(bf16x8, ys), o0, 0, 0, 0);
          o1 = __builtin_amdgcn_mfma_f32_16x16x32_bf16(__builtin_bit_cast(bf16x8, xc), __builtin_bit_cast(bf16x8, ys), o1, 0, 0, 0);
        }
        bf16_t* op = O + orow0 * 512 + h * 128 + vcol;
#pragma unroll
        for (int jj = 0; jj < 4; ++jj) {
          op[(long)(fq * 4 + jj) * ostep] = f2bf(o0[jj]);
          op[(long)(16 + fq * 4 + jj) * ostep] = f2bf(o1[jj]);
        }
        {
          const bf16x8 yv2 = *(const bf16x8*)(VT + vcol * 64 + fq * 16);
#pragma unroll
          for (int m = 0; m < 8; ++m) {
            const f32x4 ee = *(const f32x4*)(eend + m * 16 + fq * 4);
            const bf16x8 xk = *(const bf16x8*)(KT + (m * 16 + fr) * 64 + fq * 16);
            S[a][m] = __builtin_amdgcn_mfma_f32_16x16x32_bf16(xk, yv2, S[a][m] * ee, 0, 0, 0);
          }
        }
      }
      SCAN_BAR();
    }
  }
  __syncthreads();
}

struct F2Sched {
  const char* FT; const char* ZF; int G, c;
  __device__ __forceinline__ bool next(int i, Unit& u) const {
    const int P = c - 64;
    if (i > 1 || P < 0 || P >= 128) return false;
    const int loc = P >> 3; u.z = (P & 7) | (i << 3); u.pm = loc >> 1; u.pn = loc & 1; return true;
  }
  __device__ __forceinline__ const char* aptr(const Unit& u) const { return FT + (size_t)((u.z >> 3) ^ 1) * ((size_t)2048 * KH * 2) + (size_t)u.pm * ((size_t)256 * KH * 2); }
  __device__ __forceinline__ const char* bptr(const Unit& u) const { return ZF + (size_t)((u.z >> 3) ^ 1) * ((size_t)4096 * KH * 2) + ((size_t)(u.z & 7) * 512 + (size_t)u.pn * 256) * ((size_t)KH * 2); }
};
struct F2CSched {
  const char* FT; const char* ZC; int c;
  __device__ __forceinline__ bool next(int i, Unit& u) const {
    const int L = c - 192; if (i != 0 || L < 0 || L >= 16) return false;
    u.z = L >> 1; u.pm = 0; u.pn = L & 1; return true;
  }
  __device__ __forceinline__ const char* aptr(const Unit&) const { return FT; }
  __device__ __forceinline__ const char* bptr(const Unit& u) const { return ZC + (size_t)u.z * (512u * 512u * 2u) + (size_t)u.pn * (256u * 512u * 2u); }
};
struct EpiF2 {
  bf16_t* OB; int ctx; float* SX;
  __device__ __forceinline__ bool operator()(f32x4 (&acc)[2][2][4][2], const Unit& u, int wr, int wc, int fr, int fq) const {
    if (ctx) {
      bf16_t* dst = OB + ((size_t)NL + (size_t)u.z * 256) * 512 + u.pn * 256;
      pg8::epi_each(acc, wr, wc, fr, fq, [&](int r, int c, f32x4 v0, f32x4 v1) { st8bf(dst + (size_t)r * 512 + c, v0, v1); });
      return false;
    }
    const int b = u.z & 7, part = u.z >> 3;
    const int tl = (wr * 4 + wc) * 64 + fq * 16 + fr;
    float* sx = SX + ((size_t)(b + 8 * (u.pm * 2 + u.pn)) * 16) * 4096 + (size_t)tl * 8;
    bf16_t* dst = OB + (size_t)b * 4096 * 512 + u.pn * 256;
#pragma unroll
    for (int ai = 0; ai < 2; ++ai)
#pragma unroll
      for (int m = 0; m < 4; ++m)
#pragma unroll
        for (int bj = 0; bj < 2; ++bj) {
          float* q = sx + (size_t)((ai * 4 + m) * 2 + bj) * 4096;
          if (part == 0) { *(f32x4*)q = acc[ai][bj][m][0]; *(f32x4*)(q + 4) = acc[ai][bj][m][1]; }
          else {
            const f32x4 s0 = *(const f32x4*)q, s1 = *(const f32x4*)(q + 4);
            const int k = u.pm * 256 + ai * 128 + wr * 64 + m * 16 + fr, c = bj * 128 + wc * 32 + 8 * fq;
            st8bf(dst + (size_t)k * 512 + c, acc[ai][bj][m][0], acc[ai][bj][m][1]);
            if (k >= 1) st8bf(dst + (size_t)(4096 - k) * 512 + c, acc[ai][bj][m][0] - 2.0f * s0, acc[ai][bj][m][1] - 2.0f * s1);
          }
        }
    return part == 0;
  }
};
__device__ __forceinline__ void phase_fold(const Params& p, char* lds, int wid0, int bfirst) {
  const int tid = opaque_tid(wid0);
  bf16_t* zrow = (bf16_t*)lds;
  const bf16_t* ZCL = (const bf16_t*)(p.ws + O_ZCL);
  bf16_t* ZF = (bf16_t*)(p.ws + O_ZF);
  bf16_t* OB = (bf16_t*)(p.ws + O_ZB);
  float* red = (float*)(lds + 16384);
  if ((int)blockIdx.x < bfirst) return;
  for (int row = (int)blockIdx.x - bfirst; row < 8 * 512; row += (int)gridDim.x - bfirst) {
    const bf16_t* src = ZCL + (size_t)row * 8192;
#pragma unroll
    for (int i = 0; i < 2; ++i) *(u32x4*)(zrow + (tid + i * 512) * 8) = *(const u32x4*)(src + (tid + i * 512) * 8);
    __syncthreads();
    float alt = 0.f;
    for (int e8 = tid; e8 < 2 * (KH / 8); e8 += NTHREADS) {
      const int part = e8 >= KH / 8 ? 1 : 0, e = part ? e8 - KH / 8 : e8;
      float v[8];
#pragma unroll
      for (int jx = 0; jx < 8; ++jx) {
        const int t = e * 8 + jx;
        if (!part) v[jx] = t > 2048 ? 0.f : (t == 0 || t == 2048) ? bf2f(zrow[t]) : bf2f(zrow[t]) + bf2f(zrow[4096 - t]);
        else v[jx] = (t == 0 || t >= 2048) ? 0.f : bf2f(zrow[4096 + t]) - bf2f(zrow[4096 + 4096 - t]);
      }
      u32x4 w;
      w.x = pk_bf16(v[0], v[1]); w.y = pk_bf16(v[2], v[3]); w.z = pk_bf16(v[4], v[5]); w.w = pk_bf16(v[6], v[7]);
      *(u32x4*)(ZF + ((size_t)part * 4096 + row) * KH + e * 8) = w;
      if (!part) alt += (bflo(w.x) - bfhi(w.x)) + (bflo(w.y) - bfhi(w.y)) + (bflo(w.z) - bfhi(w.z)) + (bflo(w.w) - bfhi(w.w));
    }
    alt = wave_sum(alt);
    if ((tid & 63) == 0) red[tid >> 6] = alt;
    __syncthreads();
    if (tid == 0) {
      float a = 0.f;
#pragma unroll
      for (int w8 = 0; w8 < 8; ++w8) a += red[w8];
      OB[((size_t)(row >> 9) * 4096 + 2048) * 512 + (row & 511)] = f2bf(a * bf2f(f2bf(0.0013810679320049757f)));
    }
  }
}
__device__ __forceinline__ void phase_mix2(const Params& p, int l, char* lds, int wid0) {
  const int tid = opaque_tid(wid0);
  if (blockIdx.x < 64) { scan_item(p, blockIdx.x, lds, tid); return; }
  unsigned* bar = (unsigned*)(p.ws + O_BAR);
  const int nb = (int)gridDim.x - 64;
  phase_mix1(p, l, lds, wid0, 0, 64);
  sub_barrier(bar + (l * 2 + 0) * 16, nb);
  phase_fold(p, lds, wid0, 64);
  sub_barrier(bar + (l * 2 + 1) * 16, nb);
  PG8_LAS unsigned char* L = (PG8_LAS unsigned char*)lds;
  {
    F2Sched S{p.ws + O_FTL, p.ws + O_ZF, (int)gridDim.x, (int)blockIdx.x};
    EpiF2 E{(bf16_t*)(p.ws + O_ZB), 0, (float*)(p.ws + O_ZCL)};
    pg8::gemm_phase(L, KH, S, E, tid);
  }
  if (l == 0) {
    F2CSched S{p.ws + O_FTC, p.ws + O_ZCC, (int)blockIdx.x};
    EpiF2 E{(bf16_t*)(p.ws + O_ZB), 1, nullptr};
    pg8::gemm_phase(L, 512, S, E, tid);
  }
  if (blockIdx.x >= 192) { for (int sh = 0; sh < 2; ++sh) phase_mix1(p, l, lds, wid0, 1, 64, ((int)blockIdx.x - 192) * 2 + sh, 512); }
  else { for (int sh = 0; sh < 3; ++sh) phase_mix1(p, l, lds, wid0, 1, 64, 128 + ((int)blockIdx.x - 64) * 3 + sh, 512); }
  if (gridDim.x == 256) {
    pg8::GridSched S;
    S.init(p.ws + O_H, p.ws + O_WIN + (size_t)16 * 256 * 1024 * 2, 1024, GIN_R0, 12, 0, (int)gridDim.x - 64, (int)blockIdx.x - 64);
    EpiGin E{p.ws, (const float*)(p.ws + O_LB), l, 16};
    pg8::gemm_phase(L, 1024, S, E, tid);
  }
}

__device__ __forceinline__ void phase_oa(const Params& p, int l, int wid0) {
  const int tid = opaque_tid(wid0), wid = tid >> 6, lane = tid & 63;
  const int nrow = (l == 1) ? NL : NT;
  const bf16_t* OF = (const bf16_t*)(p.ws + O_OF);
  const bf16_t* OK = (const bf16_t*)(p.ws + O_OBK);
  bf16_t* GA = (bf16_t*)(p.ws + O_GA);
  const float* gw = p.gnorm_w + (size_t)l * 128;
  for (int row = blockIdx.x * NWAVE + wid; row < nrow; row += gridDim.x * NWAVE) {
    const size_t o = (size_t)row * 512 + lane * 8;
    const u32x4 a = *(const u32x4*)(OF + o), b = *(const u32x4*)(OK + o), g = *(const u32x4*)(GA + o);
    float v[8];
    v[0] = bflo(a.x) + bflo(b.x); v[1] = bfhi(a.x) + bfhi(b.x);
    v[2] = bflo(a.y) + bflo(b.y); v[3] = bfhi(a.y) + bfhi(b.y);
    v[4] = bflo(a.z) + bflo(b.z); v[5] = bfhi(a.z) + bfhi(b.z);
    v[6] = bflo(a.w) + bflo(b.w); v[7] = bfhi(a.w) + bfhi(b.w);
    float ss = 0.f;
#pragma unroll
    for (int j = 0; j < 8; ++j) ss += v[j] * v[j];
    ss += __shfl_xor(ss, 1); ss += __shfl_xor(ss, 2); ss += __shfl_xor(ss, 4); ss += __shfl_xor(ss, 8);
    const float rs = rsqrtf(ss * (1.0f / 128.0f) + 1e-6f);
    const float* gwp = gw + (lane & 15) * 8;
    const f32x4 w0 = *(const f32x4*)gwp, w1 = *(const f32x4*)(gwp + 4);
    float gg[8] = {bflo(g.x), bfhi(g.x), bflo(g.y), bfhi(g.y), bflo(g.z), bfhi(g.z), bflo(g.w), bfhi(g.w)};
    u32x4 w;
    w.x = pk_bf16(v[0] * rs * w0[0] * gg[0], v[1] * rs * w0[1] * gg[1]);
    w.y = pk_bf16(v[2] * rs * w0[2] * gg[2], v[3] * rs * w0[3] * gg[3]);
    w.z = pk_bf16(v[4] * rs * w1[0] * gg[4], v[5] * rs * w1[1] * gg[5]);
    w.w = pk_bf16(v[6] * rs * w1[2] * gg[6], v[7] * rs * w1[3] * gg[7]);
    *(u32x4*)(GA + o) = w;
  }
}

#define HC_MERGE 136
#define HC_MOE1  152
__device__ __forceinline__ void hc_publish(unsigned* cnt) {
  asm volatile("s_waitcnt vmcnt(0)" ::: "memory");
  __syncthreads();
  if (threadIdx.x == 0) { __threadfence(); (void)xb_add(cnt, 1u); }
}
__device__ __forceinline__ void hc_wait(unsigned* bar, unsigned* cnt, unsigned target) {
  if (threadIdx.x == 0) { XB_SPIN(xb_ld(cnt) < target, bar); __threadfence(); }
  __syncthreads();
}
struct OneSched {
  const char* A; const char* B; int pm, pn, z;
  __device__ __forceinline__ bool next(int i, Unit& u) const { if (i) return false; u.pm = pm; u.pn = pn; u.z = z; return true; }
  __device__ __forceinline__ const char* aptr(const Unit&) const { return A; }
  __device__ __forceinline__ const char* bptr(const Unit&) const { return B; }
};
struct EpiStoreBf16 {
  bf16_t* dst; int ld;
  __device__ __forceinline__ bool operator()(f32x4 (&acc)[2][2][4][2], const Unit& u, int wr, int wc, int fr, int fq) const {
    bf16_t* d = dst + (size_t)u.pm * 256 * ld + u.pn * 256;
    pg8::epi_each(acc, wr, wc, fr, fq, [&](int r, int c, f32x4 v0, f32x4 v1) { st8bf(d + (size_t)r * ld + c, v0, v1); });
    return false;
  }
};
struct MergeSched {
  const char* ws; int ntile, G, c, fuse;
  __device__ __forceinline__ bool next(int i, Unit& u) const {
    const int xcd = c & 7, q = c >> 3;
    int rnd = i / 3;
    if (fuse && c < 32) rnd = rnd == 0 ? 2 : rnd == 2 ? 0 : rnd;
    u.pm = (rnd * (G >> 5) + (q >> 2)) * 8 + xcd; u.pn = q & 3; u.z = i % 3;
    return u.pm * 4 < ntile && (q >> 2) < (G >> 5);
  }
  __device__ __forceinline__ const char* aptr(const Unit& u) const {
    return ws + (u.z == 0 ? O_GA : u.z == 1 ? O_ZB : O_U) + (size_t)u.pm * (256u * 512u * 2u);
  }
  __device__ __forceinline__ const char* bptr(const Unit& u) const { return ws + O_WBR + (size_t)u.z * (1024u * 512u * 2u) + (size_t)u.pn * (256u * 512u * 2u); }
};
struct EpiMerge {
  char* ws; int fuse;
  __device__ __forceinline__ bool operator()(f32x4 (&acc)[2][2][4][2], const Unit& u, int wr, int wc, int fr, int fq) const {
    const int tl = (wr * 4 + wc) * 64 + fq * 16 + fr;
    const unsigned char* GT = (const unsigned char*)(ws + O_G) + ((size_t)u.pm * 12 + u.z * 4 + u.pn) * 65536 + (size_t)tl * 8;
    auto ub = [](unsigned w, int k) { return (float)((w >> (8 * k)) & 0xffu) + 0.5f; };
    bf16_t* MG = (bf16_t*)(ws + O_H) + (size_t)u.pm * 256 * 1024 + u.pn * 256;
    const bool lastj = (u.z == 2);
#pragma unroll
    for (int ai = 0; ai < 2; ++ai)
#pragma unroll
      for (int m = 0; m < 4; ++m)
#pragma unroll
        for (int bj = 0; bj < 2; ++bj) {
          const int cidx = (ai * 4 + m) * 2 + bj;
          const u32x2 gw = *(const u32x2*)(GT + (size_t)cidx * 4096);
          f32x4 g0, g1;
#pragma unroll
          for (int q = 0; q < 4; ++q) { g0[q] = ub(gw.x, q); g1[q] = ub(gw.y, q); }
          if (lastj) {
            const int r = ai * 128 + wr * 64 + m * 16 + fr, c = bj * 128 + wc * 32 + 8 * fq;
            st8bf(MG + (size_t)r * 1024 + c, acc[ai][bj][m][0] * (g0 * 0.00390625f), acc[ai][bj][m][1] * (g1 * 0.00390625f));
          } else {
            const u32x2 hw = *(const u32x2*)(GT + 4 * 65536 + (size_t)cidx * 4096);
#pragma unroll
            for (int q = 0; q < 4; ++q) {
              acc[ai][bj][m][0][q] *= g0[q] * __builtin_amdgcn_rcpf(ub(hw.x, q));
              acc[ai][bj][m][1][q] *= g1[q] * __builtin_amdgcn_rcpf(ub(hw.y, q));
            }
          }
        }
    if (fuse && lastj && u.pm >= 128) hc_publish((unsigned*)(ws + O_BAR) + HC_MERGE);
    return !lastj;
  }
};
__device__ __forceinline__ void phase_merge(const Params& p, int l, char* lds, int wid0) {
  const int tid = opaque_tid(wid0);
  const int fuse = (l == 0 && gridDim.x == 256) ? 1 : 0;
  MergeSched S{p.ws, (l == 1 ? 128 : 136) * 4, (int)gridDim.x, (int)blockIdx.x, fuse};
  EpiMerge E{p.ws, fuse};
  pg8::gemm_phase((PG8_LAS unsigned char*)lds, 512, S, E, tid);
  if (fuse) {
    const int c = (int)blockIdx.x;
    if (c >= 32 && c < 64) {
      unsigned* bar = (unsigned*)(p.ws + O_BAR);
      hc_wait(bar, bar + HC_MERGE, 32u);
      const int pm = 128 + (c & 7), pn = (c >> 3) - 4;
      OneSched S2{p.ws + O_H + (size_t)pm * (256u * 1024u * 2u), p.ws + O_WOUT + (size_t)pn * (256u * 1024u * 2u), pm, pn, 0};
      EpiStoreBf16 E2{(bf16_t*)(p.ws + O_Y), 1024};
      pg8::gemm_phase((PG8_LAS unsigned char*)lds, 1024, S2, E2, tid);
    } else if (c >= 64) conv_fill(p, lds, wid0, 0, c - 64, 192);
  }
}

__device__ __forceinline__ void phase_wout(const Params& p, int l, char* lds, int wid0) {
  const int tid = opaque_tid(wid0);
  pg8::GridSched S;
  const bool fuse = l == 0 && gridDim.x == 256;
  S.init(p.ws + O_H, p.ws + O_WOUT, 1024, (l == 1 || fuse) ? 128 : 136, 4, 0, gridDim.x, blockIdx.x);
  EpiStoreBf16 E{(bf16_t*)(p.ws + O_Y), 1024};
  pg8::gemm_phase((PG8_LAS unsigned char*)lds, 1024, S, E, tid);
}

template <int l>
__device__ __forceinline__ void phase_rowB(const Params& p, char* lds, int wid0) {
  const int tid = opaque_tid(wid0), wid = tid >> 6, lane = tid & 63;
  const int nrow = (l == 1) ? NL : NT;
  const float* xlat = l == 0 ? p.x : p.out;
  const float* xctx = l == 0 ? p.ctx : (const float*)(p.ws + O_CTXB);
  const float* mod = (const float*)(p.ws + O_MOD);
  bf16_t* Y = (bf16_t*)(p.ws + O_Y);
  bf16_t* H = (bf16_t*)(p.ws + O_H);
  float* aff = (float*)(p.ws + O_AFF);
  const float* nw1 = p.norm_w + (size_t)(l * 4 + 1) * 1024;
  const float* nw2 = p.norm_w + (size_t)(l * 4 + 2) * 1024;
  const float* rw = p.router_w + (size_t)l * 1024 * 16;
  float* rwT = (float*)lds;
  for (int i = tid; i < 16384; i += NTHREADS) rwT[(i & 15) * 1024 + (i >> 4)] = rw[i];
  __syncthreads();
  u32x4 pfy[2]; f32x4 pfx[4];
  auto fetch = [&](int row) {
    const float* xr = row < NL ? xlat + (size_t)row * 1024 : xctx + (size_t)(row - NL) * 1024;
#pragma unroll
    for (int i = 0; i < 2; ++i) {
      const int e = i * 512 + lane * 8;
      pfy[i] = *(const u32x4*)(Y + (size_t)row * 1024 + e);
      if (l == 1) pfx[i * 2] = *(const f32x4*)((const bf16_t*)p.out + (size_t)row * 1024 + e);
      else { pfx[i * 2] = *(const f32x4*)(xr + e); pfx[i * 2 + 1] = *(const f32x4*)(xr + e + 4); }
    }
  };
  const int row0 = blockIdx.x * NWAVE + wid, rstep = gridDim.x * NWAVE;
  if (row0 < nrow) fetch(row0);
  for (int row = row0; row < nrow; row += rstep) {
    const int mr = row < NL ? (row >> 12) : 8;
    const float* md = mod + (size_t)(l * 9 + mr) * 6144;
    float yv[16], xv[16];
    float ss = 0.f;
#pragma unroll
    for (int i = 0; i < 2; ++i) {
      const u32x4 w = pfy[i];
      yv[i * 8 + 0] = bflo(w.x); yv[i * 8 + 1] = bfhi(w.x); yv[i * 8 + 2] = bflo(w.y); yv[i * 8 + 3] = bfhi(w.y);
      yv[i * 8 + 4] = bflo(w.z); yv[i * 8 + 5] = bfhi(w.z); yv[i * 8 + 6] = bflo(w.w); yv[i * 8 + 7] = bfhi(w.w);
      if (l == 1) {
        const u32x4 xw = __builtin_bit_cast(u32x4, pfx[i * 2]);
        xv[i * 8 + 0] = bflo(xw.x); xv[i * 8 + 1] = bfhi(xw.x); xv[i * 8 + 2] = bflo(xw.y); xv[i * 8 + 3] = bfhi(xw.y);
        xv[i * 8 + 4] = bflo(xw.z); xv[i * 8 + 5] = bfhi(xw.z); xv[i * 8 + 6] = bflo(xw.w); xv[i * 8 + 7] = bfhi(xw.w);
      } else {
        const f32x4 a = pfx[i * 2], b = pfx[i * 2 + 1];
#pragma unroll
        for (int j = 0; j < 4; ++j) { xv[i * 8 + j] = a[j]; xv[i * 8 + 4 + j] = b[j]; }
      }
    }
    if (row + rstep < nrow) fetch(row + rstep);
#pragma unroll
    for (int j = 0; j < 16; ++j) ss += yv[j] * yv[j];
    ss = wave_sum(ss);
    const float rs = rsqrtf(ss * (1.0f / 1024.0f) + 1e-6f);
    float ss2 = 0.f;
#pragma unroll
    for (int i = 0; i < 2; ++i) {
      const int e = i * 512 + lane * 8;
#pragma unroll
      for (int h4 = 0; h4 < 2; ++h4) {
        const f32x4 w = *(const f32x4*)(nw1 + e + h4 * 4), g1 = *(const f32x4*)(md + 2048 + e + h4 * 4);
#pragma unroll
        for (int j = 0; j < 4; ++j) {
          const int q = i * 8 + h4 * 4 + j;
          xv[q] = xv[q] + g1[j] * (yv[q] * rs * w[j]);
          ss2 += xv[q] * xv[q];
        }
      }
      u32x4 o;
      o.x = pk_bf16(xv[i * 8 + 0], xv[i * 8 + 1]); o.y = pk_bf16(xv[i * 8 + 2], xv[i * 8 + 3]); o.z = pk_bf16(xv[i * 8 + 4], xv[i * 8 + 5]); o.w = pk_bf16(xv[i * 8 + 6], xv[i * 8 + 7]);
      *(u32x4*)(Y + (size_t)row * 1024 + e) = o;
    }
    ss2 = wave_sum(ss2);
    const float rs2 = rsqrtf(ss2 * (1.0f / 1024.0f) + 1e-6f);
    float lg[16];
#pragma unroll
    for (int e2 = 0; e2 < 16; ++e2) lg[e2] = 0.f;
#pragma unroll
    for (int i = 0; i < 2; ++i) {
      const int e = i * 512 + lane * 8;
      float hv[8];
#pragma unroll
      for (int h4 = 0; h4 < 2; ++h4) {
        const f32x4 w = *(const f32x4*)(nw2 + e + h4 * 4), sh = *(const f32x4*)(md + 3072 + e + h4 * 4), sc = *(const f32x4*)(md + 4096 + e + h4 * 4);
#pragma unroll
        for (int j = 0; j < 4; ++j) hv[h4 * 4 + j] = xv[i * 8 + h4 * 4 + j] * rs2 * w[j] * (1.0f + sc[j]) + sh[j];
      }
      u32x4 w;
      w.x = pk_bf16(hv[0], hv[1]); w.y = pk_bf16(hv[2], hv[3]); w.z = pk_bf16(hv[4], hv[5]); w.w = pk_bf16(hv[6], hv[7]);
      *(u32x4*)(H + (size_t)row * 1024 + e) = w;
#pragma unroll
      for (int e2 = 0; e2 < 16; ++e2) {
        const f32x4 r0 = *(const f32x4*)(rwT + e2 * 1024 + e), r1 = *(const f32x4*)(rwT + e2 * 1024 + e + 4);
        lg[e2] += hv[0] * r0[0] + hv[1] * r0[1] + hv[2] * r0[2] + hv[3] * r0[3] + hv[4] * r1[0] + hv[5] * r1[1] + hv[6] * r1[2] + hv[7] * r1[3];
        if ((e2 & 3) == 3) __builtin_amdgcn_sched_barrier(0);
      }
    }
    float a8[8], a4[4], a2[2], a1;
    {
      const bool up = (lane & 32) != 0;
#pragma unroll
      for (int j = 0; j < 8; ++j) { const float mine = up ? lg[8 + j] : lg[j], other = up ? lg[j] : lg[8 + j]; a8[j] = mine + __shfl_xor(other, 32); }
    }
    {
      const bool up = (lane & 16) != 0;
#pragma unroll
      for (int j = 0; j < 4; ++j) { const float mine = up ? a8[4 + j] : a8[j], other = up ? a8[j] : a8[4 + j]; a4[j] = mine + __shfl_xor(other, 16); }
    }
    {
      const bool up = (lane & 8) != 0;
#pragma unroll
      for (int j = 0; j < 2; ++j) { const float mine = up ? a4[2 + j] : a4[j], other = up ? a4[j] : a4[2 + j]; a2[j] = mine + __shfl_xor(other, 8); }
    }
    {
      const bool up = (lane & 4) != 0;
      const float mine = up ? a2[1] : a2[0], other = up ? a2[0] : a2[1];
      a1 = mine + __shfl_xor(other, 4);
    }
    a1 += __shfl_xor(a1, 2);
    a1 += __shfl_xor(a1, 1);
    float mx = a1;
    mx = fmaxf(mx, __shfl_xor(mx, 4)); mx = fmaxf(mx, __shfl_xor(mx, 8)); mx = fmaxf(mx, __shfl_xor(mx, 16)); mx = fmaxf(mx, __shfl_xor(mx, 32));
    const float ex = expf(a1 - mx);
    float se = ex;
    se += __shfl_xor(se, 4); se += __shfl_xor(se, 8); se += __shfl_xor(se, 16); se += __shfl_xor(se, 32);
    if ((lane & 3) == 0) {
      const int e2 = ((lane >> 5) & 1) * 8 + ((lane >> 4) & 1) * 4 + ((lane >> 3) & 1) * 2 + ((lane >> 2) & 1);
      aff[(size_t)row * 16 + e2] = ex / se;
    }
  }
}

template <int NI, int T>
__device__ __forceinline__ void topk_body(const Params& p, int s, int e, char* lds, const int tid) {
  constexpr int CAP = T / 8;
  typedef unsigned long long u64;
  int* cntw = (int*)lds;
  int* wcnt = (int*)(lds + 256);
  int* woff = (int*)(lds + 512);
  const int wid = tid >> 6, lane = tid & 63;
  const bool isl = T == 4096;
  const size_t rowbase = isl ? (size_t)s * 4096 : (size_t)NL + (size_t)(s - 8) * 256;
  const float* aff = (const float*)(p.ws + O_AFF);
  int* sel = (int*)(p.ws + O_SEL);
  float* gate = (float*)(p.ws + O_GATE);
  int* tok = (int*)(p.ws + O_TOK);
  u64 key[NI];
  float av[NI];
#pragma unroll
  for (int q = 0; q < NI; ++q) {
    const int i = tid + q * NTHREADS;
    av[q] = 0.f; key[q] = 0ull;
    if (i < T) {
      av[q] = aff[(rowbase + i) * 16 + e];
      key[q] = ((u64)__float_as_uint(av[q]) << 12) | (u64)(4095 - i);
    }
  }
  u64 prefix = 0ull;
  for (int bit = 43; bit >= 0; --bit) {
    const u64 cand = prefix | (1ull << bit);
    int c = 0;
#pragma unroll
    for (int q = 0; q < NI; ++q) c += __popcll(__ballot(key[q] >= cand));
    if (lane == 0) cntw[(bit & 1) * 8 + wid] = c;
    __syncthreads();
    int tot = 0;
#pragma unroll
    for (int w = 0; w < 8; ++w) tot += cntw[(bit & 1) * 8 + w];
    if (tot >= CAP) prefix = cand;
  }
  int before[NI];
  bool in[NI];
#pragma unroll
  for (int q = 0; q < NI; ++q) {
    in[q] = key[q] >= prefix && key[q] != 0ull;
    const u64 m = __ballot(in[q]);
    before[q] = __popcll(m & ((1ull << lane) - 1ull));
    if (lane == 0) wcnt[q * 8 + wid] = __popcll(m);
  }
  __syncthreads();
  if (tid < 64) {
    int v = tid < NI * 8 ? wcnt[tid] : 0, x = v;
#pragma unroll
    for (int o = 1; o < 64; o <<= 1) { const int y = __shfl_up(x, o); if (lane >= o) x += y; }
    if (tid < NI * 8) woff[tid] = x - v;
  }
  __syncthreads();
  const size_t slotbase = isl ? ((size_t)e * 8 + s) * CAP : (size_t)NSLOT_L + ((size_t)e * 8 + (s - 8)) * CAP;
#pragma unroll
  for (int q = 0; q < NI; ++q) {
    const int i = tid + q * NTHREADS;
    if (i < T) {
      const int slot = woff[q * 8 + wid] + before[q];
      sel[(rowbase + i) * 16 + e] = in[q] ? slot : -1;
      if (in[q]) {
        tok[slotbase + slot] = (int)(rowbase + i);
        gate[slotbase + slot] = av[q];
      }
    }
  }
  __syncthreads();
}
__device__ __forceinline__ void phase_topk(const Params& p, int l, char* lds, int wid0) {
  const int tid = opaque_tid(wid0);
  const int NITEM = (l == 1) ? 128 : 256;
  for (int item = blockIdx.x; item < NITEM; item += gridDim.x) {
    const int s = item >> 4, e = item & 15;
    if (s < 8) topk_body<8, 4096>(p, s, e, lds, tid);
    else topk_body<1, 256>(p, s, e, lds, tid);
  }
}

struct MoeSched {
  const char* A; const char* W; int nN, nunit, G, c; size_t estep; int swap = 0;
  __device__ __forceinline__ bool next(int i, Unit& u) const {
    const int xcd = c & 7, q = c >> 3, per = (G >> 3) / nN;
    int ii = i;
    if (swap && xcd < 4) ii = i == 0 ? 8 : i == 8 ? 0 : i;
    u.pn = q % nN; u.pm = (ii * 8 + xcd) * per + q / nN;
    if (q >= per * nN || u.pm * nN >= nunit) return false;
    u.z = u.pm < 256 ? (u.pm >> 4) : (u.pm - 256); return true;
  }
  __device__ __forceinline__ const char* aptr(const Unit& u) const { return A + (size_t)u.pm * (256u * 1024u * 2u); }
  __device__ __forceinline__ const char* bptr(const Unit& u) const { return W + (size_t)u.z * estep + (size_t)u.pn * (256u * 1024u * 2u); }
};
struct MoeSchedG : MoeSched {
  static constexpr bool GATHER = true;
  const int* tok;
  __device__ __forceinline__ const char* aptr(const Unit&) const { return A; }
  __device__ __forceinline__ const int* tokptr(const Unit& u) const { return tok + (size_t)u.pm * 256; }
};
struct EpiSwiglu {
  bf16_t* HID; unsigned* cnt;
  __device__ __forceinline__ bool operator()(f32x4 (&acc)[2][2][4][2], const Unit& u, int wr, int wc, int fr, int fq) const {
    bf16_t* d = HID + (size_t)u.pm * 256 * 1024 + u.pn * 128;
#pragma unroll
    for (int ai = 0; ai < 2; ++ai)
#pragma unroll
      for (int m = 0; m < 4; ++m) {
        f32x4 o0, o1;
#pragma unroll
        for (int j = 0; j < 4; ++j) { o0[j] = siluf_(acc[ai][0][m][0][j]) * acc[ai][1][m][0][j]; o1[j] = siluf_(acc[ai][0][m][1][j]) * acc[ai][1][m][1][j]; }
        st8bf(d + (size_t)(ai * 128 + wr * 64 + m * 16 + fr) * 1024 + wc * 32 + 8 * fq, o0, o1);
      }
    if (cnt && u.pm >= 256) hc_publish(cnt);
    return false;
  }
};
__device__ __forceinline__ void phase_moe1(const Params& p, int l, char* lds, int wid0) {
  const int tid = opaque_tid(wid0);
  const int nrt = (l == 1) ? 256 : 272;
  MoeSchedG S;
  S.A = p.ws + O_H; S.W = l == 1 ? (const char*)p.out + OUT_W13B : p.ws + O_W13; S.nN = 8; S.nunit = nrt * 8; S.G = (int)gridDim.x; S.c = (int)blockIdx.x; S.estep = (size_t)2048 * 1024 * 2;
  S.tok = (const int*)(p.ws + O_TOK);
  const bool fuse = l == 0 && gridDim.x == 256;
  S.swap = fuse ? 1 : 0;
  unsigned* bar = (unsigned*)(p.ws + O_BAR);
  EpiSwiglu E{(bf16_t*)(p.ws + O_HID), fuse ? bar + HC_MOE1 : nullptr};
  pg8::gemm_phase((PG8_LAS unsigned char*)lds, 1024, S, E, tid);
  if (fuse) {
    const int xcd = (int)blockIdx.x & 7, q = (int)blockIdx.x >> 3;
    if (xcd >= 4 && q < 16) {
      const int r = q * 4 + xcd - 4, e = r >> 2, pn = r & 3, pm = 256 + e;
      hc_wait(bar, bar + HC_MOE1, 128u);
      OneSched S2{p.ws + O_HID + (size_t)pm * (256u * 1024u * 2u), p.ws + O_W2 + (size_t)e * ((size_t)1024 * 1024 * 2) + (size_t)pn * (256u * 1024u * 2u), pm, pn, e};
      EpiStoreBf16 E2{(bf16_t*)(p.ws + O_YS), 1024};
      pg8::gemm_phase((PG8_LAS unsigned char*)lds, 1024, S2, E2, tid);
    } else if (xcd >= 4) conv_fill(p, lds, wid0, 2, (q - 16) * 4 + xcd - 4, 64);
  }
}
__device__ __forceinline__ void phase_moe2(const Params& p, int l, char* lds, int wid0) {
  const int tid = opaque_tid(wid0);
  const int nrt = (l == 1 || gridDim.x == 256) ? 256 : 272;
  MoeSched S{p.ws + O_HID, p.ws + (l == 1 && p.w2sep ? O_W2B : O_W2), 4, nrt * 4, (int)gridDim.x, (int)blockIdx.x, (size_t)1024 * 1024 * 2};
  EpiStoreBf16 E{(bf16_t*)(p.ws + O_YS), 1024};
  pg8::gemm_phase((PG8_LAS unsigned char*)lds, 1024, S, E, tid);
}

__device__ __forceinline__ void phase_rowC(const Params& p, int l, int wid0) {
  const int tid = opaque_tid(wid0), wid = tid >> 6, lane = tid & 63;
  const int nrow = (l == 1) ? NL : NT;
  float* olat = p.out;
  float* octx = (float*)(p.ws + O_CTXB);
  const float* mod = (const float*)(p.ws + O_MOD);
  const bf16_t* YS = (const bf16_t*)(p.ws + O_YS);
  const int* sel = (const int*)(p.ws + O_SEL);
  const float* gate = (const float*)(p.ws + O_GATE);
  const float* nw3 = p.norm_w + (size_t)(l * 4 + 3) * 1024;
  const float* nwn = p.norm_w + (size_t)((l + 1) * 4 + 0) * 1024;
  bf16_t* H = (bf16_t*)(p.ws + O_H);
  const bf16_t* X1 = (const bf16_t*)(p.ws + O_Y);
  int pfrk; u32x4 pfx[2];
  auto fetch = [&](int row) {
    pfrk = sel[(size_t)row * 16 + (lane & 15)];
#pragma unroll
    for (int i = 0; i < 2; ++i) pfx[i] = *(const u32x4*)(X1 + (size_t)row * 1024 + i * 512 + lane * 8);
  };
  const int row0 = blockIdx.x * NWAVE + wid, rstep = gridDim.x * NWAVE;
  if (row0 < nrow) fetch(row0);
  for (int row = row0; row < nrow; row += rstep) {
    float* xo = row < NL ? olat + (size_t)row * 1024 : octx + (size_t)(row - NL) * 1024;
    const bool isl = row < NL;
    const int mr = isl ? (row >> 12) : 8;
    const int s = isl ? (row >> 12) : ((row - NL) >> 8);
    const float* md = mod + (size_t)(l * 9 + mr) * 6144;
    float mv[16];
#pragma unroll
    for (int j = 0; j < 16; ++j) mv[j] = 0.f;
    const int myrk = pfrk;
    u32x4 xcur[2];
#pragma unroll
    for (int i = 0; i < 2; ++i) xcur[i] = pfx[i];
    if (row + rstep < nrow) fetch(row + rstep);
    unsigned long long chosen = __ballot(myrk >= 0) & 0xffffull;
    while (chosen) {
      const int e0 = __builtin_ctzll(chosen); chosen &= chosen - 1;
      const int e1 = chosen ? __builtin_ctzll(chosen) : -1; if (chosen) chosen &= chosen - 1;
      const int rk0 = __shfl(myrk, e0), rk1 = e1 >= 0 ? __shfl(myrk, e1) : 0;
      const size_t slot0 = isl ? ((size_t)e0 * 8 + s) * 512 + rk0 : (size_t)NSLOT_L + ((size_t)e0 * 8 + s) * 32 + rk0;
      const size_t slot1 = e1 < 0 ? slot0 : (isl ? ((size_t)e1 * 8 + s) * 512 + rk1 : (size_t)NSLOT_L + ((size_t)e1 * 8 + s) * 32 + rk1);
      u32x4 w[4];
#pragma unroll
      for (int i = 0; i < 2; ++i) { w[i] = *(const u32x4*)(YS + slot0 * 1024 + i * 512 + lane * 8); w[2 + i] = *(const u32x4*)(YS + slot1 * 1024 + i * 512 + lane * 8); }
      const float m0 = gate[slot0], m1 = e1 >= 0 ? gate[slot1] : 0.f;
#pragma unroll
      for (int i = 0; i < 2; ++i) {
        mv[i * 8 + 0] += m0 * bflo(w[i].x) + m1 * bflo(w[2 + i].x); mv[i * 8 + 1] += m0 * bfhi(w[i].x) + m1 * bfhi(w[2 + i].x);
        mv[i * 8 + 2] += m0 * bflo(w[i].y) + m1 * bflo(w[2 + i].y); mv[i * 8 + 3] += m0 * bfhi(w[i].y) + m1 * bfhi(w[2 + i].y);
        mv[i * 8 + 4] += m0 * bflo(w[i].z) + m1 * bflo(w[2 + i].z); mv[i * 8 + 5] += m0 * bfhi(w[i].z) + m1 * bfhi(w[2 + i].z);
        mv[i * 8 + 6] += m0 * bflo(w[i].w) + m1 * bflo(w[2 + i].w); mv[i * 8 + 7] += m0 * bfhi(w[i].w) + m1 * bfhi(w[2 + i].w);
      }
    }
    float ss = 0.f;
#pragma unroll
    for (int j = 0; j < 16; ++j) ss += mv[j] * mv[j];
    ss = wave_sum(ss);
    const float rs = rsqrtf(ss * (1.0f / 1024.0f) + 1e-6f);
    float xn[16], ssn = 0.f;
#pragma unroll
    for (int i = 0; i < 2; ++i) {
      const int e = i * 512 + lane * 8;
#pragma unroll
      for (int h4 = 0; h4 < 2; ++h4) {
        const f32x4 w = *(const f32x4*)(nw3 + e + h4 * 4), g2 = *(const f32x4*)(md + 5120 + e + h4 * 4);
        f32x4 xv;
        if (h4 == 0) { xv[0] = bflo(xcur[i].x); xv[1] = bfhi(xcur[i].x); xv[2] = bflo(xcur[i].y); xv[3] = bfhi(xcur[i].y); }
        else { xv[0] = bflo(xcur[i].z); xv[1] = bfhi(xcur[i].z); xv[2] = bflo(xcur[i].w); xv[3] = bfhi(xcur[i].w); }
#pragma unroll
        for (int j = 0; j < 4; ++j) { xv[j] += g2[j] * (mv[i * 8 + h4 * 4 + j] * rs * w[j]); xn[i * 8 + h4 * 4 + j] = xv[j]; ssn += xv[j] * xv[j]; }
        if (!(l == 0 && isl)) *(f32x4*)(xo + e + h4 * 4) = xv;
      }
      if (l == 0 && isl) {
        u32x4 o;
        o.x = pk_bf16(xn[i * 8 + 0], xn[i * 8 + 1]); o.y = pk_bf16(xn[i * 8 + 2], xn[i * 8 + 3]); o.z = pk_bf16(xn[i * 8 + 4], xn[i * 8 + 5]); o.w = pk_bf16(xn[i * 8 + 6], xn[i * 8 + 7]);
        *(u32x4*)((bf16_t*)p.out + (size_t)row * 1024 + e) = o;
      }
    }
    if (l == 0) {
      ssn = wave_sum(ssn);
      const float rsn = rsqrtf(ssn * (1.0f / 1024.0f) + 1e-6f);
      const float* mdn = mod + (size_t)((l + 1) * 9 + mr) * 6144;
#pragma unroll
      for (int i = 0; i < 2; ++i) {
        const int e = i * 512 + lane * 8;
        float hv[8];
#pragma unroll
        for (int h4 = 0; h4 < 2; ++h4) {
          const f32x4 w = *(const f32x4*)(nwn + e + h4 * 4), sh = *(const f32x4*)(mdn + e + h4 * 4), sc = *(const f32x4*)(mdn + 1024 + e + h4 * 4);
#pragma unroll
          for (int j = 0; j < 4; ++j) hv[h4 * 4 + j] = xn[i * 8 + h4 * 4 + j] * rsn * w[j] * (1.0f + sc[j]) + sh[j];
        }
        u32x4 w;
        w.x = pk_bf16(hv[0], hv[1]); w.y = pk_bf16(hv[2], hv[3]); w.z = pk_bf16(hv[4], hv[5]); w.w = pk_bf16(hv[6], hv[7]);
        *(u32x4*)(H + (size_t)row * 1024 + e) = w;
      }
    }
  }
}

#define PHASE(call) do { Params q = p; asm volatile("" : "+s"(q.ws)); call; } while (0)
#ifndef PROBE_PH
#define PROBE_PH 0
#endif
#ifndef PROBE_N
#define PROBE_N 2
#endif
#define REP(id, call) do { for (int _r = 0; _r < ((PROBE_PH == (id)) ? 1 + PROBE_N : 1); ++_r) PHASE(call); } while (0)
#define SYNC() do { char* _w = p.ws; asm volatile("" : "+s"(_w)); XcdBarrier _b; _b.bar = (unsigned*)(_w + O_BAR); _b.x = xb_xcc_id(); _b.st = st; xcd_barrier(_b); } while (0)
__global__ void __launch_bounds__(NTHREADS, 2) fwd_mega(Params p) {
  extern __shared__ __attribute__((aligned(16))) char lds[];
  cg::grid_group grid = cg::this_grid();
  const int wid0 = __builtin_amdgcn_readfirstlane((int)(threadIdx.x >> 6));
  volatile PG8_LAS unsigned* st = (volatile PG8_LAS unsigned*)((PG8_LAS unsigned char*)lds + LDS_MAIN);
  if (threadIdx.x < 2) st[threadIdx.x] = 0u;
  __syncthreads();
  (void)xcd_barrier_post((unsigned*)(p.ws + O_BAR), st);
  PHASE(phase_setup(q, lds, wid0));
  PHASE(phase_conv(q, 0, lds, wid0));
  SYNC();
  PHASE(phase_rowA(q, 0, wid0));
  SYNC();
#pragma unroll 1
  for (int l = 0; l < 2; ++l) {
    REP(3, phase_gin(q, l, lds, wid0));
    SYNC();
    REP(5, phase_mix2(q, l, lds, wid0));
    SYNC();
    PHASE(phase_oa(q, l, wid0));
    SYNC();
    REP(7, phase_merge(q, l, lds, wid0));
    if (l == 0) grid.sync(); else SYNC();
    REP(8, phase_wout(q, l, lds, wid0));
    SYNC();
    if (l == 0) PHASE(phase_rowB<0>(q, lds, wid0)); else PHASE(phase_rowB<1>(q, lds, wid0));
    SYNC();
    REP(10, phase_topk(q, l, lds, wid0));
    SYNC();
    REP(11, phase_moe1(q, l, lds, wid0));
    SYNC();
    REP(12, phase_moe2(q, l, lds, wid0));
    SYNC();
    PHASE(phase_rowC(q, l, wid0));
    if (l == 0) PHASE(conv_fill(q, lds, wid0, 4, (int)blockIdx.x, (int)gridDim.x));
    if (l == 0) SYNC();
    if (PROBE_PH == 20) { for (int _r = 0; _r < 10 * PROBE_N; ++_r) SYNC(); }
  }
}

extern "C" void kernel_launch(void* const* d_in, const int* in_sizes, int n_in, void* d_out, int out_size, void* d_ws, size_t ws_size,
                              hipStream_t stream) {
  if (ws_size < WS_NEED) {
    fprintf(stderr, "kernel_launch: workspace too small: %zu < %zu\n", ws_size, (size_t)WS_NEED);
    return;
  }
  Params p{};
  p.x = (const float*)d_in[0]; p.c = (const float*)d_in[1]; p.ctx = (const float*)d_in[2]; p.c_ctx = (const float*)d_in[3];
  p.ada_w = (const float*)d_in[4]; p.ada_b = (const float*)d_in[5]; p.norm_w = (const float*)d_in[6]; p.w_in = (const float*)d_in[7];
  p.lb_raw = (const float*)d_in[8]; p.gnorm_w = (const float*)d_in[9]; p.sgu_w = (const float*)d_in[10]; p.sgu_b = (const float*)d_in[11];
  p.sgu_norm_w = (const float*)d_in[12]; p.w_branch = (const float*)d_in[13]; p.w_out = (const float*)d_in[14];
  p.router_w = (const float*)d_in[15]; p.w13 = (const float*)d_in[16]; p.w2 = (const float*)d_in[17];
  p.out = (float*)d_out;
  p.ws = (char*)d_ws;
  p.w2sep = ws_size >= WS_NEED_W2B ? 1 : 0;
  static int grid_blocks = 0;
  if (!grid_blocks) {
    int dev = 0, cus = 0, per_cu = 0;
    (void)hipGetDevice(&dev);
    (void)hipDeviceGetAttribute(&cus, hipDeviceAttributeMultiprocessorCount, dev);
    (void)hipFuncSetAttribute((const void*)fwd_mega, hipFuncAttributeMaxDynamicSharedMemorySize, LDS_TOTAL);
    (void)hipOccupancyMaxActiveBlocksPerMultiprocessor(&per_cu, fwd_mega, NTHREADS, LDS_TOTAL);
    if (per_cu > 1) per_cu = 1;
    if (per_cu < 1) fprintf(stderr, "kernel_launch: occupancy query reports %d blocks per CU\n", per_cu);
    grid_blocks = cus * (per_cu < 1 ? 1 : per_cu);
  }
  (void)hipMemsetAsync((char*)d_ws + O_BAR, 0, BAR_BYTES, stream);
  void* args[] = {&p};
  hipError_t e = hipLaunchCooperativeKernel((void*)fwd_mega, dim3(grid_blocks), dim3(NTHREADS), args, LDS_TOTAL, stream);
  if (e != hipSuccess) fprintf(stderr, "cooperative launch failed: %s (grid %d)\n", hipGetErrorString(e), grid_blocks);
}
```

```cpp
#include <hip/hip_runtime.h>
#include <hip/hip_cooperative_groups.h>
#include <cstdio>
#include <cstdint>
namespace cg = cooperative_groups;

typedef unsigned short bf16_t;
typedef short bf16x8 __attribute__((ext_vector_type(8)));
typedef float f32x4 __attribute__((ext_vector_type(4)));
typedef float f32x2 __attribute__((ext_vector_type(2)));
typedef unsigned u32x4 __attribute__((ext_vector_type(4)));
typedef unsigned u32x2 __attribute__((ext_vector_type(2)));

constexpr int D = 1024, NB = 8, TL = 4096, TCX = 256;
constexpr int NL = NB * TL, NC = NB * TCX, NT = NL + NC;
constexpr int INC = 7168;
constexpr int NSLOT_L = 16 * 8 * 512, NSLOT_C = 16 * 8 * 32, NSLOT = NSLOT_L + NSLOT_C;
constexpr int NTHREADS = 512, NWAVE = 8;
constexpr int LDS_MAIN = 147456;
constexpr int LDS_TOTAL = LDS_MAIN + 16;

constexpr size_t al(size_t x) { return (x + 255) & ~(size_t)255; }
constexpr size_t O_WIN = 0;
constexpr size_t O_WBR = O_WIN + al((size_t)INC * D * 2);
constexpr size_t O_WOUT = O_WBR + al((size_t)3 * D * 512 * 2);
constexpr size_t O_W13 = O_WOUT + al((size_t)D * D * 2);
constexpr size_t O_W2 = O_W13 + al((size_t)16 * 2048 * D * 2);
constexpr size_t O_FTL = O_W2 + al((size_t)16 * D * D * 2);
constexpr size_t O_FTC = O_FTL + al((size_t)4096 * 8192 * 2);
constexpr size_t O_CS = O_FTC + al((size_t)256 * 512 * 2);
constexpr size_t O_MOD = O_CS + al((size_t)256 * 128 * 2);
constexpr size_t O_LB = O_MOD + al((size_t)2 * 9 * 6144 * 4);
constexpr size_t O_BAR = O_LB + al((size_t)2 * 2 * 512 * 4);
constexpr size_t BAR_BYTES = 3456 * 4;
constexpr size_t O_H = O_BAR + al(BAR_BYTES);
constexpr size_t O_Y = O_H + al((size_t)NT * D * 2);
constexpr size_t O_CTXB = O_Y + al((size_t)NT * D * 2);
constexpr size_t O_AFF = O_CTXB + al((size_t)NC * D * 4);
constexpr size_t O_SEL = O_AFF + al((size_t)NT * 16 * 4);
constexpr size_t O_GATE = O_SEL + al((size_t)NT * 16 * 4);
constexpr size_t O_TOK = O_GATE + al((size_t)NSLOT * 4);
constexpr size_t O_Z = O_TOK + al((size_t)NSLOT * 4);
constexpr size_t SZ512 = al((size_t)NT * 512 * 2);
constexpr size_t O_Q = O_Z, O_LFF = O_Q + SZ512, O_LFB = O_LFF + SZ512, O_I = O_LFB + SZ512, O_GA = O_I + SZ512,
                 O_U = O_GA + SZ512, O_ZB = O_U + SZ512, O_VT = O_ZB + SZ512, O_OF = O_VT + SZ512, O_OBK = O_OF + SZ512;
constexpr size_t O_G = O_OBK + SZ512;
constexpr size_t O_ZCL = O_G + al((size_t)NT * 3072 * 2);
constexpr size_t O_ZCC = O_ZCL + al((size_t)8 * 512 * 8192 * 2);
constexpr size_t O_ZF = O_ZCC + al((size_t)8 * 512 * 512 * 2);
constexpr int KH = 2176, KF = 2 * KH;
constexpr size_t O_ZEND = O_ZF + al((size_t)8 * 512 * KF * 2);
constexpr size_t SZSLOT = al((size_t)NSLOT * 1024 * 2);
constexpr size_t O_XE = O_Z, O_HID = O_XE + SZSLOT, O_YS = O_HID + SZSLOT;
static_assert(O_YS + SZSLOT <= O_ZEND, "moe arena");
constexpr size_t O_W2B = O_ZEND;
constexpr size_t WS_NEED = O_ZEND, WS_NEED_W2B = O_W2B + al((size_t)16 * D * D * 2);

struct Params {
  const float *x, *c, *ctx, *c_ctx, *ada_w, *ada_b, *norm_w, *w_in, *lb_raw, *gnorm_w, *sgu_w, *sgu_b, *sgu_norm_w, *w_branch, *w_out,
      *router_w, *w13, *w2;
  float* out;
  char* ws;
  int w2sep;
};

typedef __bf16 bf16v2_t __attribute__((ext_vector_type(2)));
__device__ __forceinline__ unsigned pk_bf16(float lo, float hi) {
  const f32x2 v = {lo, hi};
  const bf16v2_t r = __builtin_convertvector(v, bf16v2_t);
  return __builtin_bit_cast(unsigned, r);
}
__device__ __forceinline__ bf16_t f2bf(float x) { return (bf16_t)(pk_bf16(x, 0.f) & 0xffffu); }
__device__ __forceinline__ float bf2f(bf16_t v) { return __uint_as_float(((unsigned)v) << 16); }
__device__ __forceinline__ float bflo(unsigned w) { return __uint_as_float(w << 16); }
__device__ __forceinline__ float bfhi(unsigned w) { return __uint_as_float(w & 0xffff0000u); }
__device__ __forceinline__ void st4bf(bf16_t* p, f32x4 v) {
  u32x2 w;
  w.x = pk_bf16(v[0], v[1]);
  w.y = pk_bf16(v[2], v[3]);
  *(u32x2*)p = w;
}
__device__ __forceinline__ void st8bf(bf16_t* p, f32x4 a, f32x4 b) {
  u32x4 w;
  w.x = pk_bf16(a[0], a[1]); w.y = pk_bf16(a[2], a[3]); w.z = pk_bf16(b[0], b[1]); w.w = pk_bf16(b[2], b[3]);
  *(u32x4*)p = w;
}
__device__ __forceinline__ float sigmoidf_(float x) { return __builtin_amdgcn_rcpf(1.0f + __expf(-x)); }
__device__ __forceinline__ float siluf_(float x) { return x * __builtin_amdgcn_rcpf(1.0f + __expf(-x)); }
__device__ __forceinline__ float geluf_(float v) {
  const float av = fabsf(v), t = __builtin_amdgcn_rcpf(av * 0.2316418882f + 1.0f);
  float q = t * 0.5307027145f + (-0.7265760135f);
  q = q * t + 0.7107068705f; q = q * t + (-0.142248368f); q = q * t + 0.127414796f; q = q * t;
  const float e = __builtin_amdgcn_exp2f((v * v) * (-0.72134752044f));
  const float m = v * (q * e);
  return v < 0.f ? m : v - m;
}
__device__ __forceinline__ int opaque_tid(int wid0) {
  int lane;
  asm volatile("v_mbcnt_lo_u32_b32 %0, -1, 0\n\tv_mbcnt_hi_u32_b32 %0, -1, %0" : "=v"(lane));
  return (wid0 << 6) | lane;
}
__device__ __forceinline__ float wave_sum(float v) {
#pragma unroll
  for (int o = 32; o > 0; o >>= 1) v += __shfl_xor(v, o);
  return v;
}

namespace pg8 {
#define PG8_LAS __attribute__((address_space(3)))
constexpr int BM = 256, BK = 64, HALF = 128, HTB = HALF * BK * 2, STAGE_BYTES = 8 * HTB, NXCD = 8, WGM = 8;
__device__ __forceinline__ int lds_byte(int r, int c) { const int st = (r >> 4) * 2 + (c >> 5), rr = r & 15, cc = c & 31, ob = rr * 64 + cc * 2; return st * 1024 + (ob ^ (((ob >> 9) & 1) << 5)); }
__device__ __forceinline__ void stage_rc(int b, int& R, int& C) { const int st = b / 1024, sb = b % 1024, swz = sb ^ (((sb >> 9) & 1) << 5); R = (st >> 1) * 16 + swz / 64; C = (st & 1) * 32 + (swz % 64) / 2; }
__device__ __forceinline__ int perm32(int rho) { const int n = rho >> 4, i = rho & 15; return 8 * (i >> 2) + 4 * n + (i & 3); }
struct Unit { int pm, pn, z; };
template <class T, class = void> struct gather_of { static constexpr bool v = false; };
template <class T> struct gather_of<T, decltype((void)T::GATHER)> { static constexpr bool v = T::GATHER; };

template <class Epi, class Sched>
__device__ __forceinline__ void gemm_phase(PG8_LAS unsigned char* lds, const int K, const Sched& S, const Epi& E, const int tid_in) {
  int tid = tid_in;
  asm volatile("" : "+v"(tid));
  const int wid = __builtin_amdgcn_readfirstlane(tid >> 6), lane = tid & 63, wr = wid >> 2, wc = wid & 3, fr = lane & 15, fq = lane >> 4;
  const int nt = K / BK;
  constexpr bool GA = gather_of<Sched>::v;
  unsigned voffA[2], voffB[2];
  unsigned cvA[2][2], nvA[2][2];
  int gR = 0; unsigned gC2 = 0;
#pragma unroll
  for (int i = 0; i < 2; ++i) { int R, C; stage_rc(tid * 16 + i * 8192, R, C); const int Rb = (R & ~31) + perm32(R & 31);
    if (i == 0) { gR = R; gC2 = (unsigned)C * 2u; }
    voffA[i] = (unsigned)(R * K + C) * 2u; voffB[i] = (unsigned)(Rb * K + C) * 2u; }
  const size_t kstep = (size_t)(BK * 2);
  const size_t hstep = (size_t)HALF * K * 2;
  const size_t hstepA = GA ? (size_t)0 : hstep;
  const PG8_LAS int* idxl = (const PG8_LAS int*)(lds + STAGE_BYTES);
  const unsigned ldsw = (unsigned)wid * 1024u;
  const int aoff = lds_byte(wr * 64 + fr, fq * 8), boff = lds_byte(wc * 32 + fr, fq * 8);
#define PG8_SA(b, h) (((b) * 2 + (h)) * HTB)
#define PG8_SB(b, h) ((4 + (b) * 2 + (h)) * HTB)
#define PG8_STAGE_(bufoff, gbase, voff) do { _Pragma("unroll") for (int _i = 0; _i < 2; ++_i) \
    __builtin_amdgcn_global_load_lds((const unsigned*)((const char*)(gbase) + voff[_i]), (PG8_LAS unsigned*)(lds + (bufoff) + ldsw + _i * 8192), 16, 0, 0); } while (0)
#define PG8_STAGE(bufoff, gbase) PG8_STAGE_(bufoff, gbase, voffB)
#define PG8_STAGE_A(bufoff, gbase, NX) do { _Pragma("unroll") for (int _i = 0; _i < 2; ++_i) { unsigned _vo; \
    if constexpr (GA) { _vo = (NX) ? nvA[((bufoff) / HTB) & 1][_i] : cvA[((bufoff) / HTB) & 1][_i]; } else _vo = voffA[_i]; \
    __builtin_amdgcn_global_load_lds((const unsigned*)((const char*)(gbase) + _vo), (PG8_LAS unsigned*)(lds + (bufoff) + ldsw + _i * 8192), 16, 0, 0); } } while (0)
#define PG8_LDA(dst, b, h) do { _Pragma("unroll") for (int m = 0; m < 4; ++m) _Pragma("unroll") for (int k = 0; k < 2; ++k) dst[m][k] = *(const PG8_LAS bf16x8*)(lds + PG8_SA(b, h) + aoff + m * 2048 + k * 1024); } while (0)
#define PG8_LDB(dst, b, h) do { _Pragma("unroll") for (int n = 0; n < 2; ++n) _Pragma("unroll") for (int k = 0; k < 2; ++k) dst[n][k] = *(const PG8_LAS bf16x8*)(lds + PG8_SB(b, h) + boff + n * 2048 + k * 1024); } while (0)
#define PG8_MMA(ai, bj, At, Bt) do { __builtin_amdgcn_s_setprio(1); _Pragma("unroll") for (int m = 0; m < 4; ++m) _Pragma("unroll") for (int n = 0; n < 2; ++n) _Pragma("unroll") for (int k = 0; k < 2; ++k) \
    acc[ai][bj][m][n] = __builtin_amdgcn_mfma_f32_16x16x32_bf16(Bt[n][k], At[m][k], acc[ai][bj][m][n], 0, 0, 0); __builtin_amdgcn_s_setprio(0); } while (0)
#define PG8_WAIT_V(n) asm volatile("s_waitcnt vmcnt(" #n ")" ::: "memory")
#define PG8_WAIT_L(n) asm volatile("s_waitcnt lgkmcnt(" #n ")" ::: "memory")
#define PG8_BAR __builtin_amdgcn_s_barrier()
#define PG8_SCHED __builtin_amdgcn_sched_barrier(0)
  Unit cur, nxt; int ui = 0;
  if (!S.next(0, cur)) return;
  f32x4 acc[2][2][4][2];
#pragma unroll
  for (int a = 0; a < 2; ++a)
#pragma unroll
    for (int b = 0; b < 2; ++b)
#pragma unroll
      for (int m = 0; m < 4; ++m)
#pragma unroll
        for (int n = 0; n < 2; ++n) acc[a][b][m][n] = (f32x4){0.f, 0.f, 0.f, 0.f};
  bf16x8 At[4][2], B0[2][2], B1[2][2];
  const char* cA = S.aptr(cur); const char* cB = S.bptr(cur);
  if constexpr (GA) {
    const int* tk = S.tokptr(cur);
#pragma unroll
    for (int h = 0; h < 2; ++h)
#pragma unroll
      for (int i = 0; i < 2; ++i) { cvA[h][i] = (unsigned)tk[h * 128 + i * 64 + gR] * (unsigned)(K * 2) + gC2; nvA[h][i] = cvA[h][i]; }
  }
  PG8_STAGE(PG8_SB(0, 0), cB); PG8_STAGE_A(PG8_SA(0, 0), cA, false); PG8_STAGE(PG8_SB(0, 1), cB + hstep); PG8_STAGE_A(PG8_SA(0, 1), cA + hstepA, false);
  if (wr == 1) PG8_BAR;
  PG8_WAIT_V(4); PG8_BAR;
  PG8_STAGE(PG8_SB(1, 0), cB + kstep); PG8_STAGE_A(PG8_SA(1, 0), cA + kstep, false); PG8_STAGE(PG8_SB(1, 1), cB + hstep + kstep);
  PG8_WAIT_V(6); PG8_BAR;
  for (;;) {
    const bool has_next = S.next(ui + 1, nxt);
    const char* nA = has_next ? S.aptr(nxt) : cA; const char* nB = has_next ? S.bptr(nxt) : cB;
    if constexpr (GA) {
      if (has_next && wid < 4)
        __builtin_amdgcn_global_load_lds((const unsigned*)(S.tokptr(nxt) + wid * 64 + lane), (PG8_LAS unsigned*)(lds + STAGE_BYTES + wid * 256), 4, 0, 0);
    }
    for (int t = 0; t < nt; t += 2) {
      const bool last = (t == nt - 2);
      const bool lastn = last && has_next;
      if constexpr (GA) {
#pragma unroll
        for (int h = 0; h < 2; ++h)
#pragma unroll
          for (int i = 0; i < 2; ++i) nvA[h][i] = (unsigned)idxl[h * 128 + i * 64 + gR] * (unsigned)(K * 2) + gC2;
      }
      const char* a1 = cA + (size_t)(t + 1) * kstep;
      const char* a2 = last ? nA : cA + (size_t)(t + 2) * kstep; const char* b2 = last ? nB : cB + (size_t)(t + 2) * kstep;
      const char* a3 = a2 + kstep; const char* b3 = b2 + kstep;
      PG8_LDB(B0, 0, 0); PG8_SCHED; PG8_LDA(At, 0, 0); PG8_STAGE_A(PG8_SA(1, 1), a1 + hstepA, false);
      PG8_WAIT_L(8); PG8_BAR; PG8_WAIT_L(0); PG8_MMA(0, 0, At, B0); PG8_BAR; PG8_SCHED;
      PG8_LDB(B1, 0, 1); PG8_STAGE(PG8_SB(0, 0), b2);
      PG8_BAR; PG8_WAIT_L(0); PG8_MMA(0, 1, At, B1); PG8_BAR;
      PG8_LDA(At, 0, 1); PG8_STAGE_A(PG8_SA(0, 0), a2, lastn);
      PG8_BAR; PG8_WAIT_L(0); PG8_MMA(1, 0, At, B0); PG8_BAR; PG8_SCHED;
      PG8_STAGE(PG8_SB(0, 1), b2 + hstep);
      PG8_WAIT_V(6); PG8_BAR; PG8_MMA(1, 1, At, B1); PG8_BAR;
      PG8_LDB(B0, 1, 0); PG8_SCHED; PG8_LDA(At, 1, 0); PG8_STAGE_A(PG8_SA(0, 1), a2 + hstepA, lastn);
      PG8_WAIT_L(8); PG8_BAR; PG8_WAIT_L(0); PG8_MMA(0, 0, At, B0); PG8_BAR; PG8_SCHED;
      PG8_LDB(B1, 1, 1); PG8_STAGE(PG8_SB(1, 0), b3);
      PG8_BAR; PG8_WAIT_L(0); PG8_MMA(0, 1, At, B1); PG8_BAR;
      PG8_LDA(At, 1, 1); PG8_STAGE_A(PG8_SA(1, 0), a3, lastn);
      PG8_BAR; PG8_WAIT_L(0); PG8_MMA(1, 0, At, B0); PG8_BAR; PG8_SCHED;
      PG8_STAGE(PG8_SB(1, 1), b3 + hstep);
      PG8_WAIT_V(6); PG8_BAR; PG8_MMA(1, 1, At, B1); PG8_BAR;
    }
    if (wr == 0) PG8_BAR;
    bool keep;
    { int fr2 = fr, fq2 = fq; asm volatile("" : "+v"(fr2), "+v"(fq2));
      keep = E(acc, cur, wr, wc, fr2, fq2); }
    if (!has_next) break;
    if (!keep)
#pragma unroll
    for (int a = 0; a < 2; ++a)
#pragma unroll
      for (int b = 0; b < 2; ++b)
#pragma unroll
        for (int m = 0; m < 4; ++m)
#pragma unroll
          for (int n = 0; n < 2; ++n) acc[a][b][m][n] = (f32x4){0.f, 0.f, 0.f, 0.f};
    cur = nxt; cA = nA; cB = nB; ++ui;
    if constexpr (GA) {
#pragma unroll
      for (int h = 0; h < 2; ++h)
#pragma unroll
        for (int i = 0; i < 2; ++i) cvA[h][i] = nvA[h][i];
    }
    if (wr == 1) PG8_BAR;
  }
  PG8_WAIT_V(0);
  PG8_BAR;
#undef PG8_SA
#undef PG8_SB
#undef PG8_STAGE
#undef PG8_STAGE_
#undef PG8_STAGE_A
#undef PG8_LDA
#undef PG8_LDB
#undef PG8_MMA
#undef PG8_WAIT_V
#undef PG8_WAIT_L
#undef PG8_BAR
#undef PG8_SCHED
}
template <class F>
__device__ __forceinline__ void epi_each(const f32x4 (&acc)[2][2][4][2], int wr, int wc, int fr, int fq, const F& f) {
#pragma unroll
  for (int ai = 0; ai < 2; ++ai)
#pragma unroll
    for (int m = 0; m < 4; ++m)
#pragma unroll
      for (int bj = 0; bj < 2; ++bj) f(ai * HALF + wr * 64 + m * 16 + fr, bj * HALF + wc * 32 + 8 * fq, acc[ai][bj][m][0], acc[ai][bj][m][1]);
}
struct GridSched {
  const char* A; const char* B; size_t tstep; int nM, nN, nwg, G, c, pm0;
  __device__ __forceinline__ void init(const void* A_, const void* B_, int K, int nM_, int nN_, int pm0_, int G_, int c_) {
    A = (const char*)A_; B = (const char*)B_; tstep = (size_t)BM * K * 2; nM = nM_; nN = nN_; nwg = nM * nN; G = G_; c = c_; pm0 = pm0_;
  }
  __device__ __forceinline__ bool next(int i, Unit& u) const {
    const long L = (long)i * G + c; if (L >= nwg) return false;
    int wgid = (int)L; { const int q = nwg / NXCD, r = nwg % NXCD, xcd = wgid % NXCD, off = wgid / NXCD; wgid = (xcd < r ? xcd * (q + 1) : r * (q + 1) + (xcd - r) * q) + off; }
    const int nig = WGM * nN, gid = wgid / nig, fm = gid * WGM, gsz = (nM - fm) < WGM ? (nM - fm) : WGM;
    u.pm = pm0 + fm + ((wgid % nig) % gsz); u.pn = (wgid % nig) / gsz; u.z = 0; return true;
  }
  __device__ __forceinline__ const char* aptr(const Unit& u) const { return A + (size_t)u.pm * tstep; }
  __device__ __forceinline__ const char* bptr(const Unit& u) const { return B + (size_t)u.pn * tstep; }
};
}
using pg8::Unit;


#define XB_TMO      128
#define XB_XCNT(j)  (256  + 64 * (j))
#define XB_XSUB(j)  (1280 + 64 * (j))
#define XB_XGEN(j)  (2304 + 64 * (j))
#define XB_TOP      3328
#define XB_TOPGEN   3392
#define XB_SPIN_CAP (1u << 18)
__device__ __forceinline__ unsigned xb_ld(unsigned* p)              { return __hip_atomic_load(p, __ATOMIC_RELAXED, __HIP_MEMORY_SCOPE_AGENT); }
__device__ __forceinline__ unsigned xb_add(unsigned* p, unsigned v) { return __hip_atomic_fetch_add(p, v, __ATOMIC_RELAXED, __HIP_MEMORY_SCOPE_AGENT); }
__device__ __forceinline__ unsigned xb_xcc_id() { return (unsigned)__builtin_amdgcn_s_getreg((3 << 11) | 20) & 0xFu; }
#define XB_SPIN(cond, bar) do { unsigned _sp = 0; while (cond) { __builtin_amdgcn_s_sleep(1); \
    if ((++_sp & 255u) == 0u) { if (xb_ld(&(bar)[XB_TMO])) break; if (_sp > XB_SPIN_CAP) { atomicAdd(&(bar)[XB_TMO], 1u); break; } } } } while (0)
struct XcdBarrier { unsigned* bar; unsigned x; volatile PG8_LAS unsigned* st; };
__device__ __forceinline__ XcdBarrier xcd_barrier_post(unsigned* bar, volatile PG8_LAS unsigned* st) {
  XcdBarrier b; b.bar = bar; b.x = xb_xcc_id(); b.st = st;
  if (threadIdx.x == 0) (void)xb_add(&bar[XB_XCNT(b.x)], 1u);
  return b;
}
__device__ __forceinline__ void xcd_barrier_complete(unsigned* bar, unsigned x, unsigned& nloc, unsigned& nx) {
  const unsigned G = gridDim.x * gridDim.y * gridDim.z;
  unsigned sum, cnt, mine, sp = 0u;
  for (;;) {
    sum = 0u; cnt = 0u; mine = 0u;
#pragma unroll
    for (unsigned j = 0; j < 16; ++j) { const unsigned c = xb_ld(&bar[XB_XCNT(j)]); sum += c; cnt += (c > 0u) ? 1u : 0u; mine = (j == x) ? c : mine; }
    if (sum == G) break;
    __builtin_amdgcn_s_sleep(1);
    if ((++sp & 255u) == 0u) { if (xb_ld(&bar[XB_TMO])) break; if (sp > XB_SPIN_CAP) { atomicAdd(&bar[XB_TMO], 1u); break; } }
  }
  nloc = mine > 0u ? mine : 1u; nx = cnt > 0u ? cnt : 1u;
}
__device__ __forceinline__ void xcd_barrier(const XcdBarrier& b) {
  asm volatile("s_waitcnt vmcnt(0)" ::: "memory");
  __syncthreads();
  if (threadIdx.x == 0) {
    unsigned* bar = b.bar;
    __builtin_amdgcn_s_waitcnt(0);
    unsigned nloc = b.st[0], nx = b.st[1];
    if (nloc == 0u) { xcd_barrier_complete(bar, b.x, nloc, nx); b.st[0] = nloc; b.st[1] = nx; }
    const unsigned old = xb_add(&bar[XB_XSUB(b.x)], 1u);
    const unsigned gen = old / nloc;
    if (old + 1u == (gen + 1u) * nloc) {
      __builtin_amdgcn_fence(__ATOMIC_RELEASE, "agent");
      asm volatile("s_waitcnt vmcnt(0)" ::: "memory");
      const unsigned og = xb_add(&bar[XB_TOP], 1u);
      const unsigned tg = og / nx;
      if (og + 1u == (tg + 1u) * nx) xb_add(&bar[XB_TOPGEN], 1u);
      else XB_SPIN(xb_ld(&bar[XB_TOPGEN]) == tg, bar);
      __builtin_amdgcn_fence(__ATOMIC_ACQUIRE, "agent");
      xb_add(&bar[XB_XGEN(b.x)], 1u);
      asm volatile("s_waitcnt vmcnt(0)" ::: "memory");
    } else {
      XB_SPIN(xb_ld(&bar[XB_XGEN(b.x)]) == gen, bar);
      __builtin_amdgcn_fence(__ATOMIC_ACQUIRE, "agent");
      asm volatile("s_waitcnt vmcnt(0)" ::: "memory");
    }
  }
  __syncthreads();
}


__device__ __forceinline__ void sub_barrier(unsigned* cnt, int nb) {
  asm volatile("s_waitcnt vmcnt(0)" ::: "memory");
  __syncthreads();
  if (threadIdx.x == 0) {
    __builtin_amdgcn_fence(__ATOMIC_RELEASE, "agent");
    asm volatile("s_waitcnt vmcnt(0)" ::: "memory");
    (void)xb_add(cnt, 1u);
    unsigned sp = 0;
    while (xb_ld(cnt) < (unsigned)nb && ++sp < (1u << 20)) __builtin_amdgcn_s_sleep(1);
    __builtin_amdgcn_fence(__ATOMIC_ACQUIRE, "agent");
    asm volatile("s_waitcnt vmcnt(0)" ::: "memory");
  }
  __syncthreads();
}

template <class LA, class LB>
__device__ __forceinline__ void gemm_main(f32x4 (&acc)[4][4], const int nk, const LA& la, const LB& lb, char* lds, const int t) {
  const int lane = t & 63, wid = t >> 6, fr = lane & 15, fq = lane >> 4, wr = wid >> 1, wc = wid & 1;
  const int sr = t >> 3, sc = t & 7;
  const int wofs = sr * 128 + ((sc ^ (sr & 7)) << 4);
  const int aofs = (wr * 64 + fr) * 128, bofs = 16384 + (wc * 64 + fr) * 128;
  const int x0 = ((fq) ^ (fr & 7)) << 4, x1 = ((4 + fq) ^ (fr & 7)) << 4;
  bf16x8 ra[4], rb[4];
#pragma unroll
  for (int i = 0; i < 4; ++i) { ra[i] = la(i, 0); rb[i] = lb(i, 0); }
#pragma unroll
  for (int i = 0; i < 4; ++i) { *(bf16x8*)(lds + wofs + i * 4096) = ra[i]; *(bf16x8*)(lds + 16384 + wofs + i * 4096) = rb[i]; }
  __syncthreads();
  for (int kt = 0; kt < nk; ++kt) {
    const char* cur = lds + (kt & 1) * 32768;
    const bool more = kt + 1 < nk;
    if (more) {
#pragma unroll
      for (int i = 0; i < 4; ++i) { ra[i] = la(i, (kt + 1) * 64); rb[i] = lb(i, (kt + 1) * 64); }
    }
#pragma unroll
    for (int kk = 0; kk < 2; ++kk) {
      const int xo = kk ? x1 : x0;
      bf16x8 af[4], bv[4];
#pragma unroll
      for (int m = 0; m < 4; ++m) af[m] = *(const bf16x8*)(cur + aofs + m * 2048 + xo);
#pragma unroll
      for (int n = 0; n < 4; ++n) bv[n] = *(const bf16x8*)(cur + bofs + n * 2048 + xo);
#pragma unroll
      for (int m = 0; m < 4; ++m)
#pragma unroll
        for (int n = 0; n < 4; ++n) acc[m][n] = __builtin_amdgcn_mfma_f32_16x16x32_bf16(bv[n], af[m], acc[m][n], 0, 0, 0);
    }
    if (more) {
      char* nxt = lds + ((kt + 1) & 1) * 32768;
#pragma unroll
      for (int i = 0; i < 4; ++i) { *(bf16x8*)(nxt + wofs + i * 4096) = ra[i]; *(bf16x8*)(nxt + 16384 + wofs + i * 4096) = rb[i]; }
    }
    __syncthreads();
  }
}
__device__ __forceinline__ void zero_acc(f32x4 (&acc)[4][4]) {
#pragma unroll
  for (int m = 0; m < 4; ++m)
#pragma unroll
    for (int n = 0; n < 4; ++n) acc[m][n] = (f32x4){0.f, 0.f, 0.f, 0.f};
}
template <class EP>
__device__ __forceinline__ void gemm_epi(const f32x4 (&acc)[4][4], const EP& ep, const int t) {
  const int lane = t & 63, wid = t >> 6, fr = lane & 15, fq = lane >> 4, wr = wid >> 1, wc = wid & 1;
#pragma unroll
  for (int m = 0; m < 4; ++m)
#pragma unroll
    for (int n = 0; n < 4; ++n) ep(wr * 64 + m * 16 + fr, wc * 64 + n * 16 + fq * 4, acc[m][n]);
}
struct RowLd {
  const bf16_t* p[4];
  __device__ __forceinline__ RowLd(const bf16_t* base, size_t r0, size_t ld, const int t) {
#pragma unroll
    for (int i = 0; i < 4; ++i) p[i] = base + (r0 + (t >> 3) + 32 * i) * ld + (t & 7) * 8;
  }
  __device__ __forceinline__ bf16x8 operator()(int i, int k0) const { return *(const bf16x8*)(p[i] + k0); }
};

__device__ __forceinline__ void phase_setup(const Params& p, char* lds, int wid0) {
  float* tab = (float*)lds;
  float* sv = (float*)(lds + 16384);
  float* red = (float*)(lds + 16384 + 36864);
  const int tid = opaque_tid(wid0);
  float* mod = (float*)(p.ws + O_MOD);
  bf16_t* FTL = (bf16_t*)(p.ws + O_FTL);
  bool have_tab = false;
  const int NMOD = 192, NITEM = NMOD + 4096 + 1;
  for (int item = blockIdx.x; item < NITEM; item += gridDim.x) {
    if (item < NMOD) {
      const int l = item / 96, n = (item % 96) * 64 + (tid & 63), kp = tid >> 6;
      for (int e = tid; e < 9 * 1024; e += NTHREADS) {
        const int r = e >> 10, k = e & 1023;
        const float v = r < 8 ? p.c[r * 1024 + k] : p.c_ctx[k];
        sv[e] = v / (1.0f + __expf(-v));
      }
      __syncthreads();
      float acc[9];
#pragma unroll
      for (int r = 0; r < 9; ++r) acc[r] = 0.f;
      const float* w = p.ada_w + (size_t)l * 1024 * 6144 + n;
#pragma unroll 8
      for (int k = kp * 128; k < kp * 128 + 128; ++k) {
        const float wv = w[(size_t)k * 6144];
#pragma unroll
        for (int r = 0; r < 9; ++r) acc[r] += sv[r * 1024 + k] * wv;
      }
#pragma unroll
      for (int r = 0; r < 9; ++r) red[(kp * 9 + r) * 64 + (tid & 63)] = acc[r];
      __syncthreads();
      for (int e = tid; e < 9 * 64; e += NTHREADS) {
        const int r = e >> 6, c = e & 63;
        float a = 0.f;
#pragma unroll
        for (int q8 = 0; q8 < 8; ++q8) a += red[(q8 * 9 + r) * 64 + c];
        const int nn = (item % 96) * 64 + c;
        mod[(l * 9 + r) * 6144 + nn] = a + p.ada_b[l * 6144 + nn];
      }
      __syncthreads();
    } else {
      if (!have_tab) {
        for (int j = tid; j < 4096; j += NTHREADS) tab[j] = cospif((float)j * (1.0f / 2048.0f));
        __syncthreads();
        have_tab = true;
      }
      if (item < NMOD + 4096) {
        const int k = (item - NMOD) & 2047, part = (item - NMOD) >> 11;
        const float scale = 0.0013810679320049757f;
        for (int e8 = tid; e8 < KH / 8; e8 += NTHREADS) {
          float v[8];
#pragma unroll
          for (int jx = 0; jx < 8; ++jx) {
            const int t = e8 * 8 + jx, jj = (k * t) & 4095;
            if (part == 0) v[jx] = t <= 2048 ? tab[jj] * scale : 0.f;
            else v[jx] = t < 2048 ? -tab[(jj - 1024) & 4095] * scale : 0.f;
          }
          u32x4 w;
          w.x = pk_bf16(v[0], v[1]); w.y = pk_bf16(v[2], v[3]); w.z = pk_bf16(v[4], v[5]); w.w = pk_bf16(v[6], v[7]);
          *(u32x4*)(FTL + ((size_t)part * 2048 + k) * KH + e8 * 8) = w;
        }
      } else {
        bf16_t* FTC = (bf16_t*)(p.ws + O_FTC);
        bf16_t* CS = (bf16_t*)(p.ws + O_CS);
        const float scale_c = 0.005524271728019903f;
        for (int e = tid; e < 256 * 512; e += NTHREADS) {
          const int k = e >> 9, cs = (e >> 8) & 1, t = e & 255;
          const int jj = ((k * t) & 255) * 16;
          FTC[e] = f2bf((cs == 0 ? tab[jj] : -tab[(jj - 1024) & 4095]) * scale_c);
        }
        for (int e = tid; e < 256 * 128; e += NTHREADS) {
          const int row = e >> 7, d = e & 127, cs = row >> 7, m = row & 127;
          const int jj = ((m * d) & 127) * 32;
          CS[e] = f2bf(cs == 0 ? tab[jj] : tab[(jj - 1024) & 4095]);
        }
        float* lb = (float*)(p.ws + O_LB);
        for (int e = tid; e < 2 * 512; e += NTHREADS) {
          const int dir = e >> 9, ch = e & 511;
          const float r0 = p.lb_raw[(dir * 2 + 0) * 512 + ch], r1 = p.lb_raw[(dir * 2 + 1) * 512 + ch];
          const float mx = fmaxf(r0, r1), e0 = expf(r0 - mx), e1 = expf(r1 - mx);
          const float p0 = e0 / (e0 + e1), p1 = e1 / (e0 + e1);
          lb[(dir * 2 + 0) * 512 + ch] = p0 - p0;
          lb[(dir * 2 + 1) * 512 + ch] = (p0 + p1) - p0;
        }
      }
    }
  }
  __syncthreads();
}

constexpr size_t OUT_W13B = (size_t)NL * D * 2;
template <bool VMAP>
__device__ __forceinline__ void conv_items(const Params& p, int l, char* lds, int wid0, const int lo, const int hi, const int r, const int n) {
  const int tid = opaque_tid(wid0);
  float* tile = (float*)lds;
  struct Item { const float* src; bf16_t* dst; int K, N, n0, k0, drow0; };
  auto decode = [&](int item) -> Item {
    int i = item;
    if (VMAP) {
      if (p.w2sep) i = i < 2048 ? i + 608 : i < 2496 ? i - 2048 : i < 3520 ? i + 160 : i - 3072;
      else i = i < 2048 ? i + 608 : i < 2656 ? i - 2048 : i;
    }
    Item it;
    bool w13 = false;
    if (i < 448) {
      it.src = p.w_in + (size_t)l * 1024 * INC; it.dst = (bf16_t*)(p.ws + O_WIN); it.K = 1024; it.N = INC;
    } else if ((i -= 448) < 96) {
      const int j = i / 32; i -= j * 32;
      it.src = p.w_branch + ((size_t)l * 3 + j) * 512 * 1024; it.dst = (bf16_t*)(p.ws + O_WBR) + (size_t)j * 1024 * 512; it.K = 512; it.N = 1024;
    } else if ((i -= 96) < 64) {
      it.src = p.w_out + (size_t)l * 1024 * 1024; it.dst = (bf16_t*)(p.ws + O_WOUT); it.K = 1024; it.N = 1024;
    } else if ((i -= 64) < 2048) {
      const int e = i / 128; i -= e * 128;
      it.src = p.w13 + ((size_t)l * 16 + e) * 1024 * 2048;
      it.dst = (l == 1 ? (bf16_t*)((char*)p.out + OUT_W13B) : (bf16_t*)(p.ws + O_W13)) + (size_t)e * 2048 * 1024; it.K = 1024; it.N = 2048; w13 = true;
    } else {
      i -= 2048;
      const int e = i / 64; i -= e * 64;
      it.src = p.w2 + ((size_t)l * 16 + e) * 1024 * 1024; it.dst = (bf16_t*)(p.ws + (l == 1 && p.w2sep ? O_W2B : O_W2)) + (size_t)e * 1024 * 1024; it.K = 1024; it.N = 1024;
    }
    const int nkt = it.K / 128;
    it.n0 = (i / nkt) * 128; it.k0 = (i % nkt) * 128;
    it.drow0 = w13 ? (((it.n0 & 1023) >> 7) * 256 + (it.n0 >> 10) * 128) : it.n0;
    return it;
  };
  f32x4 pf[8];
  auto fetch = [&](const Item& it) {
#pragma unroll
    for (int q = 0; q < 8; ++q) pf[q] = *(const f32x4*)(it.src + (size_t)(it.k0 + q * 16 + (tid >> 5)) * it.N + it.n0 + (tid & 31) * 4);
  };
  int rr = r; asm volatile("" : "+s"(rr));
  const int item0 = lo + rr;
  Item cur = decode(item0 < hi ? item0 : lo);
  if (item0 < hi) fetch(cur);
  for (int item = item0; item < hi; item += n) {
#pragma unroll
    for (int q = 0; q < 8; ++q) {
      const int kk = q * 16 + (tid >> 5), nn = (tid & 31) * 4;
      tile[(nn + 0) * 129 + kk] = pf[q][0]; tile[(nn + 1) * 129 + kk] = pf[q][1]; tile[(nn + 2) * 129 + kk] = pf[q][2]; tile[(nn + 3) * 129 + kk] = pf[q][3];
    }
    const Item me = cur;
    if (item + n < hi) { cur = decode(item + n); fetch(cur); }
    __syncthreads();
#pragma unroll
    for (int q2 = 0; q2 < 4; ++q2) {
      const int q = tid + q2 * 512, nn = q >> 4, kc = (q & 15) * 8;
      const float* tp = tile + nn * 129 + kc;
      u32x4 w;
      w.x = pk_bf16(tp[0], tp[1]); w.y = pk_bf16(tp[2], tp[3]); w.z = pk_bf16(tp[4], tp[5]); w.w = pk_bf16(tp[6], tp[7]);
      *(u32x4*)(me.dst + (size_t)(me.drow0 + nn) * me.K + me.k0 + kc) = w;
    }
    __syncthreads();
  }
}
__device__ __forceinline__ void phase_conv(const Params& p, int l, char* lds, int wid0) { conv_items<false>(p, l, lds, wid0, 0, 3680, blockIdx.x, gridDim.x); }
constexpr int CF_S0 = 2304, CF_S2 = 320;
__device__ __forceinline__ void conv_fill(const Params& p, char* lds, int wid0, const int slot, const int r, const int n) {
  const bool tuned = gridDim.x == 256;
  int a, b;
  int c0 = CF_S0, c2 = CF_S0 + CF_S2;
  if (!p.w2sep) { c0 = c0 < 2496 ? c0 : 2496; c2 = c2 < 2656 ? c2 : 2656; }
  if (slot == 0) { a = 0; b = c0; } else if (slot == 2) { a = c0; b = c2; } else { a = c2; b = 3680; }
  if (slot < 4) { if (!tuned) return; }
  else if (!tuned) a = 0;
  conv_items<true>(p, 1, lds, wid0, a, b, r, n);
}
__device__ __forceinline__ void phase_rowA(const Params& p, int l, int wid0) {
  const int tid = opaque_tid(wid0), wid = tid >> 6, lane = tid & 63;
  const float* xlat = l == 0 ? p.x : p.out;
  const float* xctx = l == 0 ? p.ctx : (const float*)(p.ws + O_CTXB);
  const float* mod = (const float*)(p.ws + O_MOD);
  bf16_t* H = (bf16_t*)(p.ws + O_H);
  const float* nw = p.norm_w + (size_t)(l * 4 + 0) * 1024;
  for (int row = blockIdx.x * NWAVE + wid; row < NT; row += gridDim.x * NWAVE) {
    const float* xr = row < NL ? xlat + (size_t)row * 1024 : xctx + (size_t)(row - NL) * 1024;
    const int mr = row < NL ? (row >> 12) : 8;
    const float* md = mod + (size_t)(l * 9 + mr) * 6144;
    f32x4 v[4];
    float ss = 0.f;
#pragma unroll
    for (int i = 0; i < 4; ++i) {
      v[i] = *(const f32x4*)(xr + i * 256 + lane * 4);
      ss += v[i][0] * v[i][0] + v[i][1] * v[i][1] + v[i][2] * v[i][2] + v[i][3] * v[i][3];
    }
    ss = wave_sum(ss);
    const float rs = rsqrtf(ss * (1.0f / 1024.0f) + 1e-6f);
#pragma unroll
    for (int i = 0; i < 4; ++i) {
      const int e = i * 256 + lane * 4;
      const f32x4 w = *(const f32x4*)(nw + e), sh = *(const f32x4*)(md + e), sc = *(const f32x4*)(md + 1024 + e);
      f32x4 o;
#pragma unroll
      for (int j = 0; j < 4; ++j) o[j] = v[i][j] * rs * w[j] * (1.0f + sc[j]) + sh[j];
      st4bf(H + (size_t)row * 1024 + e, o);
    }
  }
}

struct EpiGin {
  char* ws; const float* lbp; int l; int pn0;
  __device__ __forceinline__ bool operator()(f32x4 (&acc)[2][2][4][2], const Unit& u, int wr, int wc, int fr, int fq) const {
    const int pn = u.pn + pn0;
    const int sec = pn >> 1, cin0 = (pn & 1) * 256;
    const size_t row0 = (size_t)u.pm * 256;
    if (sec >= 8) {
      const int tl = (wr * 4 + wc) * 64 + fq * 16 + fr;
      unsigned char* GT = (unsigned char*)(ws + O_G) + ((size_t)u.pm * 12 + (pn - 16)) * 65536 + (size_t)tl * 8;
      auto q8 = [](float z) { return __builtin_amdgcn_rcpf(__builtin_fmaf(__expf(-z), 0.00390625f, 0.00390625f)); };
#pragma unroll
      for (int ai = 0; ai < 2; ++ai)
#pragma unroll
        for (int m = 0; m < 4; ++m)
#pragma unroll
          for (int bj = 0; bj < 2; ++bj) {
            const f32x4 a = acc[ai][bj][m][0], b = acc[ai][bj][m][1];
            u32x2 w; w.x = 0u; w.y = 0u;
#pragma unroll
            for (int j = 0; j < 4; ++j) { w.x = __builtin_amdgcn_cvt_pk_u8_f32(q8(a[j]), j, w.x); w.y = __builtin_amdgcn_cvt_pk_u8_f32(q8(b[j]), j, w.y); }
            *(u32x2*)(GT + (size_t)((ai * 4 + m) * 2 + bj) * 4096) = w;
          }
    } else if (sec == 7) {
      bf16_t* VT = (bf16_t*)(ws + O_VT);
      pg8::epi_each(acc, wr, wc, fr, fq, [&](int r, int c, f32x4 v0, f32x4 v1) {
        const int chunk = u.pm * 2 + (r >> 7), q = r & 127, g = (cin0 + c) >> 7, d = c & 127;
        bf16_t* dst = VT + (((size_t)chunk * 4 + g) * 128 + d) * 128 + q;
#pragma unroll
        for (int j = 0; j < 4; ++j) { dst[j * 128] = f2bf(geluf_(v0[j])); dst[(4 + j) * 128] = f2bf(geluf_(v1[j])); }
      });
    } else if (sec == 1 || sec == 2) {
      bf16_t* LF = (bf16_t*)(ws + (sec == 1 ? O_LFF : O_LFB)) + row0 * 512 + cin0;
      const float* lbv = lbp + ((sec - 1) * 2 + l) * 512 + cin0;
      pg8::epi_each(acc, wr, wc, fr, fq, [&](int r, int c, f32x4 v0, f32x4 v1) {
        const f32x4 b0 = *(const f32x4*)(lbv + c), b1 = *(const f32x4*)(lbv + c + 4);
        f32x4 o0, o1;
#pragma unroll
        for (int j = 0; j < 4; ++j) {
          o0[j] = 1.0f - (fmaxf(b0[j], 1e-20f) + (1.0f - b0[j]) * sigmoidf_(v0[j]));
          o1[j] = 1.0f - (fmaxf(b1[j], 1e-20f) + (1.0f - b1[j]) * sigmoidf_(v1[j]));
        }
        st8bf(LF + (size_t)r * 512 + c, o0, o1);
      });
    } else {
      const size_t off = sec == 0 ? O_Q : sec == 3 ? O_I : sec == 4 ? O_GA : sec == 5 ? O_ZB : O_U;
      bf16_t* dst = (bf16_t*)(ws + off) + row0 * 512 + cin0;
      const int act = (sec == 0 || sec == 4) ? 1 : (sec == 6 ? 2 : 0);
      pg8::epi_each(acc, wr, wc, fr, fq, [&](int r, int c, f32x4 v0, f32x4 v1) {
        f32x4 o0, o1;
#pragma unroll
        for (int j = 0; j < 4; ++j) {
          o0[j] = act == 1 ? siluf_(v0[j]) : act == 2 ? geluf_(v0[j]) : v0[j];
          o1[j] = act == 1 ? siluf_(v1[j]) : act == 2 ? geluf_(v1[j]) : v1[j];
        }
        st8bf(dst + (size_t)r * 512 + c, o0, o1);
      });
    }
    return false;
  }
};
constexpr int GIN_R0 = 0;
__device__ __forceinline__ void phase_gin(const Params& p, int l, char* lds, int wid0) {
  const int tid = opaque_tid(wid0);
  PG8_LAS unsigned char* L = (PG8_LAS unsigned char*)lds;
  EpiGin E{p.ws, (const float*)(p.ws + O_LB), l, 0};
  pg8::GridSched S;
  const int R0 = gridDim.x == 256 ? GIN_R0 : 0;
  S.init(p.ws + O_H, p.ws + O_WIN, 1024, (l == 0 ? 136 : 128) - R0, 28, R0, gridDim.x, blockIdx.x);
  pg8::gemm_phase(L, 1024, S, E, tid);
  S.init(p.ws + O_H, p.ws + O_WIN, 1024, R0, 16, 0, gridDim.x, blockIdx.x);
  pg8::gemm_phase(L, 1024, S, E, tid);
  if (l == 1) {
    S.init(p.ws + O_H, p.ws + O_WIN, 1024, 8, 8, 128, gridDim.x, (blockIdx.x + gridDim.x / 2) % gridDim.x);
    pg8::gemm_phase(L, 1024, S, E, tid);
  }
}

__device__ __forceinline__ void phase_mix1(const Params& p, int l, char* lds0, int wid0, int kind, int bfirst, int bi_o = -1, int nb_o = 0) {
  const bool last = (l == 1);
  const int tid = opaque_tid(wid0), t = tid & 255, half = tid >> 8;
  char* lds = lds0 + half * 65536;
  const bf16_t* CS = (const bf16_t*)(p.ws + O_CS);
  const bf16_t* ZB = (const bf16_t*)(p.ws + O_ZB);
  const int NF1L = 2048, NF1C = last ? 0 : 128, NCH = last ? 256 : 272;
  const int ITEM0 = kind == 0 ? 0 : NF1L + NF1C, NITEM = kind == 0 ? NF1L + NF1C : NF1L + NF1C + NCH * 4;
  const int bi = nb_o > 0 ? bi_o : (int)blockIdx.x - bfirst, nb = nb_o > 0 ? nb_o : (int)gridDim.x - bfirst;
  if (bi < 0) return;
  for (int item = ITEM0 + bi * 2 + half; item < NITEM; item += nb * 2) {
    f32x4 acc[4][4];
    zero_acc(acc);
    if (item < NF1L + NF1C) {
      const bool isl = item < NF1L;
      int i = isl ? item : item - NF1L;
      const int mh = i & 1;
      i >>= 1;
      int tt, g, b;
      if (isl) { tt = i & 31; i >>= 5; } else { tt = i & 1; i >>= 1; }
      g = i & 3; b = i >> 2;
      const size_t rowbase = isl ? (size_t)b * 4096 + tt * 128 : (size_t)NL + b * 256 + tt * 128;
      RowLd la(CS, mh * 128, 128, t), lb(ZB + g * 128, rowbase, 512, t);
      gemm_main(acc, 2, la, lb, lds, t);
      bf16_t* dst = isl ? (bf16_t*)(p.ws + O_ZCL) + ((size_t)b * 512 + g * 128) * 8192 + mh * 4096 + tt * 128
                        : (bf16_t*)(p.ws + O_ZCC) + ((size_t)b * 512 + g * 128) * 512 + mh * 256 + tt * 128;
      const size_t ld = isl ? 8192 : 512;
      gemm_epi(acc, [&](int r, int c, f32x4 v) { st4bf(dst + (size_t)r * ld + c, v); }, t);
    } else {
      const int i = item - (NF1L + NF1C), ch = i >> 2, g = i & 3;
      const bf16_t* VT = (const bf16_t*)(p.ws + O_VT) + ((size_t)ch * 4 + g) * 128 * 128;
      float* rstd = (float*)lds;
      {
        float* part = (float*)(lds + 1024);
        const int dg = t >> 4, q8 = (t & 15) * 8;
        float ps[8];
#pragma unroll
        for (int j = 0; j < 8; ++j) ps[j] = 0.f;
#pragma unroll
        for (int i = 0; i < 8; ++i) {
          const u32x4 w = *(const u32x4*)(VT + (size_t)(i * 16 + dg) * 128 + q8);
          const float v0 = bflo(w.x), v1 = bfhi(w.x), v2 = bflo(w.y), v3 = bfhi(w.y), v4 = bflo(w.z), v5 = bfhi(w.z), v6 = bflo(w.w), v7 = bfhi(w.w);
          ps[0] += v0 * v0; ps[1] += v1 * v1; ps[2] += v2 * v2; ps[3] += v3 * v3; ps[4] += v4 * v4; ps[5] += v5 * v5; ps[6] += v6 * v6; ps[7] += v7 * v7;
        }
        *(f32x4*)(part + dg * 128 + q8) = (f32x4){ps[0], ps[1], ps[2], ps[3]};
        *(f32x4*)(part + dg * 128 + q8 + 4) = (f32x4){ps[4], ps[5], ps[6], ps[7]};
        __syncthreads();
        if (t < 128) {
          float ss = 0.f;
#pragma unroll
          for (int g2 = 0; g2 < 16; ++g2) ss += part[g2 * 128 + t];
          rstd[t] = rsqrtf(ss * (1.0f / 128.0f) + 1e-6f);
        }
      }
      __syncthreads();
      const float* wsg = p.sgu_w + ((size_t)l * 4 + g) * 128 * 128;
      const int kc = (t & 7) * 8;
      float rr[2][8];
#pragma unroll
      for (int h2 = 0; h2 < 2; ++h2)
#pragma unroll
        for (int j = 0; j < 8; ++j) rr[h2][j] = rstd[h2 * 64 + kc + j];
      __syncthreads();
      auto la = [&](int ii, int k0) -> bf16x8 {
        const float* s = wsg + (size_t)((t >> 3) + 32 * ii) * 128 + k0 + kc;
        const f32x4 a = *(const f32x4*)s, b = *(const f32x4*)(s + 4);
        const int h2 = k0 >> 6;
        u32x4 w;
        w.x = pk_bf16(a[0] * (h2 ? rr[1][0] : rr[0][0]), a[1] * (h2 ? rr[1][1] : rr[0][1]));
        w.y = pk_bf16(a[2] * (h2 ? rr[1][2] : rr[0][2]), a[3] * (h2 ? rr[1][3] : rr[0][3]));
        w.z = pk_bf16(b[0] * (h2 ? rr[1][4] : rr[0][4]), b[1] * (h2 ? rr[1][5] : rr[0][5]));
        w.w = pk_bf16(b[2] * (h2 ? rr[1][6] : rr[0][6]), b[3] * (h2 ? rr[1][7] : rr[0][7]));
        return __builtin_bit_cast(bf16x8, w);
      };
      RowLd lb(VT, 0, 128, t);
      gemm_main(acc, 2, la, lb, lds, t);
      bf16_t* U = (bf16_t*)(p.ws + O_U) + (size_t)ch * 128 * 512 + g * 128;
      const float* nwv = p.sgu_norm_w + ((size_t)l * 4 + g) * 128;
      const float* sb = p.sgu_b + ((size_t)l * 4 + g) * 128;
      {
        const int lane = t & 63, wid = t >> 6, fr = lane & 15, fq = lane >> 4, wr = wid >> 1, wc = wid & 1;
        bf16_t* ub = U + (size_t)(wr * 64 + fr) * 512 + wc * 64 + fq * 4;
        u32x2 uw[4][4];
#pragma unroll
        for (int m = 0; m < 4; ++m)
#pragma unroll
          for (int n = 0; n < 4; ++n) uw[m][n] = *(const u32x2*)(ub + (size_t)m * 16 * 512 + n * 16);
#pragma unroll
        for (int m = 0; m < 4; ++m) {
          const float bb = sb[wr * 64 + m * 16 + fr];
#pragma unroll
          for (int n = 0; n < 4; ++n) {
            const f32x4 nw4 = *(const f32x4*)(nwv + wc * 64 + n * 16 + fq * 4);
            const f32x4 v = acc[m][n];
            f32x4 o;
            o[0] = bflo(uw[m][n].x) * (v[0] * nw4[0] + bb);
            o[1] = bfhi(uw[m][n].x) * (v[1] * nw4[1] + bb);
            o[2] = bflo(uw[m][n].y) * (v[2] * nw4[2] + bb);
            o[3] = bfhi(uw[m][n].y) * (v[3] * nw4[3] + bb);
            st4bf(ub + (size_t)m * 16 * 512 + n * 16, o);
          }
        }
      }
    }
  }
  __syncthreads();
}

#define SCAN_BAR() do { asm volatile("s_waitcnt lgkmcnt(0)" ::: "memory"); __builtin_amdgcn_s_barrier(); asm volatile("" ::: "memory"); } while (0)
__device__ __forceinline__ void scan_item(const Params& p, int item, char* lds, const int tid) {
  const int dir = item & 1, h = (item >> 1) & 3, b = item >> 3;
  const int wv = tid >> 6, lane = tid & 63, fr = lane & 15, fq = lane >> 4;
  const bool isP = wv < 4;
  char* RAWB = lds + 69632;
  float* qsum = (float*)(lds + 143360);
  const bf16_t* Q = (const bf16_t*)(p.ws + O_Q);
  const bf16_t* LF = (const bf16_t*)(p.ws + (dir ? O_LFB : O_LFF));
  const bf16_t* I = (const bf16_t*)(p.ws + O_I);
  bf16_t* O = (bf16_t*)(p.ws + (dir ? O_OBK : O_OF));
  auto rowOf = [&](int u) -> size_t {
    if (u < 256) return (size_t)NL + b * 256 + (dir ? 255 - u : u);
    const int v = u - 256;
    return (size_t)b * 4096 + (dir ? 4095 - v : v);
  };
  const int cp = tid & 63, tq = (tid >> 6) & 3;
  const bf16_t* srcs[3] = {LF, Q, I};
  auto dma = [&](int cc) {
    PG8_LAS unsigned char* dstb = (PG8_LAS unsigned char*)RAWB + (cc % 3) * 24576;
#pragma unroll
    for (int j = 0; j < 6; ++j) {
      const int g = j * 4 + wv, arr = g >> 3, rg = g & 7;
      const size_t o = rowOf(cc * 32 + rg * 4 + (lane >> 4)) * 512 + h * 128 + (lane & 15) * 8;
      __builtin_amdgcn_global_load_lds((const unsigned*)(srcs[arr] + o), (PG8_LAS unsigned*)(dstb + arr * 8192 + rg * 1024), 16, 0, 0);
    }
  };
  unsigned wkk[8];
  auto prepA = [&](int cc) {
    const char* raw = RAWB + (cc % 3) * 24576;
#pragma unroll
    for (int i = 0; i < 8; ++i) wkk[i] = *(const unsigned*)(raw + (tq * 8 + i) * 256 + cp * 4);
    f32x2 run = {1.f, 1.f};
#pragma unroll
    for (int i = 0; i < 8; ++i) { const f32x2 kk = {bflo(wkk[i]), bfhi(wkk[i])}; run = run * (1.0f - kk); }
    *(f32x2*)(qsum + tq * 128 + cp * 2) = run;
  };
  auto prepB = [&](int cc) {
    const char* raw = RAWB + (cc % 3) * 24576;
    char* OPB = lds + (cc & 1) * 34816;
    char* QP = OPB; char* KM = OPB + 8704; char* KT = OPB + 17408; char* VT = OPB + 25600;
    float* emid = (float*)(OPB + 33792); float* eend = emid + 128;
    unsigned wq[8], wi[8];
#pragma unroll
    for (int i = 0; i < 8; ++i) { wq[i] = *(const unsigned*)(raw + 8192 + (tq * 8 + i) * 256 + cp * 4); wi[i] = *(const unsigned*)(raw + 16384 + (tq * 8 + i) * 256 + cp * 4); }
    const f32x2 q0 = *(const f32x2*)(qsum + cp * 2), q1 = *(const f32x2*)(qsum + 128 + cp * 2), q2 = *(const f32x2*)(qsum + 256 + cp * 2), q3 = *(const f32x2*)(qsum + 384 + cp * 2);
    const f32x2 one = {1.f, 1.f};
    const f32x2 pmid = q0 * q1, pend = pmid * q2 * q3;
    const f32x2 base = tq == 0 ? one : tq == 1 ? q0 : tq == 2 ? pmid : pmid * q2;
    f32x2 rmid; rmid.x = __builtin_amdgcn_rcpf(fmaxf(pmid.x, 1e-30f)); rmid.y = __builtin_amdgcn_rcpf(fmaxf(pmid.y, 1e-30f));
    f32x2 ebm = pend * rmid; ebm.x = fminf(ebm.x, 1.0f); ebm.y = fminf(ebm.y, 1.0f);
    f32x2 run = base * rmid;
    unsigned oq[8], ok[8], kt0[4], kt1[4], vt0[4], vt1[4];
    float pk0 = 0.f, pk1 = 0.f;
#pragma unroll
    for (int i = 0; i < 8; ++i) {
      const f32x2 kk = {bflo(wkk[i]), bfhi(wkk[i])}, qv = {bflo(wq[i]), bfhi(wq[i])};
      run = run * (one - kk);
      f32x2 ea; ea.x = fminf(fmaxf(run.x, 1e-26f), 1e26f); ea.y = fminf(fmaxf(run.y, 1e-26f), 1e26f);
      f32x2 er; er.x = __builtin_amdgcn_rcpf(ea.x); er.y = __builtin_amdgcn_rcpf(ea.y);
      const f32x2 km = kk * er, qp = qv * ea, kpp = km * ebm;
      oq[i] = pk_bf16(qp.x, qp.y);
      ok[i] = pk_bf16(km.x, km.y);
      if (i & 1) {
        kt0[i >> 1] = pk_bf16(pk0, kpp.x); kt1[i >> 1] = pk_bf16(pk1, kpp.y);
        vt0[i >> 1] = (wi[i - 1] & 0xffffu) | (wi[i] << 16); vt1[i >> 1] = (wi[i - 1] >> 16) | (wi[i] & 0xffff0000u);
      } else { pk0 = kpp.x; pk1 = kpp.y; }
    }
#pragma unroll
    for (int i = 0; i < 8; ++i) { *(unsigned*)(QP + (tq * 8 + i) * 272 + cp * 4) = oq[i]; *(unsigned*)(KM + (tq * 8 + i) * 272 + cp * 4) = ok[i]; }
    u32x4 w;
    w.x = kt0[0]; w.y = kt0[1]; w.z = kt0[2]; w.w = kt0[3]; *(u32x4*)(KT + (cp * 2) * 64 + tq * 16) = w;
    w.x = kt1[0]; w.y = kt1[1]; w.z = kt1[2]; w.w = kt1[3]; *(u32x4*)(KT + (cp * 2 + 1) * 64 + tq * 16) = w;
    w.x = vt0[0]; w.y = vt0[1]; w.z = vt0[2]; w.w = vt0[3]; *(u32x4*)(VT + (cp * 2) * 64 + tq * 16) = w;
    w.x = vt1[0]; w.y = vt1[1]; w.z = vt1[2]; w.w = vt1[3]; *(u32x4*)(VT + (cp * 2 + 1) * 64 + tq * 16) = w;
    if (tq == 0) { *(f32x2*)(emid + cp * 2) = pmid; *(f32x2*)(eend + cp * 2) = pend; }
  };
  const int mw = wv - 4;
  f32x4 S[2][8];
#pragma unroll
  for (int a = 0; a < 2; ++a)
#pragma unroll
    for (int m = 0; m < 8; ++m) S[a][m] = (f32x4){0.f, 0.f, 0.f, 0.f};

  if (isP) { dma(0); dma(1); dma(2); asm volatile("s_waitcnt vmcnt(12)" ::: "memory"); }
  SCAN_BAR();
  if (isP) prepA(0);
  SCAN_BAR();
  if (isP) { prepB(0); asm volatile("s_waitcnt vmcnt(6)" ::: "memory"); }
  SCAN_BAR();
  for (int c = 0; c < 136; ++c) {
    if (isP) {
      if (c + 3 < 136) dma(c + 3);
      if (c + 1 < 136) prepA(c + 1);
      SCAN_BAR();
      if (c + 1 < 136) prepB(c + 1);
      if (c + 3 < 136) asm volatile("s_waitcnt vmcnt(6)" ::: "memory");
      else asm volatile("s_waitcnt vmcnt(0)" ::: "memory");
      SCAN_BAR();
    } else {
      const char* OPB = lds + (c & 1) * 34816;
      const char* QP = OPB; const char* KM = OPB + 8704; const char* KT = OPB + 17408; const char* VT = OPB + 25600;
      const float* emid = (const float*)(OPB + 33792); const float* eend = emid + 128;
      f32x4 PT00 = (f32x4){0.f, 0.f, 0.f, 0.f}, PT01 = PT00, PT11 = PT00;
#pragma unroll
      for (int ks = 0; ks < 4; ++ks) {
        const bf16x8 X0 = *(const bf16x8*)(KM + fr * 272 + ks * 64 + fq * 16), X1 = *(const bf16x8*)(KM + (16 + fr) * 272 + ks * 64 + fq * 16);
        const bf16x8 Y0 = *(const bf16x8*)(QP + fr * 272 + ks * 64 + fq * 16), Y1 = *(const bf16x8*)(QP + (16 + fr) * 272 + ks * 64 + fq * 16);
        PT00 = __builtin_amdgcn_mfma_f32_16x16x32_bf16(X0, Y0, PT00, 0, 0, 0);
        PT01 = __builtin_amdgcn_mfma_f32_16x16x32_bf16(X0, Y1, PT01, 0, 0, 0);
        PT11 = __builtin_amdgcn_mfma_f32_16x16x32_bf16(X1, Y1, PT11, 0, 0, 0);
      }
      SCAN_BAR();
#pragma unroll
      for (int jj = 0; jj < 4; ++jj) if (fq * 4 + jj > fr) { PT00[jj] = 0.f; PT11[jj] = 0.f; }
      u32x4 x0, x1;
      x0.x = pk_bf16(PT00[0], PT00[1]); x0.y = pk_bf16(PT00[2], PT00[3]); x0.z = 0u; x0.w = 0u;
      x1.x = pk_bf16(PT01[0], PT01[1]); x1.y = pk_bf16(PT01[2], PT01[3]); x1.z = pk_bf16(PT11[0], PT11[1]); x1.w = pk_bf16(PT11[2], PT11[3]);
      const size_t orow0 = rowOf(c * 32);
      const long ostep = dir ? -512 : 512;
#pragma unroll
      for (int a = 0; a < 2; ++a) {
        const int vcol = (mw * 2 + a) * 16 + fr;
        f32x4 o0 = (f32x4){0.f, 0.f, 0.f, 0.f}, o1 = o0;
        {
          const u32x2 vlo = *(const u32x2*)(VT + vcol * 64 + fq * 8), vhi = *(const u32x2*)(VT + vcol * 64 + 32 + fq * 8);
          u32x4 yv; yv.x = vlo.x; yv.y = vlo.y; yv.z = vhi.x; yv.w = vhi.y;
          o0 = __builtin_amdgcn_mfma_f32_16x16x32_bf16(__builtin_bit_cast(bf16x8, x0), __builtin_bit_cast(bf16x8, yv), o0, 0, 0, 0);
          o1 = __builtin_amdgcn_mfma_f32_16x16x32_bf16(__builtin_bit_cast(bf16x8, x1), __builtin_bit_cast(bf16x8, yv), o1, 0, 0, 0);
        }
#pragma unroll
        for (int ks = 0; ks < 4; ++ks) {
          const f32x4 em0 = *(const f32x4*)(emid + (2 * ks) * 16 + fq * 4), em1 = *(const f32x4*)(emid + (2 * ks + 1) * 16 + fq * 4);
          u32x4 ys;
          ys.x = pk_bf16(S[a][2 * ks][0] * em0[0], S[a][2 * ks][1] * em0[1]); ys.y = pk_bf16(S[a][2 * ks][2] * em0[2], S[a][2 * ks][3] * em0[3]);
          ys.z = pk_bf16(S[a][2 * ks + 1][0] * em1[0], S[a][2 * ks + 1][1] * em1[1]); ys.w = pk_bf16(S[a][2 * ks + 1][2] * em1[2], S[a][2 * ks + 1][3] * em1[3]);
          const u32x2 a0 = *(const u32x2*)(QP + fr * 272 + ks * 64 + fq * 8), a1 = *(const u32x2*)(QP + fr * 272 + ks * 64 + 32 + fq * 8);
          const u32x2 c0 = *(const u32x2*)(QP + (16 + fr) * 272 + ks * 64 + fq * 8), c1 = *(const u32x2*)(QP + (16 + fr) * 272 + ks * 64 + 32 + fq * 8);
          u32x4 xa, xc; xa.x = a0.x; xa.y = a0.y; xa.z = a1.x; xa.w = a1.y; xc.x = c0.x; xc.y = c0.y; xc.z = c1.x; xc.w = c1.y;
          o0 = __builtin_amdgcn_mfma_f32_16x16x32_bf16(__builtin_bit_cast(bf16x8, xa), __builtin_bit_cast(bf16x8, ys), o0, 0, 0, 0);
          o1 = __builtin_amdgcn_mfma_f32_16x16x32_bf16(__builtin_bit_cast(bf16x8, xc), __builtin_bit_cast(bf16x8, ys), o1, 0, 0, 0);
        }
        bf16_t* op = O + orow0 * 512 + h * 128 + vcol;
#pragma unroll
        for (int jj = 0; jj < 4; ++jj) {
          op[(long)(fq * 4 + jj) * ostep] = f2bf(o0[jj]);
          op[(long)(16 + fq * 4 + jj) * ostep] = f2bf(o1[jj]);
        }
        {
          const bf16x8 yv2 = *(const bf16x8*)(VT + vcol * 64 + fq * 16);
#pragma unroll
          for (int m = 0; m < 8; ++m) {
            const f32x4 ee = *(const f32x4*)(eend + m * 16 + fq * 4);
            const bf16x8 xk = *(const bf16x8*)(KT + (m * 16 + fr) * 64 + fq * 16);
            S[a][m] = __builtin_amdgcn_mfma_f32_16x16x32_bf16(xk, yv2, S[a][m] * ee, 0, 0, 0);
          }
        }
      }
      SCAN_BAR();
    }
  }
  __syncthreads();
}

struct F2Sched {
  const char* FT; const char* ZF; int G, c;
  __device__ __forceinline__ bool next(int i, Unit& u) const {
    const int P = c - 64;
    if (i > 1 || P < 0 || P >= 128) return false;
    const int loc = P >> 3; u.z = (P & 7) | (i << 3); u.pm = loc >> 1; u.pn = loc & 1; return true;
  }
  __device__ __forceinline__ const char* aptr(const Unit& u) const { return FT + (size_t)((u.z >> 3) ^ 1) * ((size_t)2048 * KH * 2) + (size_t)u.pm * ((size_t)256 * KH * 2); }
  __device__ __forceinline__ const char* bptr(const Unit& u) const { return ZF + (size_t)((u.z >> 3) ^ 1) * ((size_t)4096 * KH * 2) + ((size_t)(u.z & 7) * 512 + (size_t)u.pn * 256) * ((size_t)KH * 2); }
};
struct F2CSched {
  const char* FT; const char* ZC; int c;
  __device__ __forceinline__ bool next(int i, Unit& u) const {
    const int L = c - 192; if (i != 0 || L < 0 || L >= 16) return false;
    u.z = L >> 1; u.pm = 0; u.pn = L & 1; return true;
  }
  __device__ __forceinline__ const char* aptr(const Unit&) const { return FT; }
  __device__ __forceinline__ const char* bptr(const Unit& u) const { return ZC + (size_t)u.z * (512u * 512u * 2u) + (size_t)u.pn * (256u * 512u * 2u); }
};
struct EpiF2 {
  bf16_t* OB; int ctx; float* SX;
  __device__ __forceinline__ bool operator()(f32x4 (&acc)[2][2][4][2], const Unit& u, int wr, int wc, int fr, int fq) const {
    if (ctx) {
      bf16_t* dst = OB + ((size_t)NL + (size_t)u.z * 256) * 512 + u.pn * 256;
      pg8::epi_each(acc, wr, wc, fr, fq, [&](int r, int c, f32x4 v0, f32x4 v1) { st8bf(dst + (size_t)r * 512 + c, v0, v1); });
      return false;
    }
    const int b = u.z & 7, part = u.z >> 3;
    const int tl = (wr * 4 + wc) * 64 + fq * 16 + fr;
    float* sx = SX + ((size_t)(b + 8 * (u.pm * 2 + u.pn)) * 16) * 4096 + (size_t)tl * 8;
    bf16_t* dst = OB + (size_t)b * 4096 * 512 + u.pn * 256;
#pragma unroll
    for (int ai = 0; ai < 2; ++ai)
#pragma unroll
      for (int m = 0; m < 4; ++m)
#pragma unroll
        for (int bj = 0; bj < 2; ++bj) {
          float* q = sx + (size_t)((ai * 4 + m) * 2 + bj) * 4096;
          if (part == 0) { *(f32x4*)q = acc[ai][bj][m][0]; *(f32x4*)(q + 4) = acc[ai][bj][m][1]; }
          else {
            const f32x4 s0 = *(const f32x4*)q, s1 = *(const f32x4*)(q + 4);
            const int k = u.pm * 256 + ai * 128 + wr * 64 + m * 16 + fr, c = bj * 128 + wc * 32 + 8 * fq;
            st8bf(dst + (size_t)k * 512 + c, acc[ai][bj][m][0], acc[ai][bj][m][1]);
            if (k >= 1) st8bf(dst + (size_t)(4096 - k) * 512 + c, acc[ai][bj][m][0] - 2.0f * s0, acc[ai][bj][m][1] - 2.0f * s1);
          }
        }
    return part == 0;
  }
};
__device__ __forceinline__ void phase_fold(const Params& p, char* lds, int wid0, int bfirst) {
  const int tid = opaque_tid(wid0);
  bf16_t* zrow = (bf16_t*)lds;
  const bf16_t* ZCL = (const bf16_t*)(p.ws + O_ZCL);
  bf16_t* ZF = (bf16_t*)(p.ws + O_ZF);
  bf16_t* OB = (bf16_t*)(p.ws + O_ZB);
  float* red = (float*)(lds + 16384);
  if ((int)blockIdx.x < bfirst) return;
  for (int row = (int)blockIdx.x - bfirst; row < 8 * 512; row += (int)gridDim.x - bfirst) {
    const bf16_t* src = ZCL + (size_t)row * 8192;
#pragma unroll
    for (int i = 0; i < 2; ++i) *(u32x4*)(zrow + (tid + i * 512) * 8) = *(const u32x4*)(src + (tid + i * 512) * 8);
    __syncthreads();
    float alt = 0.f;
    for (int e8 = tid; e8 < 2 * (KH / 8); e8 += NTHREADS) {
      const int part = e8 >= KH / 8 ? 1 : 0, e = part ? e8 - KH / 8 : e8;
      float v[8];
#pragma unroll
      for (int jx = 0; jx < 8; ++jx) {
        const int t = e * 8 + jx;
        if (!part) v[jx] = t > 2048 ? 0.f : (t == 0 || t == 2048) ? bf2f(zrow[t]) : bf2f(zrow[t]) + bf2f(zrow[4096 - t]);
        else v[jx] = (t == 0 || t >= 2048) ? 0.f : bf2f(zrow[4096 + t]) - bf2f(zrow[4096 + 4096 - t]);
      }
      u32x4 w;
      w.x = pk_bf16(v[0], v[1]); w.y = pk_bf16(v[2], v[3]); w.z = pk_bf16(v[4], v[5]); w.w = pk_bf16(v[6], v[7]);
      *(u32x4*)(ZF + ((size_t)part * 4096 + row) * KH + e * 8) = w;
      if (!part) alt += (bflo(w.x) - bfhi(w.x)) + (bflo(w.y) - bfhi(w.y)) + (bflo(w.z) - bfhi(w.z)) + (bflo(w.w) - bfhi(w.w));
    }
    alt = wave_sum(alt);
    if ((tid & 63) == 0) red[tid >> 6] = alt;
    __syncthreads();
    if (tid == 0) {
      float a = 0.f;
#pragma unroll
      for (int w8 = 0; w8 < 8; ++w8) a += red[w8];
      OB[((size_t)(row >> 9) * 4096 + 2048) * 512 + (row & 511)] = f2bf(a * bf2f(f2bf(0.0013810679320049757f)));
    }
  }
}
__device__ __forceinline__ void phase_mix2(const Params& p, int l, char* lds, int wid0) {
  const int tid = opaque_tid(wid0);
  if (blockIdx.x < 64) { scan_item(p, blockIdx.x, lds, tid); return; }
  unsigned* bar = (unsigned*)(p.ws + O_BAR);
  const int nb = (int)gridDim.x - 64;
  phase_mix1(p, l, lds, wid0, 0, 64);
  sub_barrier(bar + (l * 2 + 0) * 16, nb);
  phase_fold(p, lds, wid0, 64);
  sub_barrier(bar + (l * 2 + 1) * 16, nb);
  if (blockIdx.x >= 192) { for (int sh = 0; sh < 2; ++sh) phase_mix1(p, l, lds, wid0, 1, 64, ((int)blockIdx.x - 192) * 2 + sh, 512); }
  else { for (int sh = 0; sh < 3; ++sh) phase_mix1(p, l, lds, wid0, 1, 64, 128 + ((int)blockIdx.x - 64) * 3 + sh, 512); }
  PG8_LAS unsigned char* L = (PG8_LAS unsigned char*)lds;
  {
    F2Sched S{p.ws + O_FTL, p.ws + O_ZF, (int)gridDim.x, (int)blockIdx.x};
    EpiF2 E{(bf16_t*)(p.ws + O_ZB), 0, (float*)(p.ws + O_ZCL)};
    pg8::gemm_phase(L, KH, S, E, tid);
  }
  if (l == 0) {
    F2CSched S{p.ws + O_FTC, p.ws + O_ZCC, (int)blockIdx.x};
    EpiF2 E{(bf16_t*)(p.ws + O_ZB), 1, nullptr};
    pg8::gemm_phase(L, 512, S, E, tid);
  }
  if (gridDim.x == 256) {
    pg8::GridSched S;
    S.init(p.ws + O_H, p.ws + O_WIN + (size_t)16 * 256 * 1024 * 2, 1024, GIN_R0, 12, 0, (int)gridDim.x - 64, (int)blockIdx.x - 64);
    EpiGin E{p.ws, (const float*)(p.ws + O_LB), l, 16};
    pg8::gemm_phase(L, 1024, S, E, tid);
  }
}

__device__ __forceinline__ void phase_oa(const Params& p, int l, int wid0) {
  const int tid = opaque_tid(wid0), wid = tid >> 6, lane = tid & 63;
  const int nrow = (l == 1) ? NL : NT;
  const bf16_t* OF = (const bf16_t*)(p.ws + O_OF);
  const bf16_t* OK = (const bf16_t*)(p.ws + O_OBK);
  bf16_t* GA = (bf16_t*)(p.ws + O_GA);
  const float* gw = p.gnorm_w + (size_t)l * 128;
  for (int row = blockIdx.x * NWAVE + wid; row < nrow; row += gridDim.x * NWAVE) {
    const size_t o = (size_t)row * 512 + lane * 8;
    const u32x4 a = *(const u32x4*)(OF + o), b = *(const u32x4*)(OK + o), g = *(const u32x4*)(GA + o);
    float v[8];
    v[0] = bflo(a.x) + bflo(b.x); v[1] = bfhi(a.x) + bfhi(b.x);
    v[2] = bflo(a.y) + bflo(b.y); v[3] = bfhi(a.y) + bfhi(b.y);
    v[4] = bflo(a.z) + bflo(b.z); v[5] = bfhi(a.z) + bfhi(b.z);
    v[6] = bflo(a.w) + bflo(b.w); v[7] = bfhi(a.w) + bfhi(b.w);
    float ss = 0.f;
#pragma unroll
    for (int j = 0; j < 8; ++j) ss += v[j] * v[j];
    ss += __shfl_xor(ss, 1); ss += __shfl_xor(ss, 2); ss += __shfl_xor(ss, 4); ss += __shfl_xor(ss, 8);
    const float rs = rsqrtf(ss * (1.0f / 128.0f) + 1e-6f);
    const float* gwp = gw + (lane & 15) * 8;
    const f32x4 w0 = *(const f32x4*)gwp, w1 = *(const f32x4*)(gwp + 4);
    float gg[8] = {bflo(g.x), bfhi(g.x), bflo(g.y), bfhi(g.y), bflo(g.z), bfhi(g.z), bflo(g.w), bfhi(g.w)};
    u32x4 w;
    w.x = pk_bf16(v[0] * rs * w0[0] * gg[0], v[1] * rs * w0[1] * gg[1]);
    w.y = pk_bf16(v[2] * rs * w0[2] * gg[2], v[3] * rs * w0[3] * gg[3]);
    w.z = pk_bf16(v[4] * rs * w1[0] * gg[4], v[5] * rs * w1[1] * gg[5]);
    w.w = pk_bf16(v[6] * rs * w1[2] * gg[6], v[7] * rs * w1[3] * gg[7]);
    *(u32x4*)(GA + o) = w;
  }
}

#define HC_MERGE 136
#define HC_MOE1  152
__device__ __forceinline__ void hc_publish(unsigned* cnt) {
  asm volatile("s_waitcnt vmcnt(0)" ::: "memory");
  __syncthreads();
  if (threadIdx.x == 0) { __threadfence(); (void)xb_add(cnt, 1u); }
}
__device__ __forceinline__ void hc_wait(unsigned* bar, unsigned* cnt, unsigned target) {
  if (threadIdx.x == 0) { XB_SPIN(xb_ld(cnt) < target, bar); __threadfence(); }
  __syncthreads();
}
struct OneSched {
  const char* A; const char* B; int pm, pn, z;
  __device__ __forceinline__ bool next(int i, Unit& u) const { if (i) return false; u.pm = pm; u.pn = pn; u.z = z; return true; }
  __device__ __forceinline__ const char* aptr(const Unit&) const { return A; }
  __device__ __forceinline__ const char* bptr(const Unit&) const { return B; }
};
struct EpiStoreBf16 {
  bf16_t* dst; int ld;
  __device__ __forceinline__ bool operator()(f32x4 (&acc)[2][2][4][2], const Unit& u, int wr, int wc, int fr, int fq) const {
    bf16_t* d = dst + (size_t)u.pm * 256 * ld + u.pn * 256;
    pg8::epi_each(acc, wr, wc, fr, fq, [&](int r, int c, f32x4 v0, f32x4 v1) { st8bf(d + (size_t)r * ld + c, v0, v1); });
    return false;
  }
};
struct MergeSched {
  const char* ws; int ntile, G, c, fuse;
  __device__ __forceinline__ bool next(int i, Unit& u) const {
    const int xcd = c & 7, q = c >> 3;
    int rnd = i / 3;
    if (fuse && c < 32) rnd = rnd == 0 ? 2 : rnd == 2 ? 0 : rnd;
    u.pm = (rnd * (G >> 5) + (q >> 2)) * 8 + xcd; u.pn = q & 3; u.z = i % 3;
    return u.pm * 4 < ntile && (q >> 2) < (G >> 5);
  }
  __device__ __forceinline__ const char* aptr(const Unit& u) const {
    return ws + (u.z == 0 ? O_GA : u.z == 1 ? O_ZB : O_U) + (size_t)u.pm * (256u * 512u * 2u);
  }
  __device__ __forceinline__ const char* bptr(const Unit& u) const { return ws + O_WBR + (size_t)u.z * (1024u * 512u * 2u) + (size_t)u.pn * (256u * 512u * 2u); }
};
struct EpiMerge {
  char* ws; int fuse;
  __device__ __forceinline__ bool operator()(f32x4 (&acc)[2][2][4][2], const Unit& u, int wr, int wc, int fr, int fq) const {
    const int tl = (wr * 4 + wc) * 64 + fq * 16 + fr;
    const unsigned char* GT = (const unsigned char*)(ws + O_G) + ((size_t)u.pm * 12 + u.z * 4 + u.pn) * 65536 + (size_t)tl * 8;
    auto ub = [](unsigned w, int k) { return (float)((w >> (8 * k)) & 0xffu) + 0.5f; };
    bf16_t* MG = (bf16_t*)(ws + O_H) + (size_t)u.pm * 256 * 1024 + u.pn * 256;
    const bool lastj = (u.z == 2);
#pragma unroll
    for (int ai = 0; ai < 2; ++ai)
#pragma unroll
      for (int m = 0; m < 4; ++m)
#pragma unroll
        for (int bj = 0; bj < 2; ++bj) {
          const int cidx = (ai * 4 + m) * 2 + bj;
          const u32x2 gw = *(const u32x2*)(GT + (size_t)cidx * 4096);
          f32x4 g0, g1;
#pragma unroll
          for (int q = 0; q < 4; ++q) { g0[q] = ub(gw.x, q); g1[q] = ub(gw.y, q); }
          if (lastj) {
            const int r = ai * 128 + wr * 64 + m * 16 + fr, c = bj * 128 + wc * 32 + 8 * fq;
            st8bf(MG + (size_t)r * 1024 + c, acc[ai][bj][m][0] * (g0 * 0.00390625f), acc[ai][bj][m][1] * (g1 * 0.00390625f));
          } else {
            const u32x2 hw = *(const u32x2*)(GT + 4 * 65536 + (size_t)cidx * 4096);
#pragma unroll
            for (int q = 0; q < 4; ++q) {
              acc[ai][bj][m][0][q] *= g0[q] * __builtin_amdgcn_rcpf(ub(hw.x, q));
              acc[ai][bj][m][1][q] *= g1[q] * __builtin_amdgcn_rcpf(ub(hw.y, q));
            }
          }
        }
    if (fuse && lastj && u.pm >= 128) hc_publish((unsigned*)(ws + O_BAR) + HC_MERGE);
    return !lastj;
  }
};
__device__ __forceinline__ void phase_merge(const Params& p, int l, char* lds, int wid0) {
  const int tid = opaque_tid(wid0);
  const int fuse = (l == 0 && gridDim.x == 256) ? 1 : 0;
  MergeSched S{p.ws, (l == 1 ? 128 : 136) * 4, (int)gridDim.x, (int)blockIdx.x, fuse};
  EpiMerge E{p.ws, fuse};
  pg8::gemm_phase((PG8_LAS unsigned char*)lds, 512, S, E, tid);
  if (fuse) {
    const int c = (int)blockIdx.x;
    if (c >= 32 && c < 64) {
      unsigned* bar = (unsigned*)(p.ws + O_BAR);
      hc_wait(bar, bar + HC_MERGE, 32u);
      const int pm = 128 + (c & 7), pn = (c >> 3) - 4;
      OneSched S2{p.ws + O_H + (size_t)pm * (256u * 1024u * 2u), p.ws + O_WOUT + (size_t)pn * (256u * 1024u * 2u), pm, pn, 0};
      EpiStoreBf16 E2{(bf16_t*)(p.ws + O_Y), 1024};
      pg8::gemm_phase((PG8_LAS unsigned char*)lds, 1024, S2, E2, tid);
    } else if (c >= 64) conv_fill(p, lds, wid0, 0, c - 64, 192);
  }
}

__device__ __forceinline__ void phase_wout(const Params& p, int l, char* lds, int wid0) {
  const int tid = opaque_tid(wid0);
  pg8::GridSched S;
  const bool fuse = l == 0 && gridDim.x == 256;
  S.init(p.ws + O_H, p.ws + O_WOUT, 1024, (l == 1 || fuse) ? 128 : 136, 4, 0, gridDim.x, blockIdx.x);
  EpiStoreBf16 E{(bf16_t*)(p.ws + O_Y), 1024};
  pg8::gemm_phase((PG8_LAS unsigned char*)lds, 1024, S, E, tid);
}

template <int l>
__device__ __forceinline__ void phase_rowB(const Params& p, char* lds, int wid0) {
  const int tid = opaque_tid(wid0), wid = tid >> 6, lane = tid & 63;
  const int nrow = (l == 1) ? NL : NT;
  const float* xlat = l == 0 ? p.x : p.out;
  const float* xctx = l == 0 ? p.ctx : (const float*)(p.ws + O_CTXB);
  const float* mod = (const float*)(p.ws + O_MOD);
  bf16_t* Y = (bf16_t*)(p.ws + O_Y);
  bf16_t* H = (bf16_t*)(p.ws + O_H);
  float* aff = (float*)(p.ws + O_AFF);
  const float* nw1 = p.norm_w + (size_t)(l * 4 + 1) * 1024;
  const float* nw2 = p.norm_w + (size_t)(l * 4 + 2) * 1024;
  const float* rw = p.router_w + (size_t)l * 1024 * 16;
  float* rwT = (float*)lds;
  for (int i = tid; i < 16384; i += NTHREADS) rwT[(i & 15) * 1024 + (i >> 4)] = rw[i];
  __syncthreads();
  u32x4 pfy[2]; f32x4 pfx[4];
  auto fetch = [&](int row) {
    const float* xr = row < NL ? xlat + (size_t)row * 1024 : xctx + (size_t)(row - NL) * 1024;
#pragma unroll
    for (int i = 0; i < 2; ++i) {
      const int e = i * 512 + lane * 8;
      pfy[i] = *(const u32x4*)(Y + (size_t)row * 1024 + e);
      if (l == 1) pfx[i * 2] = *(const f32x4*)((const bf16_t*)p.out + (size_t)row * 1024 + e);
      else { pfx[i * 2] = *(const f32x4*)(xr + e); pfx[i * 2 + 1] = *(const f32x4*)(xr + e + 4); }
    }
  };
  const int row0 = blockIdx.x * NWAVE + wid, rstep = gridDim.x * NWAVE;
  if (row0 < nrow) fetch(row0);
  for (int row = row0; row < nrow; row += rstep) {
    const int mr = row < NL ? (row >> 12) : 8;
    const float* md = mod + (size_t)(l * 9 + mr) * 6144;
    float yv[16], xv[16];
    float ss = 0.f;
#pragma unroll
    for (int i = 0; i < 2; ++i) {
      const u32x4 w = pfy[i];
      yv[i * 8 + 0] = bflo(w.x); yv[i * 8 + 1] = bfhi(w.x); yv[i * 8 + 2] = bflo(w.y); yv[i * 8 + 3] = bfhi(w.y);
      yv[i * 8 + 4] = bflo(w.z); yv[i * 8 + 5] = bfhi(w.z); yv[i * 8 + 6] = bflo(w.w); yv[i * 8 + 7] = bfhi(w.w);
      if (l == 1) {
        const u32x4 xw = __builtin_bit_cast(u32x4, pfx[i * 2]);
        xv[i * 8 + 0] = bflo(xw.x); xv[i * 8 + 1] = bfhi(xw.x); xv[i * 8 + 2] = bflo(xw.y); xv[i * 8 + 3] = bfhi(xw.y);
        xv[i * 8 + 4] = bflo(xw.z); xv[i * 8 + 5] = bfhi(xw.z); xv[i * 8 + 6] = bflo(xw.w); xv[i * 8 + 7] = bfhi(xw.w);
      } else {
        const f32x4 a = pfx[i * 2], b = pfx[i * 2 + 1];
#pragma unroll
        for (int j = 0; j < 4; ++j) { xv[i * 8 + j] = a[j]; xv[i * 8 + 4 + j] = b[j]; }
      }
    }
    if (row + rstep < nrow) fetch(row + rstep);
#pragma unroll
    for (int j = 0; j < 16; ++j) ss += yv[j] * yv[j];
    ss = wave_sum(ss);
    const float rs = rsqrtf(ss * (1.0f / 1024.0f) + 1e-6f);
    float ss2 = 0.f;
#pragma unroll
    for (int i = 0; i < 2; ++i) {
      const int e = i * 512 + lane * 8;
#pragma unroll
      for (int h4 = 0; h4 < 2; ++h4) {
        const f32x4 w = *(const f32x4*)(nw1 + e + h4 * 4), g1 = *(const f32x4*)(md + 2048 + e + h4 * 4);
#pragma unroll
        for (int j = 0; j < 4; ++j) {
          const int q = i * 8 + h4 * 4 + j;
          xv[q] = xv[q] + g1[j] * (yv[q] * rs * w[j]);
          ss2 += xv[q] * xv[q];
        }
      }
      u32x4 o;
      o.x = pk_bf16(xv[i * 8 + 0], xv[i * 8 + 1]); o.y = pk_bf16(xv[i * 8 + 2], xv[i * 8 + 3]); o.z = pk_bf16(xv[i * 8 + 4], xv[i * 8 + 5]); o.w = pk_bf16(xv[i * 8 + 6], xv[i * 8 + 7]);
      *(u32x4*)(Y + (size_t)row * 1024 + e) = o;
    }
    ss2 = wave_sum(ss2);
    const float rs2 = rsqrtf(ss2 * (1.0f / 1024.0f) + 1e-6f);
    float lg[16];
#pragma unroll
    for (int e2 = 0; e2 < 16; ++e2) lg[e2] = 0.f;
#pragma unroll
    for (int i = 0; i < 2; ++i) {
      const int e = i * 512 + lane * 8;
      float hv[8];
#pragma unroll
      for (int h4 = 0; h4 < 2; ++h4) {
        const f32x4 w = *(const f32x4*)(nw2 + e + h4 * 4), sh = *(const f32x4*)(md + 3072 + e + h4 * 4), sc = *(const f32x4*)(md + 4096 + e + h4 * 4);
#pragma unroll
        for (int j = 0; j < 4; ++j) hv[h4 * 4 + j] = xv[i * 8 + h4 * 4 + j] * rs2 * w[j] * (1.0f + sc[j]) + sh[j];
      }
      u32x4 w;
      w.x = pk_bf16(hv[0], hv[1]); w.y = pk_bf16(hv[2], hv[3]); w.z = pk_bf16(hv[4], hv[5]); w.w = pk_bf16(hv[6], hv[7]);
      *(u32x4*)(H + (size_t)row * 1024 + e) = w;
#pragma unroll
      for (int e2 = 0; e2 < 16; ++e2) {
        const f32x4 r0 = *(const f32x4*)(rwT + e2 * 1024 + e), r1 = *(const f32x4*)(rwT + e2 * 1024 + e + 4);
        lg[e2] += hv[0] * r0[0] + hv[1] * r0[1] + hv[2] * r0[2] + hv[3] * r0[3] + hv[4] * r1[0] + hv[5] * r1[1] + hv[6] * r1[2] + hv[7] * r1[3];
        if ((e2 & 3) == 3) __builtin_amdgcn_sched_barrier(0);
      }
    }
    float a8[8], a4[4], a2[2], a1;
    {
      const bool up = (lane & 32) != 0;
#pragma unroll
      for (int j = 0; j < 8; ++j) { const float mine = up ? lg[8 + j] : lg[j], other = up ? lg[j] : lg[8 + j]; a8[j] = mine + __shfl_xor(other, 32); }
    }
    {
      const bool up = (lane & 16) != 0;
#pragma unroll
      for (int j = 0; j < 4; ++j) { const float mine = up ? a8[4 + j] : a8[j], other = up ? a8[j] : a8[4 + j]; a4[j] = mine + __shfl_xor(other, 16); }
    }
    {
      const bool up = (lane & 8) != 0;
#pragma unroll
      for (int j = 0; j < 2; ++j) { const float mine = up ? a4[2 + j] : a4[j], other = up ? a4[j] : a4[2 + j]; a2[j] = mine + __shfl_xor(other, 8); }
    }
    {
      const bool up = (lane & 4) != 0;
      const float mine = up ? a2[1] : a2[0], other = up ? a2[0] : a2[1];
      a1 = mine + __shfl_xor(other, 4);
    }
    a1 += __shfl_xor(a1, 2);
    a1 += __shfl_xor(a1, 1);
    float mx = a1;
    mx = fmaxf(mx, __shfl_xor(mx, 4)); mx = fmaxf(mx, __shfl_xor(mx, 8)); mx = fmaxf(mx, __shfl_xor(mx, 16)); mx = fmaxf(mx, __shfl_xor(mx, 32));
    const float ex = expf(a1 - mx);
    float se = ex;
    se += __shfl_xor(se, 4); se += __shfl_xor(se, 8); se += __shfl_xor(se, 16); se += __shfl_xor(se, 32);
    if ((lane & 3) == 0) {
      const int e2 = ((lane >> 5) & 1) * 8 + ((lane >> 4) & 1) * 4 + ((lane >> 3) & 1) * 2 + ((lane >> 2) & 1);
      aff[(size_t)row * 16 + e2] = ex / se;
    }
  }
}

template <int NI, int T>
__device__ __forceinline__ void topk_body(const Params& p, int s, int e, char* lds, const int tid) {
  constexpr int CAP = T / 8;
  typedef unsigned long long u64;
  int* cntw = (int*)lds;
  int* wcnt = (int*)(lds + 256);
  int* woff = (int*)(lds + 512);
  const int wid = tid >> 6, lane = tid & 63;
  const bool isl = T == 4096;
  const size_t rowbase = isl ? (size_t)s * 4096 : (size_t)NL + (size_t)(s - 8) * 256;
  const float* aff = (const float*)(p.ws + O_AFF);
  int* sel = (int*)(p.ws + O_SEL);
  float* gate = (float*)(p.ws + O_GATE);
  int* tok = (int*)(p.ws + O_TOK);
  u64 key[NI];
  float av[NI];
#pragma unroll
  for (int q = 0; q < NI; ++q) {
    const int i = tid + q * NTHREADS;
    av[q] = 0.f; key[q] = 0ull;
    if (i < T) {
      av[q] = aff[(rowbase + i) * 16 + e];
      key[q] = ((u64)__float_as_uint(av[q]) << 12) | (u64)(4095 - i);
    }
  }
  u64 prefix = 0ull;
  for (int bit = 43; bit >= 0; --bit) {
    const u64 cand = prefix | (1ull << bit);
    int c = 0;
#pragma unroll
    for (int q = 0; q < NI; ++q) c += __popcll(__ballot(key[q] >= cand));
    if (lane == 0) cntw[(bit & 1) * 8 + wid] = c;
    __syncthreads();
    int tot = 0;
#pragma unroll
    for (int w = 0; w < 8; ++w) tot += cntw[(bit & 1) * 8 + w];
    if (tot >= CAP) prefix = cand;
  }
  int before[NI];
  bool in[NI];
#pragma unroll
  for (int q = 0; q < NI; ++q) {
    in[q] = key[q] >= prefix && key[q] != 0ull;
    const u64 m = __ballot(in[q]);
    before[q] = __popcll(m & ((1ull << lane) - 1ull));
    if (lane == 0) wcnt[q * 8 + wid] = __popcll(m);
  }
  __syncthreads();
  if (tid < 64) {
    int v = tid < NI * 8 ? wcnt[tid] : 0, x = v;
#pragma unroll
    for (int o = 1; o < 64; o <<= 1) { const int y = __shfl_up(x, o); if (lane >= o) x += y; }
    if (tid < NI * 8) woff[tid] = x - v;
  }
  __syncthreads();
  const size_t slotbase = isl ? ((size_t)e * 8 + s) * CAP : (size_t)NSLOT_L + ((size_t)e * 8 + (s - 8)) * CAP;
#pragma unroll
  for (int q = 0; q < NI; ++q) {
    const int i = tid + q * NTHREADS;
    if (i < T) {
      const int slot = woff[q * 8 + wid] + before[q];
      sel[(rowbase + i) * 16 + e] = in[q] ? slot : -1;
      if (in[q]) {
        tok[slotbase + slot] = (int)(rowbase + i);
        gate[slotbase + slot] = av[q];
      }
    }
  }
  __syncthreads();
}
__device__ __forceinline__ void phase_topk(const Params& p, int l, char* lds, int wid0) {
  const int tid = opaque_tid(wid0);
  const int NITEM = (l == 1) ? 128 : 256;
  for (int item = blockIdx.x; item < NITEM; item += gridDim.x) {
    const int s = item >> 4, e = item & 15;
    if (s < 8) topk_body<8, 4096>(p, s, e, lds, tid);
    else topk_body<1, 256>(p, s, e, lds, tid);
  }
}

struct MoeSched {
  const char* A; const char* W; int nN, nunit, G, c; size_t estep; int swap = 0;
  __device__ __forceinline__ bool next(int i, Unit& u) const {
    const int xcd = c & 7, q = c >> 3, per = (G >> 3) / nN;
    int ii = i;
    if (swap && xcd < 4) ii = i == 0 ? 8 : i == 8 ? 0 : i;
    u.pn = q % nN; u.pm = (ii * 8 + xcd) * per + q / nN;
    if (q >= per * nN || u.pm * nN >= nunit) return false;
    u.z = u.pm < 256 ? (u.pm >> 4) : (u.pm - 256); return true;
  }
  __device__ __forceinline__ const char* aptr(const Unit& u) const { return A + (size_t)u.pm * (256u * 1024u * 2u); }
  __device__ __forceinline__ const char* bptr(const Unit& u) const { return W + (size_t)u.z * estep + (size_t)u.pn * (256u * 1024u * 2u); }
};
struct MoeSchedG : MoeSched {
  static constexpr bool GATHER = true;
  const int* tok;
  __device__ __forceinline__ const char* aptr(const Unit&) const { return A; }
  __device__ __forceinline__ const int* tokptr(const Unit& u) const { return tok + (size_t)u.pm * 256; }
};
struct EpiSwiglu {
  bf16_t* HID; unsigned* cnt;
  __device__ __forceinline__ bool operator()(f32x4 (&acc)[2][2][4][2], const Unit& u, int wr, int wc, int fr, int fq) const {
    bf16_t* d = HID + (size_t)u.pm * 256 * 1024 + u.pn * 128;
#pragma unroll
    for (int ai = 0; ai < 2; ++ai)
#pragma unroll
      for (int m = 0; m < 4; ++m) {
        f32x4 o0, o1;
#pragma unroll
        for (int j = 0; j < 4; ++j) { o0[j] = siluf_(acc[ai][0][m][0][j]) * acc[ai][1][m][0][j]; o1[j] = siluf_(acc[ai][0][m][1][j]) * acc[ai][1][m][1][j]; }
        st8bf(d + (size_t)(ai * 128 + wr * 64 + m * 16 + fr) * 1024 + wc * 32 + 8 * fq, o0, o1);
      }
    if (cnt && u.pm >= 256) hc_publish(cnt);
    return false;
  }
};
__device__ __forceinline__ void phase_moe1(const Params& p, int l, char* lds, int wid0) {
  const int tid = opaque_tid(wid0);
  const int nrt = (l == 1) ? 256 : 272;
  MoeSchedG S;
  S.A = p.ws + O_H; S.W = l == 1 ? (const char*)p.out + OUT_W13B : p.ws + O_W13; S.nN = 8; S.nunit = nrt * 8; S.G = (int)gridDim.x; S.c = (int)blockIdx.x; S.estep = (size_t)2048 * 1024 * 2;
  S.tok = (const int*)(p.ws + O_TOK);
  const bool fuse = l == 0 && gridDim.x == 256;
  S.swap = fuse ? 1 : 0;
  unsigned* bar = (unsigned*)(p.ws + O_BAR);
  EpiSwiglu E{(bf16_t*)(p.ws + O_HID), fuse ? bar + HC_MOE1 : nullptr};
  pg8::gemm_phase((PG8_LAS unsigned char*)lds, 1024, S, E, tid);
  if (fuse) {
    const int xcd = (int)blockIdx.x & 7, q = (int)blockIdx.x >> 3;
    if (xcd >= 4 && q < 16) {
      const int r = q * 4 + xcd - 4, e = r >> 2, pn = r & 3, pm = 256 + e;
      hc_wait(bar, bar + HC_MOE1, 128u);
      OneSched S2{p.ws + O_HID + (size_t)pm * (256u * 1024u * 2u), p.ws + O_W2 + (size_t)e * ((size_t)1024 * 1024 * 2) + (size_t)pn * (256u * 1024u * 2u), pm, pn, e};
      EpiStoreBf16 E2{(bf16_t*)(p.ws + O_YS), 1024};
      pg8::gemm_phase((PG8_LAS unsigned char*)lds, 1024, S2, E2, tid);
    } else if (xcd >= 4) conv_fill(p, lds, wid0, 2, (q - 16) * 4 + xcd - 4, 64);
  }
}
__device__ __forceinline__ void phase_moe2(const Params& p, int l, char* lds, int wid0) {
  const int tid = opaque_tid(wid0);
  const int nrt = (l == 1 || gridDim.x == 256) ? 256 : 272;
  MoeSched S{p.ws + O_HID, p.ws + (l == 1 && p.w2sep ? O_W2B : O_W2), 4, nrt * 4, (int)gridDim.x, (int)blockIdx.x, (size_t)1024 * 1024 * 2};
  EpiStoreBf16 E{(bf16_t*)(p.ws + O_YS), 1024};
  pg8::gemm_phase((PG8_LAS unsigned char*)lds, 1024, S, E, tid);
}

__device__ __forceinline__ void phase_rowC(const Params& p, int l, int wid0) {
  const int tid = opaque_tid(wid0), wid = tid >> 6, lane = tid & 63;
  const int nrow = (l == 1) ? NL : NT;
  float* olat = p.out;
  float* octx = (float*)(p.ws + O_CTXB);
  const float* mod = (const float*)(p.ws + O_MOD);
  const bf16_t* YS = (const bf16_t*)(p.ws + O_YS);
  const int* sel = (const int*)(p.ws + O_SEL);
  const float* gate = (const float*)(p.ws + O_GATE);
  const float* nw3 = p.norm_w + (size_t)(l * 4 + 3) * 1024;
  const float* nwn = p.norm_w + (size_t)((l + 1) * 4 + 0) * 1024;
  bf16_t* H = (bf16_t*)(p.ws + O_H);
  const bf16_t* X1 = (const bf16_t*)(p.ws + O_Y);
  int pfrk; u32x4 pfx[2];
  auto fetch = [&](int row) {
    pfrk = sel[(size_t)row * 16 + (lane & 15)];
#pragma unroll
    for (int i = 0; i < 2; ++i) pfx[i] = *(const u32x4*)(X1 + (size_t)row * 1024 + i * 512 + lane * 8);
  };
  const int row0 = blockIdx.x * NWAVE + wid, rstep = gridDim.x * NWAVE;
  if (row0 < nrow) fetch(row0);
  for (int row = row0; row < nrow; row += rstep) {
    float* xo = row < NL ? olat + (size_t)row * 1024 : octx + (size_t)(row - NL) * 1024;
    const bool isl = row < NL;
    const int mr = isl ? (row >> 12) : 8;
    const int s = isl ? (row >> 12) : ((row - NL) >> 8);
    const float* md = mod + (size_t)(l * 9 + mr) * 6144;
    float mv[16];
#pragma unroll
    for (int j = 0; j < 16; ++j) mv[j] = 0.f;
    const int myrk = pfrk;
    u32x4 xcur[2];
#pragma unroll
    for (int i = 0; i < 2; ++i) xcur[i] = pfx[i];
    if (row + rstep < nrow) fetch(row + rstep);
    unsigned long long chosen = __ballot(myrk >= 0) & 0xffffull;
    while (chosen) {
      const int e0 = __builtin_ctzll(chosen); chosen &= chosen - 1;
      const int e1 = chosen ? __builtin_ctzll(chosen) : -1; if (chosen) chosen &= chosen - 1;
      const int rk0 = __shfl(myrk, e0), rk1 = e1 >= 0 ? __shfl(myrk, e1) : 0;
      const size_t slot0 = isl ? ((size_t)e0 * 8 + s) * 512 + rk0 : (size_t)NSLOT_L + ((size_t)e0 * 8 + s) * 32 + rk0;
      const size_t slot1 = e1 < 0 ? slot0 : (isl ? ((size_t)e1 * 8 + s) * 512 + rk1 : (size_t)NSLOT_L + ((size_t)e1 * 8 + s) * 32 + rk1);
      u32x4 w[4];
#pragma unroll
      for (int i = 0; i < 2; ++i) { w[i] = *(const u32x4*)(YS + slot0 * 1024 + i * 512 + lane * 8); w[2 + i] = *(const u32x4*)(YS + slot1 * 1024 + i * 512 + lane * 8); }
      const float m0 = gate[slot0], m1 = e1 >= 0 ? gate[slot1] : 0.f;
#pragma unroll
      for (int i = 0; i < 2; ++i) {
        mv[i * 8 + 0] += m0 * bflo(w[i].x) + m1 * bflo(w[2 + i].x); mv[i * 8 + 1] += m0 * bfhi(w[i].x) + m1 * bfhi(w[2 + i].x);
        mv[i * 8 + 2] += m0 * bflo(w[i].y) + m1 * bflo(w[2 + i].y); mv[i * 8 + 3] += m0 * bfhi(w[i].y) + m1 * bfhi(w[2 + i].y);
        mv[i * 8 + 4] += m0 * bflo(w[i].z) + m1 * bflo(w[2 + i].z); mv[i * 8 + 5] += m0 * bfhi(w[i].z) + m1 * bfhi(w[2 + i].z);
        mv[i * 8 + 6] += m0 * bflo(w[i].w) + m1 * bflo(w[2 + i].w); mv[i * 8 + 7] += m0 * bfhi(w[i].w) + m1 * bfhi(w[2 + i].w);
      }
    }
    float ss = 0.f;
#pragma unroll
    for (int j = 0; j < 16; ++j) ss += mv[j] * mv[j];
    ss = wave_sum(ss);
    const float rs = rsqrtf(ss * (1.0f / 1024.0f) + 1e-6f);
    float xn[16], ssn = 0.f;
#pragma unroll
    for (int i = 0; i < 2; ++i) {
      const int e = i * 512 + lane * 8;
#pragma unroll
      for (int h4 = 0; h4 < 2; ++h4) {
        const f32x4 w = *(const f32x4*)(nw3 + e + h4 * 4), g2 = *(const f32x4*)(md + 5120 + e + h4 * 4);
        f32x4 xv;
        if (h4 == 0) { xv[0] = bflo(xcur[i].x); xv[1] = bfhi(xcur[i].x); xv[2] = bflo(xcur[i].y); xv[3] = bfhi(xcur[i].y); }
        else { xv[0] = bflo(xcur[i].z); xv[1] = bfhi(xcur[i].z); xv[2] = bflo(xcur[i].w); xv[3] = bfhi(xcur[i].w); }
#pragma unroll
        for (int j = 0; j < 4; ++j) { xv[j] += g2[j] * (mv[i * 8 + h4 * 4 + j] * rs * w[j]); xn[i * 8 + h4 * 4 + j] = xv[j]; ssn += xv[j] * xv[j]; }
        if (!(l == 0 && isl)) *(f32x4*)(xo + e + h4 * 4) = xv;
      }
      if (l == 0 && isl) {
        u32x4 o;
        o.x = pk_bf16(xn[i * 8 + 0], xn[i * 8 + 1]); o.y = pk_bf16(xn[i * 8 + 2], xn[i * 8 + 3]); o.z = pk_bf16(xn[i * 8 + 4], xn[i * 8 + 5]); o.w = pk_bf16(xn[i * 8 + 6], xn[i * 8 + 7]);
        *(u32x4*)((bf16_t*)p.out + (size_t)row * 1024 + e) = o;
      }
    }
    if (l == 0) {
      ssn = wave_sum(ssn);
      const float rsn = rsqrtf(ssn * (1.0f / 1024.0f) + 1e-6f);
      const float* mdn = mod + (size_t)((l + 1) * 9 + mr) * 6144;
#pragma unroll
      for (int i = 0; i < 2; ++i) {
        const int e = i * 512 + lane * 8;
        float hv[8];
#pragma unroll
        for (int h4 = 0; h4 < 2; ++h4) {
          const f32x4 w = *(const f32x4*)(nwn + e + h4 * 4), sh = *(const f32x4*)(mdn + e + h4 * 4), sc = *(const f32x4*)(mdn + 1024 + e + h4 * 4);
#pragma unroll
          for (int j = 0; j < 4; ++j) hv[h4 * 4 + j] = xn[i * 8 + h4 * 4 + j] * rsn * w[j] * (1.0f + sc[j]) + sh[j];
        }
        u32x4 w;
        w.x = pk_bf16(hv[0], hv[1]); w.y = pk_bf16(hv[2], hv[3]); w.z = pk_bf16(hv[4], hv[5]); w.w = pk_bf16(hv[6], hv[7]);
        *(u32x4*)(H + (size_t)row * 1024 + e) = w;
      }
    }
  }
}

#define PHASE(call) do { Params q = p; asm volatile("" : "+s"(q.ws)); call; } while (0)
#ifndef PROBE_PH
#define PROBE_PH 0
#endif
#ifndef PROBE_N
#define PROBE_N 2
#endif
#define REP(id, call) do { for (int _r = 0; _r < ((PROBE_PH == (id)) ? 1 + PROBE_N : 1); ++_r) PHASE(call); } while (0)
#define SYNC() do { char* _w = p.ws; asm volatile("" : "+s"(_w)); XcdBarrier _b; _b.bar = (unsigned*)(_w + O_BAR); _b.x = xb_xcc_id(); _b.st = st; xcd_barrier(_b); } while (0)
__global__ void __launch_bounds__(NTHREADS, 2) fwd_mega(Params p) {
  extern __shared__ __attribute__((aligned(16))) char lds[];
  cg::grid_group grid = cg::this_grid();
  const int wid0 = __builtin_amdgcn_readfirstlane((int)(threadIdx.x >> 6));
  volatile PG8_LAS unsigned* st = (volatile PG8_LAS unsigned*)((PG8_LAS unsigned char*)lds + LDS_MAIN);
  if (threadIdx.x < 2) st[threadIdx.x] = 0u;
  __syncthreads();
  (void)xcd_barrier_post((unsigned*)(p.ws + O_BAR), st);
  PHASE(phase_setup(q, lds, wid0));
  PHASE(phase_conv(q, 0, lds, wid0));
  SYNC();
  PHASE(phase_rowA(q, 0, wid0));
  SYNC();
#pragma unroll 1
  for (int l = 0; l < 2; ++l) {
    REP(3, phase_gin(q, l, lds, wid0));
    SYNC();
    REP(5, phase_mix2(q, l, lds, wid0));
    SYNC();
    PHASE(phase_oa(q, l, wid0));
    SYNC();
    REP(7, phase_merge(q, l, lds, wid0));
    if (l == 0) grid.sync(); else SYNC();
    REP(8, phase_wout(q, l, lds, wid0));
    SYNC();
    if (l == 0) PHASE(phase_rowB<0>(q, lds, wid0)); else PHASE(phase_rowB<1>(q, lds, wid0));
    SYNC();
    REP(10, phase_topk(q, l, lds, wid0));
    SYNC();
    REP(11, phase_moe1(q, l, lds, wid0));
    SYNC();
    REP(12, phase_moe2(q, l, lds, wid0));
    SYNC();
    PHASE(phase_rowC(q, l, wid0));
    if (l == 0) PHASE(conv_fill(q, lds, wid0, 4, (int)blockIdx.x, (int)gridDim.x));
    if (l == 0) SYNC();
    if (PROBE_PH == 20) { for (int _r = 0; _r < 10 * PROBE_N; ++_r) SYNC(); }
  }
}

extern "C" void kernel_launch(void* const* d_in, const int* in_sizes, int n_in, void* d_out, int out_size, void* d_ws, size_t ws_size,
                              hipStream_t stream) {
  if (ws_size < WS_NEED) {
    fprintf(stderr, "kernel_launch: workspace too small: %zu < %zu\n", ws_size, (size_t)WS_NEED);
    return;
  }
  Params p{};
  p.x = (const float*)d_in[0]; p.c = (const float*)d_in[1]; p.ctx = (const float*)d_in[2]; p.c_ctx = (const float*)d_in[3];
  p.ada_w = (const float*)d_in[4]; p.ada_b = (const float*)d_in[5]; p.norm_w = (const float*)d_in[6]; p.w_in = (const float*)d_in[7];
  p.lb_raw = (const float*)d_in[8]; p.gnorm_w = (const float*)d_in[9]; p.sgu_w = (const float*)d_in[10]; p.sgu_b = (const float*)d_in[11];
  p.sgu_norm_w = (const float*)d_in[12]; p.w_branch = (const float*)d_in[13]; p.w_out = (const float*)d_in[14];
  p.router_w = (const float*)d_in[15]; p.w13 = (const float*)d_in[16]; p.w2 = (const float*)d_in[17];
  p.out = (float*)d_out;
  p.ws = (char*)d_ws;
  p.w2sep = ws_size >= WS_NEED_W2B ? 1 : 0;
  static int grid_blocks = 0;
  if (!grid_blocks) {
    int dev = 0, cus = 0, per_cu = 0;
    (void)hipGetDevice(&dev);
    (void)hipDeviceGetAttribute(&cus, hipDeviceAttributeMultiprocessorCount, dev);
    (void)hipFuncSetAttribute((const void*)fwd_mega, hipFuncAttributeMaxDynamicSharedMemorySize, LDS_TOTAL);
    (void)hipOccupancyMaxActiveBlocksPerMultiprocessor(&per_cu, fwd_mega, NTHREADS, LDS_TOTAL);
    if (per_cu > 1) per_cu = 1;
    if (per_cu < 1) fprintf(stderr, "kernel_launch: occupancy query reports %d blocks per CU\n", per_cu);
    grid_blocks = cus * (per_cu < 1 ? 1 : per_cu);
  }
  (void)hipMemsetAsync((char*)d_ws + O_BAR, 0, BAR_BYTES, stream);
  void* args[] = {&p};
  hipError_t e = hipLaunchCooperativeKernel((void*)fwd_mega, dim3(grid_blocks), dim3(NTHREADS), args, LDS_TOTAL, stream);
  if (e != hipSuccess) fprintf(stderr, "cooperative launch failed: %s (grid %d)\n", hipGetErrorString(e), grid_blocks);
}
```

```cpp
#include <hip/hip_runtime.h>
#include <hip/hip_cooperative_groups.h>
#include <cstdio>
#include <cstdint>
namespace cg = cooperative_groups;

typedef unsigned short bf16_t;
typedef short bf16x8 __attribute__((ext_vector_type(8)));
typedef float f32x4 __attribute__((ext_vector_type(4)));
typedef float f32x2 __attribute__((ext_vector_type(2)));
typedef unsigned u32x4 __attribute__((ext_vector_type(4)));
typedef unsigned u32x2 __attribute__((ext_vector_type(2)));

constexpr int D = 1024, NB = 8, TL = 4096, TCX = 256;
constexpr int NL = NB * TL, NC = NB * TCX, NT = NL + NC;
constexpr int INC = 7168;
constexpr int NSLOT_L = 16 * 8 * 512, NSLOT_C = 16 * 8 * 32, NSLOT = NSLOT_L + NSLOT_C;
constexpr int NTHREADS = 512, NWAVE = 8;
constexpr int LDS_MAIN = 147456;
constexpr int LDS_TOTAL = LDS_MAIN + 16;

constexpr size_t al(size_t x) { return (x + 255) & ~(size_t)255; }
constexpr size_t O_WIN = 0;
constexpr size_t O_WBR = O_WIN + al((size_t)INC * D * 2);
constexpr size_t O_WOUT = O_WBR + al((size_t)3 * D * 512 * 2);
constexpr size_t O_W13 = O_WOUT + al((size_t)D * D * 2);
constexpr size_t O_W2 = O_W13 + al((size_t)16 * 2048 * D * 2);
constexpr size_t O_FTL = O_W2 + al((size_t)16 * D * D * 2);
constexpr size_t O_FTC = O_FTL + al((size_t)4096 * 8192 * 2);
constexpr size_t O_CS = O_FTC + al((size_t)256 * 512 * 2);
constexpr size_t O_MOD = O_CS + al((size_t)256 * 128 * 2);
constexpr size_t O_LB = O_MOD + al((size_t)2 * 9 * 6144 * 4);
constexpr size_t O_BAR = O_LB + al((size_t)2 * 2 * 512 * 4);
constexpr size_t BAR_BYTES = 3456 * 4;
constexpr size_t O_H = O_BAR + al(BAR_BYTES);
constexpr size_t O_Y = O_H + al((size_t)NT * D * 2);
constexpr size_t O_CTXB = O_Y + al((size_t)NT * D * 2);
constexpr size_t O_AFF = O_CTXB + al((size_t)NC * D * 4);
constexpr size_t O_SEL = O_AFF + al((size_t)NT * 16 * 4);
constexpr size_t O_GATE = O_SEL + al((size_t)NT * 16 * 4);
constexpr size_t O_TOK = O_GATE + al((size_t)NSLOT * 4);
constexpr size_t O_Z = O_TOK + al((size_t)NSLOT * 4);
constexpr size_t SZ512 = al((size_t)NT * 512 * 2);
constexpr size_t O_Q = O_Z, O_LFF = O_Q + SZ512, O_LFB = O_LFF + SZ512, O_I = O_LFB + SZ512, O_GA = O_I + SZ512,
                 O_U = O_GA + SZ512, O_ZB = O_U + SZ512, O_VT = O_ZB + SZ512, O_OF = O_VT + SZ512, O_OBK = O_OF + SZ512;
constexpr size_t O_G = O_OBK + SZ512;
constexpr size_t O_ZCL = O_G + al((size_t)NT * 3072 * 2);
constexpr size_t O_ZCC = O_ZCL + al((size_t)8 * 512 * 8192 * 2);
constexpr size_t O_ZF = O_ZCC + al((size_t)8 * 512 * 512 * 2);
constexpr int KH = 2176, KF = 2 * KH;
constexpr size_t O_ZEND = O_ZF + al((size_t)8 * 512 * KF * 2);
constexpr size_t SZSLOT = al((size_t)NSLOT * 1024 * 2);
constexpr size_t O_XE = O_Z, O_HID = O_XE + SZSLOT, O_YS = O_HID + SZSLOT;
static_assert(O_YS + SZSLOT <= O_ZEND, "moe arena");
constexpr size_t O_W2B = O_ZEND;
constexpr size_t WS_NEED = O_ZEND, WS_NEED_W2B = O_W2B + al((size_t)16 * D * D * 2);

struct Params {
  const float *x, *c, *ctx, *c_ctx, *ada_w, *ada_b, *norm_w, *w_in, *lb_raw, *gnorm_w, *sgu_w, *sgu_b, *sgu_norm_w, *w_branch, *w_out,
      *router_w, *w13, *w2;
  float* out;
  char* ws;
  int w2sep;
};

typedef __bf16 bf16v2_t __attribute__((ext_vector_type(2)));
__device__ __forceinline__ unsigned pk_bf16(float lo, float hi) {
  const f32x2 v = {lo, hi};
  const bf16v2_t r = __builtin_convertvector(v, bf16v2_t);
  return __builtin_bit_cast(unsigned, r);
}
__device__ __forceinline__ bf16_t f2bf(float x) { return (bf16_t)(pk_bf16(x, 0.f) & 0xffffu); }
__device__ __forceinline__ float bf2f(bf16_t v) { return __uint_as_float(((unsigned)v) << 16); }
__device__ __forceinline__ float bflo(unsigned w) { return __uint_as_float(w << 16); }
__device__ __forceinline__ float bfhi(unsigned w) { return __uint_as_float(w & 0xffff0000u); }
__device__ __forceinline__ void st4bf(bf16_t* p, f32x4 v) {
  u32x2 w;
  w.x = pk_bf16(v[0], v[1]);
  w.y = pk_bf16(v[2], v[3]);
  *(u32x2*)p = w;
}
__device__ __forceinline__ void st8bf(bf16_t* p, f32x4 a, f32x4 b) {
  u32x4 w;
  w.x = pk_bf16(a[0], a[1]); w.y = pk_bf16(a[2], a[3]); w.z = pk_bf16(b[0], b[1]); w.w = pk_bf16(b[2], b[3]);
  *(u32x4*)p = w;
}
__device__ __forceinline__ float sigmoidf_(float x) { return __builtin_amdgcn_rcpf(1.0f + __expf(-x)); }
__device__ __forceinline__ float siluf_(float x) { return x * __builtin_amdgcn_rcpf(1.0f + __expf(-x)); }
__device__ __forceinline__ float geluf_(float v) {
  const float av = fabsf(v), t = __builtin_amdgcn_rcpf(av * 0.2316418882f + 1.0f);
  float q = t * 0.5307027145f + (-0.7265760135f);
  q = q * t + 0.7107068705f; q = q * t + (-0.142248368f); q = q * t + 0.127414796f; q = q * t;
  const float e = __builtin_amdgcn_exp2f((v * v) * (-0.72134752044f));
  const float m = v * (q * e);
  return v < 0.f ? m : v - m;
}
__device__ __forceinline__ int opaque_tid(int wid0) {
  int lane;
  asm volatile("v_mbcnt_lo_u32_b32 %0, -1, 0\n\tv_mbcnt_hi_u32_b32 %0, -1, %0" : "=v"(lane));
  return (wid0 << 6) | lane;
}
__device__ __forceinline__ float wave_sum(float v) {
#pragma unroll
  for (int o = 32; o > 0; o >>= 1) v += __shfl_xor(v, o);
  return v;
}

namespace pg8 {
#define PG8_LAS __attribute__((address_space(3)))
constexpr int BM = 256, BK = 64, HALF = 128, HTB = HALF * BK * 2, STAGE_BYTES = 8 * HTB, NXCD = 8, WGM = 8;
__device__ __forceinline__ int lds_byte(int r, int c) { const int st = (r >> 4) * 2 + (c >> 5), rr = r & 15, cc = c & 31, ob = rr * 64 + cc * 2; return st * 1024 + (ob ^ (((ob >> 9) & 1) << 5)); }
__device__ __forceinline__ void stage_rc(int b, int& R, int& C) { const int st = b / 1024, sb = b % 1024, swz = sb ^ (((sb >> 9) & 1) << 5); R = (st >> 1) * 16 + swz / 64; C = (st & 1) * 32 + (swz % 64) / 2; }
__device__ __forceinline__ int perm32(int rho) { const int n = rho >> 4, i = rho & 15; return 8 * (i >> 2) + 4 * n + (i & 3); }
struct Unit { int pm, pn, z; };
template <class T, class = void> struct gather_of { static constexpr bool v = false; };
template <class T> struct gather_of<T, decltype((void)T::GATHER)> { static constexpr bool v = T::GATHER; };

template <class Epi, class Sched>
__device__ __forceinline__ void gemm_phase(PG8_LAS unsigned char* lds, const int K, const Sched& S, const Epi& E, const int tid_in) {
  int tid = tid_in;
  asm volatile("" : "+v"(tid));
  const int wid = __builtin_amdgcn_readfirstlane(tid >> 6), lane = tid & 63, wr = wid >> 2, wc = wid & 3, fr = lane & 15, fq = lane >> 4;
  const int nt = K / BK;
  constexpr bool GA = gather_of<Sched>::v;
  unsigned voffA[2], voffB[2];
  unsigned cvA[2][2], nvA[2][2];
  int gR = 0; unsigned gC2 = 0;
#pragma unroll
  for (int i = 0; i < 2; ++i) { int R, C; stage_rc(tid * 16 + i * 8192, R, C); const int Rb = (R & ~31) + perm32(R & 31);
    if (i == 0) { gR = R; gC2 = (unsigned)C * 2u; }
    voffA[i] = (unsigned)(R * K + C) * 2u; voffB[i] = (unsigned)(Rb * K + C) * 2u; }
  const size_t kstep = (size_t)(BK * 2);
  const size_t hstep = (size_t)HALF * K * 2;
  const size_t hstepA = GA ? (size_t)0 : hstep;
  const PG8_LAS int* idxl = (const PG8_LAS int*)(lds + STAGE_BYTES);
  const unsigned ldsw = (unsigned)wid * 1024u;
  const int aoff = lds_byte(wr * 64 + fr, fq * 8), boff = lds_byte(wc * 32 + fr, fq * 8);
#define PG8_SA(b, h) (((b) * 2 + (h)) * HTB)
#define PG8_SB(b, h) ((4 + (b) * 2 + (h)) * HTB)
#define PG8_STAGE_(bufoff, gbase, voff) do { _Pragma("unroll") for (int _i = 0; _i < 2; ++_i) \
    __builtin_amdgcn_global_load_lds((const unsigned*)((const char*)(gbase) + voff[_i]), (PG8_LAS unsigned*)(lds + (bufoff) + ldsw + _i * 8192), 16, 0, 0); } while (0)
#define PG8_STAGE(bufoff, gbase) PG8_STAGE_(bufoff, gbase, voffB)
#define PG8_STAGE_A(bufoff, gbase, NX) do { _Pragma("unroll") for (int _i = 0; _i < 2; ++_i) { unsigned _vo; \
    if constexpr (GA) { _vo = (NX) ? nvA[((bufoff) / HTB) & 1][_i] : cvA[((bufoff) / HTB) & 1][_i]; } else _vo = voffA[_i]; \
    __builtin_amdgcn_global_load_lds((const unsigned*)((const char*)(gbase) + _vo), (PG8_LAS unsigned*)(lds + (bufoff) + ldsw + _i * 8192), 16, 0, 0); } } while (0)
#define PG8_LDA(dst, b, h) do { _Pragma("unroll") for (int m = 0; m < 4; ++m) _Pragma("unroll") for (int k = 0; k < 2; ++k) dst[m][k] = *(const PG8_LAS bf16x8*)(lds + PG8_SA(b, h) + aoff + m * 2048 + k * 1024); } while (0)
#define PG8_LDB(dst, b, h) do { _Pragma("unroll") for (int n = 0; n < 2; ++n) _Pragma("unroll") for (int k = 0; k < 2; ++k) dst[n][k] = *(const PG8_LAS bf16x8*)(lds + PG8_SB(b, h) + boff + n * 2048 + k * 1024); } while (0)
#define PG8_MMA(ai, bj, At, Bt) do { __builtin_amdgcn_s_setprio(1); _Pragma("unroll") for (int m = 0; m < 4; ++m) _Pragma("unroll") for (int n = 0; n < 2; ++n) _Pragma("unroll") for (int k = 0; k < 2; ++k) \
    acc[ai][bj][m][n] = __builtin_amdgcn_mfma_f32_16x16x32_bf16(Bt[n][k], At[m][k], acc[ai][bj][m][n], 0, 0, 0); __builtin_amdgcn_s_setprio(0); } while (0)
#define PG8_WAIT_V(n) asm volatile("s_waitcnt vmcnt(" #n ")" ::: "memory")
#define PG8_WAIT_L(n) asm volatile("s_waitcnt lgkmcnt(" #n ")" ::: "memory")
#define PG8_BAR __builtin_amdgcn_s_barrier()
#define PG8_SCHED __builtin_amdgcn_sched_barrier(0)
  Unit cur, nxt; int ui = 0;
  if (!S.next(0, cur)) return;
  f32x4 acc[2][2][4][2];
#pragma unroll
  for (int a = 0; a < 2; ++a)
#pragma unroll
    for (int b = 0; b < 2; ++b)
#pragma unroll
      for (int m = 0; m < 4; ++m)
#pragma unroll
        for (int n = 0; n < 2; ++n) acc[a][b][m][n] = (f32x4){0.f, 0.f, 0.f, 0.f};
  bf16x8 At[4][2], B0[2][2], B1[2][2];
  const char* cA = S.aptr(cur); const char* cB = S.bptr(cur);
  if constexpr (GA) {
    const int* tk = S.tokptr(cur);
#pragma unroll
    for (int h = 0; h < 2; ++h)
#pragma unroll
      for (int i = 0; i < 2; ++i) { cvA[h][i] = (unsigned)tk[h * 128 + i * 64 + gR] * (unsigned)(K * 2) + gC2; nvA[h][i] = cvA[h][i]; }
  }
  PG8_STAGE(PG8_SB(0, 0), cB); PG8_STAGE_A(PG8_SA(0, 0), cA, false); PG8_STAGE(PG8_SB(0, 1), cB + hstep); PG8_STAGE_A(PG8_SA(0, 1), cA + hstepA, false);
  if (wr == 1) PG8_BAR;
  PG8_WAIT_V(4); PG8_BAR;
  PG8_STAGE(PG8_SB(1, 0), cB + kstep); PG8_STAGE_A(PG8_SA(1, 0), cA + kstep, false); PG8_STAGE(PG8_SB(1, 1), cB + hstep + kstep);
  PG8_WAIT_V(6); PG8_BAR;
  for (;;) {
    const bool has_next = S.next(ui + 1, nxt);
    const char* nA = has_next ? S.aptr(nxt) : cA; const char* nB = has_next ? S.bptr(nxt) : cB;
    if constexpr (GA) {
      if (has_next && wid < 4)
        __builtin_amdgcn_global_load_lds((const unsigned*)(S.tokptr(nxt) + wid * 64 + lane), (PG8_LAS unsigned*)(lds + STAGE_BYTES + wid * 256), 4, 0, 0);
    }
    for (int t = 0; t < nt; t += 2) {
      const bool last = (t == nt - 2);
      const bool lastn = last && has_next;
      if constexpr (GA) {
#pragma unroll
        for (int h = 0; h < 2; ++h)
#pragma unroll
          for (int i = 0; i < 2; ++i) nvA[h][i] = (unsigned)idxl[h * 128 + i * 64 + gR] * (unsigned)(K * 2) + gC2;
      }
      const char* a1 = cA + (size_t)(t + 1) * kstep;
      const char* a2 = last ? nA : cA + (size_t)(t + 2) * kstep; const char* b2 = last ? nB : cB + (size_t)(t + 2) * kstep;
      const char* a3 = a2 + kstep; const char* b3 = b2 + kstep;
      PG8_LDB(B0, 0, 0); PG8_SCHED; PG8_LDA(At, 0, 0); PG8_STAGE_A(PG8_SA(1, 1), a1 + hstepA, false);
      PG8_WAIT_L(8); PG8_BAR; PG8_WAIT_L(0); PG8_MMA(0, 0, At, B0); PG8_BAR; PG8_SCHED;
      PG8_LDB(B1, 0, 1); PG8_STAGE(PG8_SB(0, 0), b2);
      PG8_BAR; PG8_WAIT_L(0); PG8_MMA(0, 1, At, B1); PG8_BAR;
      PG8_LDA(At, 0, 1); PG8_STAGE_A(PG8_SA(0, 0), a2, lastn);
      PG8_BAR; PG8_WAIT_L(0); PG8_MMA(1, 0, At, B0); PG8_BAR; PG8_SCHED;
      PG8_STAGE(PG8_SB(0, 1), b2 + hstep);
      PG8_WAIT_V(6); PG8_BAR; PG8_MMA(1, 1, At, B1); PG8_BAR;
      PG8_LDB(B0, 1, 0); PG8_SCHED; PG8_LDA(At, 1, 0); PG8_STAGE_A(PG8_SA(0, 1), a2 + hstepA, lastn);
      PG8_WAIT_L(8); PG8_BAR; PG8_WAIT_L(0); PG8_MMA(0, 0, At, B0); PG8_BAR; PG8_SCHED;
      PG8_LDB(B1, 1, 1); PG8_STAGE(PG8_SB(1, 0), b3);
      PG8_BAR; PG8_WAIT_L(0); PG8_MMA(0, 1, At, B1); PG8_BAR;
      PG8_LDA(At, 1, 1); PG8_STAGE_A(PG8_SA(1, 0), a3, lastn);
      PG8_BAR; PG8_WAIT_L(0); PG8_MMA(1, 0, At, B0); PG8_BAR; PG8_SCHED;
      PG8_STAGE(PG8_SB(1, 1), b3 + hstep);
      PG8_WAIT_V(6); PG8_BAR; PG8_MMA(1, 1, At, B1); PG8_BAR;
    }
    if (wr == 0) PG8_BAR;
    bool keep;
    { int fr2 = fr, fq2 = fq; asm volatile("" : "+v"(fr2), "+v"(fq2));
      keep = E(acc, cur, wr, wc, fr2, fq2); }
    if (!has_next) break;
    if (!keep)
#pragma unroll
    for (int a = 0; a < 2; ++a)
#pragma unroll
      for (int b = 0; b < 2; ++b)
#pragma unroll
        for (int m = 0; m < 4; ++m)
#pragma unroll
          for (int n = 0; n < 2; ++n) acc[a][b][m][n] = (f32x4){0.f, 0.f, 0.f, 0.f};
    cur = nxt; cA = nA; cB = nB; ++ui;
    if constexpr (GA) {
#pragma unroll
      for (int h = 0; h < 2; ++h)
#pragma unroll
        for (int i = 0; i < 2; ++i) cvA[h][i] = nvA[h][i];
    }
    if (wr == 1) PG8_BAR;
  }
  PG8_WAIT_V(0);
  PG8_BAR;
#undef PG8_SA
#undef PG8_SB
#undef PG8_STAGE
#undef PG8_STAGE_
#undef PG8_STAGE_A
#undef PG8_LDA
#undef PG8_LDB
#undef PG8_MMA
#undef PG8_WAIT_V
#undef PG8_WAIT_L
#undef PG8_BAR
#undef PG8_SCHED
}
template <class F>
__device__ __forceinline__ void epi_each(const f32x4 (&acc)[2][2][4][2], int wr, int wc, int fr, int fq, const F& f) {
#pragma unroll
  for (int ai = 0; ai < 2; ++ai)
#pragma unroll
    for (int m = 0; m < 4; ++m)
#pragma unroll
      for (int bj = 0; bj < 2; ++bj) f(ai * HALF + wr * 64 + m * 16 + fr, bj * HALF + wc * 32 + 8 * fq, acc[ai][bj][m][0], acc[ai][bj][m][1]);
}
struct GridSched {
  const char* A; const char* B; size_t tstep; int nM, nN, nwg, G, c, pm0;
  __device__ __forceinline__ void init(const void* A_, const void* B_, int K, int nM_, int nN_, int pm0_, int G_, int c_) {
    A = (const char*)A_; B = (const char*)B_; tstep = (size_t)BM * K * 2; nM = nM_; nN = nN_; nwg = nM * nN; G = G_; c = c_; pm0 = pm0_;
  }
  __device__ __forceinline__ bool next(int i, Unit& u) const {
    const long L = (long)i * G + c; if (L >= nwg) return false;
    int wgid = (int)L; { const int q = nwg / NXCD, r = nwg % NXCD, xcd = wgid % NXCD, off = wgid / NXCD; wgid = (xcd < r ? xcd * (q + 1) : r * (q + 1) + (xcd - r) * q) + off; }
    const int nig = WGM * nN, gid = wgid / nig, fm = gid * WGM, gsz = (nM - fm) < WGM ? (nM - fm) : WGM;
    u.pm = pm0 + fm + ((wgid % nig) % gsz); u.pn = (wgid % nig) / gsz; u.z = 0; return true;
  }
  __device__ __forceinline__ const char* aptr(const Unit& u) const { return A + (size_t)u.pm * tstep; }
  __device__ __forceinline__ const char* bptr(const Unit& u) const { return B + (size_t)u.pn * tstep; }
};
}
using pg8::Unit;


#define XB_TMO      128
#define XB_XCNT(j)  (256  + 64 * (j))
#define XB_XSUB(j)  (1280 + 64 * (j))
#define XB_XGEN(j)  (2304 + 64 * (j))
#define XB_TOP      3328
#define XB_TOPGEN   3392
#define XB_SPIN_CAP (1u << 18)
__device__ __forceinline__ unsigned xb_ld(unsigned* p)              { return __hip_atomic_load(p, __ATOMIC_RELAXED, __HIP_MEMORY_SCOPE_AGENT); }
__device__ __forceinline__ unsigned xb_add(unsigned* p, unsigned v) { return __hip_atomic_fetch_add(p, v, __ATOMIC_RELAXED, __HIP_MEMORY_SCOPE_AGENT); }
__device__ __forceinline__ unsigned xb_xcc_id() { return (unsigned)__builtin_amdgcn_s_getreg((3 << 11) | 20) & 0xFu; }
#define XB_SPIN(cond, bar) do { unsigned _sp = 0; while (cond) { __builtin_amdgcn_s_sleep(1); \
    if ((++_sp & 255u) == 0u) { if (xb_ld(&(bar)[XB_TMO])) break; if (_sp > XB_SPIN_CAP) { atomicAdd(&(bar)[XB_TMO], 1u); break; } } } } while (0)
struct XcdBarrier { unsigned* bar; unsigned x; volatile PG8_LAS unsigned* st; };
__device__ __forceinline__ XcdBarrier xcd_barrier_post(unsigned* bar, volatile PG8_LAS unsigned* st) {
  XcdBarrier b; b.bar = bar; b.x = xb_xcc_id(); b.st = st;
  if (threadIdx.x == 0) (void)xb_add(&bar[XB_XCNT(b.x)], 1u);
  return b;
}
__device__ __forceinline__ void xcd_barrier_complete(unsigned* bar, unsigned x, unsigned& nloc, unsigned& nx) {
  const unsigned G = gridDim.x * gridDim.y * gridDim.z;
  unsigned sum, cnt, mine, sp = 0u;
  for (;;) {
    sum = 0u; cnt = 0u; mine = 0u;
#pragma unroll
    for (unsigned j = 0; j < 16; ++j) { const unsigned c = xb_ld(&bar[XB_XCNT(j)]); sum += c; cnt += (c > 0u) ? 1u : 0u; mine = (j == x) ? c : mine; }
    if (sum == G) break;
    __builtin_amdgcn_s_sleep(1);
    if ((++sp & 255u) == 0u) { if (xb_ld(&bar[XB_TMO])) break; if (sp > XB_SPIN_CAP) { atomicAdd(&bar[XB_TMO], 1u); break; } }
  }
  nloc = mine > 0u ? mine : 1u; nx = cnt > 0u ? cnt : 1u;
}
__device__ __forceinline__ void xcd_barrier(const XcdBarrier& b) {
  asm volatile("s_waitcnt vmcnt(0)" ::: "memory");
  __syncthreads();
  if (threadIdx.x == 0) {
    unsigned* bar = b.bar;
    __builtin_amdgcn_s_waitcnt(0);
    unsigned nloc = b.st[0], nx = b.st[1];
    if (nloc == 0u) { xcd_barrier_complete(bar, b.x, nloc, nx); b.st[0] = nloc; b.st[1] = nx; }
    const unsigned old = xb_add(&bar[XB_XSUB(b.x)], 1u);
    const unsigned gen = old / nloc;
    if (old + 1u == (gen + 1u) * nloc) {
      __builtin_amdgcn_fence(__ATOMIC_RELEASE, "agent");
      asm volatile("s_waitcnt vmcnt(0)" ::: "memory");
      const unsigned og = xb_add(&bar[XB_TOP], 1u);
      const unsigned tg = og / nx;
      if (og + 1u == (tg + 1u) * nx) xb_add(&bar[XB_TOPGEN], 1u);
      else XB_SPIN(xb_ld(&bar[XB_TOPGEN]) == tg, bar);
      __builtin_amdgcn_fence(__ATOMIC_ACQUIRE, "agent");
      xb_add(&bar[XB_XGEN(b.x)], 1u);
      asm volatile("s_waitcnt vmcnt(0)" ::: "memory");
    } else {
      XB_SPIN(xb_ld(&bar[XB_XGEN(b.x)]) == gen, bar);
      __builtin_amdgcn_fence(__ATOMIC_ACQUIRE, "agent");
      asm volatile("s_waitcnt vmcnt(0)" ::: "memory");
    }
  }
  __syncthreads();
}


__device__ __forceinline__ void sub_barrier(unsigned* cnt, int nb) {
  asm volatile("s_waitcnt vmcnt(0)" ::: "memory");
  __syncthreads();
  if (threadIdx.x == 0) {
    __builtin_amdgcn_fence(__ATOMIC_RELEASE, "agent");
    asm volatile("s_waitcnt vmcnt(0)" ::: "memory");
    (void)xb_add(cnt, 1u);
    unsigned sp = 0;
    while (xb_ld(cnt) < (unsigned)nb && ++sp < (1u << 20)) __builtin_amdgcn_s_sleep(1);
    __builtin_amdgcn_fence(__ATOMIC_ACQUIRE, "agent");
    asm volatile("s_waitcnt vmcnt(0)" ::: "memory");
  }
  __syncthreads();
}

template <class LA, class LB>
__device__ __forceinline__ void gemm_main(f32x4 (&acc)[4][4], const int nk, const LA& la, const LB& lb, char* lds, const int t) {
  const int lane = t & 63, wid = t >> 6, fr = lane & 15, fq = lane >> 4, wr = wid >> 1, wc = wid & 1;
  const int sr = t >> 3, sc = t & 7;
  const int wofs = sr * 128 + ((sc ^ (sr & 7)) << 4);
  const int aofs = (wr * 64 + fr) * 128, bofs = 16384 + (wc * 64 + fr) * 128;
  const int x0 = ((fq) ^ (fr & 7)) << 4, x1 = ((4 + fq) ^ (fr & 7)) << 4;
  bf16x8 ra[4], rb[4];
#pragma unroll
  for (int i = 0; i < 4; ++i) { ra[i] = la(i, 0); rb[i] = lb(i, 0); }
#pragma unroll
  for (int i = 0; i < 4; ++i) { *(bf16x8*)(lds + wofs + i * 4096) = ra[i]; *(bf16x8*)(lds + 16384 + wofs + i * 4096) = rb[i]; }
  __syncthreads();
  for (int kt = 0; kt < nk; ++kt) {
    const char* cur = lds + (kt & 1) * 32768;
    const bool more = kt + 1 < nk;
    if (more) {
#pragma unroll
      for (int i = 0; i < 4; ++i) { ra[i] = la(i, (kt + 1) * 64); rb[i] = lb(i, (kt + 1) * 64); }
    }
#pragma unroll
    for (int kk = 0; kk < 2; ++kk) {
      const int xo = kk ? x1 : x0;
      bf16x8 af[4], bv[4];
#pragma unroll
      for (int m = 0; m < 4; ++m) af[m] = *(const bf16x8*)(cur + aofs + m * 2048 + xo);
#pragma unroll
      for (int n = 0; n < 4; ++n) bv[n] = *(const bf16x8*)(cur + bofs + n * 2048 + xo);
#pragma unroll
      for (int m = 0; m < 4; ++m)
#pragma unroll
        for (int n = 0; n < 4; ++n) acc[m][n] = __builtin_amdgcn_mfma_f32_16x16x32_bf16(bv[n], af[m], acc[m][n], 0, 0, 0);
    }
    if (more) {
      char* nxt = lds + ((kt + 1) & 1) * 32768;
#pragma unroll
      for (int i = 0; i < 4; ++i) { *(bf16x8*)(nxt + wofs + i * 4096) = ra[i]; *(bf16x8*)(nxt + 16384 + wofs + i * 4096) = rb[i]; }
    }
    __syncthreads();
  }
}
__device__ __forceinline__ void zero_acc(f32x4 (&acc)[4][4]) {
#pragma unroll
  for (int m = 0; m < 4; ++m)
#pragma unroll
    for (int n = 0; n < 4; ++n) acc[m][n] = (f32x4){0.f, 0.f, 0.f, 0.f};
}
template <class EP>
__device__ __forceinline__ void gemm_epi(const f32x4 (&acc)[4][4], const EP& ep, const int t) {
  const int lane = t & 63, wid = t >> 6, fr = lane & 15, fq = lane >> 4, wr = wid >> 1, wc = wid & 1;
#pragma unroll
  for (int m = 0; m < 4; ++m)
#pragma unroll
    for (int n = 0; n < 4; ++n) ep(wr * 64 + m * 16 + fr, wc * 64 + n * 16 + fq * 4, acc[m][n]);
}
struct RowLd {
  const bf16_t* p[4];
  __device__ __forceinline__ RowLd(const bf16_t* base, size_t r0, size_t ld, const int t) {
#pragma unroll
    for (int i = 0; i < 4; ++i) p[i] = base + (r0 + (t >> 3) + 32 * i) * ld + (t & 7) * 8;
  }
  __device__ __forceinline__ bf16x8 operator()(int i, int k0) const { return *(const bf16x8*)(p[i] + k0); }
};

__device__ __forceinline__ void phase_setup(const Params& p, char* lds, int wid0) {
  float* tab = (float*)lds;
  float* sv = (float*)(lds + 16384);
  float* red = (float*)(lds + 16384 + 36864);
  const int tid = opaque_tid(wid0);
  float* mod = (float*)(p.ws + O_MOD);
  bf16_t* FTL = (bf16_t*)(p.ws + O_FTL);
  bool have_tab = false;
  const int NMOD = 192, NITEM = NMOD + 4096 + 1;
  for (int item = blockIdx.x; item < NITEM; item += gridDim.x) {
    if (item < NMOD) {
      const int l = item / 96, n = (item % 96) * 64 + (tid & 63), kp = tid >> 6;
      for (int e = tid; e < 9 * 1024; e += NTHREADS) {
        const int r = e >> 10, k = e & 1023;
        const float v = r < 8 ? p.c[r * 1024 + k] : p.c_ctx[k];
        sv[e] = v / (1.0f + __expf(-v));
      }
      __syncthreads();
      float acc[9];
#pragma unroll
      for (int r = 0; r < 9; ++r) acc[r] = 0.f;
      const float* w = p.ada_w + (size_t)l * 1024 * 6144 + n;
#pragma unroll 8
      for (int k = kp * 128; k < kp * 128 + 128; ++k) {
        const float wv = w[(size_t)k * 6144];
#pragma unroll
        for (int r = 0; r < 9; ++r) acc[r] += sv[r * 1024 + k] * wv;
      }
#pragma unroll
      for (int r = 0; r < 9; ++r) red[(kp * 9 + r) * 64 + (tid & 63)] = acc[r];
      __syncthreads();
      for (int e = tid; e < 9 * 64; e += NTHREADS) {
        const int r = e >> 6, c = e & 63;
        float a = 0.f;
#pragma unroll
        for (int q8 = 0; q8 < 8; ++q8) a += red[(q8 * 9 + r) * 64 + c];
        const int nn = (item % 96) * 64 + c;
        mod[(l * 9 + r) * 6144 + nn] = a + p.ada_b[l * 6144 + nn];
      }
      __syncthreads();
    } else {
      if (!have_tab) {
        for (int j = tid; j < 4096; j += NTHREADS) tab[j] = cospif((float)j * (1.0f / 2048.0f));
        __syncthreads();
        have_tab = true;
      }
      if (item < NMOD + 4096) {
        const int k = (item - NMOD) & 2047, part = (item - NMOD) >> 11;
        const float scale = 0.0013810679320049757f;
        for (int e8 = tid; e8 < KH / 8; e8 += NTHREADS) {
          float v[8];
#pragma unroll
          for (int jx = 0; jx < 8; ++jx) {
            const int t = e8 * 8 + jx, jj = (k * t) & 4095;
            if (part == 0) v[jx] = t <= 2048 ? tab[jj] * scale : 0.f;
            else v[jx] = t < 2048 ? -tab[(jj - 1024) & 4095] * scale : 0.f;
          }
          u32x4 w;
          w.x = pk_bf16(v[0], v[1]); w.y = pk_bf16(v[2], v[3]); w.z = pk_bf16(v[4], v[5]); w.w = pk_bf16(v[6], v[7]);
          *(u32x4*)(FTL + ((size_t)part * 2048 + k) * KH + e8 * 8) = w;
        }
      } else {
        bf16_t* FTC = (bf16_t*)(p.ws + O_FTC);
        bf16_t* CS = (bf16_t*)(p.ws + O_CS);
        const float scale_c = 0.005524271728019903f;
        for (int e = tid; e < 256 * 512; e += NTHREADS) {
          const int k = e >> 9, cs = (e >> 8) & 1, t = e & 255;
          const int jj = ((k * t) & 255) * 16;
          FTC[e] = f2bf((cs == 0 ? tab[jj] : -tab[(jj - 1024) & 4095]) * scale_c);
        }
        for (int e = tid; e < 256 * 128; e += NTHREADS) {
          const int row = e >> 7, d = e & 127, cs = row >> 7, m = row & 127;
          const int jj = ((m * d) & 127) * 32;
          CS[e] = f2bf(cs == 0 ? tab[jj] : tab[(jj - 1024) & 4095]);
        }
        float* lb = (float*)(p.ws + O_LB);
        for (int e = tid; e < 2 * 512; e += NTHREADS) {
          const int dir = e >> 9, ch = e & 511;
          const float r0 = p.lb_raw[(dir * 2 + 0) * 512 + ch], r1 = p.lb_raw[(dir * 2 + 1) * 512 + ch];
          const float mx = fmaxf(r0, r1), e0 = expf(r0 - mx), e1 = expf(r1 - mx);
          const float p0 = e0 / (e0 + e1), p1 = e1 / (e0 + e1);
          lb[(dir * 2 + 0) * 512 + ch] = p0 - p0;
          lb[(dir * 2 + 1) * 512 + ch] = (p0 + p1) - p0;
        }
      }
    }
  }
  __syncthreads();
}

constexpr size_t OUT_W13B = (size_t)NL * D * 2;
template <bool VMAP>
__device__ __forceinline__ void conv_items(const Params& p, int l, char* lds, int wid0, const int lo, const int hi, const int r, const int n) {
  const int tid = opaque_tid(wid0);
  float* tile = (float*)lds;
  struct Item { const float* src; bf16_t* dst; int K, N, n0, k0, drow0; };
  auto decode = [&](int item) -> Item {
    int i = item;
    if (VMAP) {
      if (p.w2sep) i = i < 2048 ? i + 608 : i < 2496 ? i - 2048 : i < 3520 ? i + 160 : i - 3072;
      else i = i < 2048 ? i + 608 : i < 2656 ? i - 2048 : i;
    }
    Item it;
    bool w13 = false;
    if (i < 448) {
      it.src = p.w_in + (size_t)l * 1024 * INC; it.dst = (bf16_t*)(p.ws + O_WIN); it.K = 1024; it.N = INC;
    } else if ((i -= 448) < 96) {
      const int j = i / 32; i -= j * 32;
      it.src = p.w_branch + ((size_t)l * 3 + j) * 512 * 1024; it.dst = (bf16_t*)(p.ws + O_WBR) + (size_t)j * 1024 * 512; it.K = 512; it.N = 1024;
    } else if ((i -= 96) < 64) {
      it.src = p.w_out + (size_t)l * 1024 * 1024; it.dst = (bf16_t*)(p.ws + O_WOUT); it.K = 1024; it.N = 1024;
    } else if ((i -= 64) < 2048) {
      const int e = i / 128; i -= e * 128;
      it.src = p.w13 + ((size_t)l * 16 + e) * 1024 * 2048;
      it.dst = (l == 1 ? (bf16_t*)((char*)p.out + OUT_W13B) : (bf16_t*)(p.ws + O_W13)) + (size_t)e * 2048 * 1024; it.K = 1024; it.N = 2048; w13 = true;
    } else {
      i -= 2048;
      const int e = i / 64; i -= e * 64;
      it.src = p.w2 + ((size_t)l * 16 + e) * 1024 * 1024; it.dst = (bf16_t*)(p.ws + (l == 1 && p.w2sep ? O_W2B : O_W2)) + (size_t)e * 1024 * 1024; it.K = 1024; it.N = 1024;
    }
    const int nkt = it.K / 128;
    it.n0 = (i / nkt) * 128; it.k0 = (i % nkt) * 128;
    it.drow0 = w13 ? (((it.n0 & 1023) >> 7) * 256 + (it.n0 >> 10) * 128) : it.n0;
    return it;
  };
  f32x4 pf[8];
  auto fetch = [&](const Item& it) {
#pragma unroll
    for (int q = 0; q < 8; ++q) pf[q] = *(const f32x4*)(it.src + (size_t)(it.k0 + q * 16 + (tid >> 5)) * it.N + it.n0 + (tid & 31) * 4);
  };
  int rr = r; asm volatile("" : "+s"(rr));
  const int item0 = lo + rr;
  Item cur = decode(item0 < hi ? item0 : lo);
  if (item0 < hi) fetch(cur);
  for (int item = item0; item < hi; item += n) {
#pragma unroll
    for (int q = 0; q < 8; ++q) {
      const int kk = q * 16 + (tid >> 5), nn = (tid & 31) * 4;
      tile[(nn + 0) * 129 + kk] = pf[q][0]; tile[(nn + 1) * 129 + kk] = pf[q][1]; tile[(nn + 2) * 129 + kk] = pf[q][2]; tile[(nn + 3) * 129 + kk] = pf[q][3];
    }
    const Item me = cur;
    if (item + n < hi) { cur = decode(item + n); fetch(cur); }
    __syncthreads();
#pragma unroll
    for (int q2 = 0; q2 < 4; ++q2) {
      const int q = tid + q2 * 512, nn = q >> 4, kc = (q & 15) * 8;
      const float* tp = tile + nn * 129 + kc;
      u32x4 w;
      w.x = pk_bf16(tp[0], tp[1]); w.y = pk_bf16(tp[2], tp[3]); w.z = pk_bf16(tp[4], tp[5]); w.w = pk_bf16(tp[6], tp[7]);
      *(u32x4*)(me.dst + (size_t)(me.drow0 + nn) * me.K + me.k0 + kc) = w;
    }
    __syncthreads();
  }
}
__device__ __forceinline__ void phase_conv(const Params& p, int l, char* lds, int wid0) { conv_items<false>(p, l, lds, wid0, 0, 3680, blockIdx.x, gridDim.x); }
constexpr int CF_S0 = 2304, CF_S2 = 320;
__device__ __forceinline__ void conv_fill(const Params& p, char* lds, int wid0, const int slot, const int r, const int n) {
  const bool tuned = gridDim.x == 256;
  int a, b;
  int c0 = CF_S0, c2 = CF_S0 + CF_S2;
  if (!p.w2sep) { c0 = c0 < 2496 ? c0 : 2496; c2 = c2 < 2656 ? c2 : 2656; }
  if (slot == 0) { a = 0; b = c0; } else if (slot == 2) { a = c0; b = c2; } else { a = c2; b = 3680; }
  if (slot < 4) { if (!tuned) return; }
  else if (!tuned) a = 0;
  conv_items<true>(p, 1, lds, wid0, a, b, r, n);
}
__device__ __forceinline__ void phase_rowA(const Params& p, int l, int wid0) {
  const int tid = opaque_tid(wid0), wid = tid >> 6, lane = tid & 63;
  const float* xlat = l == 0 ? p.x : p.out;
  const float* xctx = l == 0 ? p.ctx : (const float*)(p.ws + O_CTXB);
  const float* mod = (const float*)(p.ws + O_MOD);
  bf16_t* H = (bf16_t*)(p.ws + O_H);
  const float* nw = p.norm_w + (size_t)(l * 4 + 0) * 1024;
  for (int row = blockIdx.x * NWAVE + wid; row < NT; row += gridDim.x * NWAVE) {
    const float* xr = row < NL ? xlat + (size_t)row * 1024 : xctx + (size_t)(row - NL) * 1024;
    const int mr = row < NL ? (row >> 12) : 8;
    const float* md = mod + (size_t)(l * 9 + mr) * 6144;
    f32x4 v[4];
    float ss = 0.f;
#pragma unroll
    for (int i = 0; i < 4; ++i) {
      v[i] = *(const f32x4*)(xr + i * 256 + lane * 4);
      ss += v[i][0] * v[i][0] + v[i][1] * v[i][1] + v[i][2] * v[i][2] + v[i][3] * v[i][3];
    }
    ss = wave_sum(ss);
    const float rs = rsqrtf(ss * (1.0f / 1024.0f) + 1e-6f);
#pragma unroll
    for (int i = 0; i < 4; ++i) {
      const int e = i * 256 + lane * 4;
      const f32x4 w = *(const f32x4*)(nw + e), sh = *(const f32x4*)(md + e), sc = *(const f32x4*)(md + 1024 + e);
      f32x4 o;
#pragma unroll
      for (int j = 0; j < 4; ++j) o[j] = v[i][j] * rs * w[j] * (1.0f + sc[j]) + sh[j];
      st4bf(H + (size_t)row * 1024 + e, o);
    }
  }
}

struct EpiGin {
  char* ws; const float* lbp; int l; int pn0;
  __device__ __forceinline__ bool operator()(f32x4 (&acc)[2][2][4][2], const Unit& u, int wr, int wc, int fr, int fq) const {
    const int pn = u.pn + pn0;
    const int sec = pn >> 1, cin0 = (pn & 1) * 256;
    const size_t row0 = (size_t)u.pm * 256;
    if (sec >= 8) {
      const int tl = (wr * 4 + wc) * 64 + fq * 16 + fr;
      unsigned char* GT = (unsigned char*)(ws + O_G) + ((size_t)u.pm * 12 + (pn - 16)) * 65536 + (size_t)tl * 8;
      auto q8 = [](float z) { return __builtin_amdgcn_rcpf(__builtin_fmaf(__expf(-z), 0.00390625f, 0.00390625f)); };
#pragma unroll
      for (int ai = 0; ai < 2; ++ai)
#pragma unroll
        for (int m = 0; m < 4; ++m)
#pragma unroll
          for (int bj = 0; bj < 2; ++bj) {
            const f32x4 a = acc[ai][bj][m][0], b = acc[ai][bj][m][1];
            u32x2 w; w.x = 0u; w.y = 0u;
#pragma unroll
            for (int j = 0; j < 4; ++j) { w.x = __builtin_amdgcn_cvt_pk_u8_f32(q8(a[j]), j, w.x); w.y = __builtin_amdgcn_cvt_pk_u8_f32(q8(b[j]), j, w.y); }
            *(u32x2*)(GT + (size_t)((ai * 4 + m) * 2 + bj) * 4096) = w;
          }
    } else if (sec == 7) {
      bf16_t* VT = (bf16_t*)(ws + O_VT);
      pg8::epi_each(acc, wr, wc, fr, fq, [&](int r, int c, f32x4 v0, f32x4 v1) {
        const int chunk = u.pm * 2 + (r >> 7), q = r & 127, g = (cin0 + c) >> 7, d = c & 127;
        bf16_t* dst = VT + (((size_t)chunk * 4 + g) * 128 + d) * 128 + q;
#pragma unroll
        for (int j = 0; j < 4; ++j) { dst[j * 128] = f2bf(geluf_(v0[j])); dst[(4 + j) * 128] = f2bf(geluf_(v1[j])); }
      });
    } else if (sec == 1 || sec == 2) {
      bf16_t* LF = (bf16_t*)(ws + (sec == 1 ? O_LFF : O_LFB)) + row0 * 512 + cin0;
      const float* lbv = lbp + ((sec - 1) * 2 + l) * 512 + cin0;
      pg8::epi_each(acc, wr, wc, fr, fq, [&](int r, int c, f32x4 v0, f32x4 v1) {
        const f32x4 b0 = *(const f32x4*)(lbv + c), b1 = *(const f32x4*)(lbv + c + 4);
        f32x4 o0, o1;
#pragma unroll
        for (int j = 0; j < 4; ++j) {
          o0[j] = 1.0f - (fmaxf(b0[j], 1e-20f) + (1.0f - b0[j]) * sigmoidf_(v0[j]));
          o1[j] = 1.0f - (fmaxf(b1[j], 1e-20f) + (1.0f - b1[j]) * sigmoidf_(v1[j]));
        }
        st8bf(LF + (size_t)r * 512 + c, o0, o1);
      });
    } else {
      const size_t off = sec == 0 ? O_Q : sec == 3 ? O_I : sec == 4 ? O_GA : sec == 5 ? O_ZB : O_U;
      bf16_t* dst = (bf16_t*)(ws + off) + row0 * 512 + cin0;
      const int act = (sec == 0 || sec == 4) ? 1 : (sec == 6 ? 2 : 0);
      pg8::epi_each(acc, wr, wc, fr, fq, [&](int r, int c, f32x4 v0, f32x4 v1) {
        f32x4 o0, o1;
#pragma unroll
        for (int j = 0; j < 4; ++j) {
          o0[j] = act == 1 ? siluf_(v0[j]) : act == 2 ? geluf_(v0[j]) : v0[j];
          o1[j] = act == 1 ? siluf_(v1[j]) : act == 2 ? geluf_(v1[j]) : v1[j];
        }
        st8bf(dst + (size_t)r * 512 + c, o0, o1);
      });
    }
    return false;
  }
};
constexpr int GIN_R0 = 0;
__device__ __forceinline__ void phase_gin(const Params& p, int l, char* lds, int wid0) {
  const int tid = opaque_tid(wid0);
  PG8_LAS unsigned char* L = (PG8_LAS unsigned char*)lds;
  EpiGin E{p.ws, (const float*)(p.ws + O_LB), l, 0};
  pg8::GridSched S;
  const int R0 = gridDim.x == 256 ? GIN_R0 : 0;
  S.init(p.ws + O_H, p.ws + O_WIN, 1024, (l == 0 ? 136 : 128) - R0, 28, R0, gridDim.x, blockIdx.x);
  pg8::gemm_phase(L, 1024, S, E, tid);
  S.init(p.ws + O_H, p.ws + O_WIN, 1024, R0, 16, 0, gridDim.x, blockIdx.x);
  pg8::gemm_phase(L, 1024, S, E, tid);
  if (l == 1) {
    S.init(p.ws + O_H, p.ws + O_WIN, 1024, 8, 8, 128, gridDim.x, (blockIdx.x + gridDim.x / 2) % gridDim.x);
    pg8::gemm_phase(L, 1024, S, E, tid);
  }
}

__device__ __forceinline__ void phase_mix1(const Params& p, int l, char* lds0, int wid0, int kind, int bfirst, int bi_o = -1, int nb_o = 0) {
  const bool last = (l == 1);
  const int tid = opaque_tid(wid0), t = tid & 255, half = tid >> 8;
  char* lds = lds0 + half * 65536;
  const bf16_t* CS = (const bf16_t*)(p.ws + O_CS);
  const bf16_t* ZB = (const bf16_t*)(p.ws + O_ZB);
  const int NF1L = 2048, NF1C = last ? 0 : 128, NCH = last ? 256 : 272;
  const int ITEM0 = kind == 0 ? 0 : NF1L + NF1C, NITEM = kind == 0 ? NF1L + NF1C : NF1L + NF1C + NCH * 4;
  const int bi = nb_o > 0 ? bi_o : (int)blockIdx.x - bfirst, nb = nb_o > 0 ? nb_o : (int)gridDim.x - bfirst;
  if (bi < 0) return;
  for (int item = ITEM0 + bi * 2 + half; item < NITEM; item += nb * 2) {
    f32x4 acc[4][4];
    zero_acc(acc);
    if (item < NF1L + NF1C) {
      const bool isl = item < NF1L;
      int i = isl ? item : item - NF1L;
      const int mh = i & 1;
      i >>= 1;
      int tt, g, b;
      if (isl) { tt = i & 31; i >>= 5; } else { tt = i & 1; i >>= 1; }
      g = i & 3; b = i >> 2;
      const size_t rowbase = isl ? (size_t)b * 4096 + tt * 128 : (size_t)NL + b * 256 + tt * 128;
      RowLd la(CS, mh * 128, 128, t), lb(ZB + g * 128, rowbase, 512, t);
      gemm_main(acc, 2, la, lb, lds, t);
      bf16_t* dst = isl ? (bf16_t*)(p.ws + O_ZCL) + ((size_t)b * 512 + g * 128) * 8192 + mh * 4096 + tt * 128
                        : (bf16_t*)(p.ws + O_ZCC) + ((size_t)b * 512 + g * 128) * 512 + mh * 256 + tt * 128;
      const size_t ld = isl ? 8192 : 512;
      gemm_epi(acc, [&](int r, int c, f32x4 v) { st4bf(dst + (size_t)r * ld + c, v); }, t);
    } else {
      const int i = item - (NF1L + NF1C), ch = i >> 2, g = i & 3;
      const bf16_t* VT = (const bf16_t*)(p.ws + O_VT) + ((size_t)ch * 4 + g) * 128 * 128;
      float* rstd = (float*)lds;
      {
        float* part = (float*)(lds + 1024);
        const int dg = t >> 4, q8 = (t & 15) * 8;
        float ps[8];
#pragma unroll
        for (int j = 0; j < 8; ++j) ps[j] = 0.f;
#pragma unroll
        for (int i = 0; i < 8; ++i) {
          const u32x4 w = *(const u32x4*)(VT + (size_t)(i * 16 + dg) * 128 + q8);
          const float v0 = bflo(w.x), v1 = bfhi(w.x), v2 = bflo(w.y), v3 = bfhi(w.y), v4 = bflo(w.z), v5 = bfhi(w.z), v6 = bflo(w.w), v7 = bfhi(w.w);
          ps[0] += v0 * v0; ps[1] += v1 * v1; ps[2] += v2 * v2; ps[3] += v3 * v3; ps[4] += v4 * v4; ps[5] += v5 * v5; ps[6] += v6 * v6; ps[7] += v7 * v7;
        }
        *(f32x4*)(part + dg * 128 + q8) = (f32x4){ps[0], ps[1], ps[2], ps[3]};
        *(f32x4*)(part + dg * 128 + q8 + 4) = (f32x4){ps[4], ps[5], ps[6], ps[7]};
        __syncthreads();
        if (t < 128) {
          float ss = 0.f;
#pragma unroll
          for (int g2 = 0; g2 < 16; ++g2) ss += part[g2 * 128 + t];
          rstd[t] = rsqrtf(ss * (1.0f / 128.0f) + 1e-6f);
        }
      }
      __syncthreads();
      const float* wsg = p.sgu_w + ((size_t)l * 4 + g) * 128 * 128;
      const int kc = (t & 7) * 8;
      float rr[2][8];
#pragma unroll
      for (int h2 = 0; h2 < 2; ++h2)
#pragma unroll
        for (int j = 0; j < 8; ++j) rr[h2][j] = rstd[h2 * 64 + kc + j];
      __syncthreads();
      auto la = [&](int ii, int k0) -> bf16x8 {
        const float* s = wsg + (size_t)((t >> 3) + 32 * ii) * 128 + k0 + kc;
        const f32x4 a = *(const f32x4*)s, b = *(const f32x4*)(s + 4);
        const int h2 = k0 >> 6;
        u32x4 w;
        w.x = pk_bf16(a[0] * (h2 ? rr[1][0] : rr[0][0]), a[1] * (h2 ? rr[1][1] : rr[0][1]));
        w.y = pk_bf16(a[2] * (h2 ? rr[1][2] : rr[0][2]), a[3] * (h2 ? rr[1][3] : rr[0][3]));
        w.z = pk_bf16(b[0] * (h2 ? rr[1][4] : rr[0][4]), b[1] * (h2 ? rr[1][5] : rr[0][5]));
        w.w = pk_bf16(b[2] * (h2 ? rr[1][6] : rr[0][6]), b[3] * (h2 ? rr[1][7] : rr[0][7]));
        return __builtin_bit_cast(bf16x8, w);
      };
      RowLd lb(VT, 0, 128, t);
      gemm_main(acc, 2, la, lb, lds, t);
      bf16_t* U = (bf16_t*)(p.ws + O_U) + (size_t)ch * 128 * 512 + g * 128;
      const float* nwv = p.sgu_norm_w + ((size_t)l * 4 + g) * 128;
      const float* sb = p.sgu_b + ((size_t)l * 4 + g) * 128;
      {
        const int lane = t & 63, wid = t >> 6, fr = lane & 15, fq = lane >> 4, wr = wid >> 1, wc = wid & 1;
        bf16_t* ub = U + (size_t)(wr * 64 + fr) * 512 + wc * 64 + fq * 4;
        u32x2 uw[4][4];
#pragma unroll
        for (int m = 0; m < 4; ++m)
#pragma unroll
          for (int n = 0; n < 4; ++n) uw[m][n] = *(const u32x2*)(ub + (size_t)m * 16 * 512 + n * 16);
#pragma unroll
        for (int m = 0; m < 4; ++m) {
          const float bb = sb[wr * 64 + m * 16 + fr];
#pragma unroll
          for (int n = 0; n < 4; ++n) {
            const f32x4 nw4 = *(const f32x4*)(nwv + wc * 64 + n * 16 + fq * 4);
            const f32x4 v = acc[m][n];
            f32x4 o;
            o[0] = bflo(uw[m][n].x) * (v[0] * nw4[0] + bb);
            o[1] = bfhi(uw[m][n].x) * (v[1] * nw4[1] + bb);
            o[2] = bflo(uw[m][n].y) * (v[2] * nw4[2] + bb);
            o[3] = bfhi(uw[m][n].y) * (v[3] * nw4[3] + bb);
            st4bf(ub + (size_t)m * 16 * 512 + n * 16, o);
          }
        }
      }
    }
  }
  __syncthreads();
}

#define SCAN_BAR() do { asm volatile("s_waitcnt lgkmcnt(0)" ::: "memory"); __builtin_amdgcn_s_barrier(); asm volatile("" ::: "memory"); } while (0)
__device__ __forceinline__ void scan_item(const Params& p, int item, char* lds, const int tid) {
  const int dir = item & 1, h = (item >> 1) & 3, b = item >> 3;
  const int wv = tid >> 6, lane = tid & 63, fr = lane & 15, fq = lane >> 4;
  const bool isP = wv < 4;
  char* RAWB = lds + 69632;
  float* qsum = (float*)(lds + 143360);
  const bf16_t* Q = (const bf16_t*)(p.ws + O_Q);
  const bf16_t* LF = (const bf16_t*)(p.ws + (dir ? O_LFB : O_LFF));
  const bf16_t* I = (const bf16_t*)(p.ws + O_I);
  bf16_t* O = (bf16_t*)(p.ws + (dir ? O_OBK : O_OF));
  auto rowOf = [&](int u) -> size_t {
    if (u < 256) return (size_t)NL + b * 256 + (dir ? 255 - u : u);
    const int v = u - 256;
    return (size_t)b * 4096 + (dir ? 4095 - v : v);
  };
  const int cp = tid & 63, tq = (tid >> 6) & 3;
  const bf16_t* srcs[3] = {LF, Q, I};
  auto dma = [&](int cc) {
    PG8_LAS unsigned char* dstb = (PG8_LAS unsigned char*)RAWB + (cc % 3) * 24576;
#pragma unroll
    for (int j = 0; j < 6; ++j) {
      const int g = j * 4 + wv, arr = g >> 3, rg = g & 7;
      const size_t o = rowOf(cc * 32 + rg * 4 + (lane >> 4)) * 512 + h * 128 + (lane & 15) * 8;
      __builtin_amdgcn_global_load_lds((const unsigned*)(srcs[arr] + o), (PG8_LAS unsigned*)(dstb + arr * 8192 + rg * 1024), 16, 0, 0);
    }
  };
  unsigned wkk[8];
  auto prepA = [&](int cc) {
    const char* raw = RAWB + (cc % 3) * 24576;
#pragma unroll
    for (int i = 0; i < 8; ++i) wkk[i] = *(const unsigned*)(raw + (tq * 8 + i) * 256 + cp * 4);
    f32x2 run = {1.f, 1.f};
#pragma unroll
    for (int i = 0; i < 8; ++i) { const f32x2 kk = {bflo(wkk[i]), bfhi(wkk[i])}; run = run * (1.0f - kk); }
    *(f32x2*)(qsum + tq * 128 + cp * 2) = run;
  };
  auto prepB = [&](int cc) {
    const char* raw = RAWB + (cc % 3) * 24576;
    char* OPB = lds + (cc & 1) * 34816;
    char* QP = OPB; char* KM = OPB + 8704; char* KT = OPB + 17408; char* VT = OPB + 25600;
    float* emid = (float*)(OPB + 33792); float* eend = emid + 128;
    unsigned wq[8], wi[8];
#pragma unroll
    for (int i = 0; i < 8; ++i) { wq[i] = *(const unsigned*)(raw + 8192 + (tq * 8 + i) * 256 + cp * 4); wi[i] = *(const unsigned*)(raw + 16384 + (tq * 8 + i) * 256 + cp * 4); }
    const f32x2 q0 = *(const f32x2*)(qsum + cp * 2), q1 = *(const f32x2*)(qsum + 128 + cp * 2), q2 = *(const f32x2*)(qsum + 256 + cp * 2), q3 = *(const f32x2*)(qsum + 384 + cp * 2);
    const f32x2 one = {1.f, 1.f};
    const f32x2 pmid = q0 * q1, pend = pmid * q2 * q3;
    const f32x2 base = tq == 0 ? one : tq == 1 ? q0 : tq == 2 ? pmid : pmid * q2;
    f32x2 rmid; rmid.x = __builtin_amdgcn_rcpf(fmaxf(pmid.x, 1e-30f)); rmid.y = __builtin_amdgcn_rcpf(fmaxf(pmid.y, 1e-30f));
    f32x2 ebm = pend * rmid; ebm.x = fminf(ebm.x, 1.0f); ebm.y = fminf(ebm.y, 1.0f);
    f32x2 run = base * rmid;
    unsigned oq[8], ok[8], kt0[4], kt1[4], vt0[4], vt1[4];
    float pk0 = 0.f, pk1 = 0.f;
#pragma unroll
    for (int i = 0; i < 8; ++i) {
      const f32x2 kk = {bflo(wkk[i]), bfhi(wkk[i])}, qv = {bflo(wq[i]), bfhi(wq[i])};
      run = run * (one - kk);
      f32x2 ea; ea.x = fminf(fmaxf(run.x, 1e-26f), 1e26f); ea.y = fminf(fmaxf(run.y, 1e-26f), 1e26f);
      f32x2 er; er.x = __builtin_amdgcn_rcpf(ea.x); er.y = __builtin_amdgcn_rcpf(ea.y);
      const f32x2 km = kk * er, qp = qv * ea, kpp = km * ebm;
      oq[i] = pk_bf16(qp.x, qp.y);
      ok[i] = pk_bf16(km.x, km.y);
      if (i & 1) {
        kt0[i >> 1] = pk_bf16(pk0, kpp.x); kt1[i >> 1] = pk_bf16(pk1, kpp.y);
        vt0[i >> 1] = (wi[i - 1] & 0xffffu) | (wi[i] << 16); vt1[i >> 1] = (wi[i - 1] >> 16) | (wi[i] & 0xffff0000u);
      } else { pk0 = kpp.x; pk1 = kpp.y; }
    }
#pragma unroll
    for (int i = 0; i < 8; ++i) { *(unsigned*)(QP + (tq * 8 + i) * 272 + cp * 4) = oq[i]; *(unsigned*)(KM + (tq * 8 + i) * 272 + cp * 4) = ok[i]; }
    u32x4 w;
    w.x = kt0[0]; w.y = kt0[1]; w.z = kt0[2]; w.w = kt0[3]; *(u32x4*)(KT + (cp * 2) * 64 + tq * 16) = w;
    w.x = kt1[0]; w.y = kt1[1]; w.z = kt1[2]; w.w = kt1[3]; *(u32x4*)(KT + (cp * 2 + 1) * 64 + tq * 16) = w;
    w.x = vt0[0]; w.y = vt0[1]; w.z = vt0[2]; w.w = vt0[3]; *(u32x4*)(VT + (cp * 2) * 64 + tq * 16) = w;
    w.x = vt1[0]; w.y = vt1[1]; w.z = vt1[2]; w.w = vt1[3]; *(u32x4*)(VT + (cp * 2 + 1) * 64 + tq * 16) = w;
    if (tq == 0) { *(f32x2*)(emid + cp * 2) = pmid; *(f32x2*)(eend + cp * 2) = pend; }
  };
  const int mw = wv - 4;
  f32x4 S[2][8];
#pragma unroll
  for (int a = 0; a < 2; ++a)
#pragma unroll
    for (int m = 0; m < 8; ++m) S[a][m] = (f32x4){0.f, 0.f, 0.f, 0.f};

  if (isP) { dma(0); dma(1); dma(2); asm volatile("s_waitcnt vmcnt(12)" ::: "memory"); }
  SCAN_BAR();
  if (isP) prepA(0);
  SCAN_BAR();
  if (isP) { prepB(0); asm volatile("s_waitcnt vmcnt(6)" ::: "memory"); }
  SCAN_BAR();
  for (int c = 0; c < 136; ++c) {
    if (isP) {
      if (c + 3 < 136) dma(c + 3);
      if (c + 1 < 136) prepA(c + 1);
      SCAN_BAR();
      if (c + 1 < 136) prepB(c + 1);
      if (c + 3 < 136) asm volatile("s_waitcnt vmcnt(6)" ::: "memory");
      else asm volatile("s_waitcnt vmcnt(0)" ::: "memory");
      SCAN_BAR();
    } else {
      const char* OPB = lds + (c & 1) * 34816;
      const char* QP = OPB; const char* KM = OPB + 8704; const char* KT = OPB + 17408; const char* VT = OPB + 25600;
      const float* emid = (const float*)(OPB + 33792); const float* eend = emid + 128;
      f32x4 PT00 = (f32x4){0.f, 0.f, 0.f, 0.f}, PT01 = PT00, PT11 = PT00;
#pragma unroll
      for (int ks = 0; ks < 4; ++ks) {
        const bf16x8 X0 = *(const bf16x8*)(KM + fr * 272 + ks * 64 + fq * 16), X1 = *(const bf16x8*)(KM + (16 + fr) * 272 + ks * 64 + fq * 16);
        const bf16x8 Y0 = *(const bf16x8*)(QP + fr * 272 + ks * 64 + fq * 16), Y1 = *(const bf16x8*)(QP + (16 + fr) * 272 + ks * 64 + fq * 16);
        PT00 = __builtin_amdgcn_mfma_f32_16x16x32_bf16(X0, Y0, PT00, 0, 0, 0);
        PT01 = __builtin_amdgcn_mfma_f32_16x16x32_bf16(X0, Y1, PT01, 0, 0, 0);
        PT11 = __builtin_amdgcn_mfma_f32_16x16x32_bf16(X1, Y1, PT11, 0, 0, 0);
      }
      SCAN_BAR();
#pragma unroll
      for (int jj = 0; jj < 4; ++jj) if (fq * 4 + jj > fr) { PT00[jj] = 0.f; PT11[jj] = 0.f; }
      u32x4 x0, x1;
      x0.x = pk_bf16(PT00[0], PT00[1]); x0.y = pk_bf16(PT00[2], PT00[3]); x0.z = 0u; x0.w = 0u;
      x1.x = pk_bf16(PT01[0], PT01[1]); x1.y = pk_bf16(PT01[2], PT01[3]); x1.z = pk_bf16(PT11[0], PT11[1]); x1.w = pk_bf16(PT11[2], PT11[3]);
      const size_t orow0 = rowOf(c * 32);
      const long ostep = dir ? -512 : 512;
#pragma unroll
      for (int a = 0; a < 2; ++a) {
        const int vcol = (mw * 2 + a) * 16 + fr;
        f32x4 o0 = (f32x4){0.f, 0.f, 0.f, 0.f}, o1 = o0;
        {
          const u32x2 vlo = *(const u32x2*)(VT + vcol * 64 + fq * 8), vhi = *(const u32x2*)(VT + vcol * 64 + 32 + fq * 8);
          u32x4 yv; yv.x = vlo.x; yv.y = vlo.y; yv.z = vhi.x; yv.w = vhi.y;
          o0 = __builtin_amdgcn_mfma_f32_16x16x32_bf16(__builtin_bit_cast(bf16x8, x0), __builtin_bit_cast(bf16x8, yv), o0, 0, 0, 0);
          o1 = __builtin_amdgcn_mfma_f32_16x16x32_bf16(__builtin_bit_cast(bf16x8, x1), __builtin_bit_cast(bf16x8, yv), o1, 0, 0, 0);
        }
#pragma unroll
        for (int ks = 0; ks < 4; ++ks) {
          const f32x4 em0 = *(const f32x4*)(emid + (2 * ks) * 16 + fq * 4), em1 = *(const f32x4*)(emid + (2 * ks + 1) * 16 + fq * 4);
          u32x4 ys;
          ys.x = pk_bf16(S[a][2 * ks][0] * em0[0], S[a][2 * ks][1] * em0[1]); ys.y = pk_bf16(S[a][2 * ks][2] * em0[2], S[a][2 * ks][3] * em0[3]);
          ys.z = pk_bf16(S[a][2 * ks + 1][0] * em1[0], S[a][2 * ks + 1][1] * em1[1]); ys.w = pk_bf16(S[a][2 * ks + 1][2] * em1[2], S[a][2 * ks + 1][3] * em1[3]);
          const u32x2 a0 = *(const u32x2*)(QP + fr * 272 + ks * 64 + fq * 8), a1 = *(const u32x2*)(QP + fr * 272 + ks * 64 + 32 + fq * 8);
          const u32x2 c0 = *(const u32x2*)(QP + (16 + fr) * 272 + ks * 64 + fq * 8), c1 = *(const u32x2*)(QP + (16 + fr) * 272 + ks * 64 + 32 + fq * 8);
          u32x4 xa, xc; xa.x = a0.x; xa.y = a0.y; xa.z = a1.x; xa.w = a1.y; xc.x = c0.x; xc.y = c0.y; xc.z = c1.x; xc.w = c1.y;
          o0 = __builtin_amdgcn_mfma_f32_16x16x32_bf16(__builtin_bit_cast(bf16x8, xa), __builtin_bit_cast(bf16x8, ys), o0, 0, 0, 0);
          o1 = __builtin_amdgcn_mfma_f32_16x16x32_bf16(__builtin_bit_cast(bf16x8, xc), __builtin_bit_cast(bf16x8, ys), o1, 0, 0, 0);
        }
        bf16_t* op = O + orow0 * 512 + h * 128 + vcol;
#pragma unroll
        for (int jj = 0; jj < 4; ++jj) {
          op[(long)(fq * 4 + jj) * ostep] = f2bf(o0[jj]);
          op[(long)(16 + fq * 4 + jj) * ostep] = f2bf(o1[jj]);
        }
        {
          const bf16x8 yv2 = *(const bf16x8*)(VT + vcol * 64 + fq * 16);
#pragma unroll
          for (int m = 0; m < 8; ++m) {
            const f32x4 ee = *(const f32x4*)(eend + m * 16 + fq * 4);
            const bf16x8 xk = *(const bf16x8*)(KT + (m * 16 + fr) * 64 + fq * 16);
            S[a][m] = __builtin_amdgcn_mfma_f32_16x16x32_bf16(xk, yv2, S[a][m] * ee, 0, 0, 0);
          }
        }
      }
      SCAN_BAR();
    }
  }
  __syncthreads();
}

struct F2Sched {
  const char* FT; const char* ZF; int G, c;
  __device__ __forceinline__ bool next(int i, Unit& u) const {
    const int P = c - 64;
    if (i > 1 || P < 0 || P >= 128) return false;
    const int loc = P >> 3; u.z = (P & 7) | (i << 3); u.pm = loc >> 1; u.pn = loc & 1; return true;
  }
  __device__ __forceinline__ const char* aptr(const Unit& u) const { return FT + (size_t)((u.z >> 3) ^ 1) * ((size_t)2048 * KH * 2) + (size_t)u.pm * ((size_t)256 * KH * 2); }
  __device__ __forceinline__ const char* bptr(const Unit& u) const { return ZF + (size_t)((u.z >> 3) ^ 1) * ((size_t)4096 * KH * 2) + ((size_t)(u.z & 7) * 512 + (size_t)u.pn * 256) * ((size_t)KH * 2); }
};
struct F2CSched {
  const char* FT; const char* ZC; int c;
  __device__ __forceinline__ bool next(int i, Unit& u) const {
    const int L = c - 192; if (i != 0 || L < 0 || L >= 16) return false;
    u.z = L >> 1; u.pm = 0; u.pn = L & 1; return true;
  }
  __device__ __forceinline__ const char* aptr(const Unit&) const { return FT; }
  __device__ __forceinline__ const char* bptr(const Unit& u) const { return ZC + (size_t)u.z * (512u * 512u * 2u) + (size_t)u.pn * (256u * 512u * 2u); }
};
struct EpiF2 {
  bf16_t* OB; int ctx; float* SX;
  __device__ __forceinline__ bool operator()(f32x4 (&acc)[2][2][4][2], const Unit& u, int wr, int wc, int fr, int fq) const {
    if (ctx) {
      bf16_t* dst = OB + ((size_t)NL + (size_t)u.z * 256) * 512 + u.pn * 256;
      pg8::epi_each(acc, wr, wc, fr, fq, [&](int r, int c, f32x4 v0, f32x4 v1) { st8bf(dst + (size_t)r * 512 + c, v0, v1); });
      return false;
    }
    const int b = u.z & 7, part = u.z >> 3;
    const int tl = (wr * 4 + wc) * 64 + fq * 16 + fr;
    float* sx = SX + ((size_t)(b + 8 * (u.pm * 2 + u.pn)) * 16) * 4096 + (size_t)tl * 8;
    bf16_t* dst = OB + (size_t)b * 4096 * 512 + u.pn * 256;
#pragma unroll
    for (int ai = 0; ai < 2; ++ai)
#pragma unroll
      for (int m = 0; m < 4; ++m)
#pragma unroll
        for (int bj = 0; bj < 2; ++bj) {
          float* q = sx + (size_t)((ai * 4 + m) * 2 + bj) * 4096;
          if (part == 0) { *(f32x4*)q = acc[ai][bj][m][0]; *(f32x4*)(q + 4) = acc[ai][bj][m][1]; }
          else {
            const f32x4 s0 = *(const f32x4*)q, s1 = *(const f32x4*)(q + 4);
            const int k = u.pm * 256 + ai * 128 + wr * 64 + m * 16 + fr, c = bj * 128 + wc * 32 + 8 * fq;
            st8bf(dst + (size_t)k * 512 + c, acc[ai][bj][m][0], acc[ai][bj][m][1]);
            if (k >= 1) st8bf(dst + (size_t)(4096 - k) * 512 + c, acc[ai][bj][m][0] - 2.0f * s0, acc[ai][bj][m][1] - 2.0f * s1);
          }
        }
    return part == 0;
  }
};
__device__ __forceinline__ void phase_fold(const Params& p, char* lds, int wid0, int bfirst) {
  const int tid = opaque_tid(wid0);
  bf16_t* zrow = (bf16_t*)lds;
  const bf16_t* ZCL = (const bf16_t*)(p.ws + O_ZCL);
  bf16_t* ZF = (bf16_t*)(p.ws + O_ZF);
  bf16_t* OB = (bf16_t*)(p.ws + O_ZB);
  float* red = (float*)(lds + 16384);
  if ((int)blockIdx.x < bfirst) return;
  const int rstep = (int)gridDim.x - bfirst;
  u32x4 pf[2];
  {
    const int row0 = (int)blockIdx.x - bfirst;
    if (row0 < 8 * 512) {
#pragma unroll
      for (int i = 0; i < 2; ++i) pf[i] = *(const u32x4*)(ZCL + (size_t)row0 * 8192 + (tid + i * 512) * 8);
    }
  }
  for (int row = (int)blockIdx.x - bfirst; row < 8 * 512; row += rstep) {
#pragma unroll
    for (int i = 0; i < 2; ++i) *(u32x4*)(zrow + (tid + i * 512) * 8) = pf[i];
    if (row + rstep < 8 * 512) {
#pragma unroll
      for (int i = 0; i < 2; ++i) pf[i] = *(const u32x4*)(ZCL + (size_t)(row + rstep) * 8192 + (tid + i * 512) * 8);
    }
    __syncthreads();
    float alt = 0.f;
    for (int e8 = tid; e8 < 2 * (KH / 8); e8 += NTHREADS) {
      const int part = e8 >= KH / 8 ? 1 : 0, e = part ? e8 - KH / 8 : e8;
      float v[8];
#pragma unroll
      for (int jx = 0; jx < 8; ++jx) {
        const int t = e * 8 + jx;
        if (!part) v[jx] = t > 2048 ? 0.f : (t == 0 || t == 2048) ? bf2f(zrow[t]) : bf2f(zrow[t]) + bf2f(zrow[4096 - t]);
        else v[jx] = (t == 0 || t >= 2048) ? 0.f : bf2f(zrow[4096 + t]) - bf2f(zrow[4096 + 4096 - t]);
      }
      u32x4 w;
      w.x = pk_bf16(v[0], v[1]); w.y = pk_bf16(v[2], v[3]); w.z = pk_bf16(v[4], v[5]); w.w = pk_bf16(v[6], v[7]);
      *(u32x4*)(ZF + ((size_t)part * 4096 + row) * KH + e * 8) = w;
      if (!part) alt += (bflo(w.x) - bfhi(w.x)) + (bflo(w.y) - bfhi(w.y)) + (bflo(w.z) - bfhi(w.z)) + (bflo(w.w) - bfhi(w.w));
    }
    alt = wave_sum(alt);
    if ((tid & 63) == 0) red[tid >> 6] = alt;
    __syncthreads();
    if (tid == 0) {
      float a = 0.f;
#pragma unroll
      for (int w8 = 0; w8 < 8; ++w8) a += red[w8];
      OB[((size_t)(row >> 9) * 4096 + 2048) * 512 + (row & 511)] = f2bf(a * bf2f(f2bf(0.0013810679320049757f)));
    }
  }
}
__device__ __forceinline__ void phase_mix2(const Params& p, int l, char* lds, int wid0) {
  const int tid = opaque_tid(wid0);
  if (blockIdx.x < 64) { scan_item(p, blockIdx.x, lds, tid); return; }
  unsigned* bar = (unsigned*)(p.ws + O_BAR);
  const int nb = (int)gridDim.x - 64;
  phase_mix1(p, l, lds, wid0, 0, 64);
  sub_barrier(bar + (l * 2 + 0) * 16, nb);
  phase_fold(p, lds, wid0, 64);
  sub_barrier(bar + (l * 2 + 1) * 16, nb);
  PG8_LAS unsigned char* L = (PG8_LAS unsigned char*)lds;
  {
    F2Sched S{p.ws + O_FTL, p.ws + O_ZF, (int)gridDim.x, (int)blockIdx.x};
    EpiF2 E{(bf16_t*)(p.ws + O_ZB), 0, (float*)(p.ws + O_ZCL)};
    pg8::gemm_phase(L, KH, S, E, tid);
  }
  if (l == 0) {
    F2CSched S{p.ws + O_FTC, p.ws + O_ZCC, (int)blockIdx.x};
    EpiF2 E{(bf16_t*)(p.ws + O_ZB), 1, nullptr};
    pg8::gemm_phase(L, 512, S, E, tid);
  }
  if (blockIdx.x >= 192) { for (int sh = 0; sh < 2; ++sh) phase_mix1(p, l, lds, wid0, 1, 64, ((int)blockIdx.x - 192) * 2 + sh, 512); }
  else { for (int sh = 0; sh < 3; ++sh) phase_mix1(p, l, lds, wid0, 1, 64, 128 + ((int)blockIdx.x - 64) * 3 + sh, 512); }
  if (gridDim.x == 256) {
    pg8::GridSched S;
    S.init(p.ws + O_H, p.ws + O_WIN + (size_t)16 * 256 * 1024 * 2, 1024, GIN_R0, 12, 0, (int)gridDim.x - 64, (int)blockIdx.x - 64);
    EpiGin E{p.ws, (const float*)(p.ws + O_LB), l, 16};
    pg8::gemm_phase(L, 1024, S, E, tid);
  }
}

__device__ __forceinline__ void phase_oa(const Params& p, int l, int wid0) {
  const int tid = opaque_tid(wid0), wid = tid >> 6, lane = tid & 63;
  const int nrow = (l == 1) ? NL : NT;
  const bf16_t* OF = (const bf16_t*)(p.ws + O_OF);
  const bf16_t* OK = (const bf16_t*)(p.ws + O_OBK);
  bf16_t* GA = (bf16_t*)(p.ws + O_GA);
  const float* gw = p.gnorm_w + (size_t)l * 128;
  for (int row = blockIdx.x * NWAVE + wid; row < nrow; row += gridDim.x * NWAVE) {
    const size_t o = (size_t)row * 512 + lane * 8;
    const u32x4 a = *(const u32x4*)(OF + o), b = *(const u32x4*)(OK + o), g = *(const u32x4*)(GA + o);
    float v[8];
    v[0] = bflo(a.x) + bflo(b.x); v[1] = bfhi(a.x) + bfhi(b.x);
    v[2] = bflo(a.y) + bflo(b.y); v[3] = bfhi(a.y) + bfhi(b.y);
    v[4] = bflo(a.z) + bflo(b.z); v[5] = bfhi(a.z) + bfhi(b.z);
    v[6] = bflo(a.w) + bflo(b.w); v[7] = bfhi(a.w) + bfhi(b.w);
    float ss = 0.f;
#pragma unroll
    for (int j = 0; j < 8; ++j) ss += v[j] * v[j];
    ss += __shfl_xor(ss, 1); ss += __shfl_xor(ss, 2); ss += __shfl_xor(ss, 4); ss += __shfl_xor(ss, 8);
    const float rs = rsqrtf(ss * (1.0f / 128.0f) + 1e-6f);
    const float* gwp = gw + (lane & 15) * 8;
    const f32x4 w0 = *(const f32x4*)gwp, w1 = *(const f32x4*)(gwp + 4);
    float gg[8] = {bflo(g.x), bfhi(g.x), bflo(g.y), bfhi(g.y), bflo(g.z), bfhi(g.z), bflo(g.w), bfhi(g.w)};
    u32x4 w;
    w.x = pk_bf16(v[0] * rs * w0[0] * gg[0], v[1] * rs * w0[1] * gg[1]);
    w.y = pk_bf16(v[2] * rs * w0[2] * gg[2], v[3] * rs * w0[3] * gg[3]);
    w.z = pk_bf16(v[4] * rs * w1[0] * gg[4], v[5] * rs * w1[1] * gg[5]);
    w.w = pk_bf16(v[6] * rs * w1[2] * gg[6], v[7] * rs * w1[3] * gg[7]);
    *(u32x4*)(GA + o) = w;
  }
}

#define HC_MERGE 136
#define HC_MOE1  152
__device__ __forceinline__ void hc_publish(unsigned* cnt) {
  asm volatile("s_waitcnt vmcnt(0)" ::: "memory");
  __syncthreads();
  if (threadIdx.x == 0) { __threadfence(); (void)xb_add(cnt, 1u); }
}
__device__ __forceinline__ void hc_wait(unsigned* bar, unsigned* cnt, unsigned target) {
  if (threadIdx.x == 0) { XB_SPIN(xb_ld(cnt) < target, bar); __threadfence(); }
  __syncthreads();
}
struct OneSched {
  const char* A; const char* B; int pm, pn, z;
  __device__ __forceinline__ bool next(int i, Unit& u) const { if (i) return false; u.pm = pm; u.pn = pn; u.z = z; return true; }
  __device__ __forceinline__ const char* aptr(const Unit&) const { return A; }
  __device__ __forceinline__ const char* bptr(const Unit&) const { return B; }
};
struct EpiStoreBf16 {
  bf16_t* dst; int ld;
  __device__ __forceinline__ bool operator()(f32x4 (&acc)[2][2][4][2], const Unit& u, int wr, int wc, int fr, int fq) const {
    bf16_t* d = dst + (size_t)u.pm * 256 * ld + u.pn * 256;
    pg8::epi_each(acc, wr, wc, fr, fq, [&](int r, int c, f32x4 v0, f32x4 v1) { st8bf(d + (size_t)r * ld + c, v0, v1); });
    return false;
  }
};
struct MergeSched {
  const char* ws; int ntile, G, c, fuse;
  __device__ __forceinline__ bool next(int i, Unit& u) const {
    const int xcd = c & 7, q = c >> 3;
    int rnd = i / 3;
    if (fuse && c < 32) rnd = rnd == 0 ? 2 : rnd == 2 ? 0 : rnd;
    u.pm = (rnd * (G >> 5) + (q >> 2)) * 8 + xcd; u.pn = q & 3; u.z = i % 3;
    return u.pm * 4 < ntile && (q >> 2) < (G >> 5);
  }
  __device__ __forceinline__ const char* aptr(const Unit& u) const {
    return ws + (u.z == 0 ? O_GA : u.z == 1 ? O_ZB : O_U) + (size_t)u.pm * (256u * 512u * 2u);
  }
  __device__ __forceinline__ const char* bptr(const Unit& u) const { return ws + O_WBR + (size_t)u.z * (1024u * 512u * 2u) + (size_t)u.pn * (256u * 512u * 2u); }
};
struct EpiMerge {
  char* ws; int fuse;
  __device__ __forceinline__ bool operator()(f32x4 (&acc)[2][2][4][2], const Unit& u, int wr, int wc, int fr, int fq) const {
    const int tl = (wr * 4 + wc) * 64 + fq * 16 + fr;
    const unsigned char* GT = (const unsigned char*)(ws + O_G) + ((size_t)u.pm * 12 + u.z * 4 + u.pn) * 65536 + (size_t)tl * 8;
    auto ub = [](unsigned w, int k) { return (float)((w >> (8 * k)) & 0xffu) + 0.5f; };
    bf16_t* MG = (bf16_t*)(ws + O_H) + (size_t)u.pm * 256 * 1024 + u.pn * 256;
    const bool lastj = (u.z == 2);
#pragma unroll
    for (int ai = 0; ai < 2; ++ai)
#pragma unroll
      for (int m = 0; m < 4; ++m)
#pragma unroll
        for (int bj = 0; bj < 2; ++bj) {
          const int cidx = (ai * 4 + m) * 2 + bj;
          const u32x2 gw = *(const u32x2*)(GT + (size_t)cidx * 4096);
          f32x4 g0, g1;
#pragma unroll
          for (int q = 0; q < 4; ++q) { g0[q] = ub(gw.x, q); g1[q] = ub(gw.y, q); }
          if (lastj) {
            const int r = ai * 128 + wr * 64 + m * 16 + fr, c = bj * 128 + wc * 32 + 8 * fq;
            st8bf(MG + (size_t)r * 1024 + c, acc[ai][bj][m][0] * (g0 * 0.00390625f), acc[ai][bj][m][1] * (g1 * 0.00390625f));
          } else {
            const u32x2 hw = *(const u32x2*)(GT + 4 * 65536 + (size_t)cidx * 4096);
#pragma unroll
            for (int q = 0; q < 4; ++q) {
              acc[ai][bj][m][0][q] *= g0[q] * __builtin_amdgcn_rcpf(ub(hw.x, q));
              acc[ai][bj][m][1][q] *= g1[q] * __builtin_amdgcn_rcpf(ub(hw.y, q));
            }
          }
        }
    if (fuse && lastj && u.pm >= 128) hc_publish((unsigned*)(ws + O_BAR) + HC_MERGE);
    return !lastj;
  }
};
__device__ __forceinline__ void phase_merge(const Params& p, int l, char* lds, int wid0) {
  const int tid = opaque_tid(wid0);
  const int fuse = (l == 0 && gridDim.x == 256) ? 1 : 0;
  MergeSched S{p.ws, (l == 1 ? 128 : 136) * 4, (int)gridDim.x, (int)blockIdx.x, fuse};
  EpiMerge E{p.ws, fuse};
  pg8::gemm_phase((PG8_LAS unsigned char*)lds, 512, S, E, tid);
  if (fuse) {
    const int c = (int)blockIdx.x;
    if (c >= 32 && c < 64) {
      unsigned* bar = (unsigned*)(p.ws + O_BAR);
      hc_wait(bar, bar + HC_MERGE, 32u);
      const int pm = 128 + (c & 7), pn = (c >> 3) - 4;
      OneSched S2{p.ws + O_H + (size_t)pm * (256u * 1024u * 2u), p.ws + O_WOUT + (size_t)pn * (256u * 1024u * 2u), pm, pn, 0};
      EpiStoreBf16 E2{(bf16_t*)(p.ws + O_Y), 1024};
      pg8::gemm_phase((PG8_LAS unsigned char*)lds, 1024, S2, E2, tid);
    } else if (c >= 64) conv_fill(p, lds, wid0, 0, c - 64, 192);
  }
}

__device__ __forceinline__ void phase_wout(const Params& p, int l, char* lds, int wid0) {
  const int tid = opaque_tid(wid0);
  pg8::GridSched S;
  const bool fuse = l == 0 && gridDim.x == 256;
  S.init(p.ws + O_H, p.ws + O_WOUT, 1024, (l == 1 || fuse) ? 128 : 136, 4, 0, gridDim.x, blockIdx.x);
  EpiStoreBf16 E{(bf16_t*)(p.ws + O_Y), 1024};
  pg8::gemm_phase((PG8_LAS unsigned char*)lds, 1024, S, E, tid);
}

template <int l>
__device__ __forceinline__ void phase_rowB(const Params& p, char* lds, int wid0) {
  const int tid = opaque_tid(wid0), wid = tid >> 6, lane = tid & 63;
  const int nrow = (l == 1) ? NL : NT;
  const float* xlat = l == 0 ? p.x : p.out;
  const float* xctx = l == 0 ? p.ctx : (const float*)(p.ws + O_CTXB);
  const float* mod = (const float*)(p.ws + O_MOD);
  bf16_t* Y = (bf16_t*)(p.ws + O_Y);
  bf16_t* H = (bf16_t*)(p.ws + O_H);
  float* aff = (float*)(p.ws + O_AFF);
  const float* nw1 = p.norm_w + (size_t)(l * 4 + 1) * 1024;
  const float* nw2 = p.norm_w + (size_t)(l * 4 + 2) * 1024;
  const float* rw = p.router_w + (size_t)l * 1024 * 16;
  float* rwT = (float*)lds;
  for (int i = tid; i < 16384; i += NTHREADS) rwT[(i & 15) * 1024 + (i >> 4)] = rw[i];
  __syncthreads();
  u32x4 pfy[2]; f32x4 pfx[4];
  auto fetch = [&](int row) {
    const float* xr = row < NL ? xlat + (size_t)row * 1024 : xctx + (size_t)(row - NL) * 1024;
#pragma unroll
    for (int i = 0; i < 2; ++i) {
      const int e = i * 512 + lane * 8;
      pfy[i] = *(const u32x4*)(Y + (size_t)row * 1024 + e);
      if (l == 1) pfx[i * 2] = *(const f32x4*)((const bf16_t*)p.out + (size_t)row * 1024 + e);
      else { pfx[i * 2] = *(const f32x4*)(xr + e); pfx[i * 2 + 1] = *(const f32x4*)(xr + e + 4); }
    }
  };
  const int row0 = blockIdx.x * NWAVE + wid, rstep = gridDim.x * NWAVE;
  if (row0 < nrow) fetch(row0);
  for (int row = row0; row < nrow; row += rstep) {
    const int mr = row < NL ? (row >> 12) : 8;
    const float* md = mod + (size_t)(l * 9 + mr) * 6144;
    float yv[16], xv[16];
    float ss = 0.f;
#pragma unroll
    for (int i = 0; i < 2; ++i) {
      const u32x4 w = pfy[i];
      yv[i * 8 + 0] = bflo(w.x); yv[i * 8 + 1] = bfhi(w.x); yv[i * 8 + 2] = bflo(w.y); yv[i * 8 + 3] = bfhi(w.y);
      yv[i * 8 + 4] = bflo(w.z); yv[i * 8 + 5] = bfhi(w.z); yv[i * 8 + 6] = bflo(w.w); yv[i * 8 + 7] = bfhi(w.w);
      if (l == 1) {
        const u32x4 xw = __builtin_bit_cast(u32x4, pfx[i * 2]);
        xv[i * 8 + 0] = bflo(xw.x); xv[i * 8 + 1] = bfhi(xw.x); xv[i * 8 + 2] = bflo(xw.y); xv[i * 8 + 3] = bfhi(xw.y);
        xv[i * 8 + 4] = bflo(xw.z); xv[i * 8 + 5] = bfhi(xw.z); xv[i * 8 + 6] = bflo(xw.w); xv[i * 8 + 7] = bfhi(xw.w);
      } else {
        const f32x4 a = pfx[i * 2], b = pfx[i * 2 + 1];
#pragma unroll
        for (int j = 0; j < 4; ++j) { xv[i * 8 + j] = a[j]; xv[i * 8 + 4 + j] = b[j]; }
      }
    }
    if (row + rstep < nrow) fetch(row + rstep);
#pragma unroll
    for (int j = 0; j < 16; ++j) ss += yv[j] * yv[j];
    ss = wave_sum(ss);
    const float rs = rsqrtf(ss * (1.0f / 1024.0f) + 1e-6f);
    float ss2 = 0.f;
#pragma unroll
    for (int i = 0; i < 2; ++i) {
      const int e = i * 512 + lane * 8;
#pragma unroll
      for (int h4 = 0; h4 < 2; ++h4) {
        const f32x4 w = *(const f32x4*)(nw1 + e + h4 * 4), g1 = *(const f32x4*)(md + 2048 + e + h4 * 4);
#pragma unroll
        for (int j = 0; j < 4; ++j) {
          const int q = i * 8 + h4 * 4 + j;
          xv[q] = xv[q] + g1[j] * (yv[q] * rs * w[j]);
          ss2 += xv[q] * xv[q];
        }
      }
      u32x4 o;
      o.x = pk_bf16(xv[i * 8 + 0], xv[i * 8 + 1]); o.y = pk_bf16(xv[i * 8 + 2], xv[i * 8 + 3]); o.z = pk_bf16(xv[i * 8 + 4], xv[i * 8 + 5]); o.w = pk_bf16(xv[i * 8 + 6], xv[i * 8 + 7]);
      *(u32x4*)(Y + (size_t)row * 1024 + e) = o;
    }
    ss2 = wave_sum(ss2);
    const float rs2 = rsqrtf(ss2 * (1.0f / 1024.0f) + 1e-6f);
    float lg[16];
#pragma unroll
    for (int e2 = 0; e2 < 16; ++e2) lg[e2] = 0.f;
#pragma unroll
    for (int i = 0; i < 2; ++i) {
      const int e = i * 512 + lane * 8;
      float hv[8];
#pragma unroll
      for (int h4 = 0; h4 < 2; ++h4) {
        const f32x4 w = *(const f32x4*)(nw2 + e + h4 * 4), sh = *(const f32x4*)(md + 3072 + e + h4 * 4), sc = *(const f32x4*)(md + 4096 + e + h4 * 4);
#pragma unroll
        for (int j = 0; j < 4; ++j) hv[h4 * 4 + j] = xv[i * 8 + h4 * 4 + j] * rs2 * w[j] * (1.0f + sc[j]) + sh[j];
      }
      u32x4 w;
      w.x = pk_bf16(hv[0], hv[1]); w.y = pk_bf16(hv[2], hv[3]); w.z = pk_bf16(hv[4], hv[5]); w.w = pk_bf16(hv[6], hv[7]);
      *(u32x4*)(H + (size_t)row * 1024 + e) = w;
#pragma unroll
      for (int e2 = 0; e2 < 16; ++e2) {
        const f32x4 r0 = *(const f32x4*)(rwT + e2 * 1024 + e), r1 = *(const f32x4*)(rwT + e2 * 1024 + e + 4);
        lg[e2] += hv[0] * r0[0] + hv[1] * r0[1] + hv[2] * r0[2] + hv[3] * r0[3] + hv[4] * r1[0] + hv[5] * r1[1] + hv[6] * r1[2] + hv[7] * r1[3];
        if ((e2 & 3) == 3) __builtin_amdgcn_sched_barrier(0);
      }
    }
    float a8[8], a4[4], a2[2], a1;
    {
      const bool up = (lane & 32) != 0;
#pragma unroll
      for (int j = 0; j < 8; ++j) { const float mine = up ? lg[8 + j] : lg[j], other = up ? lg[j] : lg[8 + j]; a8[j] = mine + __shfl_xor(other, 32); }
    }
    {
      const bool up = (lane & 16) != 0;
#pragma unroll
      for (int j = 0; j < 4; ++j) { const float mine = up ? a8[4 + j] : a8[j], other = up ? a8[j] : a8[4 + j]; a4[j] = mine + __shfl_xor(other, 16); }
    }
    {
      const bool up = (lane & 8) != 0;
#pragma unroll
      for (int j = 0; j < 2; ++j) { const float mine = up ? a4[2 + j] : a4[j], other = up ? a4[j] : a4[2 + j]; a2[j] = mine + __shfl_xor(other, 8); }
    }
    {
      const bool up = (lane & 4) != 0;
      const float mine = up ? a2[1] : a2[0], other = up ? a2[0] : a2[1];
      a1 = mine + __shfl_xor(other, 4);
    }
    a1 += __shfl_xor(a1, 2);
    a1 += __shfl_xor(a1, 1);
    float mx = a1;
    mx = fmaxf(mx, __shfl_xor(mx, 4)); mx = fmaxf(mx, __shfl_xor(mx, 8)); mx = fmaxf(mx, __shfl_xor(mx, 16)); mx = fmaxf(mx, __shfl_xor(mx, 32));
    const float ex = expf(a1 - mx);
    float se = ex;
    se += __shfl_xor(se, 4); se += __shfl_xor(se, 8); se += __shfl_xor(se, 16); se += __shfl_xor(se, 32);
    if ((lane & 3) == 0) {
      const int e2 = ((lane >> 5) & 1) * 8 + ((lane >> 4) & 1) * 4 + ((lane >> 3) & 1) * 2 + ((lane >> 2) & 1);
      aff[(size_t)row * 16 + e2] = ex / se;
    }
  }
}

template <int NI, int T>
__device__ __forceinline__ void topk_body(const Params& p, int s, int e, char* lds, const int tid) {
  constexpr int CAP = T / 8;
  typedef unsigned long long u64;
  int* cntw = (int*)lds;
  int* wcnt = (int*)(lds + 256);
  int* woff = (int*)(lds + 512);
  const int wid = tid >> 6, lane = tid & 63;
  const bool isl = T == 4096;
  const size_t rowbase = isl ? (size_t)s * 4096 : (size_t)NL + (size_t)(s - 8) * 256;
  const float* aff = (const float*)(p.ws + O_AFF);
  int* sel = (int*)(p.ws + O_SEL);
  float* gate = (float*)(p.ws + O_GATE);
  int* tok = (int*)(p.ws + O_TOK);
  u64 key[NI];
  float av[NI];
#pragma unroll
  for (int q = 0; q < NI; ++q) {
    const int i = tid + q * NTHREADS;
    av[q] = 0.f; key[q] = 0ull;
    if (i < T) {
      av[q] = aff[(rowbase + i) * 16 + e];
      key[q] = ((u64)__float_as_uint(av[q]) << 12) | (u64)(4095 - i);
    }
  }
  u64 prefix = 0ull;
  for (int bit = 43; bit >= 0; --bit) {
    const u64 cand = prefix | (1ull << bit);
    int c = 0;
#pragma unroll
    for (int q = 0; q < NI; ++q) c += __popcll(__ballot(key[q] >= cand));
    if (lane == 0) cntw[(bit & 1) * 8 + wid] = c;
    __syncthreads();
    int tot = 0;
#pragma unroll
    for (int w = 0; w < 8; ++w) tot += cntw[(bit & 1) * 8 + w];
    if (tot >= CAP) prefix = cand;
  }
  int before[NI];
  bool in[NI];
#pragma unroll
  for (int q = 0; q < NI; ++q) {
    in[q] = key[q] >= prefix && key[q] != 0ull;
    const u64 m = __ballot(in[q]);
    before[q] = __popcll(m & ((1ull << lane) - 1ull));
    if (lane == 0) wcnt[q * 8 + wid] = __popcll(m);
  }
  __syncthreads();
  if (tid < 64) {
    int v = tid < NI * 8 ? wcnt[tid] : 0, x = v;
#pragma unroll
    for (int o = 1; o < 64; o <<= 1) { const int y = __shfl_up(x, o); if (lane >= o) x += y; }
    if (tid < NI * 8) woff[tid] = x - v;
  }
  __syncthreads();
  const size_t slotbase = isl ? ((size_t)e * 8 + s) * CAP : (size_t)NSLOT_L + ((size_t)e * 8 + (s - 8)) * CAP;
#pragma unroll
  for (int q = 0; q < NI; ++q) {
    const int i = tid + q * NTHREADS;
    if (i < T) {
      const int slot = woff[q * 8 + wid] + before[q];
      sel[(rowbase + i) * 16 + e] = in[q] ? slot : -1;
      if (in[q]) {
        tok[slotbase + slot] = (int)(rowbase + i);
        gate[slotbase + slot] = av[q];
      }
    }
  }
  __syncthreads();
}
__device__ __forceinline__ void phase_topk(const Params& p, int l, char* lds, int wid0) {
  const int tid = opaque_tid(wid0);
  const int NITEM = (l == 1) ? 128 : 256;
  for (int item = blockIdx.x; item < NITEM; item += gridDim.x) {
    const int s = item >> 4, e = item & 15;
    if (s < 8) topk_body<8, 4096>(p, s, e, lds, tid);
    else topk_body<1, 256>(p, s, e, lds, tid);
  }
}

struct MoeSched {
  const char* A; const char* W; int nN, nunit, G, c; size_t estep; int swap = 0;
  __device__ __forceinline__ bool next(int i, Unit& u) const {
    const int xcd = c & 7, q = c >> 3, per = (G >> 3) / nN;
    int ii = i;
    if (swap && xcd < 4) ii = i == 0 ? 8 : i == 8 ? 0 : i;
    u.pn = q % nN; u.pm = (ii * 8 + xcd) * per + q / nN;
    if (q >= per * nN || u.pm * nN >= nunit) return false;
    u.z = u.pm < 256 ? (u.pm >> 4) : (u.pm - 256); return true;
  }
  __device__ __forceinline__ const char* aptr(const Unit& u) const { return A + (size_t)u.pm * (256u * 1024u * 2u); }
  __device__ __forceinline__ const char* bptr(const Unit& u) const { return W + (size_t)u.z * estep + (size_t)u.pn * (256u * 1024u * 2u); }
};
struct MoeSchedG : MoeSched {
  static constexpr bool GATHER = true;
  const int* tok;
  __device__ __forceinline__ const char* aptr(const Unit&) const { return A; }
  __device__ __forceinline__ const int* tokptr(const Unit& u) const { return tok + (size_t)u.pm * 256; }
};
struct EpiSwiglu {
  bf16_t* HID; unsigned* cnt;
  __device__ __forceinline__ bool operator()(f32x4 (&acc)[2][2][4][2], const Unit& u, int wr, int wc, int fr, int fq) const {
    bf16_t* d = HID + (size_t)u.pm * 256 * 1024 + u.pn * 128;
#pragma unroll
    for (int ai = 0; ai < 2; ++ai)
#pragma unroll
      for (int m = 0; m < 4; ++m) {
        f32x4 o0, o1;
#pragma unroll
        for (int j = 0; j < 4; ++j) { o0[j] = siluf_(acc[ai][0][m][0][j]) * acc[ai][1][m][0][j]; o1[j] = siluf_(acc[ai][0][m][1][j]) * acc[ai][1][m][1][j]; }
        st8bf(d + (size_t)(ai * 128 + wr * 64 + m * 16 + fr) * 1024 + wc * 32 + 8 * fq, o0, o1);
      }
    if (cnt && u.pm >= 256) hc_publish(cnt);
    return false;
  }
};
__device__ __forceinline__ void phase_moe1(const Params& p, int l, char* lds, int wid0) {
  const int tid = opaque_tid(wid0);
  const int nrt = (l == 1) ? 256 : 272;
  MoeSchedG S;
  S.A = p.ws + O_H; S.W = l == 1 ? (const char*)p.out + OUT_W13B : p.ws + O_W13; S.nN = 8; S.nunit = nrt * 8; S.G = (int)gridDim.x; S.c = (int)blockIdx.x; S.estep = (size_t)2048 * 1024 * 2;
  S.tok = (const int*)(p.ws + O_TOK);
  const bool fuse = l == 0 && gridDim.x == 256;
  S.swap = fuse ? 1 : 0;
  unsigned* bar = (unsigned*)(p.ws + O_BAR);
  EpiSwiglu E{(bf16_t*)(p.ws + O_HID), fuse ? bar + HC_MOE1 : nullptr};
  pg8::gemm_phase((PG8_LAS unsigned char*)lds, 1024, S, E, tid);
  if (fuse) {
    const int xcd = (int)blockIdx.x & 7, q = (int)blockIdx.x >> 3;
    if (xcd >= 4 && q < 16) {
      const int r = q * 4 + xcd - 4, e = r >> 2, pn = r & 3, pm = 256 + e;
      hc_wait(bar, bar + HC_MOE1, 128u);
      OneSched S2{p.ws + O_HID + (size_t)pm * (256u * 1024u * 2u), p.ws + O_W2 + (size_t)e * ((size_t)1024 * 1024 * 2) + (size_t)pn * (256u * 1024u * 2u), pm, pn, e};
      EpiStoreBf16 E2{(bf16_t*)(p.ws + O_YS), 1024};
      pg8::gemm_phase((PG8_LAS unsigned char*)lds, 1024, S2, E2, tid);
    } else if (xcd >= 4) conv_fill(p, lds, wid0, 2, (q - 16) * 4 + xcd - 4, 64);
  }
}
__device__ __forceinline__ void phase_moe2(const Params& p, int l, char* lds, int wid0) {
  const int tid = opaque_tid(wid0);
  const int nrt = (l == 1 || gridDim.x == 256) ? 256 : 272;
  MoeSched S{p.ws + O_HID, p.ws + (l == 1 && p.w2sep ? O_W2B : O_W2), 4, nrt * 4, (int)gridDim.x, (int)blockIdx.x, (size_t)1024 * 1024 * 2};
  EpiStoreBf16 E{(bf16_t*)(p.ws + O_YS), 1024};
  pg8::gemm_phase((PG8_LAS unsigned char*)lds, 1024, S, E, tid);
}

__device__ __forceinline__ void phase_rowC(const Params& p, int l, int wid0) {
  const int tid = opaque_tid(wid0), wid = tid >> 6, lane = tid & 63;
  const int nrow = (l == 1) ? NL : NT;
  float* olat = p.out;
  float* octx = (float*)(p.ws + O_CTXB);
  const float* mod = (const float*)(p.ws + O_MOD);
  const bf16_t* YS = (const bf16_t*)(p.ws + O_YS);
  const int* sel = (const int*)(p.ws + O_SEL);
  const float* gate = (const float*)(p.ws + O_GATE);
  const float* nw3 = p.norm_w + (size_t)(l * 4 + 3) * 1024;
  const float* nwn = p.norm_w + (size_t)((l + 1) * 4 + 0) * 1024;
  bf16_t* H = (bf16_t*)(p.ws + O_H);
  const bf16_t* X1 = (const bf16_t*)(p.ws + O_Y);
  int pfrk; u32x4 pfx[2];
  auto fetch = [&](int row) {
    pfrk = sel[(size_t)row * 16 + (lane & 15)];
#pragma unroll
    for (int i = 0; i < 2; ++i) pfx[i] = *(const u32x4*)(X1 + (size_t)row * 1024 + i * 512 + lane * 8);
  };
  const int row0 = blockIdx.x * NWAVE + wid, rstep = gridDim.x * NWAVE;
  if (row0 < nrow) fetch(row0);
  for (int row = row0; row < nrow; row += rstep) {
    float* xo = row < NL ? olat + (size_t)row * 1024 : octx + (size_t)(row - NL) * 1024;
    const bool isl = row < NL;
    const int mr = isl ? (row >> 12) : 8;
    const int s = isl ? (row >> 12) : ((row - NL) >> 8);
    const float* md = mod + (size_t)(l * 9 + mr) * 6144;
    float mv[16];
#pragma unroll
    for (int j = 0; j < 16; ++j) mv[j] = 0.f;
    const int myrk = pfrk;
    u32x4 xcur[2];
#pragma unroll
    for (int i = 0; i < 2; ++i) xcur[i] = pfx[i];
    if (row + rstep < nrow) fetch(row + rstep);
    unsigned long long chosen = __ballot(myrk >= 0) & 0xffffull;
    while (chosen) {
      const int e0 = __builtin_ctzll(chosen); chosen &= chosen - 1;
      const int e1 = chosen ? __builtin_ctzll(chosen) : -1; if (chosen) chosen &= chosen - 1;
      const int rk0 = __shfl(myrk, e0), rk1 = e1 >= 0 ? __shfl(myrk, e1) : 0;
      const size_t slot0 = isl ? ((size_t)e0 * 8 + s) * 512 + rk0 : (size_t)NSLOT_L + ((size_t)e0 * 8 + s) * 32 + rk0;
      const size_t slot1 = e1 < 0 ? slot0 : (isl ? ((size_t)e1 * 8 + s) * 512 + rk1 : (size_t)NSLOT_L + ((size_t)e1 * 8 + s) * 32 + rk1);
      u32x4 w[4];
#pragma unroll
      for (int i = 0; i < 2; ++i) { w[i] = *(const u32x4*)(YS + slot0 * 1024 + i * 512 + lane * 8); w[2 + i] = *(const u32x4*)(YS + slot1 * 1024 + i * 512 + lane * 8); }
      const float m0 = gate[slot0], m1 = e1 >= 0 ? gate[slot1] : 0.f;
#pragma unroll
      for (int i = 0; i < 2; ++i) {
        mv[i * 8 + 0] += m0 * bflo(w[i].x) + m1 * bflo(w[2 + i].x); mv[i * 8 + 1] += m0 * bfhi(w[i].x) + m1 * bfhi(w[2 + i].x);
        mv[i * 8 + 2] += m0 * bflo(w[i].y) + m1 * bflo(w[2 + i].y); mv[i * 8 + 3] += m0 * bfhi(w[i].y) + m1 * bfhi(w[2 + i].y);
        mv[i * 8 + 4] += m0 * bflo(w[i].z) + m1 * bflo(w[2 + i].z); mv[i * 8 + 5] += m0 * bfhi(w[i].z) + m1 * bfhi(w[2 + i].z);
        mv[i * 8 + 6] += m0 * bflo(w[i].w) + m1 * bflo(w[2 + i].w); mv[i * 8 + 7] += m0 * bfhi(w[i].w) + m1 * bfhi(w[2 + i].w);
      }
    }
    float ss = 0.f;
#pragma unroll
    for (int j = 0; j < 16; ++j) ss += mv[j] * mv[j];
    ss = wave_sum(ss);
    const float rs = rsqrtf(ss * (1.0f / 1024.0f) + 1e-6f);
    float xn[16], ssn = 0.f;
#pragma unroll
    for (int i = 0; i < 2; ++i) {
      const int e = i * 512 + lane * 8;
#pragma unroll
      for (int h4 = 0; h4 < 2; ++h4) {
        const f32x4 w = *(const f32x4*)(nw3 + e + h4 * 4), g2 = *(const f32x4*)(md + 5120 + e + h4 * 4);
        f32x4 xv;
        if (h4 == 0) { xv[0] = bflo(xcur[i].x); xv[1] = bfhi(xcur[i].x); xv[2] = bflo(xcur[i].y); xv[3] = bfhi(xcur[i].y); }
        else { xv[0] = bflo(xcur[i].z); xv[1] = bfhi(xcur[i].z); xv[2] = bflo(xcur[i].w); xv[3] = bfhi(xcur[i].w); }
#pragma unroll
        for (int j = 0; j < 4; ++j) { xv[j] += g2[j] * (mv[i * 8 + h4 * 4 + j] * rs * w[j]); xn[i * 8 + h4 * 4 + j] = xv[j]; ssn += xv[j] * xv[j]; }
        if (!(l == 0 && isl)) *(f32x4*)(xo + e + h4 * 4) = xv;
      }
      if (l == 0 && isl) {
        u32x4 o;
        o.x = pk_bf16(xn[i * 8 + 0], xn[i * 8 + 1]); o.y = pk_bf16(xn[i * 8 + 2], xn[i * 8 + 3]); o.z = pk_bf16(xn[i * 8 + 4], xn[i * 8 + 5]); o.w = pk_bf16(xn[i * 8 + 6], xn[i * 8 + 7]);
        *(u32x4*)((bf16_t*)p.out + (size_t)row * 1024 + e) = o;
      }
    }
    if (l == 0) {
      ssn = wave_sum(ssn);
      const float rsn = rsqrtf(ssn * (1.0f / 1024.0f) + 1e-6f);
      const float* mdn = mod + (size_t)((l + 1) * 9 + mr) * 6144;
#pragma unroll
      for (int i = 0; i < 2; ++i) {
        const int e = i * 512 + lane * 8;
        float hv[8];
#pragma unroll
        for (int h4 = 0; h4 < 2; ++h4) {
          const f32x4 w = *(const f32x4*)(nwn + e + h4 * 4), sh = *(const f32x4*)(mdn + e + h4 * 4), sc = *(const f32x4*)(mdn + 1024 + e + h4 * 4);
#pragma unroll
          for (int j = 0; j < 4; ++j) hv[h4 * 4 + j] = xn[i * 8 + h4 * 4 + j] * rsn * w[j] * (1.0f + sc[j]) + sh[j];
        }
        u32x4 w;
        w.x = pk_bf16(hv[0], hv[1]); w.y = pk_bf16(hv[2], hv[3]); w.z = pk_bf16(hv[4], hv[5]); w.w = pk_bf16(hv[6], hv[7]);
        *(u32x4*)(H + (size_t)row * 1024 + e) = w;
      }
    }
  }
}

#define PHASE(call) do { Params q = p; asm volatile("" : "+s"(q.ws)); call; } while (0)
#ifndef PROBE_PH
#define PROBE_PH 0
#endif
#ifndef PROBE_N
#define PROBE_N 2
#endif
#define REP(id, call) do { for (int _r = 0; _r < ((PROBE_PH == (id)) ? 1 + PROBE_N : 1); ++_r) PHASE(call); } while (0)
#define SYNC() do { char* _w = p.ws; asm volatile("" : "+s"(_w)); XcdBarrier _b; _b.bar = (unsigned*)(_w + O_BAR); _b.x = xb_xcc_id(); _b.st = st; xcd_barrier(_b); } while (0)
__global__ void __launch_bounds__(NTHREADS, 2) fwd_mega(Params p) {
  extern __shared__ __attribute__((aligned(16))) char lds[];
  cg::grid_group grid = cg::this_grid();
  const int wid0 = __builtin_amdgcn_readfirstlane((int)(threadIdx.x >> 6));
  volatile PG8_LAS unsigned* st = (volatile PG8_LAS unsigned*)((PG8_LAS unsigned char*)lds + LDS_MAIN);
  if (threadIdx.x < 2) st[threadIdx.x] = 0u;
  __syncthreads();
  (void)xcd_barrier_post((unsigned*)(p.ws + O_BAR), st);
  PHASE(phase_setup(q, lds, wid0));
  PHASE(phase_conv(q, 0, lds, wid0));
  SYNC();
  PHASE(phase_rowA(q, 0, wid0));
  SYNC();
#pragma unroll 1
  for (int l = 0; l < 2; ++l) {
    REP(3, phase_gin(q, l, lds, wid0));
    SYNC();
    REP(5, phase_mix2(q, l, lds, wid0));
    SYNC();
    PHASE(phase_oa(q, l, wid0));
    SYNC();
    REP(7, phase_merge(q, l, lds, wid0));
    if (l == 0) grid.sync(); else SYNC();
    REP(8, phase_wout(q, l, lds, wid0));
    SYNC();
    if (l == 0) PHASE(phase_rowB<0>(q, lds, wid0)); else PHASE(phase_rowB<1>(q, lds, wid0));
    SYNC();
    REP(10, phase_topk(q, l, lds, wid0));
    SYNC();
    REP(11, phase_moe1(q, l, lds, wid0));
    SYNC();
    REP(12, phase_moe2(q, l, lds, wid0));
    SYNC();
    PHASE(phase_rowC(q, l, wid0));
    if (l == 0) PHASE(conv_fill(q, lds, wid0, 4, (int)blockIdx.x, (int)gridDim.x));
    if (l == 0) SYNC();
    if (PROBE_PH == 20) { for (int _r = 0; _r < 10 * PROBE_N; ++_r) SYNC(); }
  }
}

extern "C" void kernel_launch(void* const* d_in, const int* in_sizes, int n_in, void* d_out, int out_size, void* d_ws, size_t ws_size,
                              hipStream_t stream) {
  if (ws_size < WS_NEED) {
    fprintf(stderr, "kernel_launch: workspace too small: %zu < %zu\n", ws_size, (size_t)WS_NEED);
    return;
  }
  Params p{};
  p.x = (const float*)d_in[0]; p.c = (const float*)d_in[1]; p.ctx = (const float*)d_in[2]; p.c_ctx = (const float*)d_in[3];
  p.ada_w = (const float*)d_in[4]; p.ada_b = (const float*)d_in[5]; p.norm_w = (const float*)d_in[6]; p.w_in = (const float*)d_in[7];
  p.lb_raw = (const float*)d_in[8]; p.gnorm_w = (const float*)d_in[9]; p.sgu_w = (const float*)d_in[10]; p.sgu_b = (const float*)d_in[11];
  p.sgu_norm_w = (const float*)d_in[12]; p.w_branch = (const float*)d_in[13]; p.w_out = (const float*)d_in[14];
  p.router_w = (const float*)d_in[15]; p.w13 = (const float*)d_in[16]; p.w2 = (const float*)d_in[17];
  p.out = (float*)d_out;
  p.ws = (char*)d_ws;
  p.w2sep = ws_size >= WS_NEED_W2B ? 1 : 0;
  static int grid_blocks = 0;
  if (!grid_blocks) {
    int dev = 0, cus = 0, per_cu = 0;
    (void)hipGetDevice(&dev);
    (void)hipDeviceGetAttribute(&cus, hipDeviceAttributeMultiprocessorCount, dev);
    (void)hipFuncSetAttribute((const void*)fwd_mega, hipFuncAttributeMaxDynamicSharedMemorySize, LDS_TOTAL);
    (void)hipOccupancyMaxActiveBlocksPerMultiprocessor(&per_cu, fwd_mega, NTHREADS, LDS_TOTAL);
    if (per_cu > 1) per_cu = 1;
    if (per_cu < 1) fprintf(stderr, "kernel_launch: occupancy query reports %d blocks per CU\n", per_cu);
    grid_blocks = cus * (per_cu < 1 ? 1 : per_cu);
  }
  (void)hipMemsetAsync((char*)d_ws + O_BAR, 0, BAR_BYTES, stream);
  void* args[] = {&p};
  hipError_t e = hipLaunchCooperativeKernel((void*)fwd_mega, dim3(grid_blocks), dim3(NTHREADS), args, LDS_TOTAL, stream);
  if (e != hipSuccess) fprintf(stderr, "cooperative launch failed: %s (grid %d)\n", hipGetErrorString(e), grid_blocks);
}
```

```cpp
#include <hip/hip_runtime.h>
#include <hip/hip_cooperative_groups.h>
#include <cstdio>
#include <cstdint>
namespace cg = cooperative_groups;

typedef unsigned short bf16_t;
typedef short bf16x8 __attribute__((ext_vector_type(8)));
typedef float f32x4 __attribute__((ext_vector_type(4)));
typedef float f32x2 __attribute__((ext_vector_type(2)));
typedef unsigned u32x4 __attribute__((ext_vector_type(4)));
typedef unsigned u32x2 __attribute__((ext_vector_type(2)));

constexpr int D = 1024, NB = 8, TL = 4096, TCX = 256;
constexpr int NL = NB * TL, NC = NB * TCX, NT = NL + NC;
constexpr int INC = 7168;
constexpr int NSLOT_L = 16 * 8 * 512, NSLOT_C = 16 * 8 * 32, NSLOT = NSLOT_L + NSLOT_C;
constexpr int NTHREADS = 512, NWAVE = 8;
constexpr int LDS_MAIN = 147456;
constexpr int LDS_TOTAL = LDS_MAIN + 16;

constexpr size_t al(size_t x) { return (x + 255) & ~(size_t)255; }
constexpr size_t O_WIN = 0;
constexpr size_t O_WBR = O_WIN + al((size_t)INC * D * 2);
constexpr size_t O_WOUT = O_WBR + al((size_t)3 * D * 512 * 2);
constexpr size_t O_W13 = O_WOUT + al((size_t)D * D * 2);
constexpr size_t O_W2 = O_W13 + al((size_t)16 * 2048 * D * 2);
constexpr size_t O_FTL = O_W2 + al((size_t)16 * D * D * 2);
constexpr size_t O_FTC = O_FTL + al((size_t)4096 * 8192 * 2);
constexpr size_t O_CS = O_FTC + al((size_t)256 * 512 * 2);
constexpr size_t O_MOD = O_CS + al((size_t)256 * 128 * 2);
constexpr size_t O_LB = O_MOD + al((size_t)2 * 9 * 6144 * 4);
constexpr size_t O_BAR = O_LB + al((size_t)2 * 2 * 512 * 4);
constexpr size_t BAR_BYTES = 3456 * 4;
constexpr size_t O_H = O_BAR + al(BAR_BYTES);
constexpr size_t O_Y = O_H + al((size_t)NT * D * 2);
constexpr size_t O_CTXB = O_Y + al((size_t)NT * D * 2);
constexpr size_t O_AFF = O_CTXB + al((size_t)NC * D * 4);
constexpr size_t O_SEL = O_AFF + al((size_t)NT * 16 * 4);
constexpr size_t O_GATE = O_SEL + al((size_t)NT * 16 * 4);
constexpr size_t O_TOK = O_GATE + al((size_t)NSLOT * 4);
constexpr size_t O_Z = O_TOK + al((size_t)NSLOT * 4);
constexpr size_t SZ512 = al((size_t)NT * 512 * 2);
constexpr size_t O_Q = O_Z, O_LFF = O_Q + SZ512, O_LFB = O_LFF + SZ512, O_I = O_LFB + SZ512, O_GA = O_I + SZ512,
                 O_U = O_GA + SZ512, O_ZB = O_U + SZ512, O_VT = O_ZB + SZ512, O_OF = O_VT + SZ512, O_OBK = O_OF + SZ512;
constexpr size_t O_G = O_OBK + SZ512;
constexpr size_t O_ZCL = O_G + al((size_t)NT * 3072 * 2);
constexpr size_t O_ZCC = O_ZCL + al((size_t)8 * 512 * 8192 * 2);
constexpr size_t O_ZF = O_ZCC + al((size_t)8 * 512 * 512 * 2);
constexpr int KH = 2176, KF = 2 * KH;
constexpr size_t O_ZEND = O_ZF + al((size_t)8 * 512 * KF * 2);
constexpr size_t SZSLOT = al((size_t)NSLOT * 1024 * 2);
constexpr size_t O_XE = O_Z, O_HID = O_XE + SZSLOT, O_YS = O_HID + SZSLOT;
static_assert(O_YS + SZSLOT <= O_ZEND, "moe arena");
constexpr size_t O_W2B = O_ZEND;
constexpr size_t WS_NEED = O_ZEND, WS_NEED_W2B = O_W2B + al((size_t)16 * D * D * 2);

struct Params {
  const float *x, *c, *ctx, *c_ctx, *ada_w, *ada_b, *norm_w, *w_in, *lb_raw, *gnorm_w, *sgu_w, *sgu_b, *sgu_norm_w, *w_branch, *w_out,
      *router_w, *w13, *w2;
  float* out;
  char* ws;
  int w2sep;
};

typedef __bf16 bf16v2_t __attribute__((ext_vector_type(2)));
__device__ __forceinline__ unsigned pk_bf16(float lo, float hi) {
  const f32x2 v = {lo, hi};
  const bf16v2_t r = __builtin_convertvector(v, bf16v2_t);
  return __builtin_bit_cast(unsigned, r);
}
__device__ __forceinline__ bf16_t f2bf(float x) { return (bf16_t)(pk_bf16(x, 0.f) & 0xffffu); }
__device__ __forceinline__ float bf2f(bf16_t v) { return __uint_as_float(((unsigned)v) << 16); }
__device__ __forceinline__ float bflo(unsigned w) { return __uint_as_float(w << 16); }
__device__ __forceinline__ float bfhi(unsigned w) { return __uint_as_float(w & 0xffff0000u); }
__device__ __forceinline__ void st4bf(bf16_t* p, f32x4 v) {
  u32x2 w;
  w.x = pk_bf16(v[0], v[1]);
  w.y = pk_bf16(v[2], v[3]);
  *(u32x2*)p = w;
}
__device__ __forceinline__ void st8bf(bf16_t* p, f32x4 a, f32x4 b) {
  u32x4 w;
  w.x = pk_bf16(a[0], a[1]); w.y = pk_bf16(a[2], a[3]); w.z = pk_bf16(b[0], b[1]); w.w = pk_bf16(b[2], b[3]);
  *(u32x4*)p = w;
}
__device__ __forceinline__ float sigmoidf_(float x) { return __builtin_amdgcn_rcpf(1.0f + __expf(-x)); }
__device__ __forceinline__ float siluf_(float x) { return x * __builtin_amdgcn_rcpf(1.0f + __expf(-x)); }
__device__ __forceinline__ float geluf_(float v) {
  const float av = fabsf(v), t = __builtin_amdgcn_rcpf(av * 0.2316418882f + 1.0f);
  float q = t * 0.5307027145f + (-0.7265760135f);
  q = q * t + 0.7107068705f; q = q * t + (-0.142248368f); q = q * t + 0.127414796f; q = q * t;
  const float e = __builtin_amdgcn_exp2f((v * v) * (-0.72134752044f));
  const float m = v * (q * e);
  return v < 0.f ? m : v - m;
}
__device__ __forceinline__ int opaque_tid(int wid0) {
  int lane;
  asm volatile("v_mbcnt_lo_u32_b32 %0, -1, 0\n\tv_mbcnt_hi_u32_b32 %0, -1, %0" : "=v"(lane));
  return (wid0 << 6) | lane;
}
__device__ __forceinline__ float wave_sum(float v) {
#pragma unroll
  for (int o = 32; o > 0; o >>= 1) v += __shfl_xor(v, o);
  return v;
}

namespace pg8 {
#define PG8_LAS __attribute__((address_space(3)))
constexpr int BM = 256, BK = 64, HALF = 128, HTB = HALF * BK * 2, STAGE_BYTES = 8 * HTB, NXCD = 8, WGM = 8;
__device__ __forceinline__ int lds_byte(int r, int c) { const int st = (r >> 4) * 2 + (c >> 5), rr = r & 15, cc = c & 31, ob = rr * 64 + cc * 2; return st * 1024 + (ob ^ (((ob >> 9) & 1) << 5)); }
__device__ __forceinline__ void stage_rc(int b, int& R, int& C) { const int st = b / 1024, sb = b % 1024, swz = sb ^ (((sb >> 9) & 1) << 5); R = (st >> 1) * 16 + swz / 64; C = (st & 1) * 32 + (swz % 64) / 2; }
__device__ __forceinline__ int perm32(int rho) { const int n = rho >> 4, i = rho & 15; return 8 * (i >> 2) + 4 * n + (i & 3); }
struct Unit { int pm, pn, z; };
template <class T, class = void> struct gather_of { static constexpr bool v = false; };
template <class T> struct gather_of<T, decltype((void)T::GATHER)> { static constexpr bool v = T::GATHER; };

template <class Epi, class Sched>
__device__ __forceinline__ void gemm_phase(PG8_LAS unsigned char* lds, const int K, const Sched& S, const Epi& E, const int tid_in) {
  int tid = tid_in;
  asm volatile("" : "+v"(tid));
  const int wid = __builtin_amdgcn_readfirstlane(tid >> 6), lane = tid & 63, wr = wid >> 2, wc = wid & 3, fr = lane & 15, fq = lane >> 4;
  const int nt = K / BK;
  constexpr bool GA = gather_of<Sched>::v;
  unsigned voffA[2], voffB[2];
  unsigned cvA[2][2], nvA[2][2];
  int gR = 0; unsigned gC2 = 0;
#pragma unroll
  for (int i = 0; i < 2; ++i) { int R, C; stage_rc(tid * 16 + i * 8192, R, C); const int Rb = (R & ~31) + perm32(R & 31);
    if (i == 0) { gR = R; gC2 = (unsigned)C * 2u; }
    voffA[i] = (unsigned)(R * K + C) * 2u; voffB[i] = (unsigned)(Rb * K + C) * 2u; }
  const size_t kstep = (size_t)(BK * 2);
  const size_t hstep = (size_t)HALF * K * 2;
  const size_t hstepA = GA ? (size_t)0 : hstep;
  const PG8_LAS int* idxl = (const PG8_LAS int*)(lds + STAGE_BYTES);
  const unsigned ldsw = (unsigned)wid * 1024u;
  const int aoff = lds_byte(wr * 64 + fr, fq * 8), boff = lds_byte(wc * 32 + fr, fq * 8);
#define PG8_SA(b, h) (((b) * 2 + (h)) * HTB)
#define PG8_SB(b, h) ((4 + (b) * 2 + (h)) * HTB)
#define PG8_STAGE_(bufoff, gbase, voff) do { _Pragma("unroll") for (int _i = 0; _i < 2; ++_i) \
    __builtin_amdgcn_global_load_lds((const unsigned*)((const char*)(gbase) + voff[_i]), (PG8_LAS unsigned*)(lds + (bufoff) + ldsw + _i * 8192), 16, 0, 0); } while (0)
#define PG8_STAGE(bufoff, gbase) PG8_STAGE_(bufoff, gbase, voffB)
#define PG8_STAGE_A(bufoff, gbase, NX) do { _Pragma("unroll") for (int _i = 0; _i < 2; ++_i) { unsigned _vo; \
    if constexpr (GA) { _vo = (NX) ? nvA[((bufoff) / HTB) & 1][_i] : cvA[((bufoff) / HTB) & 1][_i]; } else _vo = voffA[_i]; \
    __builtin_amdgcn_global_load_lds((const unsigned*)((const char*)(gbase) + _vo), (PG8_LAS unsigned*)(lds + (bufoff) + ldsw + _i * 8192), 16, 0, 0); } } while (0)
#define PG8_LDA(dst, b, h) do { _Pragma("unroll") for (int m = 0; m < 4; ++m) _Pragma("unroll") for (int k = 0; k < 2; ++k) dst[m][k] = *(const PG8_LAS bf16x8*)(lds + PG8_SA(b, h) + aoff + m * 2048 + k * 1024); } while (0)
#define PG8_LDB(dst, b, h) do { _Pragma("unroll") for (int n = 0; n < 2; ++n) _Pragma("unroll") for (int k = 0; k < 2; ++k) dst[n][k] = *(const PG8_LAS bf16x8*)(lds + PG8_SB(b, h) + boff + n * 2048 + k * 1024); } while (0)
#define PG8_MMA(ai, bj, At, Bt) do { __builtin_amdgcn_s_setprio(1); _Pragma("unroll") for (int m = 0; m < 4; ++m) _Pragma("unroll") for (int n = 0; n < 2; ++n) _Pragma("unroll") for (int k = 0; k < 2; ++k) \
    acc[ai][bj][m][n] = __builtin_amdgcn_mfma_f32_16x16x32_bf16(Bt[n][k], At[m][k], acc[ai][bj][m][n], 0, 0, 0); __builtin_amdgcn_s_setprio(0); } while (0)
#define PG8_WAIT_V(n) asm volatile("s_waitcnt vmcnt(" #n ")" ::: "memory")
#define PG8_WAIT_L(n) asm volatile("s_waitcnt lgkmcnt(" #n ")" ::: "memory")
#define PG8_BAR __builtin_amdgcn_s_barrier()
#define PG8_SCHED __builtin_amdgcn_sched_barrier(0)
  Unit cur, nxt; int ui = 0;
  if (!S.next(0, cur)) return;
  f32x4 acc[2][2][4][2];
#pragma unroll
  for (int a = 0; a < 2; ++a)
#pragma unroll
    for (int b = 0; b < 2; ++b)
#pragma unroll
      for (int m = 0; m < 4; ++m)
#pragma unroll
        for (int n = 0; n < 2; ++n) acc[a][b][m][n] = (f32x4){0.f, 0.f, 0.f, 0.f};
  bf16x8 At[4][2], B0[2][2], B1[2][2];
  const char* cA = S.aptr(cur); const char* cB = S.bptr(cur);
  if constexpr (GA) {
    const int* tk = S.tokptr(cur);
#pragma unroll
    for (int h = 0; h < 2; ++h)
#pragma unroll
      for (int i = 0; i < 2; ++i) { cvA[h][i] = (unsigned)tk[h * 128 + i * 64 + gR] * (unsigned)(K * 2) + gC2; nvA[h][i] = cvA[h][i]; }
  }
  PG8_STAGE(PG8_SB(0, 0), cB); PG8_STAGE_A(PG8_SA(0, 0), cA, false); PG8_STAGE(PG8_SB(0, 1), cB + hstep); PG8_STAGE_A(PG8_SA(0, 1), cA + hstepA, false);
  if (wr == 1) PG8_BAR;
  PG8_WAIT_V(4); PG8_BAR;
  PG8_STAGE(PG8_SB(1, 0), cB + kstep); PG8_STAGE_A(PG8_SA(1, 0), cA + kstep, false); PG8_STAGE(PG8_SB(1, 1), cB + hstep + kstep);
  PG8_WAIT_V(6); PG8_BAR;
  for (;;) {
    const bool has_next = S.next(ui + 1, nxt);
    const char* nA = has_next ? S.aptr(nxt) : cA; const char* nB = has_next ? S.bptr(nxt) : cB;
    if constexpr (GA) {
      if (has_next && wid < 4)
        __builtin_amdgcn_global_load_lds((const unsigned*)(S.tokptr(nxt) + wid * 64 + lane), (PG8_LAS unsigned*)(lds + STAGE_BYTES + wid * 256), 4, 0, 0);
    }
    for (int t = 0; t < nt; t += 2) {
      const bool last = (t == nt - 2);
      const bool lastn = last && has_next;
      if constexpr (GA) {
#pragma unroll
        for (int h = 0; h < 2; ++h)
#pragma unroll
          for (int i = 0; i < 2; ++i) nvA[h][i] = (unsigned)idxl[h * 128 + i * 64 + gR] * (unsigned)(K * 2) + gC2;
      }
      const char* a1 = cA + (size_t)(t + 1) * kstep;
      const char* a2 = last ? nA : cA + (size_t)(t + 2) * kstep; const char* b2 = last ? nB : cB + (size_t)(t + 2) * kstep;
      const char* a3 = a2 + kstep; const char* b3 = b2 + kstep;
      PG8_LDB(B0, 0, 0); PG8_SCHED; PG8_LDA(At, 0, 0); PG8_STAGE_A(PG8_SA(1, 1), a1 + hstepA, false);
      PG8_WAIT_L(8); PG8_BAR; PG8_WAIT_L(0); PG8_MMA(0, 0, At, B0); PG8_BAR; PG8_SCHED;
      PG8_LDB(B1, 0, 1); PG8_STAGE(PG8_SB(0, 0), b2);
      PG8_BAR; PG8_WAIT_L(0); PG8_MMA(0, 1, At, B1); PG8_BAR;
      PG8_LDA(At, 0, 1); PG8_STAGE_A(PG8_SA(0, 0), a2, lastn);
      PG8_BAR; PG8_WAIT_L(0); PG8_MMA(1, 0, At, B0); PG8_BAR; PG8_SCHED;
      PG8_STAGE(PG8_SB(0, 1), b2 + hstep);
      PG8_WAIT_V(6); PG8_BAR; PG8_MMA(1, 1, At, B1); PG8_BAR;
      PG8_LDB(B0, 1, 0); PG8_SCHED; PG8_LDA(At, 1, 0); PG8_STAGE_A(PG8_SA(0, 1), a2 + hstepA, lastn);
      PG8_WAIT_L(8); PG8_BAR; PG8_WAIT_L(0); PG8_MMA(0, 0, At, B0); PG8_BAR; PG8_SCHED;
      PG8_LDB(B1, 1, 1); PG8_STAGE(PG8_SB(1, 0), b3);
      PG8_BAR; PG8_WAIT_L(0); PG8_MMA(0, 1, At, B1); PG8_BAR;
      PG8_LDA(At, 1, 1); PG8_STAGE_A(PG8_SA(1, 0), a3, lastn);
      PG8_BAR; PG8_WAIT_L(0); PG8_MMA(1, 0, At, B0); PG8_BAR; PG8_SCHED;
      PG8_STAGE(PG8_SB(1, 1), b3 + hstep);
      PG8_WAIT_V(6); PG8_BAR; PG8_MMA(1, 1, At, B1); PG8_BAR;
    }
    if (wr == 0) PG8_BAR;
    bool keep;
    { int fr2 = fr, fq2 = fq; asm volatile("" : "+v"(fr2), "+v"(fq2));
      keep = E(acc, cur, wr, wc, fr2, fq2); }
    if (!has_next) break;
    if (!keep)
#pragma unroll
    for (int a = 0; a < 2; ++a)
#pragma unroll
      for (int b = 0; b < 2; ++b)
#pragma unroll
        for (int m = 0; m < 4; ++m)
#pragma unroll
          for (int n = 0; n < 2; ++n) acc[a][b][m][n] = (f32x4){0.f, 0.f, 0.f, 0.f};
    cur = nxt; cA = nA; cB = nB; ++ui;
    if constexpr (GA) {
#pragma unroll
      for (int h = 0; h < 2; ++h)
#pragma unroll
        for (int i = 0; i < 2; ++i) cvA[h][i] = nvA[h][i];
    }
    if (wr == 1) PG8_BAR;
  }
  PG8_WAIT_V(0);
  PG8_BAR;
#undef PG8_SA
#undef PG8_SB
#undef PG8_STAGE
#undef PG8_STAGE_
#undef PG8_STAGE_A
#undef PG8_LDA
#undef PG8_LDB
#undef PG8_MMA
#undef PG8_WAIT_V
#undef PG8_WAIT_L
#undef PG8_BAR
#undef PG8_SCHED
}
template <class F>
__device__ __forceinline__ void epi_each(const f32x4 (&acc)[2][2][4][2], int wr, int wc, int fr, int fq, const F& f) {
#pragma unroll
  for (int ai = 0; ai < 2; ++ai)
#pragma unroll
    for (int m = 0; m < 4; ++m)
#pragma unroll
      for (int bj = 0; bj < 2; ++bj) f(ai * HALF + wr * 64 + m * 16 + fr, bj * HALF + wc * 32 + 8 * fq, acc[ai][bj][m][0], acc[ai][bj][m][1]);
}
struct GridSched {
  const char* A; const char* B; size_t tstep; int nM, nN, nwg, G, c, pm0;
  __device__ __forceinline__ void init(const void* A_, const void* B_, int K, int nM_, int nN_, int pm0_, int G_, int c_) {
    A = (const char*)A_; B = (const char*)B_; tstep = (size_t)BM * K * 2; nM = nM_; nN = nN_; nwg = nM * nN; G = G_; c = c_; pm0 = pm0_;
  }
  __device__ __forceinline__ bool next(int i, Unit& u) const {
    const long L = (long)i * G + c; if (L >= nwg) return false;
    int wgid = (int)L; { const int q = nwg / NXCD, r = nwg % NXCD, xcd = wgid % NXCD, off = wgid / NXCD; wgid = (xcd < r ? xcd * (q + 1) : r * (q + 1) + (xcd - r) * q) + off; }
    const int nig = WGM * nN, gid = wgid / nig, fm = gid * WGM, gsz = (nM - fm) < WGM ? (nM - fm) : WGM;
    u.pm = pm0 + fm + ((wgid % nig) % gsz); u.pn = (wgid % nig) / gsz; u.z = 0; return true;
  }
  __device__ __forceinline__ const char* aptr(const Unit& u) const { return A + (size_t)u.pm * tstep; }
  __device__ __forceinline__ const char* bptr(const Unit& u) const { return B + (size_t)u.pn * tstep; }
};
}
using pg8::Unit;


#define XB_TMO      128
#define XB_XCNT(j)  (256  + 64 * (j))
#define XB_XSUB(j)  (1280 + 64 * (j))
#define XB_XGEN(j)  (2304 + 64 * (j))
#define XB_TOP      3328
#define XB_TOPGEN   3392
#define XB_SPIN_CAP (1u << 18)
__device__ __forceinline__ unsigned xb_ld(unsigned* p)              { return __hip_atomic_load(p, __ATOMIC_RELAXED, __HIP_MEMORY_SCOPE_AGENT); }
__device__ __forceinline__ unsigned xb_add(unsigned* p, unsigned v) { return __hip_atomic_fetch_add(p, v, __ATOMIC_RELAXED, __HIP_MEMORY_SCOPE_AGENT); }
__device__ __forceinline__ unsigned xb_xcc_id() { return (unsigned)__builtin_amdgcn_s_getreg((3 << 11) | 20) & 0xFu; }
#define XB_SPIN(cond, bar) do { unsigned _sp = 0; while (cond) { __builtin_amdgcn_s_sleep(1); \
    if ((++_sp & 255u) == 0u) { if (xb_ld(&(bar)[XB_TMO])) break; if (_sp > XB_SPIN_CAP) { atomicAdd(&(bar)[XB_TMO], 1u); break; } } } } while (0)
struct XcdBarrier { unsigned* bar; unsigned x; volatile PG8_LAS unsigned* st; };
__device__ __forceinline__ XcdBarrier xcd_barrier_post(unsigned* bar, volatile PG8_LAS unsigned* st) {
  XcdBarrier b; b.bar = bar; b.x = xb_xcc_id(); b.st = st;
  if (threadIdx.x == 0) (void)xb_add(&bar[XB_XCNT(b.x)], 1u);
  return b;
}
__device__ __forceinline__ void xcd_barrier_complete(unsigned* bar, unsigned x, unsigned& nloc, unsigned& nx) {
  const unsigned G = gridDim.x * gridDim.y * gridDim.z;
  unsigned sum, cnt, mine, sp = 0u;
  for (;;) {
    sum = 0u; cnt = 0u; mine = 0u;
#pragma unroll
    for (unsigned j = 0; j < 16; ++j) { const unsigned c = xb_ld(&bar[XB_XCNT(j)]); sum += c; cnt += (c > 0u) ? 1u : 0u; mine = (j == x) ? c : mine; }
    if (sum == G) break;
    __builtin_amdgcn_s_sleep(1);
    if ((++sp & 255u) == 0u) { if (xb_ld(&bar[XB_TMO])) break; if (sp > XB_SPIN_CAP) { atomicAdd(&bar[XB_TMO], 1u); break; } }
  }
  nloc = mine > 0u ? mine : 1u; nx = cnt > 0u ? cnt : 1u;
}
__device__ __forceinline__ void xcd_barrier(const XcdBarrier& b) {
  asm volatile("s_waitcnt vmcnt(0)" ::: "memory");
  __syncthreads();
  if (threadIdx.x == 0) {
    unsigned* bar = b.bar;
    __builtin_amdgcn_s_waitcnt(0);
    unsigned nloc = b.st[0], nx = b.st[1];
    if (nloc == 0u) { xcd_barrier_complete(bar, b.x, nloc, nx); b.st[0] = nloc; b.st[1] = nx; }
    const unsigned old = xb_add(&bar[XB_XSUB(b.x)], 1u);
    const unsigned gen = old / nloc;
    if (old + 1u == (gen + 1u) * nloc) {
      __builtin_amdgcn_fence(__ATOMIC_RELEASE, "agent");
      asm volatile("s_waitcnt vmcnt(0)" ::: "memory");
      const unsigned og = xb_add(&bar[XB_TOP], 1u);
      const unsigned tg = og / nx;
      if (og + 1u == (tg + 1u) * nx) xb_add(&bar[XB_TOPGEN], 1u);
      else XB_SPIN(xb_ld(&bar[XB_TOPGEN]) == tg, bar);
      __builtin_amdgcn_fence(__ATOMIC_ACQUIRE, "agent");
      xb_add(&bar[XB_XGEN(b.x)], 1u);
      asm volatile("s_waitcnt vmcnt(0)" ::: "memory");
    } else {
      XB_SPIN(xb_ld(&bar[XB_XGEN(b.x)]) == gen, bar);
      __builtin_amdgcn_fence(__ATOMIC_ACQUIRE, "agent");
      asm volatile("s_waitcnt vmcnt(0)" ::: "memory");
    }
  }
  __syncthreads();
}


__device__ __forceinline__ void sub_barrier(unsigned* cnt, int nb) {
  asm volatile("s_waitcnt vmcnt(0)" ::: "memory");
  __syncthreads();
  if (threadIdx.x == 0) {
    __builtin_amdgcn_fence(__ATOMIC_RELEASE, "agent");
    asm volatile("s_waitcnt vmcnt(0)" ::: "memory");
    (void)xb_add(cnt, 1u);
    unsigned sp = 0;
    while (xb_ld(cnt) < (unsigned)nb && ++sp < (1u << 20)) __builtin_amdgcn_s_sleep(1);
    __builtin_amdgcn_fence(__ATOMIC_ACQUIRE, "agent");
    asm volatile("s_waitcnt vmcnt(0)" ::: "memory");
  }
  __syncthreads();
}

template <class LA, class LB>
__device__ __forceinline__ void gemm_main(f32x4 (&acc)[4][4], const int nk, const LA& la, const LB& lb, char* lds, const int t) {
  const int lane = t & 63, wid = t >> 6, fr = lane & 15, fq = lane >> 4, wr = wid >> 1, wc = wid & 1;
  const int sr = t >> 3, sc = t & 7;
  const int wofs = sr * 128 + ((sc ^ (sr & 7)) << 4);
  const int aofs = (wr * 64 + fr) * 128, bofs = 16384 + (wc * 64 + fr) * 128;
  const int x0 = ((fq) ^ (fr & 7)) << 4, x1 = ((4 + fq) ^ (fr & 7)) << 4;
  bf16x8 ra[4], rb[4];
#pragma unroll
  for (int i = 0; i < 4; ++i) { ra[i] = la(i, 0); rb[i] = lb(i, 0); }
#pragma unroll
  for (int i = 0; i < 4; ++i) { *(bf16x8*)(lds + wofs + i * 4096) = ra[i]; *(bf16x8*)(lds + 16384 + wofs + i * 4096) = rb[i]; }
  __syncthreads();
  for (int kt = 0; kt < nk; ++kt) {
    const char* cur = lds + (kt & 1) * 32768;
    const bool more = kt + 1 < nk;
    if (more) {
#pragma unroll
      for (int i = 0; i < 4; ++i) { ra[i] = la(i, (kt + 1) * 64); rb[i] = lb(i, (kt + 1) * 64); }
    }
#pragma unroll
    for (int kk = 0; kk < 2; ++kk) {
      const int xo = kk ? x1 : x0;
      bf16x8 af[4], bv[4];
#pragma unroll
      for (int m = 0; m < 4; ++m) af[m] = *(const bf16x8*)(cur + aofs + m * 2048 + xo);
#pragma unroll
      for (int n = 0; n < 4; ++n) bv[n] = *(const bf16x8*)(cur + bofs + n * 2048 + xo);
#pragma unroll
      for (int m = 0; m < 4; ++m)
#pragma unroll
        for (int n = 0; n < 4; ++n) acc[m][n] = __builtin_amdgcn_mfma_f32_16x16x32_bf16(bv[n], af[m], acc[m][n], 0, 0, 0);
    }
    if (more) {
      char* nxt = lds + ((kt + 1) & 1) * 32768;
#pragma unroll
      for (int i = 0; i < 4; ++i) { *(bf16x8*)(nxt + wofs + i * 4096) = ra[i]; *(bf16x8*)(nxt + 16384 + wofs + i * 4096) = rb[i]; }
    }
    __syncthreads();
  }
}
__device__ __forceinline__ void zero_acc(f32x4 (&acc)[4][4]) {
#pragma unroll
  for (int m = 0; m < 4; ++m)
#pragma unroll
    for (int n = 0; n < 4; ++n) acc[m][n] = (f32x4){0.f, 0.f, 0.f, 0.f};
}
template <class EP>
__device__ __forceinline__ void gemm_epi(const f32x4 (&acc)[4][4], const EP& ep, const int t) {
  const int lane = t & 63, wid = t >> 6, fr = lane & 15, fq = lane >> 4, wr = wid >> 1, wc = wid & 1;
#pragma unroll
  for (int m = 0; m < 4; ++m)
#pragma unroll
    for (int n = 0; n < 4; ++n) ep(wr * 64 + m * 16 + fr, wc * 64 + n * 16 + fq * 4, acc[m][n]);
}
struct RowLd {
  const bf16_t* p[4];
  __device__ __forceinline__ RowLd(const bf16_t* base, size_t r0, size_t ld, const int t) {
#pragma unroll
    for (int i = 0; i < 4; ++i) p[i] = base + (r0 + (t >> 3) + 32 * i) * ld + (t & 7) * 8;
  }
  __device__ __forceinline__ bf16x8 operator()(int i, int k0) const { return *(const bf16x8*)(p[i] + k0); }
};

__device__ __forceinline__ void phase_setup(const Params& p, char* lds, int wid0) {
  float* tab = (float*)lds;
  float* sv = (float*)(lds + 16384);
  float* red = (float*)(lds + 16384 + 36864);
  const int tid = opaque_tid(wid0);
  float* mod = (float*)(p.ws + O_MOD);
  bf16_t* FTL = (bf16_t*)(p.ws + O_FTL);
  bool have_tab = false;
  const int NMOD = 192, NITEM = NMOD + 4096 + 1;
  for (int item = blockIdx.x; item < NITEM; item += gridDim.x) {
    if (item < NMOD) {
      const int l = item / 96, n = (item % 96) * 64 + (tid & 63), kp = tid >> 6;
      for (int e = tid; e < 9 * 1024; e += NTHREADS) {
        const int r = e >> 10, k = e & 1023;
        const float v = r < 8 ? p.c[r * 1024 + k] : p.c_ctx[k];
        sv[e] = v / (1.0f + __expf(-v));
      }
      __syncthreads();
      float acc[9];
#pragma unroll
      for (int r = 0; r < 9; ++r) acc[r] = 0.f;
      const float* w = p.ada_w + (size_t)l * 1024 * 6144 + n;
#pragma unroll 8
      for (int k = kp * 128; k < kp * 128 + 128; ++k) {
        const float wv = w[(size_t)k * 6144];
#pragma unroll
        for (int r = 0; r < 9; ++r) acc[r] += sv[r * 1024 + k] * wv;
      }
#pragma unroll
      for (int r = 0; r < 9; ++r) red[(kp * 9 + r) * 64 + (tid & 63)] = acc[r];
      __syncthreads();
      for (int e = tid; e < 9 * 64; e += NTHREADS) {
        const int r = e >> 6, c = e & 63;
        float a = 0.f;
#pragma unroll
        for (int q8 = 0; q8 < 8; ++q8) a += red[(q8 * 9 + r) * 64 + c];
        const int nn = (item % 96) * 64 + c;
        mod[(l * 9 + r) * 6144 + nn] = a + p.ada_b[l * 6144 + nn];
      }
      __syncthreads();
    } else {
      if (!have_tab) {
        for (int j = tid; j < 4096; j += NTHREADS) tab[j] = cospif((float)j * (1.0f / 2048.0f));
        __syncthreads();
        have_tab = true;
      }
      if (item < NMOD + 4096) {
        const int k = (item - NMOD) & 2047, part = (item - NMOD) >> 11;
        const float scale = 0.0013810679320049757f;
        for (int e8 = tid; e8 < KH / 8; e8 += NTHREADS) {
          float v[8];
#pragma unroll
          for (int jx = 0; jx < 8; ++jx) {
            const int t = e8 * 8 + jx, jj = (k * t) & 4095;
            if (part == 0) v[jx] = t <= 2048 ? tab[jj] * scale : 0.f;
            else v[jx] = t < 2048 ? -tab[(jj - 1024) & 4095] * scale : 0.f;
          }
          u32x4 w;
          w.x = pk_bf16(v[0], v[1]); w.y = pk_bf16(v[2], v[3]); w.z = pk_bf16(v[4], v[5]); w.w = pk_bf16(v[6], v[7]);
          *(u32x4*)(FTL + ((size_t)part * 2048 + k) * KH + e8 * 8) = w;
        }
      } else {
        bf16_t* FTC = (bf16_t*)(p.ws + O_FTC);
        bf16_t* CS = (bf16_t*)(p.ws + O_CS);
        const float scale_c = 0.005524271728019903f;
        for (int e = tid; e < 256 * 512; e += NTHREADS) {
          const int k = e >> 9, cs = (e >> 8) & 1, t = e & 255;
          const int jj = ((k * t) & 255) * 16;
          FTC[e] = f2bf((cs == 0 ? tab[jj] : -tab[(jj - 1024) & 4095]) * scale_c);
        }
        for (int e = tid; e < 256 * 128; e += NTHREADS) {
          const int row = e >> 7, d = e & 127, cs = row >> 7, m = row & 127;
          const int jj = ((m * d) & 127) * 32;
          CS[e] = f2bf(cs == 0 ? tab[jj] : tab[(jj - 1024) & 4095]);
        }
        float* lb = (float*)(p.ws + O_LB);
        for (int e = tid; e < 2 * 512; e += NTHREADS) {
          const int dir = e >> 9, ch = e & 511;
          const float r0 = p.lb_raw[(dir * 2 + 0) * 512 + ch], r1 = p.lb_raw[(dir * 2 + 1) * 512 + ch];
          const float mx = fmaxf(r0, r1), e0 = expf(r0 - mx), e1 = expf(r1 - mx);
          const float p0 = e0 / (e0 + e1), p1 = e1 / (e0 + e1);
          lb[(dir * 2 + 0) * 512 + ch] = p0 - p0;
          lb[(dir * 2 + 1) * 512 + ch] = (p0 + p1) - p0;
        }
      }
    }
  }
  __syncthreads();
}

constexpr size_t OUT_W13B = (size_t)NL * D * 2;
#define CONV_BAR() do { asm volatile("s_waitcnt lgkmcnt(0)" ::: "memory"); __builtin_amdgcn_s_barrier(); asm volatile("" ::: "memory"); } while (0)
template <bool VMAP>
__device__ __forceinline__ void conv_items(const Params& p, int l, char* lds, int wid0, const int lo, const int hi, const int r, const int n) {
  const int tid = opaque_tid(wid0);
  float* tile = (float*)lds;
  struct Item { const float* src; bf16_t* dst; int K, N, n0, k0, drow0; };
  auto decode = [&](int item) -> Item {
    int i = item;
    if (VMAP) {
      if (p.w2sep) i = i < 2048 ? i + 608 : i < 2496 ? i - 2048 : i < 3520 ? i + 160 : i - 3072;
      else i = i < 2048 ? i + 608 : i < 2656 ? i - 2048 : i;
    }
    Item it;
    bool w13 = false;
    if (i < 448) {
      it.src = p.w_in + (size_t)l * 1024 * INC; it.dst = (bf16_t*)(p.ws + O_WIN); it.K = 1024; it.N = INC;
    } else if ((i -= 448) < 96) {
      const int j = i / 32; i -= j * 32;
      it.src = p.w_branch + ((size_t)l * 3 + j) * 512 * 1024; it.dst = (bf16_t*)(p.ws + O_WBR) + (size_t)j * 1024 * 512; it.K = 512; it.N = 1024;
    } else if ((i -= 96) < 64) {
      it.src = p.w_out + (size_t)l * 1024 * 1024; it.dst = (bf16_t*)(p.ws + O_WOUT); it.K = 1024; it.N = 1024;
    } else if ((i -= 64) < 2048) {
      const int e = i / 128; i -= e * 128;
      it.src = p.w13 + ((size_t)l * 16 + e) * 1024 * 2048;
      it.dst = (l == 1 ? (bf16_t*)((char*)p.out + OUT_W13B) : (bf16_t*)(p.ws + O_W13)) + (size_t)e * 2048 * 1024; it.K = 1024; it.N = 2048; w13 = true;
    } else {
      i -= 2048;
      const int e = i / 64; i -= e * 64;
      it.src = p.w2 + ((size_t)l * 16 + e) * 1024 * 1024; it.dst = (bf16_t*)(p.ws + (l == 1 && p.w2sep ? O_W2B : O_W2)) + (size_t)e * 1024 * 1024; it.K = 1024; it.N = 1024;
    }
    const int nkt = it.K / 128;
    it.n0 = (i / nkt) * 128; it.k0 = (i % nkt) * 128;
    it.drow0 = w13 ? (((it.n0 & 1023) >> 7) * 256 + (it.n0 >> 10) * 128) : it.n0;
    return it;
  };
  f32x4 pf[8];
  auto fetch = [&](const Item& it) {
#pragma unroll
    for (int q = 0; q < 8; ++q) pf[q] = *(const f32x4*)(it.src + (size_t)(it.k0 + q * 16 + (tid >> 5)) * it.N + it.n0 + (tid & 31) * 4);
  };
  int rr = r; asm volatile("" : "+s"(rr));
  const int item0 = lo + rr;
  Item cur = decode(item0 < hi ? item0 : lo);
  if (item0 < hi) fetch(cur);
  for (int item = item0; item < hi; item += n) {
#pragma unroll
    for (int q = 0; q < 8; ++q) {
      const int kk = q * 16 + (tid >> 5), nn = (tid & 31) * 4;
      tile[(nn + 0) * 129 + kk] = pf[q][0]; tile[(nn + 1) * 129 + kk] = pf[q][1]; tile[(nn + 2) * 129 + kk] = pf[q][2]; tile[(nn + 3) * 129 + kk] = pf[q][3];
    }
    const Item me = cur;
    if (item + n < hi) { cur = decode(item + n); fetch(cur); }
    CONV_BAR();
#pragma unroll
    for (int q2 = 0; q2 < 4; ++q2) {
      const int q = tid + q2 * 512, nn = q >> 4, kc = (q & 15) * 8;
      const float* tp = tile + nn * 129 + kc;
      u32x4 w;
      w.x = pk_bf16(tp[0], tp[1]); w.y = pk_bf16(tp[2], tp[3]); w.z = pk_bf16(tp[4], tp[5]); w.w = pk_bf16(tp[6], tp[7]);
      *(u32x4*)(me.dst + (size_t)(me.drow0 + nn) * me.K + me.k0 + kc) = w;
    }
    CONV_BAR();
  }
  __syncthreads();
}
__device__ __forceinline__ void phase_conv(const Params& p, int l, char* lds, int wid0) { conv_items<false>(p, l, lds, wid0, 0, 3680, blockIdx.x, gridDim.x); }
constexpr int CF_S0 = 2304, CF_S2 = 320;
__device__ __forceinline__ void conv_fill(const Params& p, char* lds, int wid0, const int slot, const int r, const int n) {
  const bool tuned = gridDim.x == 256;
  int a, b;
  int c0 = CF_S0, c2 = CF_S0 + CF_S2;
  if (!p.w2sep) { c0 = c0 < 2496 ? c0 : 2496; c2 = c2 < 2656 ? c2 : 2656; }
  if (slot == 0) { a = 0; b = c0; } else if (slot == 2) { a = c0; b = c2; } else { a = c2; b = 3680; }
  if (slot < 4) { if (!tuned) return; }
  else if (!tuned) a = 0;
  conv_items<true>(p, 1, lds, wid0, a, b, r, n);
}
__device__ __forceinline__ void phase_rowA(const Params& p, int l, int wid0) {
  const int tid = opaque_tid(wid0), wid = tid >> 6, lane = tid & 63;
  const float* xlat = l == 0 ? p.x : p.out;
  const float* xctx = l == 0 ? p.ctx : (const float*)(p.ws + O_CTXB);
  const float* mod = (const float*)(p.ws + O_MOD);
  bf16_t* H = (bf16_t*)(p.ws + O_H);
  const float* nw = p.norm_w + (size_t)(l * 4 + 0) * 1024;
  for (int row = blockIdx.x * NWAVE + wid; row < NT; row += gridDim.x * NWAVE) {
    const float* xr = row < NL ? xlat + (size_t)row * 1024 : xctx + (size_t)(row - NL) * 1024;
    const int mr = row < NL ? (row >> 12) : 8;
    const float* md = mod + (size_t)(l * 9 + mr) * 6144;
    f32x4 v[4];
    float ss = 0.f;
#pragma unroll
    for (int i = 0; i < 4; ++i) {
      v[i] = *(const f32x4*)(xr + i * 256 + lane * 4);
      ss += v[i][0] * v[i][0] + v[i][1] * v[i][1] + v[i][2] * v[i][2] + v[i][3] * v[i][3];
    }
    ss = wave_sum(ss);
    const float rs = rsqrtf(ss * (1.0f / 1024.0f) + 1e-6f);
#pragma unroll
    for (int i = 0; i < 4; ++i) {
      const int e = i * 256 + lane * 4;
      const f32x4 w = *(const f32x4*)(nw + e), sh = *(const f32x4*)(md + e), sc = *(const f32x4*)(md + 1024 + e);
      f32x4 o;
#pragma unroll
      for (int j = 0; j < 4; ++j) o[j] = v[i][j] * rs * w[j] * (1.0f + sc[j]) + sh[j];
      st4bf(H + (size_t)row * 1024 + e, o);
    }
  }
}

struct EpiGin {
  char* ws; const float* lbp; int l; int pn0;
  __device__ __forceinline__ bool operator()(f32x4 (&acc)[2][2][4][2], const Unit& u, int wr, int wc, int fr, int fq) const {
    const int pn = u.pn + pn0;
    const int sec = pn >> 1, cin0 = (pn & 1) * 256;
    const size_t row0 = (size_t)u.pm * 256;
    if (sec >= 8) {
      const int tl = (wr * 4 + wc) * 64 + fq * 16 + fr;
      unsigned char* GT = (unsigned char*)(ws + O_G) + ((size_t)u.pm * 12 + (pn - 16)) * 65536 + (size_t)tl * 8;
      auto q8 = [](float z) { return __builtin_amdgcn_rcpf(__builtin_fmaf(__expf(-z), 0.00390625f, 0.00390625f)); };
#pragma unroll
      for (int ai = 0; ai < 2; ++ai)
#pragma unroll
        for (int m = 0; m < 4; ++m)
#pragma unroll
          for (int bj = 0; bj < 2; ++bj) {
            const f32x4 a = acc[ai][bj][m][0], b = acc[ai][bj][m][1];
            u32x2 w; w.x = 0u; w.y = 0u;
#pragma unroll
            for (int j = 0; j < 4; ++j) { w.x = __builtin_amdgcn_cvt_pk_u8_f32(q8(a[j]), j, w.x); w.y = __builtin_amdgcn_cvt_pk_u8_f32(q8(b[j]), j, w.y); }
            *(u32x2*)(GT + (size_t)((ai * 4 + m) * 2 + bj) * 4096) = w;
          }
    } else if (sec == 7) {
      bf16_t* VT = (bf16_t*)(ws + O_VT);
      pg8::epi_each(acc, wr, wc, fr, fq, [&](int r, int c, f32x4 v0, f32x4 v1) {
        const int chunk = u.pm * 2 + (r >> 7), q = r & 127, g = (cin0 + c) >> 7, d = c & 127;
        bf16_t* dst = VT + (((size_t)chunk * 4 + g) * 128 + d) * 128 + q;
#pragma unroll
        for (int j = 0; j < 4; ++j) { dst[j * 128] = f2bf(geluf_(v0[j])); dst[(4 + j) * 128] = f2bf(geluf_(v1[j])); }
      });
    } else if (sec == 1 || sec == 2) {
      bf16_t* LF = (bf16_t*)(ws + (sec == 1 ? O_LFF : O_LFB)) + row0 * 512 + cin0;
      const float* lbv = lbp + ((sec - 1) * 2 + l) * 512 + cin0;
      pg8::epi_each(acc, wr, wc, fr, fq, [&](int r, int c, f32x4 v0, f32x4 v1) {
        const f32x4 b0 = *(const f32x4*)(lbv + c), b1 = *(const f32x4*)(lbv + c + 4);
        f32x4 o0, o1;
#pragma unroll
        for (int j = 0; j < 4; ++j) {
          o0[j] = 1.0f - (fmaxf(b0[j], 1e-20f) + (1.0f - b0[j]) * sigmoidf_(v0[j]));
          o1[j] = 1.0f - (fmaxf(b1[j], 1e-20f) + (1.0f - b1[j]) * sigmoidf_(v1[j]));
        }
        st8bf(LF + (size_t)r * 512 + c, o0, o1);
      });
    } else {
      const size_t off = sec == 0 ? O_Q : sec == 3 ? O_I : sec == 4 ? O_GA : sec == 5 ? O_ZB : O_U;
      bf16_t* dst = (bf16_t*)(ws + off) + row0 * 512 + cin0;
      const int act = (sec == 0 || sec == 4) ? 1 : (sec == 6 ? 2 : 0);
      pg8::epi_each(acc, wr, wc, fr, fq, [&](int r, int c, f32x4 v0, f32x4 v1) {
        f32x4 o0, o1;
#pragma unroll
        for (int j = 0; j < 4; ++j) {
          o0[j] = act == 1 ? siluf_(v0[j]) : act == 2 ? geluf_(v0[j]) : v0[j];
          o1[j] = act == 1 ? siluf_(v1[j]) : act == 2 ? geluf_(v1[j]) : v1[j];
        }
        st8bf(dst + (size_t)r * 512 + c, o0, o1);
      });
    }
    return false;
  }
};
constexpr int GIN_R1 = 32;
__device__ __forceinline__ void phase_gin(const Params& p, int l, char* lds, int wid0) {
  const int tid = opaque_tid(wid0);
  PG8_LAS unsigned char* L = (PG8_LAS unsigned char*)lds;
  EpiGin E{p.ws, (const float*)(p.ws + O_LB), l, 0};
  pg8::GridSched S;
  const int R0 = (gridDim.x == 256 && l == 1) ? GIN_R1 : 0;
  S.init(p.ws + O_H, p.ws + O_WIN, 1024, (l == 0 ? 136 : 128) - R0, 28, R0, gridDim.x, blockIdx.x);
  pg8::gemm_phase(L, 1024, S, E, tid);
  S.init(p.ws + O_H, p.ws + O_WIN, 1024, R0, 16, 0, gridDim.x, blockIdx.x);
  pg8::gemm_phase(L, 1024, S, E, tid);
  {
    EpiGin E2{p.ws, (const float*)(p.ws + O_LB), l, 20};
    S.init(p.ws + O_H, p.ws + O_WIN + (size_t)20 * 256 * 1024 * 2, 1024, R0, 8, 0, gridDim.x, blockIdx.x);
    pg8::gemm_phase(L, 1024, S, E2, tid);
  }
  if (l == 1) {
    S.init(p.ws + O_H, p.ws + O_WIN, 1024, 8, 8, 128, gridDim.x, (blockIdx.x + gridDim.x / 2) % gridDim.x);
    pg8::gemm_phase(L, 1024, S, E, tid);
  }
}

__device__ __forceinline__ void phase_mix1(const Params& p, int l, char* lds0, int wid0, int kind, int bfirst, int bi_o = -1, int nb_o = 0) {
  const bool last = (l == 1);
  const int tid = opaque_tid(wid0), t = tid & 255, half = tid >> 8;
  char* lds = lds0 + half * 65536;
  const bf16_t* CS = (const bf16_t*)(p.ws + O_CS);
  const bf16_t* ZB = (const bf16_t*)(p.ws + O_ZB);
  const int NF1L = 2048, NF1C = last ? 0 : 128, NCH = last ? 256 : 272;
  const int ITEM0 = kind == 0 ? 0 : NF1L + NF1C, NITEM = kind == 0 ? NF1L + NF1C : NF1L + NF1C + NCH * 4;
  const int bi = nb_o > 0 ? bi_o : (int)blockIdx.x - bfirst, nb = nb_o > 0 ? nb_o : (int)gridDim.x - bfirst;
  if (bi < 0) return;
  for (int item = ITEM0 + bi * 2 + half; item < NITEM; item += nb * 2) {
    f32x4 acc[4][4];
    zero_acc(acc);
    if (item < NF1L + NF1C) {
      const bool isl = item < NF1L;
      int i = isl ? item : item - NF1L;
      const int mh = i & 1;
      i >>= 1;
      int tt, g, b;
      if (isl) { tt = i & 31; i >>= 5; } else { tt = i & 1; i >>= 1; }
      g = i & 3; b = i >> 2;
      const size_t rowbase = isl ? (size_t)b * 4096 + tt * 128 : (size_t)NL + b * 256 + tt * 128;
      RowLd la(CS, mh * 128, 128, t), lb(ZB + g * 128, rowbase, 512, t);
      gemm_main(acc, 2, la, lb, lds, t);
      bf16_t* dst = isl ? (bf16_t*)(p.ws + O_ZCL) + ((size_t)b * 512 + g * 128) * 8192 + mh * 4096 + tt * 128
                        : (bf16_t*)(p.ws + O_ZCC) + ((size_t)b * 512 + g * 128) * 512 + mh * 256 + tt * 128;
      const size_t ld = isl ? 8192 : 512;
      gemm_epi(acc, [&](int r, int c, f32x4 v) { st4bf(dst + (size_t)r * ld + c, v); }, t);
    } else {
      const int i = item - (NF1L + NF1C), ch = i >> 2, g = i & 3;
      const bf16_t* VT = (const bf16_t*)(p.ws + O_VT) + ((size_t)ch * 4 + g) * 128 * 128;
      float* rstd = (float*)lds;
      {
        float* part = (float*)(lds + 1024);
        const int dg = t >> 4, q8 = (t & 15) * 8;
        float ps[8];
#pragma unroll
        for (int j = 0; j < 8; ++j) ps[j] = 0.f;
#pragma unroll
        for (int i = 0; i < 8; ++i) {
          const u32x4 w = *(const u32x4*)(VT + (size_t)(i * 16 + dg) * 128 + q8);
          const float v0 = bflo(w.x), v1 = bfhi(w.x), v2 = bflo(w.y), v3 = bfhi(w.y), v4 = bflo(w.z), v5 = bfhi(w.z), v6 = bflo(w.w), v7 = bfhi(w.w);
          ps[0] += v0 * v0; ps[1] += v1 * v1; ps[2] += v2 * v2; ps[3] += v3 * v3; ps[4] += v4 * v4; ps[5] += v5 * v5; ps[6] += v6 * v6; ps[7] += v7 * v7;
        }
        *(f32x4*)(part + dg * 128 + q8) = (f32x4){ps[0], ps[1], ps[2], ps[3]};
        *(f32x4*)(part + dg * 128 + q8 + 4) = (f32x4){ps[4], ps[5], ps[6], ps[7]};
        __syncthreads();
        if (t < 128) {
          float ss = 0.f;
#pragma unroll
          for (int g2 = 0; g2 < 16; ++g2) ss += part[g2 * 128 + t];
          rstd[t] = rsqrtf(ss * (1.0f / 128.0f) + 1e-6f);
        }
      }
      __syncthreads();
      const float* wsg = p.sgu_w + ((size_t)l * 4 + g) * 128 * 128;
      const int kc = (t & 7) * 8;
      float rr[2][8];
#pragma unroll
      for (int h2 = 0; h2 < 2; ++h2)
#pragma unroll
        for (int j = 0; j < 8; ++j) rr[h2][j] = rstd[h2 * 64 + kc + j];
      __syncthreads();
      auto la = [&](int ii, int k0) -> bf16x8 {
        const float* s = wsg + (size_t)((t >> 3) + 32 * ii) * 128 + k0 + kc;
        const f32x4 a = *(const f32x4*)s, b = *(const f32x4*)(s + 4);
        const int h2 = k0 >> 6;
        u32x4 w;
        w.x = pk_bf16(a[0] * (h2 ? rr[1][0] : rr[0][0]), a[1] * (h2 ? rr[1][1] : rr[0][1]));
        w.y = pk_bf16(a[2] * (h2 ? rr[1][2] : rr[0][2]), a[3] * (h2 ? rr[1][3] : rr[0][3]));
        w.z = pk_bf16(b[0] * (h2 ? rr[1][4] : rr[0][4]), b[1] * (h2 ? rr[1][5] : rr[0][5]));
        w.w = pk_bf16(b[2] * (h2 ? rr[1][6] : rr[0][6]), b[3] * (h2 ? rr[1][7] : rr[0][7]));
        return __builtin_bit_cast(bf16x8, w);
      };
      RowLd lb(VT, 0, 128, t);
      gemm_main(acc, 2, la, lb, lds, t);
      bf16_t* U = (bf16_t*)(p.ws + O_U) + (size_t)ch * 128 * 512 + g * 128;
      const float* nwv = p.sgu_norm_w + ((size_t)l * 4 + g) * 128;
      const float* sb = p.sgu_b + ((size_t)l * 4 + g) * 128;
      {
        const int lane = t & 63, wid = t >> 6, fr = lane & 15, fq = lane >> 4, wr = wid >> 1, wc = wid & 1;
        bf16_t* ub = U + (size_t)(wr * 64 + fr) * 512 + wc * 64 + fq * 4;
        u32x2 uw[4][4];
#pragma unroll
        for (int m = 0; m < 4; ++m)
#pragma unroll
          for (int n = 0; n < 4; ++n) uw[m][n] = *(const u32x2*)(ub + (size_t)m * 16 * 512 + n * 16);
#pragma unroll
        for (int m = 0; m < 4; ++m) {
          const float bb = sb[wr * 64 + m * 16 + fr];
#pragma unroll
          for (int n = 0; n < 4; ++n) {
            const f32x4 nw4 = *(const f32x4*)(nwv + wc * 64 + n * 16 + fq * 4);
            const f32x4 v = acc[m][n];
            f32x4 o;
            o[0] = bflo(uw[m][n].x) * (v[0] * nw4[0] + bb);
            o[1] = bfhi(uw[m][n].x) * (v[1] * nw4[1] + bb);
            o[2] = bflo(uw[m][n].y) * (v[2] * nw4[2] + bb);
            o[3] = bfhi(uw[m][n].y) * (v[3] * nw4[3] + bb);
            st4bf(ub + (size_t)m * 16 * 512 + n * 16, o);
          }
        }
      }
    }
  }
  __syncthreads();
}

#define SCAN_BAR() do { asm volatile("s_waitcnt lgkmcnt(0)" ::: "memory"); __builtin_amdgcn_s_barrier(); asm volatile("" ::: "memory"); } while (0)
__device__ __forceinline__ void scan_item(const Params& p, int item, char* lds, const int tid) {
  const int dir = item & 1, h = (item >> 1) & 3, b = item >> 3;
  const int wv = tid >> 6, lane = tid & 63, fr = lane & 15, fq = lane >> 4;
  const bool isP = wv < 4;
  char* RAWB = lds + 69632;
  float* qsum = (float*)(lds + 143360);
  const bf16_t* Q = (const bf16_t*)(p.ws + O_Q);
  const bf16_t* LF = (const bf16_t*)(p.ws + (dir ? O_LFB : O_LFF));
  const bf16_t* I = (const bf16_t*)(p.ws + O_I);
  bf16_t* O = (bf16_t*)(p.ws + (dir ? O_OBK : O_OF));
  auto rowOf = [&](int u) -> size_t {
    if (u < 256) return (size_t)NL + b * 256 + (dir ? 255 - u : u);
    const int v = u - 256;
    return (size_t)b * 4096 + (dir ? 4095 - v : v);
  };
  const int cp = tid & 63, tq = (tid >> 6) & 3;
  const bf16_t* srcs[3] = {LF, Q, I};
  auto dma = [&](int cc) {
    PG8_LAS unsigned char* dstb = (PG8_LAS unsigned char*)RAWB + (cc % 3) * 24576;
#pragma unroll
    for (int j = 0; j < 6; ++j) {
      const int g = j * 4 + wv, arr = g >> 3, rg = g & 7;
      const size_t o = rowOf(cc * 32 + rg * 4 + (lane >> 4)) * 512 + h * 128 + (lane & 15) * 8;
      __builtin_amdgcn_global_load_lds((const unsigned*)(srcs[arr] + o), (PG8_LAS unsigned*)(dstb + arr * 8192 + rg * 1024), 16, 0, 0);
    }
  };
  unsigned wkk[8];
  auto prepA = [&](int cc) {
    const char* raw = RAWB + (cc % 3) * 24576;
#pragma unroll
    for (int i = 0; i < 8; ++i) wkk[i] = *(const unsigned*)(raw + (tq * 8 + i) * 256 + cp * 4);
    f32x2 run = {1.f, 1.f};
#pragma unroll
    for (int i = 0; i < 8; ++i) { const f32x2 kk = {bflo(wkk[i]), bfhi(wkk[i])}; run = run * (1.0f - kk); }
    *(f32x2*)(qsum + tq * 128 + cp * 2) = run;
  };
  auto prepB = [&](int cc) {
    const char* raw = RAWB + (cc % 3) * 24576;
    char* OPB = lds + (cc & 1) * 34816;
    char* QP = OPB; char* KM = OPB + 8704; char* KT = OPB + 17408; char* VT = OPB + 25600;
    float* emid = (float*)(OPB + 33792); float* eend = emid + 128;
    unsigned wq[8], wi[8];
#pragma unroll
    for (int i = 0; i < 8; ++i) { wq[i] = *(const unsigned*)(raw + 8192 + (tq * 8 + i) * 256 + cp * 4); wi[i] = *(const unsigned*)(raw + 16384 + (tq * 8 + i) * 256 + cp * 4); }
    const f32x2 q0 = *(const f32x2*)(qsum + cp * 2), q1 = *(const f32x2*)(qsum + 128 + cp * 2), q2 = *(const f32x2*)(qsum + 256 + cp * 2), q3 = *(const f32x2*)(qsum + 384 + cp * 2);
    const f32x2 one = {1.f, 1.f};
    const f32x2 pmid = q0 * q1, pend = pmid * q2 * q3;
    const f32x2 base = tq == 0 ? one : tq == 1 ? q0 : tq == 2 ? pmid : pmid * q2;
    f32x2 rmid; rmid.x = __builtin_amdgcn_rcpf(fmaxf(pmid.x, 1e-30f)); rmid.y = __builtin_amdgcn_rcpf(fmaxf(pmid.y, 1e-30f));
    f32x2 ebm = pend * rmid; ebm.x = fminf(ebm.x, 1.0f); ebm.y = fminf(ebm.y, 1.0f);
    f32x2 run = base * rmid;
    unsigned oq[8], ok[8], kt0[4], kt1[4], vt0[4], vt1[4];
    float pk0 = 0.f, pk1 = 0.f;
#pragma unroll
    for (int i = 0; i < 8; ++i) {
      const f32x2 kk = {bflo(wkk[i]), bfhi(wkk[i])}, qv = {bflo(wq[i]), bfhi(wq[i])};
      run = run * (one - kk);
      f32x2 ea; ea.x = fminf(fmaxf(run.x, 1e-26f), 1e26f); ea.y = fminf(fmaxf(run.y, 1e-26f), 1e26f);
      f32x2 er; er.x = __builtin_amdgcn_rcpf(ea.x); er.y = __builtin_amdgcn_rcpf(ea.y);
      const f32x2 km = kk * er, qp = qv * ea, kpp = km * ebm;
      oq[i] = pk_bf16(qp.x, qp.y);
      ok[i] = pk_bf16(km.x, km.y);
      if (i & 1) {
        kt0[i >> 1] = pk_bf16(pk0, kpp.x); kt1[i >> 1] = pk_bf16(pk1, kpp.y);
        vt0[i >> 1] = (wi[i - 1] & 0xffffu) | (wi[i] << 16); vt1[i >> 1] = (wi[i - 1] >> 16) | (wi[i] & 0xffff0000u);
      } else { pk0 = kpp.x; pk1 = kpp.y; }
    }
#pragma unroll
    for (int i = 0; i < 8; ++i) { *(unsigned*)(QP + (tq * 8 + i) * 272 + cp * 4) = oq[i]; *(unsigned*)(KM + (tq * 8 + i) * 272 + cp * 4) = ok[i]; }
    u32x4 w;
    w.x = kt0[0]; w.y = kt0[1]; w.z = kt0[2]; w.w = kt0[3]; *(u32x4*)(KT + (cp * 2) * 64 + tq * 16) = w;
    w.x = kt1[0]; w.y = kt1[1]; w.z = kt1[2]; w.w = kt1[3]; *(u32x4*)(KT + (cp * 2 + 1) * 64 + tq * 16) = w;
    w.x = vt0[0]; w.y = vt0[1]; w.z = vt0[2]; w.w = vt0[3]; *(u32x4*)(VT + (cp * 2) * 64 + tq * 16) = w;
    w.x = vt1[0]; w.y = vt1[1]; w.z = vt1[2]; w.w = vt1[3]; *(u32x4*)(VT + (cp * 2 + 1) * 64 + tq * 16) = w;
    if (tq == 0) { *(f32x2*)(emid + cp * 2) = pmid; *(f32x2*)(eend + cp * 2) = pend; }
  };
  const int mw = wv - 4;
  f32x4 S[2][8];
#pragma unroll
  for (int a = 0; a < 2; ++a)
#pragma unroll
    for (int m = 0; m < 8; ++m) S[a][m] = (f32x4){0.f, 0.f, 0.f, 0.f};

  if (isP) { dma(0); dma(1); dma(2); asm volatile("s_waitcnt vmcnt(12)" ::: "memory"); }
  SCAN_BAR();
  if (isP) prepA(0);
  SCAN_BAR();
  if (isP) { prepB(0); asm volatile("s_waitcnt vmcnt(6)" ::: "memory"); }
  SCAN_BAR();
  for (int c = 0; c < 136; ++c) {
    if (isP) {
      if (c + 3 < 136) dma(c + 3);
      if (c + 1 < 136) prepA(c + 1);
      SCAN_BAR();
      if (c + 1 < 136) prepB(c + 1);
      if (c + 3 < 136) asm volatile("s_waitcnt vmcnt(6)" ::: "memory");
      else asm volatile("s_waitcnt vmcnt(0)" ::: "memory");
      SCAN_BAR();
    } else {
      const char* OPB = lds + (c & 1) * 34816;
      const char* QP = OPB; const char* KM = OPB + 8704; const char* KT = OPB + 17408; const char* VT = OPB + 25600;
      const float* emid = (const float*)(OPB + 33792); const float* eend = emid + 128;
      f32x4 PT00 = (f32x4){0.f, 0.f, 0.f, 0.f}, PT01 = PT00, PT11 = PT00;
#pragma unroll
      for (int ks = 0; ks < 4; ++ks) {
        const bf16x8 X0 = *(const bf16x8*)(KM + fr * 272 + ks * 64 + fq * 16), X1 = *(const bf16x8*)(KM + (16 + fr) * 272 + ks * 64 + fq * 16);
        const bf16x8 Y0 = *(const bf16x8*)(QP + fr * 272 + ks * 64 + fq * 16), Y1 = *(const bf16x8*)(QP + (16 + fr) * 272 + ks * 64 + fq * 16);
        PT00 = __builtin_amdgcn_mfma_f32_16x16x32_bf16(X0, Y0, PT00, 0, 0, 0);
        PT01 = __builtin_amdgcn_mfma_f32_16x16x32_bf16(X0, Y1, PT01, 0, 0, 0);
        PT11 = __builtin_amdgcn_mfma_f32_16x16x32_bf16(X1, Y1, PT11, 0, 0, 0);
      }
      SCAN_BAR();
#pragma unroll
      for (int jj = 0; jj < 4; ++jj) if (fq * 4 + jj > fr) { PT00[jj] = 0.f; PT11[jj] = 0.f; }
      u32x4 x0, x1;
      x0.x = pk_bf16(PT00[0], PT00[1]); x0.y = pk_bf16(PT00[2], PT00[3]); x0.z = 0u; x0.w = 0u;
      x1.x = pk_bf16(PT01[0], PT01[1]); x1.y = pk_bf16(PT01[2], PT01[3]); x1.z = pk_bf16(PT11[0], PT11[1]); x1.w = pk_bf16(PT11[2], PT11[3]);
      const size_t orow0 = rowOf(c * 32);
      const long ostep = dir ? -512 : 512;
#pragma unroll
      for (int a = 0; a < 2; ++a) {
        const int vcol = (mw * 2 + a) * 16 + fr;
        f32x4 o0 = (f32x4){0.f, 0.f, 0.f, 0.f}, o1 = o0;
        {
          const u32x2 vlo = *(const u32x2*)(VT + vcol * 64 + fq * 8), vhi = *(const u32x2*)(VT + vcol * 64 + 32 + fq * 8);
          u32x4 yv; yv.x = vlo.x; yv.y = vlo.y; yv.z = vhi.x; yv.w = vhi.y;
          o0 = __builtin_amdgcn_mfma_f32_16x16x32_bf16(__builtin_bit_cast(bf16x8, x0), __builtin_bit_cast(bf16x8, yv), o0, 0, 0, 0);
          o1 = __builtin_amdgcn_mfma_f32_16x16x32_bf16(__builtin_bit_cast(bf16x8, x1), __builtin_bit_cast(bf16x8, yv), o1, 0, 0, 0);
        }
#pragma unroll
        for (int ks = 0; ks < 4; ++ks) {
          const f32x4 em0 = *(const f32x4*)(emid + (2 * ks) * 16 + fq * 4), em1 = *(const f32x4*)(emid + (2 * ks + 1) * 16 + fq * 4);
          u32x4 ys;
          ys.x = pk_bf16(S[a][2 * ks][0] * em0[0], S[a][2 * ks][1] * em0[1]); ys.y = pk_bf16(S[a][2 * ks][2] * em0[2], S[a][2 * ks][3] * em0[3]);
          ys.z = pk_bf16(S[a][2 * ks + 1][0] * em1[0], S[a][2 * ks + 1][1] * em1[1]); ys.w = pk_bf16(S[a][2 * ks + 1][2] * em1[2], S[a][2 * ks + 1][3] * em1[3]);
          const u32x2 a0 = *(const u32x2*)(QP + fr * 272 + ks * 64 + fq * 8), a1 = *(const u32x2*)(QP + fr * 272 + ks * 64 + 32 + fq * 8);
          const u32x2 c0 = *(const u32x2*)(QP + (16 + fr) * 272 + ks * 64 + fq * 8), c1 = *(const u32x2*)(QP + (16 + fr) * 272 + ks * 64 + 32 + fq * 8);
          u32x4 xa, xc; xa.x = a0.x; xa.y = a0.y; xa.z = a1.x; xa.w = a1.y; xc.x = c0.x; xc.y = c0.y; xc.z = c1.x; xc.w = c1.y;
          o0 = __builtin_amdgcn_mfma_f32_16x16x32_bf16(__builtin_bit_cast(bf16x8, xa), __builtin_bit_cast(bf16x8, ys), o0, 0, 0, 0);
          o1 = __builtin_amdgcn_mfma_f32_16x16x32_bf16(__builtin_bit_cast(bf16x8, xc), __builtin_bit_cast(bf16x8, ys), o1, 0, 0, 0);
        }
        bf16_t* op = O + orow0 * 512 + h * 128 + vcol;
#pragma unroll
        for (int jj = 0; jj < 4; ++jj) {
          op[(long)(fq * 4 + jj) * ostep] = f2bf(o0[jj]);
          op[(long)(16 + fq * 4 + jj) * ostep] = f2bf(o1[jj]);
        }
        {
          const bf16x8 yv2 = *(const bf16x8*)(VT + vcol * 64 + fq * 16);
#pragma unroll
          for (int m = 0; m < 8; ++m) {
            const f32x4 ee = *(const f32x4*)(eend + m * 16 + fq * 4);
            const bf16x8 xk = *(const bf16x8*)(KT + (m * 16 + fr) * 64 + fq * 16);
            S[a][m] = __builtin_amdgcn_mfma_f32_16x16x32_bf16(xk, yv2, S[a][m] * ee, 0, 0, 0);
          }
        }
      }
      SCAN_BAR();
    }
  }
  __syncthreads();
}

struct F2Sched {
  const char* FT; const char* ZF; int G, c;
  __device__ __forceinline__ bool next(int i, Unit& u) const {
    const int P = c - 64;
    if (i > 1 || P < 0 || P >= 128) return false;
    const int loc = P >> 3; u.z = (P & 7) | (i << 3); u.pm = loc >> 1; u.pn = loc & 1; return true;
  }
  __device__ __forceinline__ const char* aptr(const Unit& u) const { return FT + (size_t)((u.z >> 3) ^ 1) * ((size_t)2048 * KH * 2) + (size_t)u.pm * ((size_t)256 * KH * 2); }
  __device__ __forceinline__ const char* bptr(const Unit& u) const { return ZF + (size_t)((u.z >> 3) ^ 1) * ((size_t)4096 * KH * 2) + ((size_t)(u.z & 7) * 512 + (size_t)u.pn * 256) * ((size_t)KH * 2); }
};
struct F2CSched {
  const char* FT; const char* ZC; int c;
  __device__ __forceinline__ bool next(int i, Unit& u) const {
    const int L = c - 192; if (i != 0 || L < 0 || L >= 16) return false;
    u.z = L >> 1; u.pm = 0; u.pn = L & 1; return true;
  }
  __device__ __forceinline__ const char* aptr(const Unit&) const { return FT; }
  __device__ __forceinline__ const char* bptr(const Unit& u) const { return ZC + (size_t)u.z * (512u * 512u * 2u) + (size_t)u.pn * (256u * 512u * 2u); }
};
struct EpiF2 {
  bf16_t* OB; int ctx; float* SX;
  __device__ __forceinline__ bool operator()(f32x4 (&acc)[2][2][4][2], const Unit& u, int wr, int wc, int fr, int fq) const {
    if (ctx) {
      bf16_t* dst = OB + ((size_t)NL + (size_t)u.z * 256) * 512 + u.pn * 256;
      pg8::epi_each(acc, wr, wc, fr, fq, [&](int r, int c, f32x4 v0, f32x4 v1) { st8bf(dst + (size_t)r * 512 + c, v0, v1); });
      return false;
    }
    const int b = u.z & 7, part = u.z >> 3;
    const int tl = (wr * 4 + wc) * 64 + fq * 16 + fr;
    float* sx = SX + ((size_t)(b + 8 * (u.pm * 2 + u.pn)) * 16) * 4096 + (size_t)tl * 8;
    bf16_t* dst = OB + (size_t)b * 4096 * 512 + u.pn * 256;
#pragma unroll
    for (int ai = 0; ai < 2; ++ai)
#pragma unroll
      for (int m = 0; m < 4; ++m)
#pragma unroll
        for (int bj = 0; bj < 2; ++bj) {
          float* q = sx + (size_t)((ai * 4 + m) * 2 + bj) * 4096;
          if (part == 0) { *(f32x4*)q = acc[ai][bj][m][0]; *(f32x4*)(q + 4) = acc[ai][bj][m][1]; }
          else {
            const f32x4 s0 = *(const f32x4*)q, s1 = *(const f32x4*)(q + 4);
            const int k = u.pm * 256 + ai * 128 + wr * 64 + m * 16 + fr, c = bj * 128 + wc * 32 + 8 * fq;
            st8bf(dst + (size_t)k * 512 + c, acc[ai][bj][m][0], acc[ai][bj][m][1]);
            if (k >= 1) st8bf(dst + (size_t)(4096 - k) * 512 + c, acc[ai][bj][m][0] - 2.0f * s0, acc[ai][bj][m][1] - 2.0f * s1);
          }
        }
    return part == 0;
  }
};
__device__ __forceinline__ void phase_fold(const Params& p, char* lds, int wid0, int bfirst) {
  const int tid = opaque_tid(wid0);
  bf16_t* zrow = (bf16_t*)lds;
  const bf16_t* ZCL = (const bf16_t*)(p.ws + O_ZCL);
  bf16_t* ZF = (bf16_t*)(p.ws + O_ZF);
  bf16_t* OB = (bf16_t*)(p.ws + O_ZB);
  float* red = (float*)(lds + 16384);
  if ((int)blockIdx.x < bfirst) return;
  for (int row = (int)blockIdx.x - bfirst; row < 8 * 512; row += (int)gridDim.x - bfirst) {
    const bf16_t* src = ZCL + (size_t)row * 8192;
#pragma unroll
    for (int i = 0; i < 2; ++i) *(u32x4*)(zrow + (tid + i * 512) * 8) = *(const u32x4*)(src + (tid + i * 512) * 8);
    __syncthreads();
    float alt = 0.f;
    for (int e8 = tid; e8 < 2 * (KH / 8); e8 += NTHREADS) {
      const int part = e8 >= KH / 8 ? 1 : 0, e = part ? e8 - KH / 8 : e8;
      float v[8];
#pragma unroll
      for (int jx = 0; jx < 8; ++jx) {
        const int t = e * 8 + jx;
        if (!part) v[jx] = t > 2048 ? 0.f : (t == 0 || t == 2048) ? bf2f(zrow[t]) : bf2f(zrow[t]) + bf2f(zrow[4096 - t]);
        else v[jx] = (t == 0 || t >= 2048) ? 0.f : bf2f(zrow[4096 + t]) - bf2f(zrow[4096 + 4096 - t]);
      }
      u32x4 w;
      w.x = pk_bf16(v[0], v[1]); w.y = pk_bf16(v[2], v[3]); w.z = pk_bf16(v[4], v[5]); w.w = pk_bf16(v[6], v[7]);
      *(u32x4*)(ZF + ((size_t)part * 4096 + row) * KH + e * 8) = w;
      if (!part) alt += (bflo(w.x) - bfhi(w.x)) + (bflo(w.y) - bfhi(w.y)) + (bflo(w.z) - bfhi(w.z)) + (bflo(w.w) - bfhi(w.w));
    }
    alt = wave_sum(alt);
    if ((tid & 63) == 0) red[tid >> 6] = alt;
    __syncthreads();
    if (tid == 0) {
      float a = 0.f;
#pragma unroll
      for (int w8 = 0; w8 < 8; ++w8) a += red[w8];
      OB[((size_t)(row >> 9) * 4096 + 2048) * 512 + (row & 511)] = f2bf(a * bf2f(f2bf(0.0013810679320049757f)));
    }
  }
}
__device__ __forceinline__ void phase_mix2(const Params& p, int l, char* lds, int wid0) {
  const int tid = opaque_tid(wid0);
  if (blockIdx.x < 64) { scan_item(p, blockIdx.x, lds, tid); return; }
  unsigned* bar = (unsigned*)(p.ws + O_BAR);
  const int nb = (int)gridDim.x - 64;
  phase_mix1(p, l, lds, wid0, 0, 64);
  sub_barrier(bar + (l * 2 + 0) * 16, nb);
  phase_fold(p, lds, wid0, 64);
  sub_barrier(bar + (l * 2 + 1) * 16, nb);
  PG8_LAS unsigned char* L = (PG8_LAS unsigned char*)lds;
  {
    F2Sched S{p.ws + O_FTL, p.ws + O_ZF, (int)gridDim.x, (int)blockIdx.x};
    EpiF2 E{(bf16_t*)(p.ws + O_ZB), 0, (float*)(p.ws + O_ZCL)};
    pg8::gemm_phase(L, KH, S, E, tid);
  }
  if (l == 0) {
    F2CSched S{p.ws + O_FTC, p.ws + O_ZCC, (int)blockIdx.x};
    EpiF2 E{(bf16_t*)(p.ws + O_ZB), 1, nullptr};
    pg8::gemm_phase(L, 512, S, E, tid);
  }
  if (blockIdx.x >= 192) { for (int sh = 0; sh < 2; ++sh) phase_mix1(p, l, lds, wid0, 1, 64, ((int)blockIdx.x - 192) * 2 + sh, 512); }
  else { for (int sh = 0; sh < 3; ++sh) phase_mix1(p, l, lds, wid0, 1, 64, 128 + ((int)blockIdx.x - 64) * 3 + sh, 512); }
  if (gridDim.x == 256 && l == 1 && blockIdx.x >= 192) {
    pg8::GridSched S;
    S.init(p.ws + O_H, p.ws + O_WIN + (size_t)16 * 256 * 1024 * 2, 1024, GIN_R1, 4, 0, 64, (int)blockIdx.x - 192);
    EpiGin E{p.ws, (const float*)(p.ws + O_LB), l, 16};
    pg8::gemm_phase(L, 1024, S, E, tid);
  }
}

__device__ __forceinline__ void phase_oa(const Params& p, int l, int wid0) {
  const int tid = opaque_tid(wid0), wid = tid >> 6, lane = tid & 63;
  const int nrow = (l == 1) ? NL : NT;
  const bf16_t* OF = (const bf16_t*)(p.ws + O_OF);
  const bf16_t* OK = (const bf16_t*)(p.ws + O_OBK);
  bf16_t* GA = (bf16_t*)(p.ws + O_GA);
  const float* gw = p.gnorm_w + (size_t)l * 128;
  for (int row = blockIdx.x * NWAVE + wid; row < nrow; row += gridDim.x * NWAVE) {
    const size_t o = (size_t)row * 512 + lane * 8;
    const u32x4 a = *(const u32x4*)(OF + o), b = *(const u32x4*)(OK + o), g = *(const u32x4*)(GA + o);
    float v[8];
    v[0] = bflo(a.x) + bflo(b.x); v[1] = bfhi(a.x) + bfhi(b.x);
    v[2] = bflo(a.y) + bflo(b.y); v[3] = bfhi(a.y) + bfhi(b.y);
    v[4] = bflo(a.z) + bflo(b.z); v[5] = bfhi(a.z) + bfhi(b.z);
    v[6] = bflo(a.w) + bflo(b.w); v[7] = bfhi(a.w) + bfhi(b.w);
    float ss = 0.f;
#pragma unroll
    for (int j = 0; j < 8; ++j) ss += v[j] * v[j];
    ss += __shfl_xor(ss, 1); ss += __shfl_xor(ss, 2); ss += __shfl_xor(ss, 4); ss += __shfl_xor(ss, 8);
    const float rs = rsqrtf(ss * (1.0f / 128.0f) + 1e-6f);
    const float* gwp = gw + (lane & 15) * 8;
    const f32x4 w0 = *(const f32x4*)gwp, w1 = *(const f32x4*)(gwp + 4);
    float gg[8] = {bflo(g.x), bfhi(g.x), bflo(g.y), bfhi(g.y), bflo(g.z), bfhi(g.z), bflo(g.w), bfhi(g.w)};
    u32x4 w;
    w.x = pk_bf16(v[0] * rs * w0[0] * gg[0], v[1] * rs * w0[1] * gg[1]);
    w.y = pk_bf16(v[2] * rs * w0[2] * gg[2], v[3] * rs * w0[3] * gg[3]);
    w.z = pk_bf16(v[4] * rs * w1[0] * gg[4], v[5] * rs * w1[1] * gg[5]);
    w.w = pk_bf16(v[6] * rs * w1[2] * gg[6], v[7] * rs * w1[3] * gg[7]);
    *(u32x4*)(GA + o) = w;
  }
}

#define HC_MERGE 136
#define HC_MOE1  152
__device__ __forceinline__ void hc_publish(unsigned* cnt) {
  asm volatile("s_waitcnt vmcnt(0)" ::: "memory");
  __syncthreads();
  if (threadIdx.x == 0) { __threadfence(); (void)xb_add(cnt, 1u); }
}
__device__ __forceinline__ void hc_wait(unsigned* bar, unsigned* cnt, unsigned target) {
  if (threadIdx.x == 0) { XB_SPIN(xb_ld(cnt) < target, bar); __threadfence(); }
  __syncthreads();
}
struct OneSched {
  const char* A; const char* B; int pm, pn, z;
  __device__ __forceinline__ bool next(int i, Unit& u) const { if (i) return false; u.pm = pm; u.pn = pn; u.z = z; return true; }
  __device__ __forceinline__ const char* aptr(const Unit&) const { return A; }
  __device__ __forceinline__ const char* bptr(const Unit&) const { return B; }
};
struct EpiStoreBf16 {
  bf16_t* dst; int ld;
  __device__ __forceinline__ bool operator()(f32x4 (&acc)[2][2][4][2], const Unit& u, int wr, int wc, int fr, int fq) const {
    bf16_t* d = dst + (size_t)u.pm * 256 * ld + u.pn * 256;
    pg8::epi_each(acc, wr, wc, fr, fq, [&](int r, int c, f32x4 v0, f32x4 v1) { st8bf(d + (size_t)r * ld + c, v0, v1); });
    return false;
  }
};
struct MergeSched {
  const char* ws; int ntile, G, c, fuse;
  __device__ __forceinline__ bool next(int i, Unit& u) const {
    const int xcd = c & 7, q = c >> 3;
    int rnd = i / 3;
    if (fuse && c < 32) rnd = rnd == 0 ? 2 : rnd == 2 ? 0 : rnd;
    u.pm = (rnd * (G >> 5) + (q >> 2)) * 8 + xcd; u.pn = q & 3; u.z = i % 3;
    return u.pm * 4 < ntile && (q >> 2) < (G >> 5);
  }
  __device__ __forceinline__ const char* aptr(const Unit& u) const {
    return ws + (u.z == 0 ? O_GA : u.z == 1 ? O_ZB : O_U) + (size_t)u.pm * (256u * 512u * 2u);
  }
  __device__ __forceinline__ const char* bptr(const Unit& u) const { return ws + O_WBR + (size_t)u.z * (1024u * 512u * 2u) + (size_t)u.pn * (256u * 512u * 2u); }
};
struct EpiMerge {
  char* ws; int fuse;
  __device__ __forceinline__ bool operator()(f32x4 (&acc)[2][2][4][2], const Unit& u, int wr, int wc, int fr, int fq) const {
    const int tl = (wr * 4 + wc) * 64 + fq * 16 + fr;
    const unsigned char* GT = (const unsigned char*)(ws + O_G) + ((size_t)u.pm * 12 + u.z * 4 + u.pn) * 65536 + (size_t)tl * 8;
    auto ub = [](unsigned w, int k) { return (float)((w >> (8 * k)) & 0xffu) + 0.5f; };
    bf16_t* MG = (bf16_t*)(ws + O_H) + (size_t)u.pm * 256 * 1024 + u.pn * 256;
    const bool lastj = (u.z == 2);
#pragma unroll
    for (int ai = 0; ai < 2; ++ai)
#pragma unroll
      for (int m = 0; m < 4; ++m)
#pragma unroll
        for (int bj = 0; bj < 2; ++bj) {
          const int cidx = (ai * 4 + m) * 2 + bj;
          const u32x2 gw = *(const u32x2*)(GT + (size_t)cidx * 4096);
          f32x4 g0, g1;
#pragma unroll
          for (int q = 0; q < 4; ++q) { g0[q] = ub(gw.x, q); g1[q] = ub(gw.y, q); }
          if (lastj) {
            const int r = ai * 128 + wr * 64 + m * 16 + fr, c = bj * 128 + wc * 32 + 8 * fq;
            st8bf(MG + (size_t)r * 1024 + c, acc[ai][bj][m][0] * (g0 * 0.00390625f), acc[ai][bj][m][1] * (g1 * 0.00390625f));
          } else {
            const u32x2 hw = *(const u32x2*)(GT + 4 * 65536 + (size_t)cidx * 4096);
#pragma unroll
            for (int q = 0; q < 4; ++q) {
              acc[ai][bj][m][0][q] *= g0[q] * __builtin_amdgcn_rcpf(ub(hw.x, q));
              acc[ai][bj][m][1][q] *= g1[q] * __builtin_amdgcn_rcpf(ub(hw.y, q));
            }
          }
        }
    if (fuse && lastj && u.pm >= 128) hc_publish((unsigned*)(ws + O_BAR) + HC_MERGE);
    return !lastj;
  }
};
__device__ __forceinline__ void phase_merge(const Params& p, int l, char* lds, int wid0) {
  const int tid = opaque_tid(wid0);
  const int fuse = (l == 0 && gridDim.x == 256) ? 1 : 0;
  MergeSched S{p.ws, (l == 1 ? 128 : 136) * 4, (int)gridDim.x, (int)blockIdx.x, fuse};
  EpiMerge E{p.ws, fuse};
  pg8::gemm_phase((PG8_LAS unsigned char*)lds, 512, S, E, tid);
  if (fuse) {
    const int c = (int)blockIdx.x;
    if (c >= 32 && c < 64) {
      unsigned* bar = (unsigned*)(p.ws + O_BAR);
      hc_wait(bar, bar + HC_MERGE, 32u);
      const int pm = 128 + (c & 7), pn = (c >> 3) - 4;
      OneSched S2{p.ws + O_H + (size_t)pm * (256u * 1024u * 2u), p.ws + O_WOUT + (size_t)pn * (256u * 1024u * 2u), pm, pn, 0};
      EpiStoreBf16 E2{(bf16_t*)(p.ws + O_Y), 1024};
      pg8::gemm_phase((PG8_LAS unsigned char*)lds, 1024, S2, E2, tid);
    } else if (c >= 64) conv_fill(p, lds, wid0, 0, c - 64, 192);
  }
}

__device__ __forceinline__ void phase_wout(const Params& p, int l, char* lds, int wid0) {
  const int tid = opaque_tid(wid0);
  pg8::GridSched S;
  const bool fuse = l == 0 && gridDim.x == 256;
  S.init(p.ws + O_H, p.ws + O_WOUT, 1024, (l == 1 || fuse) ? 128 : 136, 4, 0, gridDim.x, blockIdx.x);
  EpiStoreBf16 E{(bf16_t*)(p.ws + O_Y), 1024};
  pg8::gemm_phase((PG8_LAS unsigned char*)lds, 1024, S, E, tid);
}

template <int l>
__device__ __forceinline__ void phase_rowB(const Params& p, char* lds, int wid0) {
  const int tid = opaque_tid(wid0), wid = tid >> 6, lane = tid & 63;
  const int nrow = (l == 1) ? NL : NT;
  const float* xlat = l == 0 ? p.x : p.out;
  const float* xctx = l == 0 ? p.ctx : (const float*)(p.ws + O_CTXB);
  const float* mod = (const float*)(p.ws + O_MOD);
  bf16_t* Y = (bf16_t*)(p.ws + O_Y);
  bf16_t* H = (bf16_t*)(p.ws + O_H);
  float* aff = (float*)(p.ws + O_AFF);
  const float* nw1 = p.norm_w + (size_t)(l * 4 + 1) * 1024;
  const float* nw2 = p.norm_w + (size_t)(l * 4 + 2) * 1024;
  const float* rw = p.router_w + (size_t)l * 1024 * 16;
  float* rwT = (float*)lds;
  for (int i = tid; i < 16384; i += NTHREADS) rwT[(i & 15) * 1024 + (i >> 4)] = rw[i];
  __syncthreads();
  u32x4 pfy[2]; f32x4 pfx[4];
  auto fetch = [&](int row) {
    const float* xr = row < NL ? xlat + (size_t)row * 1024 : xctx + (size_t)(row - NL) * 1024;
#pragma unroll
    for (int i = 0; i < 2; ++i) {
      const int e = i * 512 + lane * 8;
      pfy[i] = *(const u32x4*)(Y + (size_t)row * 1024 + e);
      if (l == 1) pfx[i * 2] = *(const f32x4*)((const bf16_t*)p.out + (size_t)row * 1024 + e);
      else { pfx[i * 2] = *(const f32x4*)(xr + e); pfx[i * 2 + 1] = *(const f32x4*)(xr + e + 4); }
    }
  };
  const int row0 = blockIdx.x * NWAVE + wid, rstep = gridDim.x * NWAVE;
  if (row0 < nrow) fetch(row0);
  for (int row = row0; row < nrow; row += rstep) {
    const int mr = row < NL ? (row >> 12) : 8;
    const float* md = mod + (size_t)(l * 9 + mr) * 6144;
    float yv[16], xv[16];
    float ss = 0.f;
#pragma unroll
    for (int i = 0; i < 2; ++i) {
      const u32x4 w = pfy[i];
      yv[i * 8 + 0] = bflo(w.x); yv[i * 8 + 1] = bfhi(w.x); yv[i * 8 + 2] = bflo(w.y); yv[i * 8 + 3] = bfhi(w.y);
      yv[i * 8 + 4] = bflo(w.z); yv[i * 8 + 5] = bfhi(w.z); yv[i * 8 + 6] = bflo(w.w); yv[i * 8 + 7] = bfhi(w.w);
      if (l == 1) {
        const u32x4 xw = __builtin_bit_cast(u32x4, pfx[i * 2]);
        xv[i * 8 + 0] = bflo(xw.x); xv[i * 8 + 1] = bfhi(xw.x); xv[i * 8 + 2] = bflo(xw.y); xv[i * 8 + 3] = bfhi(xw.y);
        xv[i * 8 + 4] = bflo(xw.z); xv[i * 8 + 5] = bfhi(xw.z); xv[i * 8 + 6] = bflo(xw.w); xv[i * 8 + 7] = bfhi(xw.w);
      } else {
        const f32x4 a = pfx[i * 2], b = pfx[i * 2 + 1];
#pragma unroll
        for (int j = 0; j < 4; ++j) { xv[i * 8 + j] = a[j]; xv[i * 8 + 4 + j] = b[j]; }
      }
    }
#pragma unroll
    for (int j = 0; j < 16; ++j) ss += yv[j] * yv[j];
    ss = wave_sum(ss);
    const float rs = rsqrtf(ss * (1.0f / 1024.0f) + 1e-6f);
    float ss2 = 0.f;
#pragma unroll
    for (int i = 0; i < 2; ++i) {
      const int e = i * 512 + lane * 8;
#pragma unroll
      for (int h4 = 0; h4 < 2; ++h4) {
        const f32x4 w = *(const f32x4*)(nw1 + e + h4 * 4), g1 = *(const f32x4*)(md + 2048 + e + h4 * 4);
#pragma unroll
        for (int j = 0; j < 4; ++j) {
          const int q = i * 8 + h4 * 4 + j;
          xv[q] = xv[q] + g1[j] * (yv[q] * rs * w[j]);
          ss2 += xv[q] * xv[q];
        }
      }
      u32x4 o;
      o.x = pk_bf16(xv[i * 8 + 0], xv[i * 8 + 1]); o.y = pk_bf16(xv[i * 8 + 2], xv[i * 8 + 3]); o.z = pk_bf16(xv[i * 8 + 4], xv[i * 8 + 5]); o.w = pk_bf16(xv[i * 8 + 6], xv[i * 8 + 7]);
      *(u32x4*)(Y + (size_t)row * 1024 + e) = o;
    }
    ss2 = wave_sum(ss2);
    const float rs2 = rsqrtf(ss2 * (1.0f / 1024.0f) + 1e-6f);
    float lg[16];
#pragma unroll
    for (int e2 = 0; e2 < 16; ++e2) lg[e2] = 0.f;
    float hv[2][8];
#pragma unroll
    for (int i = 0; i < 2; ++i) {
      const int e = i * 512 + lane * 8;
#pragma unroll
      for (int h4 = 0; h4 < 2; ++h4) {
        const f32x4 w = *(const f32x4*)(nw2 + e + h4 * 4), sh = *(const f32x4*)(md + 3072 + e + h4 * 4), sc = *(const f32x4*)(md + 4096 + e + h4 * 4);
#pragma unroll
        for (int j = 0; j < 4; ++j) hv[i][h4 * 4 + j] = xv[i * 8 + h4 * 4 + j] * rs2 * w[j] * (1.0f + sc[j]) + sh[j];
      }
      u32x4 w;
      w.x = pk_bf16(hv[i][0], hv[i][1]); w.y = pk_bf16(hv[i][2], hv[i][3]); w.z = pk_bf16(hv[i][4], hv[i][5]); w.w = pk_bf16(hv[i][6], hv[i][7]);
      *(u32x4*)(H + (size_t)row * 1024 + e) = w;
    }
    __builtin_amdgcn_sched_barrier(0);
    if (row + rstep < nrow) fetch(row + rstep);
    __builtin_amdgcn_sched_barrier(0);
#pragma unroll
    for (int i = 0; i < 2; ++i) {
      const int e = i * 512 + lane * 8;
#pragma unroll
      for (int e2 = 0; e2 < 16; ++e2) {
        const f32x4 r0 = *(const f32x4*)(rwT + e2 * 1024 + e), r1 = *(const f32x4*)(rwT + e2 * 1024 + e + 4);
        lg[e2] += hv[i][0] * r0[0] + hv[i][1] * r0[1] + hv[i][2] * r0[2] + hv[i][3] * r0[3] + hv[i][4] * r1[0] + hv[i][5] * r1[1] + hv[i][6] * r1[2] + hv[i][7] * r1[3];
        if ((e2 & 3) == 3) __builtin_amdgcn_sched_barrier(0);
      }
    }
    float a8[8], a4[4], a2[2], a1;
    {
      const bool up = (lane & 32) != 0;
#pragma unroll
      for (int j = 0; j < 8; ++j) { const float mine = up ? lg[8 + j] : lg[j], other = up ? lg[j] : lg[8 + j]; a8[j] = mine + __shfl_xor(other, 32); }
    }
    {
      const bool up = (lane & 16) != 0;
#pragma unroll
      for (int j = 0; j < 4; ++j) { const float mine = up ? a8[4 + j] : a8[j], other = up ? a8[j] : a8[4 + j]; a4[j] = mine + __shfl_xor(other, 16); }
    }
    {
      const bool up = (lane & 8) != 0;
#pragma unroll
      for (int j = 0; j < 2; ++j) { const float mine = up ? a4[2 + j] : a4[j], other = up ? a4[j] : a4[2 + j]; a2[j] = mine + __shfl_xor(other, 8); }
    }
    {
      const bool up = (lane & 4) != 0;
      const float mine = up ? a2[1] : a2[0], other = up ? a2[0] : a2[1];
      a1 = mine + __shfl_xor(other, 4);
    }
    a1 += __shfl_xor(a1, 2);
    a1 += __shfl_xor(a1, 1);
    float mx = a1;
    mx = fmaxf(mx, __shfl_xor(mx, 4)); mx = fmaxf(mx, __shfl_xor(mx, 8)); mx = fmaxf(mx, __shfl_xor(mx, 16)); mx = fmaxf(mx, __shfl_xor(mx, 32));
    const float ex = expf(a1 - mx);
    float se = ex;
    se += __shfl_xor(se, 4); se += __shfl_xor(se, 8); se += __shfl_xor(se, 16); se += __shfl_xor(se, 32);
    if ((lane & 3) == 0) {
      const int e2 = ((lane >> 5) & 1) * 8 + ((lane >> 4) & 1) * 4 + ((lane >> 3) & 1) * 2 + ((lane >> 2) & 1);
      aff[(size_t)row * 16 + e2] = ex / se;
    }
  }
}

template <int NI, int T>
__device__ __forceinline__ void topk_body(const Params& p, int s, int e, char* lds, const int tid) {
  constexpr int CAP = T / 8;
  typedef unsigned long long u64;
  int* cntw = (int*)lds;
  int* wcnt = (int*)(lds + 256);
  int* woff = (int*)(lds + 512);
  const int wid = tid >> 6, lane = tid & 63;
  const bool isl = T == 4096;
  const size_t rowbase = isl ? (size_t)s * 4096 : (size_t)NL + (size_t)(s - 8) * 256;
  const float* aff = (const float*)(p.ws + O_AFF);
  int* sel = (int*)(p.ws + O_SEL);
  float* gate = (float*)(p.ws + O_GATE);
  int* tok = (int*)(p.ws + O_TOK);
  u64 key[NI];
  float av[NI];
#pragma unroll
  for (int q = 0; q < NI; ++q) {
    const int i = tid + q * NTHREADS;
    av[q] = 0.f; key[q] = 0ull;
    if (i < T) {
      av[q] = aff[(rowbase + i) * 16 + e];
      key[q] = ((u64)__float_as_uint(av[q]) << 12) | (u64)(4095 - i);
    }
  }
  u64 prefix = 0ull;
  for (int bit = 43; bit >= 0; --bit) {
    const u64 cand = prefix | (1ull << bit);
    int c = 0;
#pragma unroll
    for (int q = 0; q < NI; ++q) c += __popcll(__ballot(key[q] >= cand));
    if (lane == 0) cntw[(bit & 1) * 8 + wid] = c;
    __syncthreads();
    int tot = 0;
#pragma unroll
    for (int w = 0; w < 8; ++w) tot += cntw[(bit & 1) * 8 + w];
    if (tot >= CAP) prefix = cand;
  }
  int before[NI];
  bool in[NI];
#pragma unroll
  for (int q = 0; q < NI; ++q) {
    in[q] = key[q] >= prefix && key[q] != 0ull;
    const u64 m = __ballot(in[q]);
    before[q] = __popcll(m & ((1ull << lane) - 1ull));
    if (lane == 0) wcnt[q * 8 + wid] = __popcll(m);
  }
  __syncthreads();
  if (tid < 64) {
    int v = tid < NI * 8 ? wcnt[tid] : 0, x = v;
#pragma unroll
    for (int o = 1; o < 64; o <<= 1) { const int y = __shfl_up(x, o); if (lane >= o) x += y; }
    if (tid < NI * 8) woff[tid] = x - v;
  }
  __syncthreads();
  const size_t slotbase = isl ? ((size_t)e * 8 + s) * CAP : (size_t)NSLOT_L + ((size_t)e * 8 + (s - 8)) * CAP;
#pragma unroll
  for (int q = 0; q < NI; ++q) {
    const int i = tid + q * NTHREADS;
    if (i < T) {
      const int slot = woff[q * 8 + wid] + before[q];
      sel[(rowbase + i) * 16 + e] = in[q] ? slot : -1;
      if (in[q]) {
        tok[slotbase + slot] = (int)(rowbase + i);
        gate[slotbase + slot] = av[q];
      }
    }
  }
  __syncthreads();
}
__device__ __forceinline__ void phase_topk(const Params& p, int l, char* lds, int wid0) {
  const int tid = opaque_tid(wid0);
  const int NITEM = (l == 1) ? 128 : 256;
  for (int item = blockIdx.x; item < NITEM; item += gridDim.x) {
    const int s = item >> 4, e = item & 15;
    if (s < 8) topk_body<8, 4096>(p, s, e, lds, tid);
    else topk_body<1, 256>(p, s, e, lds, tid);
  }
}

struct MoeSched {
  const char* A; const char* W; int nN, nunit, G, c; size_t estep; int swap = 0;
  __device__ __forceinline__ bool next(int i, Unit& u) const {
    const int xcd = c & 7, q = c >> 3, per = (G >> 3) / nN;
    int ii = i;
    if (swap && xcd < 4) ii = i == 0 ? 8 : i == 8 ? 0 : i;
    u.pn = q % nN; u.pm = (ii * 8 + xcd) * per + q / nN;
    if (q >= per * nN || u.pm * nN >= nunit) return false;
    u.z = u.pm < 256 ? (u.pm >> 4) : (u.pm - 256); return true;
  }
  __device__ __forceinline__ const char* aptr(const Unit& u) const { return A + (size_t)u.pm * (256u * 1024u * 2u); }
  __device__ __forceinline__ const char* bptr(const Unit& u) const { return W + (size_t)u.z * estep + (size_t)u.pn * (256u * 1024u * 2u); }
};
struct MoeSchedG : MoeSched {
  static constexpr bool GATHER = true;
  const int* tok;
  __device__ __forceinline__ const char* aptr(const Unit&) const { return A; }
  __device__ __forceinline__ const int* tokptr(const Unit& u) const { return tok + (size_t)u.pm * 256; }
};
struct EpiSwiglu {
  bf16_t* HID; unsigned* cnt;
  __device__ __forceinline__ bool operator()(f32x4 (&acc)[2][2][4][2], const Unit& u, int wr, int wc, int fr, int fq) const {
    bf16_t* d = HID + (size_t)u.pm * 256 * 1024 + u.pn * 128;
#pragma unroll
    for (int ai = 0; ai < 2; ++ai)
#pragma unroll
      for (int m = 0; m < 4; ++m) {
        f32x4 o0, o1;
#pragma unroll
        for (int j = 0; j < 4; ++j) { o0[j] = siluf_(acc[ai][0][m][0][j]) * acc[ai][1][m][0][j]; o1[j] = siluf_(acc[ai][0][m][1][j]) * acc[ai][1][m][1][j]; }
        st8bf(d + (size_t)(ai * 128 + wr * 64 + m * 16 + fr) * 1024 + wc * 32 + 8 * fq, o0, o1);
      }
    if (cnt && u.pm >= 256) hc_publish(cnt);
    return false;
  }
};
__device__ __forceinline__ void phase_moe1(const Params& p, int l, char* lds, int wid0) {
  const int tid = opaque_tid(wid0);
  const int nrt = (l == 1) ? 256 : 272;
  MoeSchedG S;
  S.A = p.ws + O_H; S.W = l == 1 ? (const char*)p.out + OUT_W13B : p.ws + O_W13; S.nN = 8; S.nunit = nrt * 8; S.G = (int)gridDim.x; S.c = (int)blockIdx.x; S.estep = (size_t)2048 * 1024 * 2;
  S.tok = (const int*)(p.ws + O_TOK);
  const bool fuse = l == 0 && gridDim.x == 256;
  S.swap = fuse ? 1 : 0;
  unsigned* bar = (unsigned*)(p.ws + O_BAR);
  EpiSwiglu E{(bf16_t*)(p.ws + O_HID), fuse ? bar + HC_MOE1 : nullptr};
  pg8::gemm_phase((PG8_LAS unsigned char*)lds, 1024, S, E, tid);
  if (fuse) {
    const int xcd = (int)blockIdx.x & 7, q = (int)blockIdx.x >> 3;
    if (xcd >= 4 && q < 16) {
      const int r = q * 4 + xcd - 4, e = r >> 2, pn = r & 3, pm = 256 + e;
      hc_wait(bar, bar + HC_MOE1, 128u);
      OneSched S2{p.ws + O_HID + (size_t)pm * (256u * 1024u * 2u), p.ws + O_W2 + (size_t)e * ((size_t)1024 * 1024 * 2) + (size_t)pn * (256u * 1024u * 2u), pm, pn, e};
      EpiStoreBf16 E2{(bf16_t*)(p.ws + O_YS), 1024};
      pg8::gemm_phase((PG8_LAS unsigned char*)lds, 1024, S2, E2, tid);
    } else if (xcd >= 4) conv_fill(p, lds, wid0, 2, (q - 16) * 4 + xcd - 4, 64);
  }
}
__device__ __forceinline__ void phase_moe2(const Params& p, int l, char* lds, int wid0) {
  const int tid = opaque_tid(wid0);
  const int nrt = (l == 1 || gridDim.x == 256) ? 256 : 272;
  MoeSched S{p.ws + O_HID, p.ws + (l == 1 && p.w2sep ? O_W2B : O_W2), 4, nrt * 4, (int)gridDim.x, (int)blockIdx.x, (size_t)1024 * 1024 * 2};
  EpiStoreBf16 E{(bf16_t*)(p.ws + O_YS), 1024};
  pg8::gemm_phase((PG8_LAS unsigned char*)lds, 1024, S, E, tid);
}

__device__ __forceinline__ void phase_rowC(const Params& p, int l, int wid0) {
  const int tid = opaque_tid(wid0), wid = tid >> 6, lane = tid & 63;
  const int nrow = (l == 1) ? NL : NT;
  float* olat = p.out;
  float* octx = (float*)(p.ws + O_CTXB);
  const float* mod = (const float*)(p.ws + O_MOD);
  const bf16_t* YS = (const bf16_t*)(p.ws + O_YS);
  const int* sel = (const int*)(p.ws + O_SEL);
  const float* gate = (const float*)(p.ws + O_GATE);
  const float* nw3 = p.norm_w + (size_t)(l * 4 + 3) * 1024;
  const float* nwn = p.norm_w + (size_t)((l + 1) * 4 + 0) * 1024;
  bf16_t* H = (bf16_t*)(p.ws + O_H);
  const bf16_t* X1 = (const bf16_t*)(p.ws + O_Y);
  int pfrk; u32x4 pfx[2];
  auto fetch = [&](int row) {
    pfrk = sel[(size_t)row * 16 + (lane & 15)];
#pragma unroll
    for (int i = 0; i < 2; ++i) pfx[i] = *(const u32x4*)(X1 + (size_t)row * 1024 + i * 512 + lane * 8);
  };
  const int row0 = blockIdx.x * NWAVE + wid, rstep = gridDim.x * NWAVE;
  if (row0 < nrow) fetch(row0);
  for (int row = row0; row < nrow; row += rstep) {
    float* xo = row < NL ? olat + (size_t)row * 1024 : octx + (size_t)(row - NL) * 1024;
    const bool isl = row < NL;
    const int mr = isl ? (row >> 12) : 8;
    const int s = isl ? (row >> 12) : ((row - NL) >> 8);
    const float* md = mod + (size_t)(l * 9 + mr) * 6144;
    float mv[16];
#pragma unroll
    for (int j = 0; j < 16; ++j) mv[j] = 0.f;
    const int myrk = pfrk;
    u32x4 xcur[2];
#pragma unroll
    for (int i = 0; i < 2; ++i) xcur[i] = pfx[i];
    if (row + rstep < nrow) fetch(row + rstep);
    f32x4 w3[2][2], g2v[2][2];
#pragma unroll
    for (int i = 0; i < 2; ++i)
#pragma unroll
      for (int h4 = 0; h4 < 2; ++h4) { w3[i][h4] = *(const f32x4*)(nw3 + i * 512 + lane * 8 + h4 * 4); g2v[i][h4] = *(const f32x4*)(md + 5120 + i * 512 + lane * 8 + h4 * 4); }
    unsigned long long chosen = __ballot(myrk >= 0) & 0xffffull;
    while (chosen) {
      const int e0 = __builtin_ctzll(chosen); chosen &= chosen - 1;
      const int e1 = chosen ? __builtin_ctzll(chosen) : -1; if (chosen) chosen &= chosen - 1;
      const int rk0 = __shfl(myrk, e0), rk1 = e1 >= 0 ? __shfl(myrk, e1) : 0;
      const size_t slot0 = isl ? ((size_t)e0 * 8 + s) * 512 + rk0 : (size_t)NSLOT_L + ((size_t)e0 * 8 + s) * 32 + rk0;
      const size_t slot1 = e1 < 0 ? slot0 : (isl ? ((size_t)e1 * 8 + s) * 512 + rk1 : (size_t)NSLOT_L + ((size_t)e1 * 8 + s) * 32 + rk1);
      u32x4 w[4];
#pragma unroll
      for (int i = 0; i < 2; ++i) { w[i] = *(const u32x4*)(YS + slot0 * 1024 + i * 512 + lane * 8); w[2 + i] = *(const u32x4*)(YS + slot1 * 1024 + i * 512 + lane * 8); }
      const float m0 = gate[slot0], m1 = e1 >= 0 ? gate[slot1] : 0.f;
#pragma unroll
      for (int i = 0; i < 2; ++i) {
        mv[i * 8 + 0] += m0 * bflo(w[i].x) + m1 * bflo(w[2 + i].x); mv[i * 8 + 1] += m0 * bfhi(w[i].x) + m1 * bfhi(w[2 + i].x);
        mv[i * 8 + 2] += m0 * bflo(w[i].y) + m1 * bflo(w[2 + i].y); mv[i * 8 + 3] += m0 * bfhi(w[i].y) + m1 * bfhi(w[2 + i].y);
        mv[i * 8 + 4] += m0 * bflo(w[i].z) + m1 * bflo(w[2 + i].z); mv[i * 8 + 5] += m0 * bfhi(w[i].z) + m1 * bfhi(w[2 + i].z);
        mv[i * 8 + 6] += m0 * bflo(w[i].w) + m1 * bflo(w[2 + i].w); mv[i * 8 + 7] += m0 * bfhi(w[i].w) + m1 * bfhi(w[2 + i].w);
      }
    }
    float ss = 0.f;
#pragma unroll
    for (int j = 0; j < 16; ++j) ss += mv[j] * mv[j];
    ss = wave_sum(ss);
    const float rs = rsqrtf(ss * (1.0f / 1024.0f) + 1e-6f);
    float xn[16], ssn = 0.f;
#pragma unroll
    for (int i = 0; i < 2; ++i) {
      const int e = i * 512 + lane * 8;
#pragma unroll
      for (int h4 = 0; h4 < 2; ++h4) {
        const f32x4 w = w3[i][h4], g2 = g2v[i][h4];
        f32x4 xv;
        if (h4 == 0) { xv[0] = bflo(xcur[i].x); xv[1] = bfhi(xcur[i].x); xv[2] = bflo(xcur[i].y); xv[3] = bfhi(xcur[i].y); }
        else { xv[0] = bflo(xcur[i].z); xv[1] = bfhi(xcur[i].z); xv[2] = bflo(xcur[i].w); xv[3] = bfhi(xcur[i].w); }
#pragma unroll
        for (int j = 0; j < 4; ++j) { xv[j] += g2[j] * (mv[i * 8 + h4 * 4 + j] * rs * w[j]); xn[i * 8 + h4 * 4 + j] = xv[j]; ssn += xv[j] * xv[j]; }
        if (!(l == 0 && isl)) *(f32x4*)(xo + e + h4 * 4) = xv;
      }
      if (l == 0 && isl) {
        u32x4 o;
        o.x = pk_bf16(xn[i * 8 + 0], xn[i * 8 + 1]); o.y = pk_bf16(xn[i * 8 + 2], xn[i * 8 + 3]); o.z = pk_bf16(xn[i * 8 + 4], xn[i * 8 + 5]); o.w = pk_bf16(xn[i * 8 + 6], xn[i * 8 + 7]);
        *(u32x4*)((bf16_t*)p.out + (size_t)row * 1024 + e) = o;
      }
    }
    if (l == 0) {
      ssn = wave_sum(ssn);
      const float rsn = rsqrtf(ssn * (1.0f / 1024.0f) + 1e-6f);
      const float* mdn = mod + (size_t)((l + 1) * 9 + mr) * 6144;
#pragma unroll
      for (int i = 0; i < 2; ++i) {
        const int e = i * 512 + lane * 8;
        float hv[8];
#pragma unroll
        for (int h4 = 0; h4 < 2; ++h4) {
          const f32x4 w = *(const f32x4*)(nwn + e + h4 * 4), sh = *(const f32x4*)(mdn + e + h4 * 4), sc = *(const f32x4*)(mdn + 1024 + e + h4 * 4);
#pragma unroll
          for (int j = 0; j < 4; ++j) hv[h4 * 4 + j] = xn[i * 8 + h4 * 4 + j] * rsn * w[j] * (1.0f + sc[j]) + sh[j];
        }
        u32x4 w;
        w.x = pk_bf16(hv[0], hv[1]); w.y = pk_bf16(hv[2], hv[3]); w.z = pk_bf16(hv[4], hv[5]); w.w = pk_bf16(hv[6], hv[7]);
        *(u32x4*)(H + (size_t)row * 1024 + e) = w;
      }
    }
  }
}

#define PHASE(call) do { Params q = p; asm volatile("" : "+s"(q.ws)); call; } while (0)
#ifndef PROBE_PH
#define PROBE_PH 0
#endif
#ifndef PROBE_N
#define PROBE_N 2
#endif
#define REP(id, call) do { for (int _r = 0; _r < ((PROBE_PH == (id)) ? 1 + PROBE_N : 1); ++_r) PHASE(call); } while (0)
#define SYNC() do { char* _w = p.ws; asm volatile("" : "+s"(_w)); XcdBarrier _b; _b.bar = (unsigned*)(_w + O_BAR); _b.x = xb_xcc_id(); _b.st = st; xcd_barrier(_b); } while (0)
__global__ void __launch_bounds__(NTHREADS, 2) fwd_mega(Params p) {
  extern __shared__ __attribute__((aligned(16))) char lds[];
  cg::grid_group grid = cg::this_grid();
  const int wid0 = __builtin_amdgcn_readfirstlane((int)(threadIdx.x >> 6));
  volatile PG8_LAS unsigned* st = (volatile PG8_LAS unsigned*)((PG8_LAS unsigned char*)lds + LDS_MAIN);
  if (threadIdx.x < 2) st[threadIdx.x] = 0u;
  __syncthreads();
  (void)xcd_barrier_post((unsigned*)(p.ws + O_BAR), st);
  PHASE(phase_setup(q, lds, wid0));
  PHASE(phase_conv(q, 0, lds, wid0));
  SYNC();
  PHASE(phase_rowA(q, 0, wid0));
  SYNC();
#pragma unroll 1
  for (int l = 0; l < 2; ++l) {
    REP(3, phase_gin(q, l, lds, wid0));
    SYNC();
    REP(5, phase_mix2(q, l, lds, wid0));
    SYNC();
    PHASE(phase_oa(q, l, wid0));
    SYNC();
    REP(7, phase_merge(q, l, lds, wid0));
    if (l == 0) grid.sync(); else SYNC();
    REP(8, phase_wout(q, l, lds, wid0));
    SYNC();
    if (l == 0) PHASE(phase_rowB<0>(q, lds, wid0)); else PHASE(phase_rowB<1>(q, lds, wid0));
    SYNC();
    REP(10, phase_topk(q, l, lds, wid0));
    SYNC();
    REP(11, phase_moe1(q, l, lds, wid0));
    SYNC();
    REP(12, phase_moe2(q, l, lds, wid0));
    SYNC();
    PHASE(phase_rowC(q, l, wid0));
    if (l == 0) PHASE(conv_fill(q, lds, wid0, 4, (int)blockIdx.x, (int)gridDim.x));
    if (l == 0) SYNC();
    if (PROBE_PH == 20) { for (int _r = 0; _r < 10 * PROBE_N; ++_r) SYNC(); }
  }
}

extern "C" void kernel_launch(void* const* d_in, const int* in_sizes, int n_in, void* d_out, int out_size, void* d_ws, size_t ws_size,
                              hipStream_t stream) {
  if (ws_size < WS_NEED) {
    fprintf(stderr, "kernel_launch: workspace too small: %zu < %zu\n", ws_size, (size_t)WS_NEED);
    return;
  }
  Params p{};
  p.x = (const float*)d_in[0]; p.c = (const float*)d_in[1]; p.ctx = (const float*)d_in[2]; p.c_ctx = (const float*)d_in[3];
  p.ada_w = (const float*)d_in[4]; p.ada_b = (const float*)d_in[5]; p.norm_w = (const float*)d_in[6]; p.w_in = (const float*)d_in[7];
  p.lb_raw = (const float*)d_in[8]; p.gnorm_w = (const float*)d_in[9]; p.sgu_w = (const float*)d_in[10]; p.sgu_b = (const float*)d_in[11];
  p.sgu_norm_w = (const float*)d_in[12]; p.w_branch = (const float*)d_in[13]; p.w_out = (const float*)d_in[14];
  p.router_w = (const float*)d_in[15]; p.w13 = (const float*)d_in[16]; p.w2 = (const float*)d_in[17];
  p.out = (float*)d_out;
  p.ws = (char*)d_ws;
  p.w2sep = ws_size >= WS_NEED_W2B ? 1 : 0;
  static int grid_blocks = 0;
  if (!grid_blocks) {
    int dev = 0, cus = 0, per_cu = 0;
    (void)hipGetDevice(&dev);
    (void)hipDeviceGetAttribute(&cus, hipDeviceAttributeMultiprocessorCount, dev);
    (void)hipFuncSetAttribute((const void*)fwd_mega, hipFuncAttributeMaxDynamicSharedMemorySize, LDS_TOTAL);
    (void)hipOccupancyMaxActiveBlocksPerMultiprocessor(&per_cu, fwd_mega, NTHREADS, LDS_TOTAL);
    if (per_cu > 1) per_cu = 1;
    if (per_cu < 1) fprintf(stderr, "kernel_launch: occupancy query reports %d blocks per CU\n", per_cu);
    grid_blocks = cus * (per_cu < 1 ? 1 : per_cu);
  }
  (void)hipMemsetAsync((char*)d_ws + O_BAR, 0, BAR_BYTES, stream);
  void* args[] = {&p};
  hipError_t e = hipLaunchCooperativeKernel((void*)fwd_mega, dim3(grid_blocks), dim3(NTHREADS), args, LDS_TOTAL, stream);
  if (e != hipSuccess) fprintf(stderr, "cooperative launch failed: %s (grid %d)\n", hipGetErrorString(e), grid_blocks);
}
```
